# Optimizing an MI355X kernel written in HIP

```python
import math
import jax, jax.numpy as jnp
from jax import lax
import numpy as np

D_MODEL = 2048
BATCH = 1
SEQ = 8192
DEPTH = 4

N_MIXERS = 2
N_A = (DEPTH + 1) // 2
N_B = DEPTH // 2
EPS = 1e-6
LRU_W = D_MODEL
RG_BLOCK = 128
RG_HEADS = LRU_W // RG_BLOCK
CONV_W = 4
CONV_PAD_L = 1
CONV_PAD_R = CONV_W - 1 - CONV_PAD_L
C_RG = 8.0
NA_HEAD_DIM = 128
NA_HEADS = D_MODEL // NA_HEAD_DIM
GRID_W = 64
WIN_H = 8
WIN_W = 16
D_FF = 4 * D_MODEL
PLE_DIM = 256

kernel_name = "hybrid_rglru_natten_encoder"


def rms_norm(x, g):
    xf = x.astype(jnp.float32)
    y = xf * lax.rsqrt(jnp.mean(xf * xf, axis=-1, keepdims=True) + EPS)
    return (y * g.astype(jnp.float32)).astype(x.dtype)


def depthwise_conv_centred(x, w, b):
    c = x.shape[-1]
    y = lax.conv_general_dilated(
        x, w[:, None, :].astype(x.dtype), window_strides=(1,),
        padding=[(CONV_PAD_L, CONV_PAD_R)],
        dimension_numbers=("NWC", "WIO", "NWC"), feature_group_count=c)
    return y + b.astype(x.dtype)


def _linear_combine(e1, e2):
    a1, b1 = e1
    a2, b2 = e2
    return a1 * a2, a2 * b1 + b2


def rglru_direction(xc, w_a, b_a, w_x, b_x, lam, reverse):
    bsz, s, _ = xc.shape
    xb = xc.reshape(bsz, s, RG_HEADS, RG_BLOCK)
    r = jax.nn.sigmoid(jnp.einsum("bshi,hij->bshj", xb, w_a).reshape(bsz, s, LRU_W) + b_a)
    ig = jax.nn.sigmoid(jnp.einsum("bshi,hij->bshj", xb, w_x).reshape(bsz, s, LRU_W) + b_x)
    log_a = -C_RG * r.astype(jnp.float32) * jax.nn.softplus(-lam.astype(jnp.float32))
    a = jnp.exp(log_a)
    u = jnp.sqrt(-jnp.expm1(2.0 * log_a)) * (ig * xc).astype(jnp.float32)
    _, h = lax.associative_scan(_linear_combine, (a, u), axis=1, reverse=reverse)
    return h


def rglru_mixer(h, w_in, conv_w, conv_b, ga_w, ga_b, gx_w, gx_b, lam, w_out):
    z = h @ w_in
    xr, yg = jnp.split(z, 2, axis=-1)
    yg = jax.nn.gelu(yg, approximate=True)
    xc = depthwise_conv_centred(xr, conv_w, conv_b)
    hf = rglru_direction(xc, ga_w[0], ga_b[0], gx_w[0], gx_b[0], lam[0], reverse=False)
    hb = rglru_direction(xc, ga_w[1], ga_b[1], gx_w[1], gx_b[1], lam[1], reverse=True)
    y = (hf + hb).astype(h.dtype) * yg
    return y @ w_out


def neighborhood_attention(q, k, v, rpb):
    bsz, s, nh, dh = q.shape
    rows = s // GRID_W
    kh = min(WIN_H, rows)
    kw = WIN_W
    qg = q.reshape(bsz, rows, GRID_W, nh, dh)
    kg = k.reshape(bsz, rows, GRID_W, nh, dh)
    vg = v.reshape(bsz, rows, GRID_W, nh, dh)
    cols = jnp.arange(GRID_W)
    col_start = jnp.clip(cols - kw // 2, 0, GRID_W - kw)
    col_idx = col_start[:, None] + jnp.arange(kw)[None, :]
    rel_c = col_idx - cols[:, None] + (WIN_W - 1)

    def row_block(r):
        row_start = jnp.clip(r - kh // 2, 0, rows - kh)
        q_row = lax.dynamic_index_in_dim(qg, r, axis=1, keepdims=False)
        k_rows = lax.dynamic_slice_in_dim(kg, row_start, kh, axis=1)
        v_rows = lax.dynamic_slice_in_dim(vg, row_start, kh, axis=1)
        k_win = k_rows[:, :, col_idx]
        v_win = v_rows[:, :, col_idx]
        scores = jnp.einsum("bchd,bicjhd->bhcij", q_row, k_win).astype(jnp.float32)
        rel_r = row_start + jnp.arange(kh) - r + (WIN_H - 1)
        bias = rpb[:, rel_r[:, None, None], rel_c[None, :, :]]
        scores = scores + jnp.transpose(bias, (0, 2, 1, 3)).astype(jnp.float32)[None]
        probs = jax.nn.softmax(scores.reshape(bsz, nh, GRID_W, kh * kw), axis=-1)
        probs = probs.reshape(bsz, nh, GRID_W, kh, kw).astype(v.dtype)
        return jnp.einsum("bhcij,bicjhd->bchd", probs, v_win)

    out = lax.map(row_block, jnp.arange(rows))
    out = jnp.transpose(out, (1, 0, 2, 3, 4))
    return out.reshape(bsz, s, nh * dh)


def na_mixer(h, w_qkv, rpb, w_out):
    bsz, s, _ = h.shape
    qkv = (h @ w_qkv).reshape(bsz, s, 3, NA_HEADS, NA_HEAD_DIM)
    q = qkv[:, :, 0] * (1.0 / math.sqrt(NA_HEAD_DIM))
    k = qkv[:, :, 1]
    v = qkv[:, :, 2]
    return neighborhood_attention(q, k, v, rpb) @ w_out


def sqrelu_mlp(h, w1, w2):
    a = jax.nn.relu(h @ w1)
    return (a * a) @ w2


def setup_inputs(seed: int = 0) -> dict:
    key = jax.random.key(seed)
    ks = jax.random.split(key, 24)

    def nrm(k, shape, scale):
        return jax.random.normal(k, shape, jnp.float32) * scale

    x = nrm(ks[0], (BATCH, SEQ, D_MODEL), 1.0)
    p = nrm(ks[1], (DEPTH, BATCH, SEQ, PLE_DIM), 1.0)
    norm_mix = 1.0 + nrm(ks[2], (DEPTH, D_MODEL), 0.05)
    norm_mlp = 1.0 + nrm(ks[3], (DEPTH, D_MODEL), 0.05)
    norm_ple = 1.0 + nrm(ks[4], (DEPTH, D_MODEL), 0.05)
    norm_final = 1.0 + nrm(ks[5], (D_MODEL,), 0.05)
    rg_w_in = nrm(ks[6], (N_A, D_MODEL, 2 * LRU_W), D_MODEL ** -0.5)
    rg_conv_w = nrm(ks[7], (N_A, CONV_W, LRU_W), CONV_W ** -0.5)
    rg_conv_b = nrm(ks[8], (N_A, LRU_W), 0.01)
    rg_gate_a_w = nrm(ks[9], (N_A, 2, RG_HEADS, RG_BLOCK, RG_BLOCK), RG_BLOCK ** -0.5)
    rg_gate_a_b = nrm(ks[10], (N_A, 2, LRU_W), 0.01)
    rg_gate_x_w = nrm(ks[11], (N_A, 2, RG_HEADS, RG_BLOCK, RG_BLOCK), RG_BLOCK ** -0.5)
    rg_gate_x_b = nrm(ks[12], (N_A, 2, LRU_W), 0.01)
    a_c = jax.random.uniform(ks[13], (N_A, 2, LRU_W), jnp.float32, minval=0.9, maxval=0.999)
    s_lam = a_c ** (1.0 / C_RG)
    rg_lambda = jnp.log(s_lam) - jnp.log1p(-s_lam)
    rg_w_out = nrm(ks[14], (N_A, LRU_W, D_MODEL), LRU_W ** -0.5)
    na_w_qkv = nrm(ks[15], (N_B, D_MODEL, 3 * D_MODEL), D_MODEL ** -0.5)
    na_rpb = nrm(ks[16], (N_B, NA_HEADS, 2 * WIN_H - 1, 2 * WIN_W - 1), 0.1)
    na_w_out = nrm(ks[17], (N_B, D_MODEL, D_MODEL), D_MODEL ** -0.5)
    mlp_w1 = nrm(ks[18], (DEPTH, D_MODEL, D_FF), D_MODEL ** -0.5)
    mlp_w2 = nrm(ks[19], (DEPTH, D_FF, D_MODEL), D_FF ** -0.5)
    ple_w_gate = nrm(ks[20], (DEPTH, D_MODEL, D_MODEL), D_MODEL ** -0.5)
    ple_w_proj = nrm(ks[21], (DEPTH, PLE_DIM, D_MODEL), PLE_DIM ** -0.5)
    return {
        "x": x, "p": p,
        "norm_mix": norm_mix, "norm_mlp": norm_mlp, "norm_ple": norm_ple, "norm_final": norm_final,
        "rg_w_in": rg_w_in, "rg_conv_w": rg_conv_w, "rg_conv_b": rg_conv_b,
        "rg_gate_a_w": rg_gate_a_w, "rg_gate_a_b": rg_gate_a_b,
        "rg_gate_x_w": rg_gate_x_w, "rg_gate_x_b": rg_gate_x_b,
        "rg_lambda": rg_lambda, "rg_w_out": rg_w_out,
        "na_w_qkv": na_w_qkv, "na_rpb": na_rpb, "na_w_out": na_w_out,
        "mlp_w1": mlp_w1, "mlp_w2": mlp_w2,
        "ple_w_gate": ple_w_gate, "ple_w_proj": ple_w_proj,
    }


def reference(x, p, norm_mix, norm_mlp, norm_ple, norm_final,
              rg_w_in, rg_conv_w, rg_conv_b, rg_gate_a_w, rg_gate_a_b,
              rg_gate_x_w, rg_gate_x_b, rg_lambda, rg_w_out,
              na_w_qkv, na_rpb, na_w_out,
              mlp_w1, mlp_w2, ple_w_gate, ple_w_proj):
    h = x
    for i in range(DEPTH):
        j = i // N_MIXERS
        hn = rms_norm(h, norm_mix[i])
        if i % N_MIXERS == 0:
            mix = rglru_mixer(hn, rg_w_in[j], rg_conv_w[j], rg_conv_b[j],
                              rg_gate_a_w[j], rg_gate_a_b[j], rg_gate_x_w[j], rg_gate_x_b[j],
                              rg_lambda[j], rg_w_out[j])
        else:
            mix = na_mixer(hn, na_w_qkv[j], na_rpb[j], na_w_out[j])
        h = h + mix
        h = h + sqrelu_mlp(rms_norm(h, norm_mlp[i]), mlp_w1[i], mlp_w2[i])
        gate = jax.nn.sigmoid(rms_norm(h, norm_ple[i]) @ ple_w_gate[i])
        h = h + gate * (p[i] @ ple_w_proj[i])
    return rms_norm(h, norm_final)
```

```cpp
#include <hip/hip_runtime.h>
#include <hip/hip_cooperative_groups.h>
#include <cstdio>
#include <cstdint>
namespace cg = cooperative_groups;
namespace pg8 {
#define PG8_LAS __attribute__((address_space(3)))
typedef unsigned short bf16_t;
typedef short bf16x8 __attribute__((ext_vector_type(8)));
typedef float f32x4 __attribute__((ext_vector_type(4)));
typedef unsigned u32x4 __attribute__((ext_vector_type(4)));
constexpr int BM = 256, BK = 64, HALF = 128, HTB = HALF * BK * 2  , STAGE_BYTES = 8 * HTB, NXCD = 8, WGM = 8;

__host__ __device__ __forceinline__ int lds_byte(int r, int c) { const int st = (r >> 4) * 2 + (c >> 5), rr = r & 15, cc = c & 31, ob = rr * 64 + cc * 2; return st * 1024 + (ob ^ (((ob >> 9) & 1) << 5)); }
__host__ __device__ __forceinline__ void stage_rc(int b, int& R, int& C) { const int st = b / 1024, sb = b % 1024, swz = sb ^ (((sb >> 9) & 1) << 5); R = (st >> 1) * 16 + swz / 64; C = (st & 1) * 32 + (swz % 64) / 2; }
__host__ __device__ __forceinline__ int perm32(int rho) { const int n = rho >> 4, i = rho & 15; return 8 * (i >> 2) + 4 * n + (i & 3); }

struct Unit { int pm, pn; };
struct Gemm { const bf16_t* A; const bf16_t* Bt; int M, N, K; };

struct StaticOrder {
    int nM, nN, nwg, G, c;
    __host__ __device__ void init(int M, int N, int G_, int c_) { nM = M / BM; nN = N / BM; nwg = nM * nN; G = G_; c = c_; }
    __host__ __device__ bool next(int i, Unit& u) const {
        const long L = (long)i * G + c; if (L >= nwg) return false;
        int wgid = (int)L; { const int q = nwg / NXCD, r = nwg % NXCD, xcd = wgid % NXCD, off = wgid / NXCD; wgid = (xcd < r ? xcd * (q + 1) : r * (q + 1) + (xcd - r) * q) + off; }
        const int nig = WGM * nN, gid = wgid / nig, fm = gid * WGM, gsz = (nM - fm) < WGM ? (nM - fm) : WGM;
        u.pm = fm + ((wgid % nig) % gsz); u.pn = (wgid % nig) / gsz; return true;
    }
    __device__ __forceinline__ void a_ready(const Unit&) const {}
    __device__ __forceinline__ void done(const Unit&) const {}
};

__device__ __forceinline__ unsigned cvt_pk_bf16(float lo, float hi) { unsigned r; asm volatile("v_cvt_pk_bf16_f32 %0, %1, %2" : "=v"(r) : "v"(lo), "v"(hi)); return r; }
typedef float f32x2 __attribute__((ext_vector_type(2)));
constexpr float RMS_EPS = 1e-6f;
constexpr int DM = 2048;
__device__ __forceinline__ float fsigmoid(float x) { return __builtin_amdgcn_rcpf(1.f + __expf(-x)); }
__device__ __forceinline__ float gelu_tanh(float v) { return v * fsigmoid(1.5957691216057308f * (v + 0.044715f * v * v * v)); }
__device__ __forceinline__ float rstd_row(const float* ssp, int row) {
    const f32x4* p = (const f32x4*)(ssp + (size_t)row * 32); float s = 0.f;
#pragma unroll
    for (int i = 0; i < 8; ++i) { const f32x4 v = p[i]; s += (v[0] + v[1]) + (v[2] + v[3]); }
    return rsqrtf(s * (1.f / DM) + RMS_EPS);
}
__device__ __forceinline__ float bf_lo(unsigned w) { return __uint_as_float(w << 16); }
__device__ __forceinline__ float bf_hi(unsigned w) { return __uint_as_float(w & 0xffff0000u); }

template <int MODE> struct EpiAct {
    static constexpr bool PERM = true, AFTER_DRAIN = false;
    bf16_t* O0; bf16_t* O1; int ldc; int split; const float* ss;
    __device__ __forceinline__ void operator()(const f32x4 (&acc)[2][2][4][2], const Unit& u, int wr, int wc, int fr, int fq) const {
        const int row0 = u.pm * BM + wr * 64 + fr; int colt = u.pn * BM; bf16_t* base = O0; bool second = false;
        if (MODE <= 1) { if (colt >= split) { base = O1; colt -= split; second = true; } }
        const int col0 = colt + wc * 32 + 8 * fq;
        f32x4 cs[2][2];
        if (MODE == 4) {
#pragma unroll
            for (int bj = 0; bj < 2; ++bj)
#pragma unroll
                for (int n = 0; n < 2; ++n) {
#pragma unroll
                    for (int e = 0; e < 4; ++e) cs[bj][n][e] = rstd_row(ss, col0 + bj * HALF + 4 * n + e); }
        }
#pragma unroll
        for (int ai = 0; ai < 2; ++ai)
#pragma unroll
            for (int m = 0; m < 4; ++m) {
                const int row = row0 + ai * HALF + m * 16;
                float rs = 1.f;
                if (MODE <= 2) { rs = rstd_row(ss, row); if (MODE == 1 && !second) rs *= 0.08838834764831845f; }
                bf16_t* rowp = base + (size_t)row * ldc + col0;
#pragma unroll
                for (int bj = 0; bj < 2; ++bj) {
                    f32x4 v0 = acc[ai][bj][m][0], v1 = acc[ai][bj][m][1];
                    if (MODE == 4) { v0 = v0 * cs[bj][0]; v1 = v1 * cs[bj][1]; } else { v0 = v0 * rs; v1 = v1 * rs; }
                    if (MODE == 0) { if (second) {
#pragma unroll
                        for (int e = 0; e < 4; ++e) { v0[e] = gelu_tanh(v0[e]); v1[e] = gelu_tanh(v1[e]); } } }
                    if (MODE == 2) {
#pragma unroll
                        for (int e = 0; e < 4; ++e) { const float a = fmaxf(v0[e], 0.f), b = fmaxf(v1[e], 0.f); v0[e] = a * a; v1[e] = b * b; } }
                    u32x4 w; w.x = cvt_pk_bf16(v0[0], v0[1]); w.y = cvt_pk_bf16(v0[2], v0[3]); w.z = cvt_pk_bf16(v1[0], v1[1]); w.w = cvt_pk_bf16(v1[2], v1[3]);
                    *(u32x4*)(rowp + bj * HALF) = w;
                }
            }
    }
};

template <int MODE> struct EpiRes {
    static constexpr bool PERM = true, AFTER_DRAIN = false;
    const float* base; float* out; bf16_t* hb; float* ss_out; const float* ss_in; const bf16_t* proj;
    __device__ __forceinline__ void operator()(const f32x4 (&acc)[2][2][4][2], const Unit& u, int wr, int wc, int fr, int fq) const {
        const int row0 = u.pm * BM + wr * 64 + fr; const int col0 = u.pn * BM + wc * 32 + 8 * fq;
#pragma unroll
        for (int ai = 0; ai < 2; ++ai)
#pragma unroll
            for (int m = 0; m < 4; ++m) {
                const int row = row0 + ai * HALF + m * 16; const size_t off = (size_t)row * DM + col0;
                float rs = 0.f; if (MODE == 1) rs = rstd_row(ss_in, row);
                float sq = 0.f;
#pragma unroll
                for (int bj = 0; bj < 2; ++bj) {
                    const f32x4 b0 = *(const f32x4*)(base + off + bj * HALF), b1 = *(const f32x4*)(base + off + bj * HALF + 4);
                    f32x4 v0 = acc[ai][bj][m][0], v1 = acc[ai][bj][m][1];
                    if (MODE == 1) {
                        const u32x4 pw = *(const u32x4*)(proj + off + bj * HALF);
                        const f32x4 p0 = (f32x4){bf_lo(pw.x), bf_hi(pw.x), bf_lo(pw.y), bf_hi(pw.y)}, p1 = (f32x4){bf_lo(pw.z), bf_hi(pw.z), bf_lo(pw.w), bf_hi(pw.w)};
#pragma unroll
                        for (int e = 0; e < 4; ++e) { v0[e] = fsigmoid(v0[e] * rs) * p0[e]; v1[e] = fsigmoid(v1[e] * rs) * p1[e]; }
                    }
                    const f32x4 o0 = b0 + v0, o1 = b1 + v1;
                    *(f32x4*)(out + off + bj * HALF) = o0; *(f32x4*)(out + off + bj * HALF + 4) = o1;
                    u32x4 w; w.x = cvt_pk_bf16(o0[0], o0[1]); w.y = cvt_pk_bf16(o0[2], o0[3]); w.z = cvt_pk_bf16(o1[0], o1[1]); w.w = cvt_pk_bf16(o1[2], o1[3]);
                    *(u32x4*)(hb + off + bj * HALF) = w;
                    sq += (o0[0] * o0[0] + o0[1] * o0[1]) + (o0[2] * o0[2] + o0[3] * o0[3]) + (o1[0] * o1[0] + o1[1] * o1[1]) + (o1[2] * o1[2] + o1[3] * o1[3]);
                }
                sq += __shfl_xor(sq, 16); sq += __shfl_xor(sq, 32);
                if (fq == 0) ss_out[(size_t)row * 32 + u.pn * 4 + wc] = sq;
            }
    }
};

template <class Epi, class Sched, bool ALIGN_EPI = false, bool SP2 = false>
__device__ __forceinline__ void gemm_phase(PG8_LAS unsigned char* lds, const Gemm g, const Sched& S, const Epi& E) {
    int tid_ = threadIdx.x; asm volatile("" : "+v"(tid_)); const int tid = tid_, wid = __builtin_amdgcn_readfirstlane(tid >> 6), lane = tid & 63, wr = wid >> 2, wc = wid & 3, fr = lane & 15, fq = lane >> 4;
    const int K = g.K, nt = K / BK;
    unsigned voffA[2], voffB[2];
#pragma unroll
    for (int i = 0; i < 2; ++i) { int R, C; stage_rc(tid * 16 + i * 8192, R, C); const int Rb = Epi::PERM ? ((R & ~31) + perm32(R & 31)) : R;
        voffA[i] = (unsigned)(R * K + C) * 2u; voffB[i] = (unsigned)(Rb * K + C) * 2u; }
    const size_t kstep = (size_t)(BK * 2);
    const size_t hstep = (size_t)HALF * K * 2;
    const size_t tstep = 2 * hstep;
    const unsigned ldsw = (unsigned)wid * 1024u;
    const int aoff = lds_byte(wr * 64 + fr, fq * 8), boff = lds_byte(wc * 32 + fr, fq * 8);
#define PG8_SA(b, h) (((b) * 2 + (h)) * HTB)
#define PG8_SB(b, h) ((4 + (b) * 2 + (h)) * HTB)
#define PG8_STAGE(bufoff, gbase, voff) do { _Pragma("unroll") for (int _i = 0; _i < 2; ++_i) \
        __builtin_amdgcn_global_load_lds((const unsigned*)((const char*)(gbase) + (voff)[_i]), (PG8_LAS unsigned*)(lds + (bufoff) + ldsw + _i * 8192), 16, 0, 0); } while (0)
#define PG8_LDA(dst, b, h) do { _Pragma("unroll") for (int m = 0; m < 4; ++m) _Pragma("unroll") for (int k = 0; k < 2; ++k) dst[m][k] = *(const PG8_LAS bf16x8*)(lds + PG8_SA(b, h) + aoff + m * 2048 + k * 1024); } while (0)
#define PG8_LDB(dst, b, h) do { _Pragma("unroll") for (int n = 0; n < 2; ++n) _Pragma("unroll") for (int k = 0; k < 2; ++k) dst[n][k] = *(const PG8_LAS bf16x8*)(lds + PG8_SB(b, h) + boff + n * 2048 + k * 1024); } while (0)
#define PG8_MMA(ai, bj, At, Bt) do { __builtin_amdgcn_s_setprio(1); _Pragma("unroll") for (int m = 0; m < 4; ++m) _Pragma("unroll") for (int n = 0; n < 2; ++n) _Pragma("unroll") for (int k = 0; k < 2; ++k) \
        acc[ai][bj][m][n] = __builtin_amdgcn_mfma_f32_16x16x32_bf16(Bt[n][k], At[m][k], acc[ai][bj][m][n], 0, 0, 0); __builtin_amdgcn_s_setprio(0); } while (0)
#define PG8_WAIT_V(n) asm volatile("s_waitcnt vmcnt(" #n ")" ::: "memory")
#define PG8_WAIT_L(n) asm volatile("s_waitcnt lgkmcnt(" #n ")" ::: "memory")
#define PG8_BAR __builtin_amdgcn_s_barrier()
#define PG8_SCHED __builtin_amdgcn_sched_barrier(0)
    Unit cur, nxt; int ui = 0;
    if (!S.next(0, cur)) return;
    f32x4 acc[2][2][4][2];
#pragma unroll
    for (int a = 0; a < 2; ++a)
#pragma unroll
        for (int b = 0; b < 2; ++b)
#pragma unroll
            for (int m = 0; m < 4; ++m)
#pragma unroll
                for (int n = 0; n < 2; ++n) acc[a][b][m][n] = (f32x4){0.f, 0.f, 0.f, 0.f};
    bf16x8 At[4][2], B0[2][2], B1[2][2];
    const char* cA = (const char*)g.A + (size_t)cur.pm * tstep; const char* cB = (const char*)g.Bt + (size_t)cur.pn * tstep;
    S.a_ready(cur);
    if constexpr (SP2) {
        PG8_STAGE(PG8_SB(0, 0), cB, voffB); PG8_STAGE(PG8_SB(0, 1), cB + hstep, voffB); PG8_STAGE(PG8_SA(0, 0), cA, voffA); PG8_STAGE(PG8_SA(0, 1), cA + hstep, voffA);
        if (wr == 1) PG8_BAR;
        PG8_WAIT_V(2); PG8_BAR;
        PG8_STAGE(PG8_SB(1, 0), cB + kstep, voffB); PG8_STAGE(PG8_SA(1, 0), cA + kstep, voffA); PG8_STAGE(PG8_SB(1, 1), cB + hstep + kstep, voffB);
        PG8_WAIT_V(6); PG8_BAR;
    } else {
        PG8_STAGE(PG8_SB(0, 0), cB, voffB); PG8_STAGE(PG8_SA(0, 0), cA, voffA); PG8_STAGE(PG8_SB(0, 1), cB + hstep, voffB); PG8_STAGE(PG8_SA(0, 1), cA + hstep, voffA);
        if (wr == 1) PG8_BAR;
        PG8_WAIT_V(4); PG8_BAR;
        PG8_STAGE(PG8_SB(1, 0), cB + kstep, voffB); PG8_STAGE(PG8_SA(1, 0), cA + kstep, voffA); PG8_STAGE(PG8_SB(1, 1), cB + hstep + kstep, voffB);
        PG8_WAIT_V(6); PG8_BAR;
    }
    for (;;) {
        const bool has_next = S.next(ui + 1, nxt);
        const char* nA = has_next ? (const char*)g.A + (size_t)nxt.pm * tstep : cA; const char* nB = has_next ? (const char*)g.Bt + (size_t)nxt.pn * tstep : cB;
        for (int t = 0; t < nt; t += 2) {
            const bool last = (t == nt - 2);
            const char* a1 = cA + (size_t)(t + 1) * kstep;
            const char* a2 = last ? nA : cA + (size_t)(t + 2) * kstep; const char* b2 = last ? nB : cB + (size_t)(t + 2) * kstep;
            const char* a3 = a2 + kstep; const char* b3 = b2 + kstep;
            if (last && has_next) S.a_ready(nxt);
            if constexpr (SP2) {
            PG8_LDB(B0, 0, 0); PG8_LDB(B1, 0, 1); PG8_SCHED; PG8_LDA(At, 0, 0); PG8_STAGE(PG8_SA(1, 1), a1 + hstep, voffA);
            PG8_WAIT_V(8); PG8_WAIT_L(0); PG8_BAR; PG8_MMA(0, 0, At, B0); PG8_MMA(0, 1, At, B1); PG8_BAR; PG8_SCHED;
            PG8_LDA(At, 0, 1); PG8_STAGE(PG8_SB(0, 0), b2, voffB); PG8_STAGE(PG8_SB(0, 1), b2 + hstep, voffB); PG8_STAGE(PG8_SA(0, 0), a2, voffA);
            PG8_WAIT_V(8); PG8_WAIT_L(0); PG8_BAR; PG8_MMA(1, 0, At, B0); PG8_MMA(1, 1, At, B1); PG8_BAR; PG8_SCHED;
            PG8_LDB(B0, 1, 0); PG8_LDB(B1, 1, 1); PG8_SCHED; PG8_LDA(At, 1, 0); PG8_STAGE(PG8_SA(0, 1), a2 + hstep, voffA);
            PG8_WAIT_V(8); PG8_WAIT_L(0); PG8_BAR; PG8_MMA(0, 0, At, B0); PG8_MMA(0, 1, At, B1); PG8_BAR; PG8_SCHED;
            PG8_LDA(At, 1, 1); PG8_STAGE(PG8_SB(1, 0), b3, voffB); PG8_STAGE(PG8_SB(1, 1), b3 + hstep, voffB); PG8_STAGE(PG8_SA(1, 0), a3, voffA);
            PG8_WAIT_V(8); PG8_WAIT_L(0); PG8_BAR; PG8_MMA(1, 0, At, B0); PG8_MMA(1, 1, At, B1); PG8_BAR; PG8_SCHED;
            } else {
            PG8_LDB(B0, 0, 0); PG8_SCHED; PG8_LDA(At, 0, 0); PG8_STAGE(PG8_SA(1, 1), a1 + hstep, voffA);
            PG8_WAIT_L(8); PG8_BAR; PG8_WAIT_L(0); PG8_MMA(0, 0, At, B0); PG8_BAR; PG8_SCHED;
            PG8_LDB(B1, 0, 1); PG8_STAGE(PG8_SB(0, 0), b2, voffB);
            PG8_BAR; PG8_WAIT_L(0); PG8_MMA(0, 1, At, B1); PG8_BAR;
            PG8_LDA(At, 0, 1); PG8_STAGE(PG8_SA(0, 0), a2, voffA);
            PG8_BAR; PG8_WAIT_L(0); PG8_MMA(1, 0, At, B0); PG8_BAR; PG8_SCHED;
            PG8_STAGE(PG8_SB(0, 1), b2 + hstep, voffB);
            PG8_WAIT_V(6); PG8_BAR; PG8_MMA(1, 1, At, B1); PG8_BAR;
            PG8_LDB(B0, 1, 0); PG8_SCHED; PG8_LDA(At, 1, 0); PG8_STAGE(PG8_SA(0, 1), a2 + hstep, voffA);
            PG8_WAIT_L(8); PG8_BAR; PG8_WAIT_L(0); PG8_MMA(0, 0, At, B0); PG8_BAR; PG8_SCHED;
            PG8_LDB(B1, 1, 1); PG8_STAGE(PG8_SB(1, 0), b3, voffB);
            PG8_BAR; PG8_WAIT_L(0); PG8_MMA(0, 1, At, B1); PG8_BAR;
            PG8_LDA(At, 1, 1); PG8_STAGE(PG8_SA(1, 0), a3, voffA);
            PG8_BAR; PG8_WAIT_L(0); PG8_MMA(1, 0, At, B0); PG8_BAR; PG8_SCHED;
            PG8_STAGE(PG8_SB(1, 1), b3 + hstep, voffB);
            PG8_WAIT_V(6); PG8_BAR; PG8_MMA(1, 1, At, B1); PG8_BAR;
            }
        }
        if constexpr (ALIGN_EPI) { if (wr == 0) PG8_BAR; }
        if constexpr (!Epi::AFTER_DRAIN) { E(acc, cur, wr, wc, fr, fq); S.done(cur); }
        if (!has_next) break;
#pragma unroll
        for (int a = 0; a < 2; ++a)
#pragma unroll
            for (int b = 0; b < 2; ++b)
#pragma unroll
                for (int m = 0; m < 4; ++m)
#pragma unroll
                    for (int n = 0; n < 2; ++n) acc[a][b][m][n] = (f32x4){0.f, 0.f, 0.f, 0.f};
        cur = nxt; cA = nA; cB = nB; ++ui;
        if constexpr (ALIGN_EPI) { if (wr == 1) PG8_BAR; }
    }
    PG8_WAIT_V(0);
    if constexpr (!ALIGN_EPI) { if (wr == 0) PG8_BAR; }
    PG8_BAR;
    if constexpr (Epi::AFTER_DRAIN) { E.fused(acc, cur, wr, wc, fr, fq, lds, wid, lane); S.done(cur); }
#undef PG8_SA
#undef PG8_SB
#undef PG8_STAGE
#undef PG8_LDA
#undef PG8_LDB
#undef PG8_MMA
#undef PG8_WAIT_V
#undef PG8_WAIT_L
#undef PG8_BAR
#undef PG8_SCHED
}
}

constexpr int SEQ = 8192, DM = 2048, DFF = 8192, PLE = 256, DEPTH = 4, NHEAD = 16, HD = 128;
constexpr int NWAVES = 8, NTHREADS = 512;
constexpr int LDS_BYTES = 147456;
typedef unsigned short bf16;
typedef unsigned u32x4 __attribute__((ext_vector_type(4)));
typedef unsigned u32x2 __attribute__((ext_vector_type(2)));
typedef float f32x4 __attribute__((ext_vector_type(4)));
typedef float f32x2 __attribute__((ext_vector_type(2)));
typedef short bf16x8 __attribute__((ext_vector_type(8)));
#define LAS __attribute__((address_space(3)))
#define LDS_WAIT() asm volatile("s_waitcnt lgkmcnt(0)" ::: "memory")

constexpr size_t MiB = 1u << 20;
constexpr size_t WS_SS = 880 * MiB;
constexpr size_t WS_AGG = 2 * MiB;
constexpr size_t WS_X0 = 8 * MiB, WS_X1 = 40 * MiB;
constexpr size_t WS_BA = 72 * MiB, WS_BB = 104 * MiB, WS_BC = 136 * MiB, WS_BD = 168 * MiB;
constexpr size_t WS_A1 = 200 * MiB;
constexpr size_t WS_PROJ = 328 * MiB;
constexpr size_t WS_PB = 456 * MiB;
constexpr size_t WS_W1T = 472 * MiB, WS_W2T = 600 * MiB, WS_WGT = 728 * MiB, WS_WPT = 760 * MiB, WS_WINT = 764 * MiB, WS_WORT = 796 * MiB,
                 WS_GAT = 812 * MiB, WS_GXT = 814 * MiB, WS_WQKVT = 816 * MiB, WS_WONT = 864 * MiB, WS_END = 893 * MiB;

struct Args {
    const float* in[22];
    float* out; unsigned char* ws;
    int ph_lo, ph_hi;
};
static_assert(sizeof(Args) == 200 && offsetof(Args, out) == 176 && offsetof(Args, ws) == 184 && offsetof(Args, ph_lo) == 192, "Args layout");

typedef const unsigned char __attribute__((address_space(4)))* KA;
#define INP(k) (*(const float* const __attribute__((address_space(4)))*)(ka + 8 * (k)))
__device__ __forceinline__ int opaque_tid() { int t = threadIdx.x; asm volatile("" : "+v"(t)); return t; }
__device__ __forceinline__ unsigned cvt_pk(float lo, float hi) { return pg8::cvt_pk_bf16(lo, hi); }
__device__ __forceinline__ float bfl(unsigned w) { return __uint_as_float(w << 16); }
__device__ __forceinline__ float bfh(unsigned w) { return __uint_as_float(w & 0xffff0000u); }
__device__ __forceinline__ float wave_sum(float v) {
#pragma unroll
    for (int o = 1; o < 64; o <<= 1) v += __shfl_xor(v, o);
    return v;
}

__device__ __forceinline__ void transpose_item(const float* W, int K, int N, const float* g, bf16* WT, LAS float* scr, int kb, int nb, int lane) {
    const int k0 = 64 * kb, n0 = 32 * nb;
#pragma unroll 8
    for (int i = 0; i < 32; ++i) { const int kk = 2 * i + (lane >> 5); float v = W[(size_t)(k0 + kk) * N + n0 + (lane & 31)]; if (g) v *= g[k0 + kk]; scr[kk * 33 + (lane & 31)] = v; }
    LDS_WAIT(); asm volatile("" ::: "memory");
    const int c = lane & 7;
#pragma unroll
    for (int j = 0; j < 4; ++j) { const int n = (lane >> 3) + 8 * j; const LAS float* s = scr + (8 * c) * 33 + n;
        u32x4 o; o.x = cvt_pk(s[0 * 33], s[1 * 33]); o.y = cvt_pk(s[2 * 33], s[3 * 33]); o.z = cvt_pk(s[4 * 33], s[5 * 33]); o.w = cvt_pk(s[6 * 33], s[7 * 33]);
        *(u32x4*)(WT + (size_t)(n0 + n) * K + k0 + 8 * c) = o; }
    LDS_WAIT(); asm volatile("" ::: "memory");
}

__device__ __forceinline__ void p0_phase(LAS unsigned char* lds, KA ka, unsigned char* ws, int G) {
    const int tid = opaque_tid(), lane = tid & 63, wave = tid >> 6;
    LAS float* scr = (LAS float*)(lds + wave * 16384);
    const int gw = blockIdx.x * NWAVES + wave, NGW = G * NWAVES;
    float* ss = (float*)(ws + WS_SS);
    {
        const float* x = INP(0); bf16* X0 = (bf16*)(ws + WS_X0);
        for (int row = gw; row < SEQ; row += NGW) {
            const f32x4* xr = (const f32x4*)(x + (size_t)row * DM) + lane; float s = 0.f;
            u32x2* o = (u32x2*)(X0 + (size_t)row * DM) + lane;
#pragma unroll
            for (int j = 0; j < 8; ++j) { const f32x4 v = xr[64 * j]; s += (v[0] * v[0] + v[1] * v[1]) + (v[2] * v[2] + v[3] * v[3]); u32x2 w; w.x = cvt_pk(v[0], v[1]); w.y = cvt_pk(v[2], v[3]); o[64 * j] = w; }
            s = wave_sum(s);
            if (lane < 32) ss[(size_t)row * 32 + lane] = (lane == 0) ? s : 0.f;
        }
    }
    {
        const f32x4* p = (const f32x4*)INP(1); u32x2* o = (u32x2*)(ws + WS_PB);
        const int n4 = DEPTH * SEQ * PLE / 4;
        for (int i = blockIdx.x * NTHREADS + tid; i < n4; i += G * NTHREADS) { const f32x4 v = p[i]; u32x2 w; w.x = cvt_pk(v[0], v[1]); w.y = cvt_pk(v[2], v[3]); o[i] = w; }
    }
    const int nitems_total =
        4 * (2048 / 64) * (8192 / 32) + 4 * (8192 / 64) * (2048 / 32) + 4 * (2048 / 64) * (2048 / 32) + 4 * (256 / 64) * (2048 / 32) +
        2 * (2048 / 64) * (4096 / 32) + 2 * (2048 / 64) * (2048 / 32) + 64 * (128 / 64) * (128 / 32) + 64 * (128 / 64) * (128 / 32) +
        2 * (2048 / 64) * (6144 / 32) + 2 * (2048 / 64) * (2048 / 32);
    for (int it = gw; it < nitems_total; it += NGW) {
        int r = it;
#define CONV_TRY(Wp, nmat, K, N, gp, gstride, WTp) { const int ipm = ((K) / 64) * ((N) / 32); const int tot = (nmat) * ipm; \
            if (r < tot) { const int mat = r / ipm, rr = r % ipm, kb = rr / ((N) / 32), nb = rr % ((N) / 32); const float* g_ = (gp); \
                transpose_item((Wp) + (size_t)mat * (K) * (N), (K), (N), g_ ? g_ + (size_t)mat * (gstride) : nullptr, (bf16*)(ws + (WTp)) + (size_t)mat * (K) * (N), scr, kb, nb, lane); continue; } r -= tot; }
        CONV_TRY(INP(18), 4, 2048, 8192, INP(3), 2048, WS_W1T)
        CONV_TRY(INP(19), 4, 8192, 2048, (const float*)nullptr, 0, WS_W2T)
        CONV_TRY(INP(20), 4, 2048, 2048, INP(4), 2048, WS_WGT)
        CONV_TRY(INP(21), 4, 256, 2048, (const float*)nullptr, 0, WS_WPT)
        CONV_TRY(INP(6), 2, 2048, 4096, INP(2), 4096, WS_WINT)
        CONV_TRY(INP(14), 2, 2048, 2048, (const float*)nullptr, 0, WS_WORT)
        CONV_TRY(INP(9), 64, 128, 128, (const float*)nullptr, 0, WS_GAT)
        CONV_TRY(INP(11), 64, 128, 128, (const float*)nullptr, 0, WS_GXT)
        CONV_TRY(INP(15), 2, 2048, 6144, INP(2) + 2048, 4096, WS_WQKVT)
        CONV_TRY(INP(17), 2, 2048, 2048, (const float*)nullptr, 0, WS_WONT)
#undef CONV_TRY
    }
}

constexpr int SC_T = 64, SC_NCH = SEQ / SC_T;
constexpr int XCF_STRIDE = 132;
constexpr int XCB_STRIDE = 136;
constexpr int LDS_XCF = 0, LDS_XCB = LDS_XCF + SC_T * XCF_STRIDE * 4, LDS_YGS = LDS_XCB + SC_T * XCB_STRIDE * 2, LDS_SEG = LDS_YGS + SC_T * 128 * 2, LDS_SC_END = LDS_SEG + 2 * 128 * 17 * 8;
static_assert(LDS_SC_END <= 131072, "scan LDS");

struct ScanArgs {
    const bf16* XR; const bf16* YG; bf16* Y;
    const float* conv_w; const float* conv_b;
    const bf16* gaT; const bf16* gxT;
    const float* ga_b; const float* gx_b; const float* lam;
    f32x2* agg;
};

template <bool FINAL>
__device__ __forceinline__ void scan_phase(LAS unsigned char* lds, const ScanArgs& sa, int G) {
    const int tid = opaque_tid(), lane = tid & 63, w = tid >> 6, fr = lane & 15, fq = lane >> 4;
    LAS float* xcf = (LAS float*)(lds + LDS_XCF);
    LAS bf16* xcb = (LAS bf16*)(lds + LDS_XCB);
    LAS bf16* ygs = (LAS bf16*)(lds + LDS_YGS);
    LAS f32x2* seg = (LAS f32x2*)(lds + LDS_SEG);
    int cur_hd = -1;
    bf16x8 Bf[4][4];
    float ba[2], bx[2], sp8[2];
#pragma unroll
    for (int m = 0; m < 4; ++m)
#pragma unroll
        for (int k = 0; k < 4; ++k) Bf[m][k] = (bf16x8){0, 0, 0, 0, 0, 0, 0, 0};
    ba[0] = ba[1] = bx[0] = bx[1] = sp8[0] = sp8[1] = 0.f;
    for (int it = blockIdx.x; it < SC_NCH * NHEAD; it += G) {
        const int hd = it & 15, chunk = it >> 4, t0 = chunk * SC_T;
        __syncthreads();
        if (hd != cur_hd) {
            cur_hd = hd;
#pragma unroll
            for (int dir = 0; dir < 2; ++dir) {
                const bf16* wa = sa.gaT + ((size_t)(dir * 16 + hd) * 128 + 16 * w + fr) * 128 + 8 * fq;
                const bf16* wx = sa.gxT + ((size_t)(dir * 16 + hd) * 128 + 16 * w + fr) * 128 + 8 * fq;
#pragma unroll
                for (int k = 0; k < 4; ++k) { Bf[dir * 2 + 0][k] = *(const bf16x8*)(wa + 32 * k); Bf[dir * 2 + 1][k] = *(const bf16x8*)(wx + 32 * k); }
                const int gch = hd * 128 + 16 * w + fr;
                ba[dir] = sa.ga_b[dir * DM + gch]; bx[dir] = sa.gx_b[dir * DM + gch];
                sp8[dir] = 8.f * log1pf(expf(-sa.lam[dir * DM + gch]));
            }
        }
        {
            const int cp = tid & 63, tg = tid >> 6;
            const int gc = hd * 128 + 2 * cp;
            float x0[11], x1[11];
#pragma unroll
            for (int q = 0; q < 11; ++q) { const int t = t0 + 8 * tg - 1 + q; unsigned v = 0u; if (t >= 0 && t < SEQ) v = *(const unsigned*)(sa.XR + (size_t)t * DM + gc); x0[q] = bfl(v); x1[q] = bfh(v); }
            float w0[4], w1[4];
#pragma unroll
            for (int k = 0; k < 4; ++k) { const f32x2 wv = *(const f32x2*)(sa.conv_w + k * DM + gc); w0[k] = wv[0]; w1[k] = wv[1]; }
            const f32x2 bv = *(const f32x2*)(sa.conv_b + gc);
#pragma unroll
            for (int q = 0; q < 8; ++q) {
                const float c0 = bv[0] + ((w0[0] * x0[q] + w0[1] * x0[q + 1]) + (w0[2] * x0[q + 2] + w0[3] * x0[q + 3]));
                const float c1 = bv[1] + ((w1[0] * x1[q] + w1[1] * x1[q + 1]) + (w1[2] * x1[q + 2] + w1[3] * x1[q + 3]));
                const int tau = 8 * tg + q;
                *(LAS f32x2*)(xcf + tau * XCF_STRIDE + 2 * cp) = (f32x2){c0, c1};
                *(LAS unsigned*)(xcb + tau * XCB_STRIDE + 2 * cp) = cvt_pk(c0, c1);
            }
            if (FINAL) {
#pragma unroll
                for (int i = 0; i < 2; ++i) { const int idx = tid + i * NTHREADS, row = idx >> 4, c16 = idx & 15;
                    *(LAS u32x4*)(ygs + row * 128 + c16 * 8) = *(const u32x4*)(sa.YG + (size_t)(t0 + row) * DM + hd * 128 + c16 * 8); }
            }
        }
        __syncthreads();
        f32x4 acc[4][4];
#pragma unroll
        for (int m = 0; m < 4; ++m)
#pragma unroll
            for (int mb = 0; mb < 4; ++mb) acc[m][mb] = (f32x4){0.f, 0.f, 0.f, 0.f};
#pragma unroll
        for (int mb = 0; mb < 4; ++mb) {
            bf16x8 Af[4];
#pragma unroll
            for (int k = 0; k < 4; ++k) Af[k] = *(const LAS bf16x8*)(xcb + (16 * mb + fr) * XCB_STRIDE + 32 * k + 8 * fq);
#pragma unroll
            for (int m = 0; m < 4; ++m)
#pragma unroll
                for (int k = 0; k < 4; ++k) acc[m][mb] = __builtin_amdgcn_mfma_f32_16x16x32_bf16(Af[k], Bf[m][k], acc[m][mb], 0, 0, 0);
        }
        const int ch = 16 * w + fr;
#pragma unroll
        for (int mb = 0; mb < 4; ++mb) {
            float xv[4];
#pragma unroll
            for (int j = 0; j < 4; ++j) xv[j] = xcf[(16 * mb + 4 * fq + j) * XCF_STRIDE + ch];
#pragma unroll
            for (int dir = 0; dir < 2; ++dir) {
#pragma unroll
                for (int j = 0; j < 4; ++j) {
                    const float r = pg8::fsigmoid(acc[2 * dir][mb][j] + ba[dir]);
                    const float ig = pg8::fsigmoid(acc[2 * dir + 1][mb][j] + bx[dir]);
                    const float la = -sp8[dir] * r;
                    const float av = __expf(la);
                    const float x2 = 2.f * la;
                    const float om = (x2 > -0.04f) ? -x2 * (1.f + x2 * (0.5f + x2 * (0.16666667f + x2 * 0.041666668f))) : 1.f - av * av;
                    acc[2 * dir][mb][j] = av;
                    acc[2 * dir + 1][mb][j] = sqrtf(om) * ig * xv[j];
                }
                const f32x4 A = acc[2 * dir][mb], U = acc[2 * dir + 1][mb];
                float P, Q;
                if (dir == 0) { P = (A[0] * A[1]) * (A[2] * A[3]); Q = ((U[0] * A[1] + U[1]) * A[2] + U[2]) * A[3] + U[3]; }
                else          { P = (A[0] * A[1]) * (A[2] * A[3]); Q = ((U[3] * A[2] + U[2]) * A[1] + U[1]) * A[0] + U[0]; }
                seg[(dir * 128 + ch) * 17 + mb * 4 + fq] = (f32x2){P, Q};
            }
        }
        __syncthreads();
        if (tid < 256) {
            const int dir = tid >> 7, c = tid & 127, gch = hd * 128 + c;
            LAS f32x2* sg = seg + (dir * 128 + c) * 17;
            if (!FINAL) {
                float h = 0.f, Pt = 1.f;
                if (dir == 0) { for (int s = 0; s < 16; ++s) { const f32x2 e = sg[s]; h = e[0] * h + e[1]; Pt *= e[0]; } }
                else          { for (int s = 15; s >= 0; --s) { const f32x2 e = sg[s]; h = e[0] * h + e[1]; Pt *= e[0]; } }
                sa.agg[((size_t)dir * SC_NCH + chunk) * DM + gch] = (f32x2){Pt, h};
            } else {
                float h = 0.f;
                const f32x2* ag = sa.agg + (size_t)dir * SC_NCH * DM + gch;
                if (dir == 0) { for (int cc = 0; cc < chunk; ++cc) { const f32x2 e = ag[(size_t)cc * DM]; h = e[0] * h + e[1]; } }
                else          { for (int cc = SC_NCH - 1; cc > chunk; --cc) { const f32x2 e = ag[(size_t)cc * DM]; h = e[0] * h + e[1]; } }
                if (dir == 0) { for (int s = 0; s < 16; ++s) { const f32x2 e = sg[s]; sg[s] = (f32x2){h, 0.f}; h = e[0] * h + e[1]; } }
                else          { for (int s = 15; s >= 0; --s) { const f32x2 e = sg[s]; sg[s] = (f32x2){h, 0.f}; h = e[0] * h + e[1]; } }
            }
        }
        if (FINAL) {
            __syncthreads();
#pragma unroll
            for (int mb = 0; mb < 4; ++mb) {
                float hs[4];
                { float h = seg[(0 * 128 + ch) * 17 + mb * 4 + fq][0]; const f32x4 A = acc[0][mb], U = acc[1][mb];
#pragma unroll
                  for (int j = 0; j < 4; ++j) { h = A[j] * h + U[j]; hs[j] = h; } }
                { float h = seg[(1 * 128 + ch) * 17 + mb * 4 + fq][0]; const f32x4 A = acc[2][mb], U = acc[3][mb];
#pragma unroll
                  for (int j = 3; j >= 0; --j) { h = A[j] * h + U[j]; hs[j] += h; } }
#pragma unroll
                for (int j = 0; j < 4; ++j) {
                    LAS bf16* yp = ygs + (16 * mb + 4 * fq + j) * 128 + ch;
                    const float yg = __uint_as_float((unsigned)(*yp) << 16);
                    *yp = (bf16)(cvt_pk(hs[j] * yg, 0.f) & 0xffffu);
                }
            }
            __syncthreads();
#pragma unroll
            for (int i = 0; i < 2; ++i) { const int idx = tid + i * NTHREADS, row = idx >> 4, c16 = idx & 15;
                *(u32x4*)(sa.Y + (size_t)(t0 + row) * DM + hd * 128 + c16 * 8) = *(const LAS u32x4*)(ygs + row * 128 + c16 * 8); }
        }
    }
}

struct AttArgs { const bf16* Q; const bf16* K; const bf16* VT; bf16* O; const float* rpb; };

__device__ __forceinline__ void attn_phase(LAS unsigned char* lds, const AttArgs& aa, int G) {
    const int tid = opaque_tid(), lane = tid & 63, w = tid >> 6, fr = lane & 15, fq = lane >> 4;
    const int hsel = w >> 2, qg = w & 3;
    LAS float* rp = (LAS float*)lds;
    const int c0 = 16 * qg, kb0 = (qg == 0) ? 0 : (qg == 1) ? 8 : (qg == 2) ? 24 : 32;
    const int qc = c0 + fr;
    const int cs = min(max(qc - 8, 0), 48);
    for (int id = blockIdx.x; id < 128 * 8; id += G) {
        const int hp = id & 7, r = id >> 3, h = hp * 2 + hsel;
        const int rs = min(max(r - 4, 0), 120);
        __syncthreads();
        for (int i = tid; i < 2 * 465; i += NTHREADS) { const int hh = i / 465, e = i % 465; rp[hh * 480 + e] = aa.rpb[(size_t)(hp * 2 + hh) * 465 + e]; }
        __syncthreads();
        bf16x8 qf[4];
        { const bf16* qp = aa.Q + (size_t)(r * 64 + qc) * DM + h * 128 + 8 * fq;
#pragma unroll
          for (int k = 0; k < 4; ++k) qf[k] = *(const bf16x8*)(qp + 32 * k); }
        f32x4 s[8][2];
        const int krow = 8 * (fr >> 2) + (fr & 3);
#pragma unroll
        for (int i = 0; i < 8; ++i)
#pragma unroll
            for (int nb = 0; nb < 2; ++nb) {
                const bf16* kp = aa.K + (size_t)((rs + i) * 64 + kb0 + krow + 4 * nb) * DM + h * 128 + 8 * fq;
                f32x4 c = (f32x4){0.f, 0.f, 0.f, 0.f};
#pragma unroll
                for (int k = 0; k < 4; ++k) { const bf16x8 kf = *(const bf16x8*)(kp + 32 * k); c = __builtin_amdgcn_mfma_f32_16x16x32_bf16(kf, qf[k], c, 0, 0, 0); }
                s[i][nb] = c;
            }
        float mx = -INFINITY;
        const LAS float* rph = rp + hsel * 480;
#pragma unroll
        for (int i = 0; i < 8; ++i) {
            const int relr = rs + i - r + 7;
#pragma unroll
            for (int nb = 0; nb < 2; ++nb)
#pragma unroll
                for (int j = 0; j < 4; ++j) {
                    const int kc = kb0 + 8 * fq + 4 * nb + j;
                    const bool valid = (unsigned)(kc - cs) < 16u;
                    const int idx = valid ? relr * 31 + (kc - qc + 15) : 0;
                    const float v = valid ? s[i][nb][j] + rph[idx] : -INFINITY;
                    s[i][nb][j] = v; mx = fmaxf(mx, v);
                }
        }
        mx = fmaxf(mx, __shfl_xor(mx, 16)); mx = fmaxf(mx, __shfl_xor(mx, 32));
        float l = 0.f;
#pragma unroll
        for (int i = 0; i < 8; ++i)
#pragma unroll
            for (int nb = 0; nb < 2; ++nb)
#pragma unroll
                for (int j = 0; j < 4; ++j) { const float p = __expf(s[i][nb][j] - mx); s[i][nb][j] = p; l += p; }
        l += __shfl_xor(l, 16); l += __shfl_xor(l, 32);
        f32x4 o[8];
#pragma unroll
        for (int db = 0; db < 8; ++db) o[db] = (f32x4){0.f, 0.f, 0.f, 0.f};
#pragma unroll
        for (int i = 0; i < 8; ++i) {
            u32x4 pw; pw.x = cvt_pk(s[i][0][0], s[i][0][1]); pw.y = cvt_pk(s[i][0][2], s[i][0][3]); pw.z = cvt_pk(s[i][1][0], s[i][1][1]); pw.w = cvt_pk(s[i][1][2], s[i][1][3]);
            const bf16x8 pb = __builtin_bit_cast(bf16x8, pw);
            const bf16* vp = aa.VT + (size_t)(h * 128 + fr) * SEQ + (rs + i) * 64 + kb0 + 8 * fq;
#pragma unroll
            for (int db = 0; db < 8; ++db) { const bf16x8 vf = *(const bf16x8*)(vp + (size_t)(16 * db) * SEQ); o[db] = __builtin_amdgcn_mfma_f32_16x16x32_bf16(vf, pb, o[db], 0, 0, 0); }
        }
        const float inv = 1.f / l;
        bf16* op = aa.O + (size_t)(r * 64 + qc) * DM + h * 128 + 4 * fq;
#pragma unroll
        for (int db = 0; db < 8; ++db) { u32x2 wv; wv.x = cvt_pk(o[db][0] * inv, o[db][1] * inv); wv.y = cvt_pk(o[db][2] * inv, o[db][3] * inv); *(u32x2*)(op + 16 * db) = wv; }
    }
}

__device__ __forceinline__ void final_phase(float* out, const float* ss, const float* g, int G) {
    const int tid = opaque_tid(), lane = tid & 63, wave = tid >> 6;
    const int gw = blockIdx.x * NWAVES + wave, NGW = G * NWAVES;
    for (int row = gw; row < SEQ; row += NGW) {
        const float rs = pg8::rstd_row(ss, row);
        f32x4* o = (f32x4*)(out + (size_t)row * DM) + lane; const f32x4* gp = (const f32x4*)g + lane;
#pragma unroll
        for (int j = 0; j < 8; ++j) { f32x4 v = o[64 * j]; const f32x4 gv = gp[64 * j]; v = v * rs * gv; o[64 * j] = v; }
    }
}

constexpr int N_PHASES = 28;
#ifndef DBG_DUMP_OFF
#define DBG_DUMP_OFF WS_BC
#endif
#ifndef DBG_NPH
#define DBG_NPH N_PHASES
#endif
#ifndef DBG_DUMP
#define DBG_DUMP 0
#endif
enum Kind { K_P0, K_WIN, K_S1, K_S2, K_WOUT, K_QKV, K_ATT, K_W1, K_W2, K_PLE, K_FINAL, K_DUMP };

__global__ void __launch_bounds__(NTHREADS, 2) mega_fwd(Args args) {
    extern __shared__ __attribute__((aligned(16))) unsigned char lds_raw[];
    LAS unsigned char* lds = (LAS unsigned char*)lds_raw;
    cg::grid_group grid = cg::this_grid();
    const int G = gridDim.x;
    KA ka0 = (KA)__builtin_amdgcn_kernarg_segment_ptr();
    const int lo = *(const int __attribute__((address_space(4)))*)(ka0 + 192), hi = *(const int __attribute__((address_space(4)))*)(ka0 + 196);
    for (int ph = lo; ph < hi; ++ph) {
        KA ka = ka0; asm volatile("" : "+s"(ka));
        unsigned char* ws = *(unsigned char* const __attribute__((address_space(4)))*)(ka + 184);
        float* hout = *(float* const __attribute__((address_space(4)))*)(ka + 176);
        float* ss = (float*)(ws + WS_SS);
        int kind, L = 0;
        if (ph == 0) kind = K_P0; else if (ph == 99) kind = K_DUMP; else if (ph == N_PHASES - 1) kind = K_FINAL;
        else { int q = ph - 1; const int pair = q / 13; q -= pair * 13; L = 2 * pair;
            if (q < 7) { kind = (q == 0) ? K_WIN : (q == 1) ? K_S1 : (q == 2) ? K_S2 : (q == 3) ? K_WOUT : (q == 4) ? K_W1 : (q == 5) ? K_W2 : K_PLE; }
            else { q -= 7; L += 1; kind = (q == 0) ? K_QKV : (q == 1) ? K_ATT : (q == 2) ? K_WOUT : (q == 3) ? K_W1 : (q == 4) ? K_W2 : K_PLE; } }
        const int j = L >> 1;
        bf16* Xc = (bf16*)(ws + ((L & 1) ? WS_X1 : WS_X0));
        bf16* Xo = (bf16*)(ws + ((L & 1) ? WS_X0 : WS_X1));
        const float* ss_mix = ss + (size_t)(3 * L) * SEQ * 32; float* ss_mlp = ss + (size_t)(3 * L + 1) * SEQ * 32; float* ss_ple = ss + (size_t)(3 * L + 2) * SEQ * 32; float* ss_next = ss + (size_t)(3 * L + 3) * SEQ * 32;
        switch (kind) {
        case K_P0:
#ifndef DIS_P0
 p0_phase(lds, ka, ws, G);
#endif
 break;
        case K_WIN: {
#ifdef DBG_BJ0
            pg8::Gemm g{Xc, (const bf16*)(ws + WS_WINT), SEQ, 2 * DM, DM};
#elif defined(DBG_AX1)
            pg8::Gemm g{(L == 2) ? Xo : Xc, (const bf16*)(ws + WS_WINT) + (size_t)j * DM * 2 * DM, SEQ, 2 * DM, DM};
#else
            pg8::Gemm g{Xc, (const bf16*)(ws + WS_WINT) + (size_t)j * DM * 2 * DM, SEQ, 2 * DM, DM};
#endif
            pg8::StaticOrder S; S.init(SEQ, 2 * DM, G, (int)blockIdx.x);
#ifdef DBG_FRESHOUT
            pg8::EpiAct<0> E{(L == 2) ? (bf16*)(ws + WS_PROJ + 96 * MiB) : (bf16*)(ws + WS_BA), (bf16*)(ws + WS_BB), DM, DM, ss_mix};
#elif defined(DBG_SS0)
            pg8::EpiAct<0> E{(bf16*)(ws + WS_BA), (bf16*)(ws + WS_BB), DM, DM, ss};
#else
            pg8::EpiAct<0> E{(bf16*)(ws + WS_BA), (bf16*)(ws + WS_BB), DM, DM, ss_mix};
#endif
#ifndef DIS_ACT0
            pg8::gemm_phase<pg8::EpiAct<0>, pg8::StaticOrder, true, true>(lds, g, S, E);
#endif
        } break;
        case K_S1: case K_S2: {
            ScanArgs sa{(const bf16*)(ws + WS_BA), (const bf16*)(ws + WS_BB), (bf16*)(ws + WS_BC),
                        INP(7) + (size_t)j * 4 * DM, INP(8) + (size_t)j * DM,
                        (const bf16*)(ws + WS_GAT) + (size_t)j * 32 * 128 * 128, (const bf16*)(ws + WS_GXT) + (size_t)j * 32 * 128 * 128,
                        INP(10) + (size_t)j * 2 * DM, INP(12) + (size_t)j * 2 * DM, INP(13) + (size_t)j * 2 * DM,
                        (f32x2*)(ws + WS_AGG)};
            #ifndef DIS_SCAN
            if (kind == K_S1) scan_phase<false>(lds, sa, G); else scan_phase<true>(lds, sa, G);
#endif
        } break;
        case K_QKV: {
            {
                pg8::Gemm g{Xc, (const bf16*)(ws + WS_WQKVT) + (size_t)j * 3 * DM * DM, SEQ, 2 * DM, DM};
                pg8::StaticOrder S; S.init(SEQ, 2 * DM, G, (int)blockIdx.x);
                pg8::EpiAct<1> E{(bf16*)(ws + WS_BA), (bf16*)(ws + WS_BB), DM, DM, ss_mix};
#ifndef DIS_ACT1
                pg8::gemm_phase<pg8::EpiAct<1>, pg8::StaticOrder, true, true>(lds, g, S, E);
#endif
            }
            __syncthreads();
            {
                pg8::Gemm g{(const bf16*)(ws + WS_WQKVT) + (size_t)j * 3 * DM * DM + (size_t)2 * DM * DM, Xc, DM, SEQ, DM};
                pg8::StaticOrder S; S.init(DM, SEQ, G, (int)blockIdx.x);
                pg8::EpiAct<4> E{(bf16*)(ws + WS_BD), nullptr, SEQ, 0, ss_mix};
#ifndef DIS_ACT4
                pg8::gemm_phase<pg8::EpiAct<4>, pg8::StaticOrder, true, true>(lds, g, S, E);
#endif
            }
        } break;
        case K_ATT: {
            AttArgs aa{(const bf16*)(ws + WS_BA), (const bf16*)(ws + WS_BB), (const bf16*)(ws + WS_BD), (bf16*)(ws + WS_BC), INP(16) + (size_t)j * NHEAD * 465};
#ifndef DIS_ATT
            attn_phase(lds, aa, G);
#endif
        } break;
        case K_WOUT: case K_W2: {
            const bf16* A; const bf16* Bt; int K;
            float* sso; bf16* hb;
            if (kind == K_WOUT) { A = (const bf16*)(ws + WS_BC); K = DM; Bt = (L & 1) ? (const bf16*)(ws + WS_WONT) + (size_t)j * DM * DM : (const bf16*)(ws + WS_WORT) + (size_t)j * DM * DM; sso = ss_mlp; hb = Xo; }
            else { A = (const bf16*)(ws + WS_A1); K = DFF; Bt = (const bf16*)(ws + WS_W2T) + (size_t)L * DM * DFF; sso = ss_ple; hb = Xc; }
            const float* base = (kind == K_WOUT && L == 0) ? INP(0) : hout;
            pg8::Gemm g{A, Bt, SEQ, DM, K};
            pg8::StaticOrder S; S.init(SEQ, DM, G, (int)blockIdx.x);
            pg8::EpiRes<0> E{base, hout, hb, sso, nullptr, nullptr};
#ifndef DIS_RES0
            pg8::gemm_phase<pg8::EpiRes<0>, pg8::StaticOrder, true, true>(lds, g, S, E);
#endif
        } break;
        case K_W1: {
            {
                int Kp = PLE; asm volatile("" : "+s"(Kp));
                pg8::Gemm g{(const bf16*)(ws + WS_PB) + (size_t)L * SEQ * PLE, (const bf16*)(ws + WS_WPT) + (size_t)L * DM * PLE, SEQ, DM, Kp};
                pg8::StaticOrder S; S.init(SEQ, DM, G, (int)blockIdx.x);
                pg8::EpiAct<3> E{(bf16*)(ws + WS_PROJ) + (size_t)L * SEQ * DM, nullptr, DM, 0, nullptr};
#ifndef DIS_ACT3
                pg8::gemm_phase<pg8::EpiAct<3>, pg8::StaticOrder, true, true>(lds, g, S, E);
#endif
            }
            __syncthreads();
            pg8::Gemm g{Xo, (const bf16*)(ws + WS_W1T) + (size_t)L * DM * DFF, SEQ, DFF, DM};
            pg8::StaticOrder S; S.init(SEQ, DFF, G, (int)blockIdx.x);
            pg8::EpiAct<2> E{(bf16*)(ws + WS_A1), nullptr, DFF, 0, ss_mlp};
#ifndef DIS_ACT2
            pg8::gemm_phase<pg8::EpiAct<2>, pg8::StaticOrder, true, true>(lds, g, S, E);
#endif
        } break;
        case K_PLE: {
            pg8::Gemm g{Xc, (const bf16*)(ws + WS_WGT) + (size_t)L * DM * DM, SEQ, DM, DM};
            pg8::StaticOrder S; S.init(SEQ, DM, G, (int)blockIdx.x);
            pg8::EpiRes<1> E{hout, hout, Xo, ss_next, ss_ple, (const bf16*)(ws + WS_PROJ) + (size_t)L * SEQ * DM};
#ifndef DIS_RES1
            pg8::gemm_phase<pg8::EpiRes<1>, pg8::StaticOrder, true, true>(lds, g, S, E);
#endif
        } break;
        case K_DUMP: {
            const bf16* src = (const bf16*)(ws + DBG_DUMP_OFF); const float* srcf = (const float*)(ws + DBG_DUMP_OFF);
            for (size_t i = (size_t)blockIdx.x * NTHREADS + threadIdx.x; i < (size_t)SEQ * DM; i += (size_t)G * NTHREADS) hout[i] = (DBG_DUMP == 2) ? srcf[i & 8191] : bfl((unsigned)src[i]);
        } break;
        case K_FINAL: final_phase(hout, ss + (size_t)12 * SEQ * 32, INP(5), G); break;
        }
        if (ph + 1 < hi) grid.sync();
    }
}

#ifndef MK_MULTI
#define MK_MULTI 0
#endif

extern "C" void kernel_launch(void* const* d_in, const int* in_sizes, int n_in, void* d_out, int out_size, void* d_ws, size_t ws_size, hipStream_t stream) {
    static int grid = 0;
    if (grid == 0) {
        if (n_in != 22 || out_size != SEQ * DM || ws_size < WS_END) { fprintf(stderr, "kernel_launch: unexpected shapes (n_in %d out %d ws %zu)\n", n_in, out_size, ws_size); grid = -1; return; }
        int dev = 0, cus = 0, per_cu = 0;
        (void)hipGetDevice(&dev); (void)hipDeviceGetAttribute(&cus, hipDeviceAttributeMultiprocessorCount, dev);
        if (hipFuncSetAttribute((const void*)mega_fwd, hipFuncAttributeMaxDynamicSharedMemorySize, LDS_BYTES) != hipSuccess) { fprintf(stderr, "kernel_launch: hipFuncSetAttribute failed\n"); grid = -1; return; }
        if (hipOccupancyMaxActiveBlocksPerMultiprocessor(&per_cu, (const void*)mega_fwd, NTHREADS, LDS_BYTES) != hipSuccess || per_cu < 1) { fprintf(stderr, "kernel_launch: occupancy query says %d\n", per_cu); per_cu = 1; }
        (void)hipGetLastError();
        grid = cus * per_cu; if (grid > 256) grid = 256;
        fprintf(stderr, "kernel_launch: grid %d (cus %d per_cu %d)\n", grid, cus, per_cu);
    }
    if (grid < 0) return;
    Args a{};
    for (int i = 0; i < 22; ++i) a.in[i] = (const float*)d_in[i];
    a.out = (float*)d_out; a.ws = (unsigned char*)d_ws;
#if MK_MULTI
#ifdef DBG_SEQ
    { const int seq[] = {DBG_SEQ}; for (int ph : seq) { a.ph_lo = ph; a.ph_hi = ph + 1; hipLaunchKernelGGL(mega_fwd, dim3(grid), dim3(NTHREADS), LDS_BYTES, stream, a); } }
#else
    for (int ph = 0; ph < DBG_NPH; ++ph) { a.ph_lo = ph; a.ph_hi = ph + 1; hipLaunchKernelGGL(mega_fwd, dim3(grid), dim3(NTHREADS), LDS_BYTES, stream, a); }
#endif
    if (DBG_DUMP) { a.ph_lo = 99; a.ph_hi = 100; hipLaunchKernelGGL(mega_fwd, dim3(grid), dim3(NTHREADS), LDS_BYTES, stream, a); }
#else
    a.ph_lo = 0; a.ph_hi = N_PHASES;
    void* kargs[] = {&a};
    hipError_t e = hipLaunchCooperativeKernel((const void*)mega_fwd, dim3(grid), dim3(NTHREADS), kargs, LDS_BYTES, stream);
    if (e != hipSuccess) fprintf(stderr, "kernel_launch: cooperative launch failed: %s (grid %d)\n", hipGetErrorString(e), grid);
#endif
}
```

```cpp
#include <hip/hip_runtime.h>
#include <hip/hip_cooperative_groups.h>
#include <cstdio>
#include <cstdint>
namespace cg = cooperative_groups;
namespace pg8 {
#define PG8_LAS __attribute__((address_space(3)))
typedef unsigned short bf16_t;
typedef short bf16x8 __attribute__((ext_vector_type(8)));
typedef float f32x4 __attribute__((ext_vector_type(4)));
typedef unsigned u32x4 __attribute__((ext_vector_type(4)));
constexpr int BM = 256, BK = 64, HALF = 128, HTB = HALF * BK * 2  , STAGE_BYTES = 8 * HTB, NXCD = 8, WGM = 8;

__host__ __device__ __forceinline__ int lds_byte(int r, int c) { const int st = (r >> 4) * 2 + (c >> 5), rr = r & 15, cc = c & 31, ob = rr * 64 + cc * 2; return st * 1024 + (ob ^ (((ob >> 9) & 1) << 5)); }
__host__ __device__ __forceinline__ void stage_rc(int b, int& R, int& C) { const int st = b / 1024, sb = b % 1024, swz = sb ^ (((sb >> 9) & 1) << 5); R = (st >> 1) * 16 + swz / 64; C = (st & 1) * 32 + (swz % 64) / 2; }
__host__ __device__ __forceinline__ int perm32(int rho) { const int n = rho >> 4, i = rho & 15; return 8 * (i >> 2) + 4 * n + (i & 3); }

struct Unit { int pm, pn; };
struct Gemm { const bf16_t* A; const bf16_t* Bt; int M, N, K; };

struct StaticOrder {
    int nM, nN, nwg, G, c;
    __host__ __device__ void init(int M, int N, int G_, int c_) { nM = M / BM; nN = N / BM; nwg = nM * nN; G = G_; c = c_; }
    __host__ __device__ bool next(int i, Unit& u) const {
        const long L = (long)i * G + c; if (L >= nwg) return false;
        int wgid = (int)L; { const int q = nwg / NXCD, r = nwg % NXCD, xcd = wgid % NXCD, off = wgid / NXCD; wgid = (xcd < r ? xcd * (q + 1) : r * (q + 1) + (xcd - r) * q) + off; }
        const int nig = WGM * nN, gid = wgid / nig, fm = gid * WGM, gsz = (nM - fm) < WGM ? (nM - fm) : WGM;
        u.pm = fm + ((wgid % nig) % gsz); u.pn = (wgid % nig) / gsz; return true;
    }
    __device__ __forceinline__ void a_ready(const Unit&) const {}
    __device__ __forceinline__ void done(const Unit&) const {}
};

__device__ __forceinline__ unsigned cvt_pk_bf16(float lo, float hi) { unsigned r; asm volatile("v_cvt_pk_bf16_f32 %0, %1, %2" : "=v"(r) : "v"(lo), "v"(hi)); return r; }
typedef float f32x2 __attribute__((ext_vector_type(2)));
constexpr float RMS_EPS = 1e-6f;
constexpr int DM = 2048;
__device__ __forceinline__ float fsigmoid(float x) { return __builtin_amdgcn_rcpf(1.f + __expf(-x)); }
__device__ __forceinline__ float gelu_tanh(float v) { return v * fsigmoid(1.5957691216057308f * (v + 0.044715f * v * v * v)); }
__device__ __forceinline__ float rstd_row(const float* ssp, int row) {
    const f32x4* p = (const f32x4*)(ssp + (size_t)row * 32); float s = 0.f;
#pragma unroll
    for (int i = 0; i < 8; ++i) { const f32x4 v = p[i]; s += (v[0] + v[1]) + (v[2] + v[3]); }
    return rsqrtf(s * (1.f / DM) + RMS_EPS);
}
__device__ __forceinline__ float bf_lo(unsigned w) { return __uint_as_float(w << 16); }
__device__ __forceinline__ float bf_hi(unsigned w) { return __uint_as_float(w & 0xffff0000u); }

template <int MODE> struct EpiAct {
    static constexpr bool PERM = true, AFTER_DRAIN = false;
    bf16_t* O0; bf16_t* O1; int ldc; int split; const float* ss;
    __device__ __forceinline__ void operator()(const f32x4 (&acc)[2][2][4][2], const Unit& u, int wr, int wc, int fr, int fq) const {
        const int row0 = u.pm * BM + wr * 64 + fr; int colt = u.pn * BM; bf16_t* base = O0; bool second = false;
        if (MODE <= 1) { if (colt >= split) { base = O1; colt -= split; second = true; } }
        const int col0 = colt + wc * 32 + 8 * fq;
        f32x4 cs[2][2];
        if (MODE == 4) {
#pragma unroll
            for (int bj = 0; bj < 2; ++bj)
#pragma unroll
                for (int n = 0; n < 2; ++n) {
#pragma unroll
                    for (int e = 0; e < 4; ++e) cs[bj][n][e] = rstd_row(ss, col0 + bj * HALF + 4 * n + e); }
        }
#pragma unroll
        for (int ai = 0; ai < 2; ++ai)
#pragma unroll
            for (int m = 0; m < 4; ++m) {
                const int row = row0 + ai * HALF + m * 16;
                float rs = 1.f;
                if (MODE <= 2) { rs = rstd_row(ss, row); if (MODE == 1 && !second) rs *= 0.08838834764831845f; }
                bf16_t* rowp = base + (size_t)row * ldc + col0;
#pragma unroll
                for (int bj = 0; bj < 2; ++bj) {
                    f32x4 v0 = acc[ai][bj][m][0], v1 = acc[ai][bj][m][1];
                    if (MODE == 4) { v0 = v0 * cs[bj][0]; v1 = v1 * cs[bj][1]; } else { v0 = v0 * rs; v1 = v1 * rs; }
                    if (MODE == 0) { if (second) {
#pragma unroll
                        for (int e = 0; e < 4; ++e) { v0[e] = gelu_tanh(v0[e]); v1[e] = gelu_tanh(v1[e]); } } }
                    if (MODE == 2) {
#pragma unroll
                        for (int e = 0; e < 4; ++e) { const float a = fmaxf(v0[e], 0.f), b = fmaxf(v1[e], 0.f); v0[e] = a * a; v1[e] = b * b; } }
                    u32x4 w; w.x = cvt_pk_bf16(v0[0], v0[1]); w.y = cvt_pk_bf16(v0[2], v0[3]); w.z = cvt_pk_bf16(v1[0], v1[1]); w.w = cvt_pk_bf16(v1[2], v1[3]);
                    *(u32x4*)(rowp + bj * HALF) = w;
                }
            }
    }
};

template <int MODE> struct EpiRes {
    static constexpr bool PERM = true, AFTER_DRAIN = false;
    const float* base; float* out; bf16_t* hb; float* ss_out; const float* ss_in; const bf16_t* proj;
    __device__ __forceinline__ void operator()(const f32x4 (&acc)[2][2][4][2], const Unit& u, int wr, int wc, int fr, int fq) const {
        const int row0 = u.pm * BM + wr * 64 + fr; const int col0 = u.pn * BM + wc * 32 + 8 * fq;
#pragma unroll
        for (int ai = 0; ai < 2; ++ai)
#pragma unroll
            for (int m = 0; m < 4; ++m) {
                const int row = row0 + ai * HALF + m * 16; const size_t off = (size_t)row * DM + col0;
                float rs = 0.f; if (MODE == 1) rs = rstd_row(ss_in, row);
                float sq = 0.f;
#pragma unroll
                for (int bj = 0; bj < 2; ++bj) {
                    const f32x4 b0 = *(const f32x4*)(base + off + bj * HALF), b1 = *(const f32x4*)(base + off + bj * HALF + 4);
                    f32x4 v0 = acc[ai][bj][m][0], v1 = acc[ai][bj][m][1];
                    if (MODE == 1) {
                        const u32x4 pw = *(const u32x4*)(proj + off + bj * HALF);
                        const f32x4 p0 = (f32x4){bf_lo(pw.x), bf_hi(pw.x), bf_lo(pw.y), bf_hi(pw.y)}, p1 = (f32x4){bf_lo(pw.z), bf_hi(pw.z), bf_lo(pw.w), bf_hi(pw.w)};
#pragma unroll
                        for (int e = 0; e < 4; ++e) { v0[e] = fsigmoid(v0[e] * rs) * p0[e]; v1[e] = fsigmoid(v1[e] * rs) * p1[e]; }
                    }
                    const f32x4 o0 = b0 + v0, o1 = b1 + v1;
                    *(f32x4*)(out + off + bj * HALF) = o0; *(f32x4*)(out + off + bj * HALF + 4) = o1;
                    u32x4 w; w.x = cvt_pk_bf16(o0[0], o0[1]); w.y = cvt_pk_bf16(o0[2], o0[3]); w.z = cvt_pk_bf16(o1[0], o1[1]); w.w = cvt_pk_bf16(o1[2], o1[3]);
                    *(u32x4*)(hb + off + bj * HALF) = w;
                    sq += (o0[0] * o0[0] + o0[1] * o0[1]) + (o0[2] * o0[2] + o0[3] * o0[3]) + (o1[0] * o1[0] + o1[1] * o1[1]) + (o1[2] * o1[2] + o1[3] * o1[3]);
                }
                sq += __shfl_xor(sq, 16); sq += __shfl_xor(sq, 32);
                if (fq == 0) ss_out[(size_t)row * 32 + u.pn * 4 + wc] = sq;
            }
    }
};

template <class Epi, class Sched, bool ALIGN_EPI = false, bool SP2 = false>
__device__ __forceinline__ void gemm_phase(PG8_LAS unsigned char* lds, const Gemm g, const Sched& S, const Epi& E) {
    int tid_ = threadIdx.x; asm volatile("" : "+v"(tid_)); const int tid = tid_, wid = __builtin_amdgcn_readfirstlane(tid >> 6), lane = tid & 63, wr = wid >> 2, wc = wid & 3, fr = lane & 15, fq = lane >> 4;
    const int K = g.K, nt = K / BK;
    unsigned voffA[2], voffB[2];
#pragma unroll
    for (int i = 0; i < 2; ++i) { int R, C; stage_rc(tid * 16 + i * 8192, R, C); const int Rb = Epi::PERM ? ((R & ~31) + perm32(R & 31)) : R;
        voffA[i] = (unsigned)(R * K + C) * 2u; voffB[i] = (unsigned)(Rb * K + C) * 2u; }
    const size_t kstep = (size_t)(BK * 2);
    const size_t hstep = (size_t)HALF * K * 2;
    const size_t tstep = 2 * hstep;
    const unsigned ldsw = (unsigned)wid * 1024u;
    const int aoff = lds_byte(wr * 64 + fr, fq * 8), boff = lds_byte(wc * 32 + fr, fq * 8);
#define PG8_SA(b, h) (((b) * 2 + (h)) * HTB)
#define PG8_SB(b, h) ((4 + (b) * 2 + (h)) * HTB)
#define PG8_STAGE(bufoff, gbase, voff) do { _Pragma("unroll") for (int _i = 0; _i < 2; ++_i) \
        __builtin_amdgcn_global_load_lds((const unsigned*)((const char*)(gbase) + (voff)[_i]), (PG8_LAS unsigned*)(lds + (bufoff) + ldsw + _i * 8192), 16, 0, 0); } while (0)
#define PG8_LDA(dst, b, h) do { _Pragma("unroll") for (int m = 0; m < 4; ++m) _Pragma("unroll") for (int k = 0; k < 2; ++k) dst[m][k] = *(const PG8_LAS bf16x8*)(lds + PG8_SA(b, h) + aoff + m * 2048 + k * 1024); } while (0)
#define PG8_LDB(dst, b, h) do { _Pragma("unroll") for (int n = 0; n < 2; ++n) _Pragma("unroll") for (int k = 0; k < 2; ++k) dst[n][k] = *(const PG8_LAS bf16x8*)(lds + PG8_SB(b, h) + boff + n * 2048 + k * 1024); } while (0)
#define PG8_MMA(ai, bj, At, Bt) do { __builtin_amdgcn_s_setprio(1); _Pragma("unroll") for (int m = 0; m < 4; ++m) _Pragma("unroll") for (int n = 0; n < 2; ++n) _Pragma("unroll") for (int k = 0; k < 2; ++k) \
        acc[ai][bj][m][n] = __builtin_amdgcn_mfma_f32_16x16x32_bf16(Bt[n][k], At[m][k], acc[ai][bj][m][n], 0, 0, 0); __builtin_amdgcn_s_setprio(0); } while (0)
#define PG8_WAIT_V(n) asm volatile("s_waitcnt vmcnt(" #n ")" ::: "memory")
#define PG8_WAIT_L(n) asm volatile("s_waitcnt lgkmcnt(" #n ")" ::: "memory")
#define PG8_BAR __builtin_amdgcn_s_barrier()
#define PG8_SCHED __builtin_amdgcn_sched_barrier(0)
    Unit cur, nxt; int ui = 0;
    if (!S.next(0, cur)) return;
    f32x4 acc[2][2][4][2];
#pragma unroll
    for (int a = 0; a < 2; ++a)
#pragma unroll
        for (int b = 0; b < 2; ++b)
#pragma unroll
            for (int m = 0; m < 4; ++m)
#pragma unroll
                for (int n = 0; n < 2; ++n) acc[a][b][m][n] = (f32x4){0.f, 0.f, 0.f, 0.f};
    bf16x8 At[4][2], B0[2][2], B1[2][2];
    const char* cA = (const char*)g.A + (size_t)cur.pm * tstep; const char* cB = (const char*)g.Bt + (size_t)cur.pn * tstep;
    S.a_ready(cur);
    if constexpr (SP2) {
        PG8_STAGE(PG8_SB(0, 0), cB, voffB); PG8_STAGE(PG8_SB(0, 1), cB + hstep, voffB); PG8_STAGE(PG8_SA(0, 0), cA, voffA); PG8_STAGE(PG8_SA(0, 1), cA + hstep, voffA);
        if (wr == 1) PG8_BAR;
        PG8_WAIT_V(2); PG8_BAR;
        PG8_STAGE(PG8_SB(1, 0), cB + kstep, voffB); PG8_STAGE(PG8_SA(1, 0), cA + kstep, voffA); PG8_STAGE(PG8_SB(1, 1), cB + hstep + kstep, voffB);
        PG8_WAIT_V(6); PG8_BAR;
    } else {
        PG8_STAGE(PG8_SB(0, 0), cB, voffB); PG8_STAGE(PG8_SA(0, 0), cA, voffA); PG8_STAGE(PG8_SB(0, 1), cB + hstep, voffB); PG8_STAGE(PG8_SA(0, 1), cA + hstep, voffA);
        if (wr == 1) PG8_BAR;
        PG8_WAIT_V(4); PG8_BAR;
        PG8_STAGE(PG8_SB(1, 0), cB + kstep, voffB); PG8_STAGE(PG8_SA(1, 0), cA + kstep, voffA); PG8_STAGE(PG8_SB(1, 1), cB + hstep + kstep, voffB);
        PG8_WAIT_V(6); PG8_BAR;
    }
    for (;;) {
        const bool has_next = S.next(ui + 1, nxt);
        const char* nA = has_next ? (const char*)g.A + (size_t)nxt.pm * tstep : cA; const char* nB = has_next ? (const char*)g.Bt + (size_t)nxt.pn * tstep : cB;
        for (int t = 0; t < nt; t += 2) {
            const bool last = (t == nt - 2);
            const char* a1 = cA + (size_t)(t + 1) * kstep;
            const char* a2 = last ? nA : cA + (size_t)(t + 2) * kstep; const char* b2 = last ? nB : cB + (size_t)(t + 2) * kstep;
            const char* a3 = a2 + kstep; const char* b3 = b2 + kstep;
            if (last && has_next) S.a_ready(nxt);
            if constexpr (SP2) {
            PG8_LDB(B0, 0, 0); PG8_LDB(B1, 0, 1); PG8_SCHED; PG8_LDA(At, 0, 0); PG8_STAGE(PG8_SA(1, 1), a1 + hstep, voffA);
            PG8_WAIT_V(8); PG8_WAIT_L(0); PG8_BAR; PG8_MMA(0, 0, At, B0); PG8_MMA(0, 1, At, B1); PG8_BAR; PG8_SCHED;
            PG8_LDA(At, 0, 1); PG8_STAGE(PG8_SB(0, 0), b2, voffB); PG8_STAGE(PG8_SB(0, 1), b2 + hstep, voffB); PG8_STAGE(PG8_SA(0, 0), a2, voffA);
            PG8_WAIT_V(8); PG8_WAIT_L(0); PG8_BAR; PG8_MMA(1, 0, At, B0); PG8_MMA(1, 1, At, B1); PG8_BAR; PG8_SCHED;
            PG8_LDB(B0, 1, 0); PG8_LDB(B1, 1, 1); PG8_SCHED; PG8_LDA(At, 1, 0); PG8_STAGE(PG8_SA(0, 1), a2 + hstep, voffA);
            PG8_WAIT_V(8); PG8_WAIT_L(0); PG8_BAR; PG8_MMA(0, 0, At, B0); PG8_MMA(0, 1, At, B1); PG8_BAR; PG8_SCHED;
            PG8_LDA(At, 1, 1); PG8_STAGE(PG8_SB(1, 0), b3, voffB); PG8_STAGE(PG8_SB(1, 1), b3 + hstep, voffB); PG8_STAGE(PG8_SA(1, 0), a3, voffA);
            PG8_WAIT_V(8); PG8_WAIT_L(0); PG8_BAR; PG8_MMA(1, 0, At, B0); PG8_MMA(1, 1, At, B1); PG8_BAR; PG8_SCHED;
            } else {
            PG8_LDB(B0, 0, 0); PG8_SCHED; PG8_LDA(At, 0, 0); PG8_STAGE(PG8_SA(1, 1), a1 + hstep, voffA);
            PG8_WAIT_L(8); PG8_BAR; PG8_WAIT_L(0); PG8_MMA(0, 0, At, B0); PG8_BAR; PG8_SCHED;
            PG8_LDB(B1, 0, 1); PG8_STAGE(PG8_SB(0, 0), b2, voffB);
            PG8_BAR; PG8_WAIT_L(0); PG8_MMA(0, 1, At, B1); PG8_BAR;
            PG8_LDA(At, 0, 1); PG8_STAGE(PG8_SA(0, 0), a2, voffA);
            PG8_BAR; PG8_WAIT_L(0); PG8_MMA(1, 0, At, B0); PG8_BAR; PG8_SCHED;
            PG8_STAGE(PG8_SB(0, 1), b2 + hstep, voffB);
            PG8_WAIT_V(6); PG8_BAR; PG8_MMA(1, 1, At, B1); PG8_BAR;
            PG8_LDB(B0, 1, 0); PG8_SCHED; PG8_LDA(At, 1, 0); PG8_STAGE(PG8_SA(0, 1), a2 + hstep, voffA);
            PG8_WAIT_L(8); PG8_BAR; PG8_WAIT_L(0); PG8_MMA(0, 0, At, B0); PG8_BAR; PG8_SCHED;
            PG8_LDB(B1, 1, 1); PG8_STAGE(PG8_SB(1, 0), b3, voffB);
            PG8_BAR; PG8_WAIT_L(0); PG8_MMA(0, 1, At, B1); PG8_BAR;
            PG8_LDA(At, 1, 1); PG8_STAGE(PG8_SA(1, 0), a3, voffA);
            PG8_BAR; PG8_WAIT_L(0); PG8_MMA(1, 0, At, B0); PG8_BAR; PG8_SCHED;
            PG8_STAGE(PG8_SB(1, 1), b3 + hstep, voffB);
            PG8_WAIT_V(6); PG8_BAR; PG8_MMA(1, 1, At, B1); PG8_BAR;
            }
        }
        if constexpr (ALIGN_EPI) { if (wr == 0) PG8_BAR; }
        if constexpr (!Epi::AFTER_DRAIN) { E(acc, cur, wr, wc, fr, fq); S.done(cur); }
        if (!has_next) break;
#pragma unroll
        for (int a = 0; a < 2; ++a)
#pragma unroll
            for (int b = 0; b < 2; ++b)
#pragma unroll
                for (int m = 0; m < 4; ++m)
#pragma unroll
                    for (int n = 0; n < 2; ++n) acc[a][b][m][n] = (f32x4){0.f, 0.f, 0.f, 0.f};
        cur = nxt; cA = nA; cB = nB; ++ui;
        if constexpr (ALIGN_EPI) { if (wr == 1) PG8_BAR; }
    }
    PG8_WAIT_V(0);
    if constexpr (!ALIGN_EPI) { if (wr == 0) PG8_BAR; }
    PG8_BAR;
    if constexpr (Epi::AFTER_DRAIN) { E.fused(acc, cur, wr, wc, fr, fq, lds, wid, lane); S.done(cur); }
#undef PG8_SA
#undef PG8_SB
#undef PG8_STAGE
#undef PG8_LDA
#undef PG8_LDB
#undef PG8_MMA
#undef PG8_WAIT_V
#undef PG8_WAIT_L
#undef PG8_BAR
#undef PG8_SCHED
}
}

constexpr int SEQ = 8192, DM = 2048, DFF = 8192, PLE = 256, DEPTH = 4, NHEAD = 16, HD = 128;
constexpr int NWAVES = 8, NTHREADS = 512;
constexpr int LDS_BYTES = 147456;
typedef unsigned short bf16;
typedef unsigned u32x4 __attribute__((ext_vector_type(4)));
typedef unsigned u32x2 __attribute__((ext_vector_type(2)));
typedef float f32x4 __attribute__((ext_vector_type(4)));
typedef float f32x2 __attribute__((ext_vector_type(2)));
typedef short bf16x8 __attribute__((ext_vector_type(8)));
#define LAS __attribute__((address_space(3)))
#define LDS_WAIT() asm volatile("s_waitcnt lgkmcnt(0)" ::: "memory")

constexpr size_t MiB = 1u << 20;
constexpr size_t WS_SS = 880 * MiB;
constexpr size_t WS_BAR = 0;
constexpr size_t WS_AGG = 2 * MiB;
constexpr size_t WS_X0 = 8 * MiB, WS_X1 = 40 * MiB;
constexpr size_t WS_BA = 72 * MiB, WS_BB = 104 * MiB, WS_BC = 136 * MiB, WS_BD = 168 * MiB;
constexpr size_t WS_A1 = 200 * MiB;
constexpr size_t WS_PROJ = 328 * MiB;
constexpr size_t WS_PB = 456 * MiB;
constexpr size_t WS_W1T = 472 * MiB, WS_W2T = 600 * MiB, WS_WGT = 728 * MiB, WS_WPT = 760 * MiB, WS_WINT = 764 * MiB, WS_WORT = 796 * MiB,
                 WS_GAT = 812 * MiB, WS_GXT = 814 * MiB, WS_WQKVT = 816 * MiB, WS_WONT = 864 * MiB, WS_END = 893 * MiB;

struct Args {
    const float* in[22];
    float* out; unsigned char* ws;
    int ph_lo, ph_hi;
};
static_assert(sizeof(Args) == 200 && offsetof(Args, out) == 176 && offsetof(Args, ws) == 184 && offsetof(Args, ph_lo) == 192, "Args layout");

typedef const unsigned char __attribute__((address_space(4)))* KA;
#define INP(k) (*(const float* const __attribute__((address_space(4)))*)(ka + 8 * (k)))
__device__ __forceinline__ int opaque_tid() { int t = threadIdx.x; asm volatile("" : "+v"(t)); return t; }
__device__ __forceinline__ unsigned cvt_pk(float lo, float hi) { return pg8::cvt_pk_bf16(lo, hi); }
__device__ __forceinline__ float bfl(unsigned w) { return __uint_as_float(w << 16); }
__device__ __forceinline__ float bfh(unsigned w) { return __uint_as_float(w & 0xffff0000u); }
__device__ __forceinline__ float wave_sum(float v) {
#pragma unroll
    for (int o = 1; o < 64; o <<= 1) v += __shfl_xor(v, o);
    return v;
}

__device__ __forceinline__ void transpose_item(const float* W, int K, int N, const float* g, bf16* WT, LAS float* scr, int kb, int nb, int lane) {
    const int k0 = 64 * kb, n0 = 32 * nb;
#pragma unroll 8
    for (int i = 0; i < 32; ++i) { const int kk = 2 * i + (lane >> 5); float v = W[(size_t)(k0 + kk) * N + n0 + (lane & 31)]; if (g) v *= g[k0 + kk]; scr[kk * 33 + (lane & 31)] = v; }
    LDS_WAIT(); asm volatile("" ::: "memory");
    const int c = lane & 7;
#pragma unroll
    for (int j = 0; j < 4; ++j) { const int n = (lane >> 3) + 8 * j; const LAS float* s = scr + (8 * c) * 33 + n;
        u32x4 o; o.x = cvt_pk(s[0 * 33], s[1 * 33]); o.y = cvt_pk(s[2 * 33], s[3 * 33]); o.z = cvt_pk(s[4 * 33], s[5 * 33]); o.w = cvt_pk(s[6 * 33], s[7 * 33]);
        *(u32x4*)(WT + (size_t)(n0 + n) * K + k0 + 8 * c) = o; }
    LDS_WAIT(); asm volatile("" ::: "memory");
}

__device__ __forceinline__ void p0_phase(LAS unsigned char* lds, KA ka, unsigned char* ws, int G) {
    const int tid = opaque_tid(), lane = tid & 63, wave = tid >> 6;
    LAS float* scr = (LAS float*)(lds + wave * 16384);
    const int gw = blockIdx.x * NWAVES + wave, NGW = G * NWAVES;
    float* ss = (float*)(ws + WS_SS);
    {
        const float* x = INP(0); bf16* X0 = (bf16*)(ws + WS_X0);
        for (int row = gw; row < SEQ; row += NGW) {
            const f32x4* xr = (const f32x4*)(x + (size_t)row * DM) + lane; float s = 0.f;
            u32x2* o = (u32x2*)(X0 + (size_t)row * DM) + lane;
#pragma unroll
            for (int j = 0; j < 8; ++j) { const f32x4 v = xr[64 * j]; s += (v[0] * v[0] + v[1] * v[1]) + (v[2] * v[2] + v[3] * v[3]); u32x2 w; w.x = cvt_pk(v[0], v[1]); w.y = cvt_pk(v[2], v[3]); o[64 * j] = w; }
            s = wave_sum(s);
            if (lane < 32) ss[(size_t)row * 32 + lane] = (lane == 0) ? s : 0.f;
        }
    }
    {
        const f32x4* p = (const f32x4*)INP(1); u32x2* o = (u32x2*)(ws + WS_PB);
        const int n4 = DEPTH * SEQ * PLE / 4;
        for (int i = blockIdx.x * NTHREADS + tid; i < n4; i += G * NTHREADS) { const f32x4 v = p[i]; u32x2 w; w.x = cvt_pk(v[0], v[1]); w.y = cvt_pk(v[2], v[3]); o[i] = w; }
    }
    const int nitems_total =
        4 * (2048 / 64) * (8192 / 32) + 4 * (8192 / 64) * (2048 / 32) + 4 * (2048 / 64) * (2048 / 32) + 4 * (256 / 64) * (2048 / 32) +
        2 * (2048 / 64) * (4096 / 32) + 2 * (2048 / 64) * (2048 / 32) + 64 * (128 / 64) * (128 / 32) + 64 * (128 / 64) * (128 / 32) +
        2 * (2048 / 64) * (6144 / 32) + 2 * (2048 / 64) * (2048 / 32);
    for (int it = gw; it < nitems_total; it += NGW) {
        int r = it;
#define CONV_TRY(Wp, nmat, K, N, gp, gstride, WTp) { const int ipm = ((K) / 64) * ((N) / 32); const int tot = (nmat) * ipm; \
            if (r < tot) { const int mat = r / ipm, rr = r % ipm, kb = rr / ((N) / 32), nb = rr % ((N) / 32); const float* g_ = (gp); \
                transpose_item((Wp) + (size_t)mat * (K) * (N), (K), (N), g_ ? g_ + (size_t)mat * (gstride) : nullptr, (bf16*)(ws + (WTp)) + (size_t)mat * (K) * (N), scr, kb, nb, lane); continue; } r -= tot; }
        CONV_TRY(INP(18), 4, 2048, 8192, INP(3), 2048, WS_W1T)
        CONV_TRY(INP(19), 4, 8192, 2048, (const float*)nullptr, 0, WS_W2T)
        CONV_TRY(INP(20), 4, 2048, 2048, INP(4), 2048, WS_WGT)
        CONV_TRY(INP(21), 4, 256, 2048, (const float*)nullptr, 0, WS_WPT)
        CONV_TRY(INP(6), 2, 2048, 4096, INP(2), 4096, WS_WINT)
        CONV_TRY(INP(14), 2, 2048, 2048, (const float*)nullptr, 0, WS_WORT)
        CONV_TRY(INP(9), 64, 128, 128, (const float*)nullptr, 0, WS_GAT)
        CONV_TRY(INP(11), 64, 128, 128, (const float*)nullptr, 0, WS_GXT)
        CONV_TRY(INP(15), 2, 2048, 6144, INP(2) + 2048, 4096, WS_WQKVT)
        CONV_TRY(INP(17), 2, 2048, 2048, (const float*)nullptr, 0, WS_WONT)
#undef CONV_TRY
    }
}

constexpr int SC_T = 64, SC_NCH = SEQ / SC_T;
constexpr int XCF_STRIDE = 132;
constexpr int XCB_STRIDE = 136;
constexpr int LDS_XCF = 0, LDS_XCB = LDS_XCF + SC_T * XCF_STRIDE * 4, LDS_YGS = LDS_XCB + SC_T * XCB_STRIDE * 2, LDS_SEG = LDS_YGS + SC_T * 128 * 2, LDS_SC_END = LDS_SEG + 2 * 128 * 17 * 8;
static_assert(LDS_SC_END <= 131072, "scan LDS");

struct ScanArgs {
    const bf16* XR; const bf16* YG; bf16* Y;
    const float* conv_w; const float* conv_b;
    const bf16* gaT; const bf16* gxT;
    const float* ga_b; const float* gx_b; const float* lam;
    f32x2* agg;
};

template <bool FINAL>
__device__ __forceinline__ void scan_phase(LAS unsigned char* lds, const ScanArgs& sa, int G) {
    const int tid = opaque_tid(), lane = tid & 63, w = tid >> 6, fr = lane & 15, fq = lane >> 4;
    LAS float* xcf = (LAS float*)(lds + LDS_XCF);
    LAS bf16* xcb = (LAS bf16*)(lds + LDS_XCB);
    LAS bf16* ygs = (LAS bf16*)(lds + LDS_YGS);
    LAS f32x2* seg = (LAS f32x2*)(lds + LDS_SEG);
    int cur_hd = -1;
    bf16x8 Bf[4][4];
    float ba[2], bx[2], sp8[2];
#pragma unroll
    for (int m = 0; m < 4; ++m)
#pragma unroll
        for (int k = 0; k < 4; ++k) Bf[m][k] = (bf16x8){0, 0, 0, 0, 0, 0, 0, 0};
    ba[0] = ba[1] = bx[0] = bx[1] = sp8[0] = sp8[1] = 0.f;
    for (int it = blockIdx.x; it < SC_NCH * NHEAD; it += G) {
        const int hd = it & 15, chunk = it >> 4, t0 = chunk * SC_T;
        __syncthreads();
        if (hd != cur_hd) {
            cur_hd = hd;
#pragma unroll
            for (int dir = 0; dir < 2; ++dir) {
                const bf16* wa = sa.gaT + ((size_t)(dir * 16 + hd) * 128 + 16 * w + fr) * 128 + 8 * fq;
                const bf16* wx = sa.gxT + ((size_t)(dir * 16 + hd) * 128 + 16 * w + fr) * 128 + 8 * fq;
#pragma unroll
                for (int k = 0; k < 4; ++k) { Bf[dir * 2 + 0][k] = *(const bf16x8*)(wa + 32 * k); Bf[dir * 2 + 1][k] = *(const bf16x8*)(wx + 32 * k); }
                const int gch = hd * 128 + 16 * w + fr;
                ba[dir] = sa.ga_b[dir * DM + gch]; bx[dir] = sa.gx_b[dir * DM + gch];
                sp8[dir] = 8.f * log1pf(expf(-sa.lam[dir * DM + gch]));
            }
        }
        {
            const int cp = tid & 63, tg = tid >> 6;
            const int gc = hd * 128 + 2 * cp;
            float x0[11], x1[11];
#pragma unroll
            for (int q = 0; q < 11; ++q) { const int t = t0 + 8 * tg - 1 + q; unsigned v = 0u; if (t >= 0 && t < SEQ) v = *(const unsigned*)(sa.XR + (size_t)t * DM + gc); x0[q] = bfl(v); x1[q] = bfh(v); }
            float w0[4], w1[4];
#pragma unroll
            for (int k = 0; k < 4; ++k) { const f32x2 wv = *(const f32x2*)(sa.conv_w + k * DM + gc); w0[k] = wv[0]; w1[k] = wv[1]; }
            const f32x2 bv = *(const f32x2*)(sa.conv_b + gc);
#pragma unroll
            for (int q = 0; q < 8; ++q) {
                const float c0 = bv[0] + ((w0[0] * x0[q] + w0[1] * x0[q + 1]) + (w0[2] * x0[q + 2] + w0[3] * x0[q + 3]));
                const float c1 = bv[1] + ((w1[0] * x1[q] + w1[1] * x1[q + 1]) + (w1[2] * x1[q + 2] + w1[3] * x1[q + 3]));
                const int tau = 8 * tg + q;
                *(LAS f32x2*)(xcf + tau * XCF_STRIDE + 2 * cp) = (f32x2){c0, c1};
                *(LAS unsigned*)(xcb + tau * XCB_STRIDE + 2 * cp) = cvt_pk(c0, c1);
            }
            if (FINAL) {
#pragma unroll
                for (int i = 0; i < 2; ++i) { const int idx = tid + i * NTHREADS, row = idx >> 4, c16 = idx & 15;
                    *(LAS u32x4*)(ygs + row * 128 + c16 * 8) = *(const u32x4*)(sa.YG + (size_t)(t0 + row) * DM + hd * 128 + c16 * 8); }
            }
        }
        __syncthreads();
        f32x4 acc[4][4];
#pragma unroll
        for (int m = 0; m < 4; ++m)
#pragma unroll
            for (int mb = 0; mb < 4; ++mb) acc[m][mb] = (f32x4){0.f, 0.f, 0.f, 0.f};
#pragma unroll
        for (int mb = 0; mb < 4; ++mb) {
            bf16x8 Af[4];
#pragma unroll
            for (int k = 0; k < 4; ++k) Af[k] = *(const LAS bf16x8*)(xcb + (16 * mb + fr) * XCB_STRIDE + 32 * k + 8 * fq);
#pragma unroll
            for (int m = 0; m < 4; ++m)
#pragma unroll
                for (int k = 0; k < 4; ++k) acc[m][mb] = __builtin_amdgcn_mfma_f32_16x16x32_bf16(Af[k], Bf[m][k], acc[m][mb], 0, 0, 0);
        }
        const int ch = 16 * w + fr;
#pragma unroll
        for (int mb = 0; mb < 4; ++mb) {
            float xv[4];
#pragma unroll
            for (int j = 0; j < 4; ++j) xv[j] = xcf[(16 * mb + 4 * fq + j) * XCF_STRIDE + ch];
#pragma unroll
            for (int dir = 0; dir < 2; ++dir) {
#pragma unroll
                for (int j = 0; j < 4; ++j) {
                    const float r = pg8::fsigmoid(acc[2 * dir][mb][j] + ba[dir]);
                    const float ig = pg8::fsigmoid(acc[2 * dir + 1][mb][j] + bx[dir]);
                    const float la = -sp8[dir] * r;
                    const float av = __expf(la);
                    const float x2 = 2.f * la;
                    const float om = (x2 > -0.04f) ? -x2 * (1.f + x2 * (0.5f + x2 * (0.16666667f + x2 * 0.041666668f))) : 1.f - av * av;
                    acc[2 * dir][mb][j] = av;
                    acc[2 * dir + 1][mb][j] = sqrtf(om) * ig * xv[j];
                }
                const f32x4 A = acc[2 * dir][mb], U = acc[2 * dir + 1][mb];
                float P, Q;
                if (dir == 0) { P = (A[0] * A[1]) * (A[2] * A[3]); Q = ((U[0] * A[1] + U[1]) * A[2] + U[2]) * A[3] + U[3]; }
                else          { P = (A[0] * A[1]) * (A[2] * A[3]); Q = ((U[3] * A[2] + U[2]) * A[1] + U[1]) * A[0] + U[0]; }
                seg[(dir * 128 + ch) * 17 + mb * 4 + fq] = (f32x2){P, Q};
            }
        }
        __syncthreads();
        if (tid < 256) {
            const int dir = tid >> 7, c = tid & 127, gch = hd * 128 + c;
            LAS f32x2* sg = seg + (dir * 128 + c) * 17;
            if (!FINAL) {
                float h = 0.f, Pt = 1.f;
                if (dir == 0) { for (int s = 0; s < 16; ++s) { const f32x2 e = sg[s]; h = e[0] * h + e[1]; Pt *= e[0]; } }
                else          { for (int s = 15; s >= 0; --s) { const f32x2 e = sg[s]; h = e[0] * h + e[1]; Pt *= e[0]; } }
                sa.agg[((size_t)dir * SC_NCH + chunk) * DM + gch] = (f32x2){Pt, h};
            } else {
                float h = 0.f;
                const f32x2* ag = sa.agg + (size_t)dir * SC_NCH * DM + gch;
                if (dir == 0) { for (int cc = 0; cc < chunk; ++cc) { const f32x2 e = ag[(size_t)cc * DM]; h = e[0] * h + e[1]; } }
                else          { for (int cc = SC_NCH - 1; cc > chunk; --cc) { const f32x2 e = ag[(size_t)cc * DM]; h = e[0] * h + e[1]; } }
                if (dir == 0) { for (int s = 0; s < 16; ++s) { const f32x2 e = sg[s]; sg[s] = (f32x2){h, 0.f}; h = e[0] * h + e[1]; } }
                else          { for (int s = 15; s >= 0; --s) { const f32x2 e = sg[s]; sg[s] = (f32x2){h, 0.f}; h = e[0] * h + e[1]; } }
            }
        }
        if (FINAL) {
            __syncthreads();
#pragma unroll
            for (int mb = 0; mb < 4; ++mb) {
                float hs[4];
                { float h = seg[(0 * 128 + ch) * 17 + mb * 4 + fq][0]; const f32x4 A = acc[0][mb], U = acc[1][mb];
#pragma unroll
                  for (int j = 0; j < 4; ++j) { h = A[j] * h + U[j]; hs[j] = h; } }
                { float h = seg[(1 * 128 + ch) * 17 + mb * 4 + fq][0]; const f32x4 A = acc[2][mb], U = acc[3][mb];
#pragma unroll
                  for (int j = 3; j >= 0; --j) { h = A[j] * h + U[j]; hs[j] += h; } }
#pragma unroll
                for (int j = 0; j < 4; ++j) {
                    LAS bf16* yp = ygs + (16 * mb + 4 * fq + j) * 128 + ch;
                    const float yg = __uint_as_float((unsigned)(*yp) << 16);
                    *yp = (bf16)(cvt_pk(hs[j] * yg, 0.f) & 0xffffu);
                }
            }
            __syncthreads();
#pragma unroll
            for (int i = 0; i < 2; ++i) { const int idx = tid + i * NTHREADS, row = idx >> 4, c16 = idx & 15;
                *(u32x4*)(sa.Y + (size_t)(t0 + row) * DM + hd * 128 + c16 * 8) = *(const LAS u32x4*)(ygs + row * 128 + c16 * 8); }
        }
    }
}

struct AttArgs { const bf16* Q; const bf16* K; const bf16* VT; bf16* O; const float* rpb; };

__device__ __forceinline__ void attn_phase(LAS unsigned char* lds, const AttArgs& aa, int G) {
    const int tid = opaque_tid(), lane = tid & 63, w = tid >> 6, fr = lane & 15, fq = lane >> 4;
    const int hsel = w >> 2, qg = w & 3;
    LAS float* rp = (LAS float*)lds;
    const int c0 = 16 * qg, kb0 = (qg == 0) ? 0 : (qg == 1) ? 8 : (qg == 2) ? 24 : 32;
    const int qc = c0 + fr;
    const int cs = min(max(qc - 8, 0), 48);
    for (int id = blockIdx.x; id < 128 * 8; id += G) {
        const int hp = id & 7, r = id >> 3, h = hp * 2 + hsel;
        const int rs = min(max(r - 4, 0), 120);
        __syncthreads();
        for (int i = tid; i < 2 * 465; i += NTHREADS) { const int hh = i / 465, e = i % 465; rp[hh * 480 + e] = aa.rpb[(size_t)(hp * 2 + hh) * 465 + e]; }
        __syncthreads();
        bf16x8 qf[4];
        { const bf16* qp = aa.Q + (size_t)(r * 64 + qc) * DM + h * 128 + 8 * fq;
#pragma unroll
          for (int k = 0; k < 4; ++k) qf[k] = *(const bf16x8*)(qp + 32 * k); }
        f32x4 s[8][2];
        const int krow = 8 * (fr >> 2) + (fr & 3);
#pragma unroll
        for (int i = 0; i < 8; ++i)
#pragma unroll
            for (int nb = 0; nb < 2; ++nb) {
                const bf16* kp = aa.K + (size_t)((rs + i) * 64 + kb0 + krow + 4 * nb) * DM + h * 128 + 8 * fq;
                f32x4 c = (f32x4){0.f, 0.f, 0.f, 0.f};
#pragma unroll
                for (int k = 0; k < 4; ++k) { const bf16x8 kf = *(const bf16x8*)(kp + 32 * k); c = __builtin_amdgcn_mfma_f32_16x16x32_bf16(kf, qf[k], c, 0, 0, 0); }
                s[i][nb] = c;
            }
        float mx = -INFINITY;
        const LAS float* rph = rp + hsel * 480;
#pragma unroll
        for (int i = 0; i < 8; ++i) {
            const int relr = rs + i - r + 7;
#pragma unroll
            for (int nb = 0; nb < 2; ++nb)
#pragma unroll
                for (int j = 0; j < 4; ++j) {
                    const int kc = kb0 + 8 * fq + 4 * nb + j;
                    const bool valid = (unsigned)(kc - cs) < 16u;
                    const int idx = valid ? relr * 31 + (kc - qc + 15) : 0;
                    const float v = valid ? s[i][nb][j] + rph[idx] : -INFINITY;
                    s[i][nb][j] = v; mx = fmaxf(mx, v);
                }
        }
        mx = fmaxf(mx, __shfl_xor(mx, 16)); mx = fmaxf(mx, __shfl_xor(mx, 32));
        float l = 0.f;
#pragma unroll
        for (int i = 0; i < 8; ++i)
#pragma unroll
            for (int nb = 0; nb < 2; ++nb)
#pragma unroll
                for (int j = 0; j < 4; ++j) { const float p = __expf(s[i][nb][j] - mx); s[i][nb][j] = p; l += p; }
        l += __shfl_xor(l, 16); l += __shfl_xor(l, 32);
        f32x4 o[8];
#pragma unroll
        for (int db = 0; db < 8; ++db) o[db] = (f32x4){0.f, 0.f, 0.f, 0.f};
#pragma unroll
        for (int i = 0; i < 8; ++i) {
            u32x4 pw; pw.x = cvt_pk(s[i][0][0], s[i][0][1]); pw.y = cvt_pk(s[i][0][2], s[i][0][3]); pw.z = cvt_pk(s[i][1][0], s[i][1][1]); pw.w = cvt_pk(s[i][1][2], s[i][1][3]);
            const bf16x8 pb = __builtin_bit_cast(bf16x8, pw);
            const bf16* vp = aa.VT + (size_t)(h * 128 + fr) * SEQ + (rs + i) * 64 + kb0 + 8 * fq;
#pragma unroll
            for (int db = 0; db < 8; ++db) { const bf16x8 vf = *(const bf16x8*)(vp + (size_t)(16 * db) * SEQ); o[db] = __builtin_amdgcn_mfma_f32_16x16x32_bf16(vf, pb, o[db], 0, 0, 0); }
        }
        const float inv = 1.f / l;
        bf16* op = aa.O + (size_t)(r * 64 + qc) * DM + h * 128 + 4 * fq;
#pragma unroll
        for (int db = 0; db < 8; ++db) { u32x2 wv; wv.x = cvt_pk(o[db][0] * inv, o[db][1] * inv); wv.y = cvt_pk(o[db][2] * inv, o[db][3] * inv); *(u32x2*)(op + 16 * db) = wv; }
    }
}

__device__ __forceinline__ void final_phase(float* out, const float* ss, const float* g, int G) {
    const int tid = opaque_tid(), lane = tid & 63, wave = tid >> 6;
    const int gw = blockIdx.x * NWAVES + wave, NGW = G * NWAVES;
    for (int row = gw; row < SEQ; row += NGW) {
        const float rs = pg8::rstd_row(ss, row);
        f32x4* o = (f32x4*)(out + (size_t)row * DM) + lane; const f32x4* gp = (const f32x4*)g + lane;
#pragma unroll
        for (int j = 0; j < 8; ++j) { f32x4 v = o[64 * j]; const f32x4 gv = gp[64 * j]; v = v * rs * gv; o[64 * j] = v; }
    }
}

#define XB_TMO      128
#define XB_XCNT(j)  (256  + 64 * (j))
#define XB_XSUB(j)  (1280 + 64 * (j))
#define XB_XGEN(j)  (2304 + 64 * (j))
#define XB_TOP      3328
#define XB_TOPGEN   3392
#define XCD_BAR_WORDS 3456
#define XB_SPIN_CAP (1u << 18)

__device__ __forceinline__ unsigned xb_ld(unsigned* p)              { return __hip_atomic_load(p, __ATOMIC_RELAXED, __HIP_MEMORY_SCOPE_AGENT); }
__device__ __forceinline__ unsigned xb_add(unsigned* p, unsigned v) { return __hip_atomic_fetch_add(p, v, __ATOMIC_RELAXED, __HIP_MEMORY_SCOPE_AGENT); }
__device__ __forceinline__ unsigned xb_xcc_id() { return (unsigned)__builtin_amdgcn_s_getreg((3 << 11) | 20) & 0xFu; }
#define XB_SPIN(cond, bar) do { unsigned _sp = 0; while (cond) { __builtin_amdgcn_s_sleep(1); \
    if ((++_sp & 255u) == 0u) { if (xb_ld(&(bar)[XB_TMO])) break; if (_sp > XB_SPIN_CAP) { atomicAdd(&(bar)[XB_TMO], 1u); break; } } } } while (0)

struct XcdBarrier {
    unsigned* bar; unsigned x;
    volatile LAS unsigned* st;
};

__device__ __forceinline__ XcdBarrier xcd_barrier_post(unsigned* bar, volatile LAS unsigned* st) {
    XcdBarrier b; b.bar = bar; b.x = xb_xcc_id(); b.st = st;
    if (threadIdx.x == 0) (void)xb_add(&bar[XB_XCNT(b.x)], 1u);
    return b;
}
__device__ __forceinline__ void xcd_barrier_complete(unsigned* bar, unsigned x, unsigned& nloc, unsigned& nx) {
    const unsigned G = gridDim.x * gridDim.y * gridDim.z;
    unsigned sum, cnt, mine, sp = 0u;
    for (;;) {
        sum = 0u; cnt = 0u; mine = 0u;
#pragma unroll
        for (unsigned j = 0; j < 16; ++j) { const unsigned c = xb_ld(&bar[XB_XCNT(j)]); sum += c; cnt += (c > 0u) ? 1u : 0u; mine = (j == x) ? c : mine; }
        if (sum == G) break;
        __builtin_amdgcn_s_sleep(1);
        if ((++sp & 255u) == 0u) { if (xb_ld(&bar[XB_TMO])) break; if (sp > XB_SPIN_CAP) { atomicAdd(&bar[XB_TMO], 1u); break; } }
    }
    nloc = mine > 0u ? mine : 1u; nx = cnt > 0u ? cnt : 1u;
}

__device__ __forceinline__ void xcd_barrier(const XcdBarrier& b) {
    asm volatile("s_waitcnt vmcnt(0)" ::: "memory");
    __syncthreads();
    if (threadIdx.x == 0) {
        unsigned* bar = b.bar;
        __builtin_amdgcn_s_waitcnt(0);
        unsigned nloc = b.st[0], nx = b.st[1];
        if (nloc == 0u) { xcd_barrier_complete(bar, b.x, nloc, nx); b.st[0] = nloc; b.st[1] = nx; }
        const unsigned old = xb_add(&bar[XB_XSUB(b.x)], 1u);
        const unsigned gen = old / nloc;
        if (old + 1u == (gen + 1u) * nloc) {
            __builtin_amdgcn_fence(__ATOMIC_RELEASE, "agent");
            asm volatile("s_waitcnt vmcnt(0)" ::: "memory");
            const unsigned og = xb_add(&bar[XB_TOP], 1u);
            const unsigned tg = og / nx;
            if (og + 1u == (tg + 1u) * nx) xb_add(&bar[XB_TOPGEN], 1u);
            else XB_SPIN(xb_ld(&bar[XB_TOPGEN]) == tg, bar);
            __builtin_amdgcn_fence(__ATOMIC_ACQUIRE, "agent");
            xb_add(&bar[XB_XGEN(b.x)], 1u);
            asm volatile("s_waitcnt vmcnt(0)" ::: "memory");
        } else {
            XB_SPIN(xb_ld(&bar[XB_XGEN(b.x)]) == gen, bar);
            __builtin_amdgcn_fence(__ATOMIC_ACQUIRE, "agent");
            asm volatile("s_waitcnt vmcnt(0)" ::: "memory");
        }
    }
    __syncthreads();
}

constexpr int N_PHASES = 28;
#ifndef DBG_DUMP_OFF
#define DBG_DUMP_OFF WS_BC
#endif
#ifndef DBG_NPH
#define DBG_NPH N_PHASES
#endif
#ifndef DBG_DUMP
#define DBG_DUMP 0
#endif
enum Kind { K_P0, K_WIN, K_S1, K_S2, K_WOUT, K_QKV, K_ATT, K_W1, K_W2, K_PLE, K_FINAL, K_DUMP };

__global__ void __launch_bounds__(NTHREADS, 2) mega_fwd(Args args) {
    extern __shared__ __attribute__((aligned(16))) unsigned char lds_raw[];
    LAS unsigned char* lds = (LAS unsigned char*)lds_raw;
    cg::grid_group grid = cg::this_grid();
    const int G = gridDim.x;
    KA ka0 = (KA)__builtin_amdgcn_kernarg_segment_ptr();
    const int lo = *(const int __attribute__((address_space(4)))*)(ka0 + 192), hi = *(const int __attribute__((address_space(4)))*)(ka0 + 196);
    if (hi - lo > 1) {
        volatile LAS unsigned* st = (volatile LAS unsigned*)(lds + 131072 + 64);
        if (threadIdx.x < 2) st[threadIdx.x] = 0u;
        __syncthreads();
        unsigned char* ws0 = *(unsigned char* const __attribute__((address_space(4)))*)(ka0 + 184);
        (void)xcd_barrier_post((unsigned*)(ws0 + WS_BAR), st);
    }
    if (hi > 100000) grid.sync();
    for (int ph = lo; ph < hi; ++ph) {
        KA ka = ka0; asm volatile("" : "+s"(ka));
        unsigned char* ws = *(unsigned char* const __attribute__((address_space(4)))*)(ka + 184);
        float* hout = *(float* const __attribute__((address_space(4)))*)(ka + 176);
        float* ss = (float*)(ws + WS_SS);
        int kind, L = 0;
        if (ph == 0) kind = K_P0; else if (ph == 99) kind = K_DUMP; else if (ph == N_PHASES - 1) kind = K_FINAL;
        else { int q = ph - 1; const int pair = q / 13; q -= pair * 13; L = 2 * pair;
            if (q < 7) { kind = (q == 0) ? K_WIN : (q == 1) ? K_S1 : (q == 2) ? K_S2 : (q == 3) ? K_WOUT : (q == 4) ? K_W1 : (q == 5) ? K_W2 : K_PLE; }
            else { q -= 7; L += 1; kind = (q == 0) ? K_QKV : (q == 1) ? K_ATT : (q == 2) ? K_WOUT : (q == 3) ? K_W1 : (q == 4) ? K_W2 : K_PLE; } }
        const int j = L >> 1;
        bf16* Xc = (bf16*)(ws + ((L & 1) ? WS_X1 : WS_X0));
        bf16* Xo = (bf16*)(ws + ((L & 1) ? WS_X0 : WS_X1));
        const float* ss_mix = ss + (size_t)(3 * L) * SEQ * 32; float* ss_mlp = ss + (size_t)(3 * L + 1) * SEQ * 32; float* ss_ple = ss + (size_t)(3 * L + 2) * SEQ * 32; float* ss_next = ss + (size_t)(3 * L + 3) * SEQ * 32;
        switch (kind) {
        case K_P0:
#ifndef DIS_P0
 p0_phase(lds, ka, ws, G);
#endif
 break;
        case K_WIN: {
#ifdef DBG_BJ0
            pg8::Gemm g{Xc, (const bf16*)(ws + WS_WINT), SEQ, 2 * DM, DM};
#elif defined(DBG_AX1)
            pg8::Gemm g{(L == 2) ? Xo : Xc, (const bf16*)(ws + WS_WINT) + (size_t)j * DM * 2 * DM, SEQ, 2 * DM, DM};
#else
            pg8::Gemm g{Xc, (const bf16*)(ws + WS_WINT) + (size_t)j * DM * 2 * DM, SEQ, 2 * DM, DM};
#endif
            pg8::StaticOrder S; S.init(SEQ, 2 * DM, G, (int)blockIdx.x);
#ifdef DBG_FRESHOUT
            pg8::EpiAct<0> E{(L == 2) ? (bf16*)(ws + WS_PROJ + 96 * MiB) : (bf16*)(ws + WS_BA), (bf16*)(ws + WS_BB), DM, DM, ss_mix};
#elif defined(DBG_SS0)
            pg8::EpiAct<0> E{(bf16*)(ws + WS_BA), (bf16*)(ws + WS_BB), DM, DM, ss};
#else
            pg8::EpiAct<0> E{(bf16*)(ws + WS_BA), (bf16*)(ws + WS_BB), DM, DM, ss_mix};
#endif
#ifndef DIS_ACT0
            pg8::gemm_phase<pg8::EpiAct<0>, pg8::StaticOrder, true, true>(lds, g, S, E);
#endif
        } break;
        case K_S1: case K_S2: {
            ScanArgs sa{(const bf16*)(ws + WS_BA), (const bf16*)(ws + WS_BB), (bf16*)(ws + WS_BC),
                        INP(7) + (size_t)j * 4 * DM, INP(8) + (size_t)j * DM,
                        (const bf16*)(ws + WS_GAT) + (size_t)j * 32 * 128 * 128, (const bf16*)(ws + WS_GXT) + (size_t)j * 32 * 128 * 128,
                        INP(10) + (size_t)j * 2 * DM, INP(12) + (size_t)j * 2 * DM, INP(13) + (size_t)j * 2 * DM,
                        (f32x2*)(ws + WS_AGG)};
            #ifndef DIS_SCAN
            if (kind == K_S1) scan_phase<false>(lds, sa, G); else scan_phase<true>(lds, sa, G);
#endif
        } break;
        case K_QKV: {
            {
                pg8::Gemm g{Xc, (const bf16*)(ws + WS_WQKVT) + (size_t)j * 3 * DM * DM, SEQ, 2 * DM, DM};
                pg8::StaticOrder S; S.init(SEQ, 2 * DM, G, (int)blockIdx.x);
                pg8::EpiAct<1> E{(bf16*)(ws + WS_BA), (bf16*)(ws + WS_BB), DM, DM, ss_mix};
#ifndef DIS_ACT1
                pg8::gemm_phase<pg8::EpiAct<1>, pg8::StaticOrder, true, true>(lds, g, S, E);
#endif
            }
            __syncthreads();
            {
                pg8::Gemm g{(const bf16*)(ws + WS_WQKVT) + (size_t)j * 3 * DM * DM + (size_t)2 * DM * DM, Xc, DM, SEQ, DM};
                pg8::StaticOrder S; S.init(DM, SEQ, G, (int)blockIdx.x);
                pg8::EpiAct<4> E{(bf16*)(ws + WS_BD), nullptr, SEQ, 0, ss_mix};
#ifndef DIS_ACT4
                pg8::gemm_phase<pg8::EpiAct<4>, pg8::StaticOrder, true, true>(lds, g, S, E);
#endif
            }
        } break;
        case K_ATT: {
            AttArgs aa{(const bf16*)(ws + WS_BA), (const bf16*)(ws + WS_BB), (const bf16*)(ws + WS_BD), (bf16*)(ws + WS_BC), INP(16) + (size_t)j * NHEAD * 465};
#ifndef DIS_ATT
            attn_phase(lds, aa, G);
#endif
        } break;
        case K_WOUT: case K_W2: {
            const bf16* A; const bf16* Bt; int K;
            float* sso; bf16* hb;
            if (kind == K_WOUT) { A = (const bf16*)(ws + WS_BC); K = DM; Bt = (L & 1) ? (const bf16*)(ws + WS_WONT) + (size_t)j * DM * DM : (const bf16*)(ws + WS_WORT) + (size_t)j * DM * DM; sso = ss_mlp; hb = Xo; }
            else { A = (const bf16*)(ws + WS_A1); K = DFF; Bt = (const bf16*)(ws + WS_W2T) + (size_t)L * DM * DFF; sso = ss_ple; hb = Xc; }
            const float* base = (kind == K_WOUT && L == 0) ? INP(0) : hout;
            pg8::Gemm g{A, Bt, SEQ, DM, K};
            pg8::StaticOrder S; S.init(SEQ, DM, G, (int)blockIdx.x);
            pg8::EpiRes<0> E{base, hout, hb, sso, nullptr, nullptr};
#ifndef DIS_RES0
            pg8::gemm_phase<pg8::EpiRes<0>, pg8::StaticOrder, true, true>(lds, g, S, E);
#endif
        } break;
        case K_W1: {
            {
                int Kp = PLE; asm volatile("" : "+s"(Kp));
                pg8::Gemm g{(const bf16*)(ws + WS_PB) + (size_t)L * SEQ * PLE, (const bf16*)(ws + WS_WPT) + (size_t)L * DM * PLE, SEQ, DM, Kp};
                pg8::StaticOrder S; S.init(SEQ, DM, G, (int)blockIdx.x);
                pg8::EpiAct<3> E{(bf16*)(ws + WS_PROJ) + (size_t)L * SEQ * DM, nullptr, DM, 0, nullptr};
#ifndef DIS_ACT3
                pg8::gemm_phase<pg8::EpiAct<3>, pg8::StaticOrder, true, true>(lds, g, S, E);
#endif
            }
            __syncthreads();
            pg8::Gemm g{Xo, (const bf16*)(ws + WS_W1T) + (size_t)L * DM * DFF, SEQ, DFF, DM};
            pg8::StaticOrder S; S.init(SEQ, DFF, G, (int)blockIdx.x);
            pg8::EpiAct<2> E{(bf16*)(ws + WS_A1), nullptr, DFF, 0, ss_mlp};
#ifndef DIS_ACT2
            pg8::gemm_phase<pg8::EpiAct<2>, pg8::StaticOrder, true, true>(lds, g, S, E);
#endif
        } break;
        case K_PLE: {
            pg8::Gemm g{Xc, (const bf16*)(ws + WS_WGT) + (size_t)L * DM * DM, SEQ, DM, DM};
            pg8::StaticOrder S; S.init(SEQ, DM, G, (int)blockIdx.x);
            pg8::EpiRes<1> E{hout, hout, Xo, ss_next, ss_ple, (const bf16*)(ws + WS_PROJ) + (size_t)L * SEQ * DM};
#ifndef DIS_RES1
            pg8::gemm_phase<pg8::EpiRes<1>, pg8::StaticOrder, true, true>(lds, g, S, E);
#endif
        } break;
        case K_DUMP: {
            const bf16* src = (const bf16*)(ws + DBG_DUMP_OFF); const float* srcf = (const float*)(ws + DBG_DUMP_OFF);
            for (size_t i = (size_t)blockIdx.x * NTHREADS + threadIdx.x; i < (size_t)SEQ * DM; i += (size_t)G * NTHREADS) hout[i] = (DBG_DUMP == 2) ? srcf[i & 8191] : bfl((unsigned)src[i]);
        } break;
        case K_FINAL: final_phase(hout, ss + (size_t)12 * SEQ * 32, INP(5), G); break;
        }
        if (ph + 1 < hi) { XcdBarrier b; b.bar = (unsigned*)(ws + WS_BAR); b.x = xb_xcc_id(); b.st = (volatile LAS unsigned*)(lds + 131072 + 64); xcd_barrier(b); }
    }
}

#ifndef MK_MULTI
#define MK_MULTI 0
#endif

extern "C" void kernel_launch(void* const* d_in, const int* in_sizes, int n_in, void* d_out, int out_size, void* d_ws, size_t ws_size, hipStream_t stream) {
    static int grid = 0;
    if (grid == 0) {
        if (n_in != 22 || out_size != SEQ * DM || ws_size < WS_END) { fprintf(stderr, "kernel_launch: unexpected shapes (n_in %d out %d ws %zu)\n", n_in, out_size, ws_size); grid = -1; return; }
        int dev = 0, cus = 0, per_cu = 0;
        (void)hipGetDevice(&dev); (void)hipDeviceGetAttribute(&cus, hipDeviceAttributeMultiprocessorCount, dev);
        if (hipFuncSetAttribute((const void*)mega_fwd, hipFuncAttributeMaxDynamicSharedMemorySize, LDS_BYTES) != hipSuccess) { fprintf(stderr, "kernel_launch: hipFuncSetAttribute failed\n"); grid = -1; return; }
        if (hipOccupancyMaxActiveBlocksPerMultiprocessor(&per_cu, (const void*)mega_fwd, NTHREADS, LDS_BYTES) != hipSuccess || per_cu < 1) { fprintf(stderr, "kernel_launch: occupancy query says %d\n", per_cu); per_cu = 1; }
        (void)hipGetLastError();
        grid = cus * per_cu; if (grid > 256) grid = 256;
        fprintf(stderr, "kernel_launch: grid %d (cus %d per_cu %d)\n", grid, cus, per_cu);
    }
    if (grid < 0) return;
    Args a{};
    for (int i = 0; i < 22; ++i) a.in[i] = (const float*)d_in[i];
    a.out = (float*)d_out; a.ws = (unsigned char*)d_ws;
#if MK_MULTI
#ifdef DBG_SEQ
    { const int seq[] = {DBG_SEQ}; for (int ph : seq) { a.ph_lo = ph; a.ph_hi = ph + 1; hipLaunchKernelGGL(mega_fwd, dim3(grid), dim3(NTHREADS), LDS_BYTES, stream, a); } }
#else
    for (int ph = 0; ph < DBG_NPH; ++ph) { a.ph_lo = ph; a.ph_hi = ph + 1; hipLaunchKernelGGL(mega_fwd, dim3(grid), dim3(NTHREADS), LDS_BYTES, stream, a); }
#endif
    if (DBG_DUMP) { a.ph_lo = 99; a.ph_hi = 100; hipLaunchKernelGGL(mega_fwd, dim3(grid), dim3(NTHREADS), LDS_BYTES, stream, a); }
#else
    a.ph_lo = 0; a.ph_hi = N_PHASES;
    if (hipMemsetAsync((char*)d_ws + WS_BAR, 0, 16384, stream) != hipSuccess) { fprintf(stderr, "kernel_launch: memset of the barrier words failed\n"); return; }
    void* kargs[] = {&a};
    hipError_t e = hipLaunchCooperativeKernel((const void*)mega_fwd, dim3(grid), dim3(NTHREADS), kargs, LDS_BYTES, stream);
    if (e != hipSuccess) fprintf(stderr, "kernel_launch: cooperative launch failed: %s (grid %d)\n", hipGetErrorString(e), grid);
#endif
}
```

```cpp
#include <hip/hip_runtime.h>
#include <hip/hip_cooperative_groups.h>
#include <cstdio>
#include <cstdint>
namespace cg = cooperative_groups;
namespace pg8 {
#define PG8_LAS __attribute__((address_space(3)))
typedef unsigned short bf16_t;
typedef short bf16x8 __attribute__((ext_vector_type(8)));
typedef float f32x4 __attribute__((ext_vector_type(4)));
typedef unsigned u32x4 __attribute__((ext_vector_type(4)));
constexpr int BM = 256, BK = 64, HALF = 128, HTB = HALF * BK * 2  , STAGE_BYTES = 8 * HTB, NXCD = 8, WGM = 8;

__host__ __device__ __forceinline__ int lds_byte(int r, int c) { const int st = (r >> 4) * 2 + (c >> 5), rr = r & 15, cc = c & 31, ob = rr * 64 + cc * 2; return st * 1024 + (ob ^ (((ob >> 9) & 1) << 5)); }
__host__ __device__ __forceinline__ void stage_rc(int b, int& R, int& C) { const int st = b / 1024, sb = b % 1024, swz = sb ^ (((sb >> 9) & 1) << 5); R = (st >> 1) * 16 + swz / 64; C = (st & 1) * 32 + (swz % 64) / 2; }
__host__ __device__ __forceinline__ int perm32(int rho) { const int n = rho >> 4, i = rho & 15; return 8 * (i >> 2) + 4 * n + (i & 3); }

struct Unit { int pm, pn; };
struct Gemm { const bf16_t* A; const bf16_t* Bt; int M, N, K; };

struct StaticOrder {
    int nM, nN, nwg, G, c;
    __host__ __device__ void init(int M, int N, int G_, int c_) { nM = M / BM; nN = N / BM; nwg = nM * nN; G = G_; c = c_; }
    __host__ __device__ bool next(int i, Unit& u) const {
        const long L = (long)i * G + c; if (L >= nwg) return false;
        int wgid = (int)L; { const int q = nwg / NXCD, r = nwg % NXCD, xcd = wgid % NXCD, off = wgid / NXCD; wgid = (xcd < r ? xcd * (q + 1) : r * (q + 1) + (xcd - r) * q) + off; }
        const int nig = WGM * nN, gid = wgid / nig, fm = gid * WGM, gsz = (nM - fm) < WGM ? (nM - fm) : WGM;
        u.pm = fm + ((wgid % nig) % gsz); u.pn = (wgid % nig) / gsz; return true;
    }
    __device__ __forceinline__ void a_ready(const Unit&) const {}
    __device__ __forceinline__ void done(const Unit&) const {}
};

__device__ __forceinline__ unsigned cvt_pk_bf16(float lo, float hi) { unsigned r; asm volatile("v_cvt_pk_bf16_f32 %0, %1, %2" : "=v"(r) : "v"(lo), "v"(hi)); return r; }
typedef float f32x2 __attribute__((ext_vector_type(2)));
constexpr float RMS_EPS = 1e-6f;
constexpr int DM = 2048;
__device__ __forceinline__ float fsigmoid(float x) { return __builtin_amdgcn_rcpf(1.f + __expf(-x)); }
__device__ __forceinline__ float gelu_tanh(float v) { return v * fsigmoid(1.5957691216057308f * (v + 0.044715f * v * v * v)); }
__device__ __forceinline__ float rstd_row(const float* ssp, int row) {
    const f32x4* p = (const f32x4*)(ssp + (size_t)row * 32); float s = 0.f;
#pragma unroll
    for (int i = 0; i < 8; ++i) { const f32x4 v = p[i]; s += (v[0] + v[1]) + (v[2] + v[3]); }
    return rsqrtf(s * (1.f / DM) + RMS_EPS);
}
__device__ __forceinline__ float bf_lo(unsigned w) { return __uint_as_float(w << 16); }
__device__ __forceinline__ float bf_hi(unsigned w) { return __uint_as_float(w & 0xffff0000u); }

template <int MODE> struct EpiAct {
    static constexpr bool PERM = true, AFTER_DRAIN = false;
    bf16_t* O0; bf16_t* O1; int ldc; int split; const float* ss;
    __device__ __forceinline__ void operator()(const f32x4 (&acc)[2][2][4][2], const Unit& u, int wr, int wc, int fr, int fq) const {
        const int row0 = u.pm * BM + wr * 64 + fr; int colt = u.pn * BM; bf16_t* base = O0; bool second = false;
        if (MODE <= 1) { if (colt >= split) { base = O1; colt -= split; second = true; } }
        const int col0 = colt + wc * 32 + 8 * fq;
        f32x4 cs[2][2];
        if (MODE == 4) {
#pragma unroll
            for (int bj = 0; bj < 2; ++bj)
#pragma unroll
                for (int n = 0; n < 2; ++n) {
#pragma unroll
                    for (int e = 0; e < 4; ++e) cs[bj][n][e] = rstd_row(ss, col0 + bj * HALF + 4 * n + e); }
        }
#pragma unroll
        for (int ai = 0; ai < 2; ++ai)
#pragma unroll
            for (int m = 0; m < 4; ++m) {
                const int row = row0 + ai * HALF + m * 16;
                float rs = 1.f;
                if (MODE <= 2) { rs = rstd_row(ss, row); if (MODE == 1 && !second) rs *= 0.08838834764831845f; }
                bf16_t* rowp = base + (size_t)row * ldc + col0;
#pragma unroll
                for (int bj = 0; bj < 2; ++bj) {
                    f32x4 v0 = acc[ai][bj][m][0], v1 = acc[ai][bj][m][1];
                    if (MODE == 4) { v0 = v0 * cs[bj][0]; v1 = v1 * cs[bj][1]; } else { v0 = v0 * rs; v1 = v1 * rs; }
                    if (MODE == 0) { if (second) {
#pragma unroll
                        for (int e = 0; e < 4; ++e) { v0[e] = gelu_tanh(v0[e]); v1[e] = gelu_tanh(v1[e]); } } }
                    if (MODE == 2) {
#pragma unroll
                        for (int e = 0; e < 4; ++e) { const float a = fmaxf(v0[e], 0.f), b = fmaxf(v1[e], 0.f); v0[e] = a * a; v1[e] = b * b; } }
                    u32x4 w; w.x = cvt_pk_bf16(v0[0], v0[1]); w.y = cvt_pk_bf16(v0[2], v0[3]); w.z = cvt_pk_bf16(v1[0], v1[1]); w.w = cvt_pk_bf16(v1[2], v1[3]);
                    *(u32x4*)(rowp + bj * HALF) = w;
                }
            }
    }
};

template <int MODE> struct EpiRes {
    static constexpr bool PERM = true, AFTER_DRAIN = false;
    const float* base; float* out; bf16_t* hb; float* ss_out; const float* ss_in; const bf16_t* proj;
    __device__ __forceinline__ void operator()(const f32x4 (&acc)[2][2][4][2], const Unit& u, int wr, int wc, int fr, int fq) const {
        const int row0 = u.pm * BM + wr * 64 + fr; const int col0 = u.pn * BM + wc * 32 + 8 * fq;
#pragma unroll
        for (int ai = 0; ai < 2; ++ai)
#pragma unroll
            for (int m = 0; m < 4; ++m) {
                const int row = row0 + ai * HALF + m * 16; const size_t off = (size_t)row * DM + col0;
                float rs = 0.f; if (MODE == 1) rs = rstd_row(ss_in, row);
                float sq = 0.f;
#pragma unroll
                for (int bj = 0; bj < 2; ++bj) {
                    const f32x4 b0 = *(const f32x4*)(base + off + bj * HALF), b1 = *(const f32x4*)(base + off + bj * HALF + 4);
                    f32x4 v0 = acc[ai][bj][m][0], v1 = acc[ai][bj][m][1];
                    if (MODE == 1) {
                        const u32x4 pw = *(const u32x4*)(proj + off + bj * HALF);
                        const f32x4 p0 = (f32x4){bf_lo(pw.x), bf_hi(pw.x), bf_lo(pw.y), bf_hi(pw.y)}, p1 = (f32x4){bf_lo(pw.z), bf_hi(pw.z), bf_lo(pw.w), bf_hi(pw.w)};
#pragma unroll
                        for (int e = 0; e < 4; ++e) { v0[e] = fsigmoid(v0[e] * rs) * p0[e]; v1[e] = fsigmoid(v1[e] * rs) * p1[e]; }
                    }
                    const f32x4 o0 = b0 + v0, o1 = b1 + v1;
                    *(f32x4*)(out + off + bj * HALF) = o0; *(f32x4*)(out + off + bj * HALF + 4) = o1;
                    u32x4 w; w.x = cvt_pk_bf16(o0[0], o0[1]); w.y = cvt_pk_bf16(o0[2], o0[3]); w.z = cvt_pk_bf16(o1[0], o1[1]); w.w = cvt_pk_bf16(o1[2], o1[3]);
                    *(u32x4*)(hb + off + bj * HALF) = w;
                    sq += (o0[0] * o0[0] + o0[1] * o0[1]) + (o0[2] * o0[2] + o0[3] * o0[3]) + (o1[0] * o1[0] + o1[1] * o1[1]) + (o1[2] * o1[2] + o1[3] * o1[3]);
                }
                sq += __shfl_xor(sq, 16); sq += __shfl_xor(sq, 32);
                if (fq == 0) ss_out[(size_t)row * 32 + u.pn * 4 + wc] = sq;
            }
    }
};

template <class Epi, class Sched, bool ALIGN_EPI = false, bool SP2 = false>
__device__ __forceinline__ void gemm_phase(PG8_LAS unsigned char* lds, const Gemm g, const Sched& S, const Epi& E) {
    int tid_ = threadIdx.x; asm volatile("" : "+v"(tid_)); const int tid = tid_, wid = __builtin_amdgcn_readfirstlane(tid >> 6), lane = tid & 63, wr = wid >> 2, wc = wid & 3, fr = lane & 15, fq = lane >> 4;
    const int K = g.K, nt = K / BK;
    unsigned voffA[2], voffB[2];
#pragma unroll
    for (int i = 0; i < 2; ++i) { int R, C; stage_rc(tid * 16 + i * 8192, R, C); const int Rb = Epi::PERM ? ((R & ~31) + perm32(R & 31)) : R;
        voffA[i] = (unsigned)(R * K + C) * 2u; voffB[i] = (unsigned)(Rb * K + C) * 2u; }
    const size_t kstep = (size_t)(BK * 2);
    const size_t hstep = (size_t)HALF * K * 2;
    const size_t tstep = 2 * hstep;
    const unsigned ldsw = (unsigned)wid * 1024u;
    const int aoff = lds_byte(wr * 64 + fr, fq * 8), boff = lds_byte(wc * 32 + fr, fq * 8);
#define PG8_SA(b, h) (((b) * 2 + (h)) * HTB)
#define PG8_SB(b, h) ((4 + (b) * 2 + (h)) * HTB)
#define PG8_STAGE(bufoff, gbase, voff) do { _Pragma("unroll") for (int _i = 0; _i < 2; ++_i) \
        __builtin_amdgcn_global_load_lds((const unsigned*)((const char*)(gbase) + (voff)[_i]), (PG8_LAS unsigned*)(lds + (bufoff) + ldsw + _i * 8192), 16, 0, 0); } while (0)
#define PG8_LDA(dst, b, h) do { _Pragma("unroll") for (int m = 0; m < 4; ++m) _Pragma("unroll") for (int k = 0; k < 2; ++k) dst[m][k] = *(const PG8_LAS bf16x8*)(lds + PG8_SA(b, h) + aoff + m * 2048 + k * 1024); } while (0)
#define PG8_LDB(dst, b, h) do { _Pragma("unroll") for (int n = 0; n < 2; ++n) _Pragma("unroll") for (int k = 0; k < 2; ++k) dst[n][k] = *(const PG8_LAS bf16x8*)(lds + PG8_SB(b, h) + boff + n * 2048 + k * 1024); } while (0)
#define PG8_MMA(ai, bj, At, Bt) do { __builtin_amdgcn_s_setprio(1); _Pragma("unroll") for (int m = 0; m < 4; ++m) _Pragma("unroll") for (int n = 0; n < 2; ++n) _Pragma("unroll") for (int k = 0; k < 2; ++k) \
        acc[ai][bj][m][n] = __builtin_amdgcn_mfma_f32_16x16x32_bf16(Bt[n][k], At[m][k], acc[ai][bj][m][n], 0, 0, 0); __builtin_amdgcn_s_setprio(0); } while (0)
#define PG8_WAIT_V(n) asm volatile("s_waitcnt vmcnt(" #n ")" ::: "memory")
#define PG8_WAIT_L(n) asm volatile("s_waitcnt lgkmcnt(" #n ")" ::: "memory")
#define PG8_BAR __builtin_amdgcn_s_barrier()
#define PG8_SCHED __builtin_amdgcn_sched_barrier(0)
    Unit cur, nxt; int ui = 0;
    if (!S.next(0, cur)) return;
    f32x4 acc[2][2][4][2];
#pragma unroll
    for (int a = 0; a < 2; ++a)
#pragma unroll
        for (int b = 0; b < 2; ++b)
#pragma unroll
            for (int m = 0; m < 4; ++m)
#pragma unroll
                for (int n = 0; n < 2; ++n) acc[a][b][m][n] = (f32x4){0.f, 0.f, 0.f, 0.f};
    bf16x8 At[4][2], B0[2][2], B1[2][2];
    const char* cA = (const char*)g.A + (size_t)cur.pm * tstep; const char* cB = (const char*)g.Bt + (size_t)cur.pn * tstep;
    S.a_ready(cur);
    if constexpr (SP2) {
        PG8_STAGE(PG8_SB(0, 0), cB, voffB); PG8_STAGE(PG8_SB(0, 1), cB + hstep, voffB); PG8_STAGE(PG8_SA(0, 0), cA, voffA); PG8_STAGE(PG8_SA(0, 1), cA + hstep, voffA);
        if (wr == 1) PG8_BAR;
        PG8_WAIT_V(2); PG8_BAR;
        PG8_STAGE(PG8_SB(1, 0), cB + kstep, voffB); PG8_STAGE(PG8_SA(1, 0), cA + kstep, voffA); PG8_STAGE(PG8_SB(1, 1), cB + hstep + kstep, voffB);
        PG8_WAIT_V(6); PG8_BAR;
    } else {
        PG8_STAGE(PG8_SB(0, 0), cB, voffB); PG8_STAGE(PG8_SA(0, 0), cA, voffA); PG8_STAGE(PG8_SB(0, 1), cB + hstep, voffB); PG8_STAGE(PG8_SA(0, 1), cA + hstep, voffA);
        if (wr == 1) PG8_BAR;
        PG8_WAIT_V(4); PG8_BAR;
        PG8_STAGE(PG8_SB(1, 0), cB + kstep, voffB); PG8_STAGE(PG8_SA(1, 0), cA + kstep, voffA); PG8_STAGE(PG8_SB(1, 1), cB + hstep + kstep, voffB);
        PG8_WAIT_V(6); PG8_BAR;
    }
    for (;;) {
        const bool has_next = S.next(ui + 1, nxt);
        const char* nA = has_next ? (const char*)g.A + (size_t)nxt.pm * tstep : cA; const char* nB = has_next ? (const char*)g.Bt + (size_t)nxt.pn * tstep : cB;
        for (int t = 0; t < nt; t += 2) {
            const bool last = (t == nt - 2);
            const char* a1 = cA + (size_t)(t + 1) * kstep;
            const char* a2 = last ? nA : cA + (size_t)(t + 2) * kstep; const char* b2 = last ? nB : cB + (size_t)(t + 2) * kstep;
            const char* a3 = a2 + kstep; const char* b3 = b2 + kstep;
            if (last && has_next) S.a_ready(nxt);
            if constexpr (SP2) {
            PG8_LDB(B0, 0, 0); PG8_LDB(B1, 0, 1); PG8_SCHED; PG8_LDA(At, 0, 0); PG8_STAGE(PG8_SA(1, 1), a1 + hstep, voffA);
            PG8_WAIT_V(8); PG8_WAIT_L(0); PG8_BAR; PG8_MMA(0, 0, At, B0); PG8_MMA(0, 1, At, B1); PG8_BAR; PG8_SCHED;
            PG8_LDA(At, 0, 1); PG8_STAGE(PG8_SB(0, 0), b2, voffB); PG8_STAGE(PG8_SB(0, 1), b2 + hstep, voffB); PG8_STAGE(PG8_SA(0, 0), a2, voffA);
            PG8_WAIT_V(8); PG8_WAIT_L(0); PG8_BAR; PG8_MMA(1, 0, At, B0); PG8_MMA(1, 1, At, B1); PG8_BAR; PG8_SCHED;
            PG8_LDB(B0, 1, 0); PG8_LDB(B1, 1, 1); PG8_SCHED; PG8_LDA(At, 1, 0); PG8_STAGE(PG8_SA(0, 1), a2 + hstep, voffA);
            PG8_WAIT_V(8); PG8_WAIT_L(0); PG8_BAR; PG8_MMA(0, 0, At, B0); PG8_MMA(0, 1, At, B1); PG8_BAR; PG8_SCHED;
            PG8_LDA(At, 1, 1); PG8_STAGE(PG8_SB(1, 0), b3, voffB); PG8_STAGE(PG8_SB(1, 1), b3 + hstep, voffB); PG8_STAGE(PG8_SA(1, 0), a3, voffA);
            PG8_WAIT_V(8); PG8_WAIT_L(0); PG8_BAR; PG8_MMA(1, 0, At, B0); PG8_MMA(1, 1, At, B1); PG8_BAR; PG8_SCHED;
            } else {
            PG8_LDB(B0, 0, 0); PG8_SCHED; PG8_LDA(At, 0, 0); PG8_STAGE(PG8_SA(1, 1), a1 + hstep, voffA);
            PG8_WAIT_L(8); PG8_BAR; PG8_WAIT_L(0); PG8_MMA(0, 0, At, B0); PG8_BAR; PG8_SCHED;
            PG8_LDB(B1, 0, 1); PG8_STAGE(PG8_SB(0, 0), b2, voffB);
            PG8_BAR; PG8_WAIT_L(0); PG8_MMA(0, 1, At, B1); PG8_BAR;
            PG8_LDA(At, 0, 1); PG8_STAGE(PG8_SA(0, 0), a2, voffA);
            PG8_BAR; PG8_WAIT_L(0); PG8_MMA(1, 0, At, B0); PG8_BAR; PG8_SCHED;
            PG8_STAGE(PG8_SB(0, 1), b2 + hstep, voffB);
            PG8_WAIT_V(6); PG8_BAR; PG8_MMA(1, 1, At, B1); PG8_BAR;
            PG8_LDB(B0, 1, 0); PG8_SCHED; PG8_LDA(At, 1, 0); PG8_STAGE(PG8_SA(0, 1), a2 + hstep, voffA);
            PG8_WAIT_L(8); PG8_BAR; PG8_WAIT_L(0); PG8_MMA(0, 0, At, B0); PG8_BAR; PG8_SCHED;
            PG8_LDB(B1, 1, 1); PG8_STAGE(PG8_SB(1, 0), b3, voffB);
            PG8_BAR; PG8_WAIT_L(0); PG8_MMA(0, 1, At, B1); PG8_BAR;
            PG8_LDA(At, 1, 1); PG8_STAGE(PG8_SA(1, 0), a3, voffA);
            PG8_BAR; PG8_WAIT_L(0); PG8_MMA(1, 0, At, B0); PG8_BAR; PG8_SCHED;
            PG8_STAGE(PG8_SB(1, 1), b3 + hstep, voffB);
            PG8_WAIT_V(6); PG8_BAR; PG8_MMA(1, 1, At, B1); PG8_BAR;
            }
        }
        if constexpr (ALIGN_EPI) { if (wr == 0) PG8_BAR; }
        if constexpr (!Epi::AFTER_DRAIN) { E(acc, cur, wr, wc, fr, fq); S.done(cur); }
        if (!has_next) break;
#pragma unroll
        for (int a = 0; a < 2; ++a)
#pragma unroll
            for (int b = 0; b < 2; ++b)
#pragma unroll
                for (int m = 0; m < 4; ++m)
#pragma unroll
                    for (int n = 0; n < 2; ++n) acc[a][b][m][n] = (f32x4){0.f, 0.f, 0.f, 0.f};
        cur = nxt; cA = nA; cB = nB; ++ui;
        if constexpr (ALIGN_EPI) { if (wr == 1) PG8_BAR; }
    }
    PG8_WAIT_V(0);
    if constexpr (!ALIGN_EPI) { if (wr == 0) PG8_BAR; }
    PG8_BAR;
    if constexpr (Epi::AFTER_DRAIN) { E.fused(acc, cur, wr, wc, fr, fq, lds, wid, lane); S.done(cur); }
#undef PG8_SA
#undef PG8_SB
#undef PG8_STAGE
#undef PG8_LDA
#undef PG8_LDB
#undef PG8_MMA
#undef PG8_WAIT_V
#undef PG8_WAIT_L
#undef PG8_BAR
#undef PG8_SCHED
}
}

constexpr int SEQ = 8192, DM = 2048, DFF = 8192, PLE = 256, DEPTH = 4, NHEAD = 16, HD = 128;
constexpr int NWAVES = 8, NTHREADS = 512;
constexpr int LDS_BYTES = 147456;
typedef unsigned short bf16;
typedef unsigned u32x4 __attribute__((ext_vector_type(4)));
typedef unsigned u32x2 __attribute__((ext_vector_type(2)));
typedef float f32x4 __attribute__((ext_vector_type(4)));
typedef float f32x2 __attribute__((ext_vector_type(2)));
typedef short bf16x8 __attribute__((ext_vector_type(8)));
#define LAS __attribute__((address_space(3)))
#define LDS_WAIT() asm volatile("s_waitcnt lgkmcnt(0)" ::: "memory")

constexpr size_t MiB = 1u << 20;
constexpr size_t WS_SS = 880 * MiB;
constexpr size_t WS_BAR = 0;
constexpr size_t WS_AGG = 2 * MiB;
constexpr size_t WS_X0 = 8 * MiB, WS_X1 = 40 * MiB;
constexpr size_t WS_BA = 72 * MiB, WS_BB = 104 * MiB, WS_BC = 136 * MiB, WS_BD = 168 * MiB;
constexpr size_t WS_A1 = 200 * MiB;
constexpr size_t WS_PROJ = 328 * MiB;
constexpr size_t WS_PB = 456 * MiB;
constexpr size_t WS_W1T = 472 * MiB, WS_W2T = 600 * MiB, WS_WGT = 728 * MiB, WS_WPT = 760 * MiB, WS_WINT = 764 * MiB, WS_WORT = 796 * MiB,
                 WS_GAT = 812 * MiB, WS_GXT = 814 * MiB, WS_WQKVT = 816 * MiB, WS_WONT = 864 * MiB, WS_END = 893 * MiB;

struct Args {
    const float* in[22];
    float* out; unsigned char* ws;
    int ph_lo, ph_hi;
};
static_assert(sizeof(Args) == 200 && offsetof(Args, out) == 176 && offsetof(Args, ws) == 184 && offsetof(Args, ph_lo) == 192, "Args layout");

typedef const unsigned char __attribute__((address_space(4)))* KA;
#define INP(k) (*(const float* const __attribute__((address_space(4)))*)(ka + 8 * (k)))
__device__ __forceinline__ int opaque_tid() { int t = threadIdx.x; asm volatile("" : "+v"(t)); return t; }
__device__ __forceinline__ unsigned cvt_pk(float lo, float hi) { return pg8::cvt_pk_bf16(lo, hi); }
__device__ __forceinline__ float bfl(unsigned w) { return __uint_as_float(w << 16); }
__device__ __forceinline__ float bfh(unsigned w) { return __uint_as_float(w & 0xffff0000u); }
__device__ __forceinline__ float wave_sum(float v) {
#pragma unroll
    for (int o = 1; o < 64; o <<= 1) v += __shfl_xor(v, o);
    return v;
}

__device__ __forceinline__ void transpose_item(const float* W, int K, int N, const float* g, bf16* WT, int kb, int nb, int lane) {
    const int q = lane >> 4, ln = lane & 15;
    const int kbase = 64 * kb + 16 * q, n = 64 * nb + 4 * ln;
    f32x4 v[16];
    const float* wp = W + (size_t)kbase * N + n;
#pragma unroll
    for (int i = 0; i < 16; ++i) v[i] = *(const f32x4*)(wp + (size_t)i * N);
    if (g) {
#pragma unroll
        for (int i4 = 0; i4 < 4; ++i4) { const f32x4 gv = *(const f32x4*)(g + kbase + 4 * i4);
#pragma unroll
            for (int e = 0; e < 4; ++e) v[4 * i4 + e] = v[4 * i4 + e] * gv[e]; }
    }
#pragma unroll
    for (int e = 0; e < 4; ++e) {
        bf16* op = WT + (size_t)(n + e) * K + kbase;
#pragma unroll
        for (int h = 0; h < 2; ++h) {
            u32x4 o; o.x = cvt_pk(v[8 * h + 0][e], v[8 * h + 1][e]); o.y = cvt_pk(v[8 * h + 2][e], v[8 * h + 3][e]); o.z = cvt_pk(v[8 * h + 4][e], v[8 * h + 5][e]); o.w = cvt_pk(v[8 * h + 6][e], v[8 * h + 7][e]);
            *(u32x4*)(op + 8 * h) = o;
        }
    }
}

__device__ __forceinline__ void p0_phase(LAS unsigned char* lds, KA ka, unsigned char* ws, int G) {
    const int tid = opaque_tid(), lane = tid & 63, wave = tid >> 6;
    const int gw = blockIdx.x * NWAVES + wave, NGW = G * NWAVES;
    float* ss = (float*)(ws + WS_SS);
    {
        const float* x = INP(0); bf16* X0 = (bf16*)(ws + WS_X0);
        for (int row = gw; row < SEQ; row += NGW) {
            const f32x4* xr = (const f32x4*)(x + (size_t)row * DM) + lane; float s = 0.f;
            u32x2* o = (u32x2*)(X0 + (size_t)row * DM) + lane;
#pragma unroll
            for (int j = 0; j < 8; ++j) { const f32x4 v = xr[64 * j]; s += (v[0] * v[0] + v[1] * v[1]) + (v[2] * v[2] + v[3] * v[3]); u32x2 w; w.x = cvt_pk(v[0], v[1]); w.y = cvt_pk(v[2], v[3]); o[64 * j] = w; }
            s = wave_sum(s);
            if (lane < 32) ss[(size_t)row * 32 + lane] = (lane == 0) ? s : 0.f;
        }
    }
    {
        const f32x4* p = (const f32x4*)INP(1); u32x2* o = (u32x2*)(ws + WS_PB);
        const int n4 = DEPTH * SEQ * PLE / 4;
        for (int i = blockIdx.x * NTHREADS + tid; i < n4; i += G * NTHREADS) { const f32x4 v = p[i]; u32x2 w; w.x = cvt_pk(v[0], v[1]); w.y = cvt_pk(v[2], v[3]); o[i] = w; }
    }
    const int nitems_total =
        4 * (2048 / 64) * (8192 / 64) + 4 * (8192 / 64) * (2048 / 64) + 4 * (2048 / 64) * (2048 / 64) + 4 * (256 / 64) * (2048 / 64) +
        2 * (2048 / 64) * (4096 / 64) + 2 * (2048 / 64) * (2048 / 64) + 64 * (128 / 64) * (128 / 64) + 64 * (128 / 64) * (128 / 64) +
        2 * (2048 / 64) * (6144 / 64) + 2 * (2048 / 64) * (2048 / 64);
    for (int it = gw; it < nitems_total; it += NGW) {
        int r = it;
#define CONV_TRY(Wp, nmat, K, N, gp, gstride, WTp) { const int ipm = ((K) / 64) * ((N) / 64); const int tot = (nmat) * ipm; \
            if (r < tot) { const int mat = r / ipm, rr = r % ipm, kb = rr / ((N) / 64), nb = rr % ((N) / 64); const float* g_ = (gp); \
                transpose_item((Wp) + (size_t)mat * (K) * (N), (K), (N), g_ ? g_ + (size_t)mat * (gstride) : nullptr, (bf16*)(ws + (WTp)) + (size_t)mat * (K) * (N), kb, nb, lane); continue; } r -= tot; }
        CONV_TRY(INP(18), 4, 2048, 8192, INP(3), 2048, WS_W1T)
        CONV_TRY(INP(19), 4, 8192, 2048, (const float*)nullptr, 0, WS_W2T)
        CONV_TRY(INP(20), 4, 2048, 2048, INP(4), 2048, WS_WGT)
        CONV_TRY(INP(21), 4, 256, 2048, (const float*)nullptr, 0, WS_WPT)
        CONV_TRY(INP(6), 2, 2048, 4096, INP(2), 4096, WS_WINT)
        CONV_TRY(INP(14), 2, 2048, 2048, (const float*)nullptr, 0, WS_WORT)
        CONV_TRY(INP(9), 64, 128, 128, (const float*)nullptr, 0, WS_GAT)
        CONV_TRY(INP(11), 64, 128, 128, (const float*)nullptr, 0, WS_GXT)
        CONV_TRY(INP(15), 2, 2048, 6144, INP(2) + 2048, 4096, WS_WQKVT)
        CONV_TRY(INP(17), 2, 2048, 2048, (const float*)nullptr, 0, WS_WONT)
#undef CONV_TRY
    }
}

constexpr int SC_T = 64, SC_NCH = SEQ / SC_T;
constexpr int XCF_STRIDE = 132;
constexpr int XCB_STRIDE = 136;
constexpr int LDS_XCF = 0, LDS_XCB = LDS_XCF + SC_T * XCF_STRIDE * 4, LDS_YGS = LDS_XCB + SC_T * XCB_STRIDE * 2, LDS_SEG = LDS_YGS + SC_T * 128 * 2, LDS_CAR = LDS_SEG + 2 * 128 * 17 * 8, LDS_SC_END = LDS_CAR + 2 * 8 * 128 * 4;
static_assert(LDS_SC_END <= 131072, "scan LDS");

struct ScanArgs {
    const bf16* XR; const bf16* YG; bf16* Y;
    const float* conv_w; const float* conv_b;
    const bf16* gaT; const bf16* gxT;
    const float* ga_b; const float* gx_b; const float* lam;
    f32x2* agg;
};

template <bool FINAL>
__device__ __forceinline__ void scan_phase(LAS unsigned char* lds, const ScanArgs& sa, int G) {
    const int tid = opaque_tid(), lane = tid & 63, w = tid >> 6, fr = lane & 15, fq = lane >> 4;
    LAS float* xcf = (LAS float*)(lds + LDS_XCF);
    LAS bf16* xcb = (LAS bf16*)(lds + LDS_XCB);
    LAS bf16* ygs = (LAS bf16*)(lds + LDS_YGS);
    LAS f32x2* seg = (LAS f32x2*)(lds + LDS_SEG);
    int cur_hd = -1;
    bf16x8 Bf[4][4];
    float ba[2], bx[2], sp8[2];
#pragma unroll
    for (int m = 0; m < 4; ++m)
#pragma unroll
        for (int k = 0; k < 4; ++k) Bf[m][k] = (bf16x8){0, 0, 0, 0, 0, 0, 0, 0};
    ba[0] = ba[1] = bx[0] = bx[1] = sp8[0] = sp8[1] = 0.f;
    LAS float* car = (LAS float*)(lds + LDS_CAR);
    const bool fast = FINAL && (G == 256);
    if (fast) {
        if (tid < 256) {
            const int dir = tid >> 7, c = tid & 127, gch = (blockIdx.x & 15) * 128 + c, cmod = blockIdx.x >> 4;
            const f32x2* ag = sa.agg + (size_t)dir * SC_NCH * DM + gch;
            float h = 0.f;
            if (dir == 0) {
#pragma unroll 16
                for (int cc = 0; cc < SC_NCH; ++cc) { const f32x2 e = ag[(size_t)cc * DM]; if ((cc & 15) == cmod) car[(dir * 8 + (cc >> 4)) * 128 + c] = h; h = e[0] * h + e[1]; }
            } else {
#pragma unroll 16
                for (int cc = SC_NCH - 1; cc >= 0; --cc) { const f32x2 e = ag[(size_t)cc * DM]; if ((cc & 15) == cmod) car[(dir * 8 + (cc >> 4)) * 128 + c] = h; h = e[0] * h + e[1]; }
            }
        }
    }
    for (int it = blockIdx.x; it < SC_NCH * NHEAD; it += G) {
        const int hd = it & 15, chunk = it >> 4, t0 = chunk * SC_T;
        __syncthreads();
        if (hd != cur_hd) {
            cur_hd = hd;
#pragma unroll
            for (int dir = 0; dir < 2; ++dir) {
                const bf16* wa = sa.gaT + ((size_t)(dir * 16 + hd) * 128 + 16 * w + fr) * 128 + 8 * fq;
                const bf16* wx = sa.gxT + ((size_t)(dir * 16 + hd) * 128 + 16 * w + fr) * 128 + 8 * fq;
#pragma unroll
                for (int k = 0; k < 4; ++k) { Bf[dir * 2 + 0][k] = *(const bf16x8*)(wa + 32 * k); Bf[dir * 2 + 1][k] = *(const bf16x8*)(wx + 32 * k); }
                const int gch = hd * 128 + 16 * w + fr;
                ba[dir] = sa.ga_b[dir * DM + gch]; bx[dir] = sa.gx_b[dir * DM + gch];
                sp8[dir] = 8.f * log1pf(expf(-sa.lam[dir * DM + gch]));
            }
        }
        {
            const int cp = tid & 63, tg = tid >> 6;
            const int gc = hd * 128 + 2 * cp;
            float x0[11], x1[11];
#pragma unroll
            for (int q = 0; q < 11; ++q) { const int t = t0 + 8 * tg - 1 + q; unsigned v = 0u; if (t >= 0 && t < SEQ) v = *(const unsigned*)(sa.XR + (size_t)t * DM + gc); x0[q] = bfl(v); x1[q] = bfh(v); }
            float w0[4], w1[4];
#pragma unroll
            for (int k = 0; k < 4; ++k) { const f32x2 wv = *(const f32x2*)(sa.conv_w + k * DM + gc); w0[k] = wv[0]; w1[k] = wv[1]; }
            const f32x2 bv = *(const f32x2*)(sa.conv_b + gc);
#pragma unroll
            for (int q = 0; q < 8; ++q) {
                const float c0 = bv[0] + ((w0[0] * x0[q] + w0[1] * x0[q + 1]) + (w0[2] * x0[q + 2] + w0[3] * x0[q + 3]));
                const float c1 = bv[1] + ((w1[0] * x1[q] + w1[1] * x1[q + 1]) + (w1[2] * x1[q + 2] + w1[3] * x1[q + 3]));
                const int tau = 8 * tg + q;
                *(LAS f32x2*)(xcf + tau * XCF_STRIDE + 2 * cp) = (f32x2){c0, c1};
                *(LAS unsigned*)(xcb + tau * XCB_STRIDE + 2 * cp) = cvt_pk(c0, c1);
            }
            if (FINAL) {
#pragma unroll
                for (int i = 0; i < 2; ++i) { const int idx = tid + i * NTHREADS, row = idx >> 4, c16 = idx & 15;
                    *(LAS u32x4*)(ygs + row * 128 + c16 * 8) = *(const u32x4*)(sa.YG + (size_t)(t0 + row) * DM + hd * 128 + c16 * 8); }
            }
        }
        __syncthreads();
        f32x4 acc[4][4];
#pragma unroll
        for (int m = 0; m < 4; ++m)
#pragma unroll
            for (int mb = 0; mb < 4; ++mb) acc[m][mb] = (f32x4){0.f, 0.f, 0.f, 0.f};
#pragma unroll
        for (int mb = 0; mb < 4; ++mb) {
            bf16x8 Af[4];
#pragma unroll
            for (int k = 0; k < 4; ++k) Af[k] = *(const LAS bf16x8*)(xcb + (16 * mb + fr) * XCB_STRIDE + 32 * k + 8 * fq);
#pragma unroll
            for (int m = 0; m < 4; ++m)
#pragma unroll
                for (int k = 0; k < 4; ++k) acc[m][mb] = __builtin_amdgcn_mfma_f32_16x16x32_bf16(Af[k], Bf[m][k], acc[m][mb], 0, 0, 0);
        }
        const int ch = 16 * w + fr;
#pragma unroll
        for (int mb = 0; mb < 4; ++mb) {
            float xv[4];
#pragma unroll
            for (int j = 0; j < 4; ++j) xv[j] = xcf[(16 * mb + 4 * fq + j) * XCF_STRIDE + ch];
#pragma unroll
            for (int dir = 0; dir < 2; ++dir) {
#pragma unroll
                for (int j = 0; j < 4; ++j) {
                    const float r = pg8::fsigmoid(acc[2 * dir][mb][j] + ba[dir]);
                    const float ig = pg8::fsigmoid(acc[2 * dir + 1][mb][j] + bx[dir]);
                    const float la = -sp8[dir] * r;
                    const float av = __expf(la);
                    const float x2 = 2.f * la;
                    const float om = (x2 > -0.04f) ? -x2 * (1.f + x2 * (0.5f + x2 * (0.16666667f + x2 * 0.041666668f))) : 1.f - av * av;
                    acc[2 * dir][mb][j] = av;
                    acc[2 * dir + 1][mb][j] = sqrtf(om) * ig * xv[j];
                }
                const f32x4 A = acc[2 * dir][mb], U = acc[2 * dir + 1][mb];
                float P, Q;
                if (dir == 0) { P = (A[0] * A[1]) * (A[2] * A[3]); Q = ((U[0] * A[1] + U[1]) * A[2] + U[2]) * A[3] + U[3]; }
                else          { P = (A[0] * A[1]) * (A[2] * A[3]); Q = ((U[3] * A[2] + U[2]) * A[1] + U[1]) * A[0] + U[0]; }
                seg[(dir * 128 + ch) * 17 + mb * 4 + fq] = (f32x2){P, Q};
            }
        }
        __syncthreads();
        if (tid < 256) {
            const int dir = tid >> 7, c = tid & 127, gch = hd * 128 + c;
            LAS f32x2* sg = seg + (dir * 128 + c) * 17;
            if (!FINAL) {
                float h = 0.f, Pt = 1.f;
                if (dir == 0) { for (int s = 0; s < 16; ++s) { const f32x2 e = sg[s]; h = e[0] * h + e[1]; Pt *= e[0]; } }
                else          { for (int s = 15; s >= 0; --s) { const f32x2 e = sg[s]; h = e[0] * h + e[1]; Pt *= e[0]; } }
                sa.agg[((size_t)dir * SC_NCH + chunk) * DM + gch] = (f32x2){Pt, h};
            } else {
                float h = 0.f;
                if (fast) h = car[(dir * 8 + (chunk >> 4)) * 128 + c];
                else {
                    const f32x2* ag = sa.agg + (size_t)dir * SC_NCH * DM + gch;
                    if (dir == 0) { for (int cc = 0; cc < chunk; ++cc) { const f32x2 e = ag[(size_t)cc * DM]; h = e[0] * h + e[1]; } }
                    else          { for (int cc = SC_NCH - 1; cc > chunk; --cc) { const f32x2 e = ag[(size_t)cc * DM]; h = e[0] * h + e[1]; } }
                }
                if (dir == 0) { for (int s = 0; s < 16; ++s) { const f32x2 e = sg[s]; sg[s] = (f32x2){h, 0.f}; h = e[0] * h + e[1]; } }
                else          { for (int s = 15; s >= 0; --s) { const f32x2 e = sg[s]; sg[s] = (f32x2){h, 0.f}; h = e[0] * h + e[1]; } }
            }
        }
        if (FINAL) {
            __syncthreads();
#pragma unroll
            for (int mb = 0; mb < 4; ++mb) {
                float hs[4];
                { float h = seg[(0 * 128 + ch) * 17 + mb * 4 + fq][0]; const f32x4 A = acc[0][mb], U = acc[1][mb];
#pragma unroll
                  for (int j = 0; j < 4; ++j) { h = A[j] * h + U[j]; hs[j] = h; } }
                { float h = seg[(1 * 128 + ch) * 17 + mb * 4 + fq][0]; const f32x4 A = acc[2][mb], U = acc[3][mb];
#pragma unroll
                  for (int j = 3; j >= 0; --j) { h = A[j] * h + U[j]; hs[j] += h; } }
#pragma unroll
                for (int j = 0; j < 4; ++j) {
                    LAS bf16* yp = ygs + (16 * mb + 4 * fq + j) * 128 + ch;
                    const float yg = __uint_as_float((unsigned)(*yp) << 16);
                    *yp = (bf16)(cvt_pk(hs[j] * yg, 0.f) & 0xffffu);
                }
            }
            __syncthreads();
#pragma unroll
            for (int i = 0; i < 2; ++i) { const int idx = tid + i * NTHREADS, row = idx >> 4, c16 = idx & 15;
                *(u32x4*)(sa.Y + (size_t)(t0 + row) * DM + hd * 128 + c16 * 8) = *(const LAS u32x4*)(ygs + row * 128 + c16 * 8); }
        }
    }
}

struct AttArgs { const bf16* Q; const bf16* K; const bf16* VT; bf16* O; const float* rpb; };

__device__ __forceinline__ void attn_phase(LAS unsigned char* lds, const AttArgs& aa, int G) {
    const int tid = opaque_tid(), lane = tid & 63, w = tid >> 6, fr = lane & 15, fq = lane >> 4;
    const int hsel = w >> 2, qg = w & 3;
    LAS float* rp = (LAS float*)lds;
    const int c0 = 16 * qg, kb0 = (qg == 0) ? 0 : (qg == 1) ? 8 : (qg == 2) ? 24 : 32;
    const int qc = c0 + fr;
    const int cs = min(max(qc - 8, 0), 48);
    for (int id = blockIdx.x; id < 128 * 8; id += G) {
        const int hp = id & 7, r = id >> 3, h = hp * 2 + hsel;
        const int rs = min(max(r - 4, 0), 120);
        __syncthreads();
        for (int i = tid; i < 2 * 465; i += NTHREADS) { const int hh = i / 465, e = i % 465; rp[hh * 480 + e] = aa.rpb[(size_t)(hp * 2 + hh) * 465 + e]; }
        __syncthreads();
        bf16x8 qf[4];
        { const bf16* qp = aa.Q + (size_t)(r * 64 + qc) * DM + h * 128 + 8 * fq;
#pragma unroll
          for (int k = 0; k < 4; ++k) qf[k] = *(const bf16x8*)(qp + 32 * k); }
        f32x4 s[8][2];
        const int krow = 8 * (fr >> 2) + (fr & 3);
#pragma unroll
        for (int i = 0; i < 8; ++i)
#pragma unroll
            for (int nb = 0; nb < 2; ++nb) {
                const bf16* kp = aa.K + (size_t)((rs + i) * 64 + kb0 + krow + 4 * nb) * DM + h * 128 + 8 * fq;
                f32x4 c = (f32x4){0.f, 0.f, 0.f, 0.f};
#pragma unroll
                for (int k = 0; k < 4; ++k) { const bf16x8 kf = *(const bf16x8*)(kp + 32 * k); c = __builtin_amdgcn_mfma_f32_16x16x32_bf16(kf, qf[k], c, 0, 0, 0); }
                s[i][nb] = c;
            }
        float mx = -INFINITY;
        const LAS float* rph = rp + hsel * 480;
#pragma unroll
        for (int i = 0; i < 8; ++i) {
            const int relr = rs + i - r + 7;
#pragma unroll
            for (int nb = 0; nb < 2; ++nb)
#pragma unroll
                for (int j = 0; j < 4; ++j) {
                    const int kc = kb0 + 8 * fq + 4 * nb + j;
                    const bool valid = (unsigned)(kc - cs) < 16u;
                    const int idx = valid ? relr * 31 + (kc - qc + 15) : 0;
                    const float v = valid ? s[i][nb][j] + rph[idx] : -INFINITY;
                    s[i][nb][j] = v; mx = fmaxf(mx, v);
                }
        }
        mx = fmaxf(mx, __shfl_xor(mx, 16)); mx = fmaxf(mx, __shfl_xor(mx, 32));
        float l = 0.f;
#pragma unroll
        for (int i = 0; i < 8; ++i)
#pragma unroll
            for (int nb = 0; nb < 2; ++nb)
#pragma unroll
                for (int j = 0; j < 4; ++j) { const float p = __expf(s[i][nb][j] - mx); s[i][nb][j] = p; l += p; }
        l += __shfl_xor(l, 16); l += __shfl_xor(l, 32);
        f32x4 o[8];
#pragma unroll
        for (int db = 0; db < 8; ++db) o[db] = (f32x4){0.f, 0.f, 0.f, 0.f};
#pragma unroll
        for (int i = 0; i < 8; ++i) {
            u32x4 pw; pw.x = cvt_pk(s[i][0][0], s[i][0][1]); pw.y = cvt_pk(s[i][0][2], s[i][0][3]); pw.z = cvt_pk(s[i][1][0], s[i][1][1]); pw.w = cvt_pk(s[i][1][2], s[i][1][3]);
            const bf16x8 pb = __builtin_bit_cast(bf16x8, pw);
            const bf16* vp = aa.VT + (size_t)(h * 128 + fr) * SEQ + (rs + i) * 64 + kb0 + 8 * fq;
#pragma unroll
            for (int db = 0; db < 8; ++db) { const bf16x8 vf = *(const bf16x8*)(vp + (size_t)(16 * db) * SEQ); o[db] = __builtin_amdgcn_mfma_f32_16x16x32_bf16(vf, pb, o[db], 0, 0, 0); }
        }
        const float inv = 1.f / l;
        bf16* op = aa.O + (size_t)(r * 64 + qc) * DM + h * 128 + 4 * fq;
#pragma unroll
        for (int db = 0; db < 8; ++db) { u32x2 wv; wv.x = cvt_pk(o[db][0] * inv, o[db][1] * inv); wv.y = cvt_pk(o[db][2] * inv, o[db][3] * inv); *(u32x2*)(op + 16 * db) = wv; }
    }
}

__device__ __forceinline__ void final_phase(float* out, const float* ss, const float* g, int G) {
    const int tid = opaque_tid(), lane = tid & 63, wave = tid >> 6;
    const int gw = blockIdx.x * NWAVES + wave, NGW = G * NWAVES;
    for (int row = gw; row < SEQ; row += NGW) {
        const float rs = pg8::rstd_row(ss, row);
        f32x4* o = (f32x4*)(out + (size_t)row * DM) + lane; const f32x4* gp = (const f32x4*)g + lane;
#pragma unroll
        for (int j = 0; j < 8; ++j) { f32x4 v = o[64 * j]; const f32x4 gv = gp[64 * j]; v = v * rs * gv; o[64 * j] = v; }
    }
}

#define XB_TMO      128
#define XB_XCNT(j)  (256  + 64 * (j))
#define XB_XSUB(j)  (1280 + 64 * (j))
#define XB_XGEN(j)  (2304 + 64 * (j))
#define XB_TOP      3328
#define XB_TOPGEN   3392
#define XCD_BAR_WORDS 3456
#define XB_SPIN_CAP (1u << 18)

__device__ __forceinline__ unsigned xb_ld(unsigned* p)              { return __hip_atomic_load(p, __ATOMIC_RELAXED, __HIP_MEMORY_SCOPE_AGENT); }
__device__ __forceinline__ unsigned xb_add(unsigned* p, unsigned v) { return __hip_atomic_fetch_add(p, v, __ATOMIC_RELAXED, __HIP_MEMORY_SCOPE_AGENT); }
__device__ __forceinline__ unsigned xb_xcc_id() { return (unsigned)__builtin_amdgcn_s_getreg((3 << 11) | 20) & 0xFu; }
#define XB_SPIN(cond, bar) do { unsigned _sp = 0; while (cond) { __builtin_amdgcn_s_sleep(1); \
    if ((++_sp & 255u) == 0u) { if (xb_ld(&(bar)[XB_TMO])) break; if (_sp > XB_SPIN_CAP) { atomicAdd(&(bar)[XB_TMO], 1u); break; } } } } while (0)

struct XcdBarrier {
    unsigned* bar; unsigned x;
    volatile LAS unsigned* st;
};

__device__ __forceinline__ XcdBarrier xcd_barrier_post(unsigned* bar, volatile LAS unsigned* st) {
    XcdBarrier b; b.bar = bar; b.x = xb_xcc_id(); b.st = st;
    if (threadIdx.x == 0) (void)xb_add(&bar[XB_XCNT(b.x)], 1u);
    return b;
}
__device__ __forceinline__ void xcd_barrier_complete(unsigned* bar, unsigned x, unsigned& nloc, unsigned& nx) {
    const unsigned G = gridDim.x * gridDim.y * gridDim.z;
    unsigned sum, cnt, mine, sp = 0u;
    for (;;) {
        sum = 0u; cnt = 0u; mine = 0u;
#pragma unroll
        for (unsigned j = 0; j < 16; ++j) { const unsigned c = xb_ld(&bar[XB_XCNT(j)]); sum += c; cnt += (c > 0u) ? 1u : 0u; mine = (j == x) ? c : mine; }
        if (sum == G) break;
        __builtin_amdgcn_s_sleep(1);
        if ((++sp & 255u) == 0u) { if (xb_ld(&bar[XB_TMO])) break; if (sp > XB_SPIN_CAP) { atomicAdd(&bar[XB_TMO], 1u); break; } }
    }
    nloc = mine > 0u ? mine : 1u; nx = cnt > 0u ? cnt : 1u;
}

__device__ __forceinline__ void xcd_barrier(const XcdBarrier& b) {
    asm volatile("s_waitcnt vmcnt(0)" ::: "memory");
    __syncthreads();
    if (threadIdx.x == 0) {
        unsigned* bar = b.bar;
        __builtin_amdgcn_s_waitcnt(0);
        unsigned nloc = b.st[0], nx = b.st[1];
        if (nloc == 0u) { xcd_barrier_complete(bar, b.x, nloc, nx); b.st[0] = nloc; b.st[1] = nx; }
        const unsigned old = xb_add(&bar[XB_XSUB(b.x)], 1u);
        const unsigned gen = old / nloc;
        if (old + 1u == (gen + 1u) * nloc) {
            __builtin_amdgcn_fence(__ATOMIC_RELEASE, "agent");
            asm volatile("s_waitcnt vmcnt(0)" ::: "memory");
            const unsigned og = xb_add(&bar[XB_TOP], 1u);
            const unsigned tg = og / nx;
            if (og + 1u == (tg + 1u) * nx) xb_add(&bar[XB_TOPGEN], 1u);
            else XB_SPIN(xb_ld(&bar[XB_TOPGEN]) == tg, bar);
            __builtin_amdgcn_fence(__ATOMIC_ACQUIRE, "agent");
            xb_add(&bar[XB_XGEN(b.x)], 1u);
            asm volatile("s_waitcnt vmcnt(0)" ::: "memory");
        } else {
            XB_SPIN(xb_ld(&bar[XB_XGEN(b.x)]) == gen, bar);
            __builtin_amdgcn_fence(__ATOMIC_ACQUIRE, "agent");
            asm volatile("s_waitcnt vmcnt(0)" ::: "memory");
        }
    }
    __syncthreads();
}

constexpr int N_PHASES = 28;
#ifndef DBG_DUMP_OFF
#define DBG_DUMP_OFF WS_BC
#endif
#ifndef DBG_NPH
#define DBG_NPH N_PHASES
#endif
#ifndef DBG_DUMP
#define DBG_DUMP 0
#endif
enum Kind { K_P0, K_WIN, K_S1, K_S2, K_WOUT, K_QKV, K_ATT, K_W1, K_W2, K_PLE, K_FINAL, K_DUMP };

__global__ void __launch_bounds__(NTHREADS, 2) mega_fwd(Args args) {
    extern __shared__ __attribute__((aligned(16))) unsigned char lds_raw[];
    LAS unsigned char* lds = (LAS unsigned char*)lds_raw;
    cg::grid_group grid = cg::this_grid();
    const int G = gridDim.x;
    KA ka0 = (KA)__builtin_amdgcn_kernarg_segment_ptr();
    const int lo = *(const int __attribute__((address_space(4)))*)(ka0 + 192), hi = *(const int __attribute__((address_space(4)))*)(ka0 + 196);
    if (hi - lo > 1) {
        volatile LAS unsigned* st = (volatile LAS unsigned*)(lds + 131072 + 64);
        if (threadIdx.x < 2) st[threadIdx.x] = 0u;
        __syncthreads();
        unsigned char* ws0 = *(unsigned char* const __attribute__((address_space(4)))*)(ka0 + 184);
        (void)xcd_barrier_post((unsigned*)(ws0 + WS_BAR), st);
    }
    if (hi > 100000) grid.sync();
    for (int ph = lo; ph < hi; ++ph) {
        KA ka = ka0; asm volatile("" : "+s"(ka));
        unsigned char* ws = *(unsigned char* const __attribute__((address_space(4)))*)(ka + 184);
        float* hout = *(float* const __attribute__((address_space(4)))*)(ka + 176);
        float* ss = (float*)(ws + WS_SS);
        int kind, L = 0;
        if (ph == 0) kind = K_P0; else if (ph == 99) kind = K_DUMP; else if (ph == N_PHASES - 1) kind = K_FINAL;
        else { int q = ph - 1; const int pair = q / 13; q -= pair * 13; L = 2 * pair;
            if (q < 7) { kind = (q == 0) ? K_WIN : (q == 1) ? K_S1 : (q == 2) ? K_S2 : (q == 3) ? K_WOUT : (q == 4) ? K_W1 : (q == 5) ? K_W2 : K_PLE; }
            else { q -= 7; L += 1; kind = (q == 0) ? K_QKV : (q == 1) ? K_ATT : (q == 2) ? K_WOUT : (q == 3) ? K_W1 : (q == 4) ? K_W2 : K_PLE; } }
        const int j = L >> 1;
        bf16* Xc = (bf16*)(ws + ((L & 1) ? WS_X1 : WS_X0));
        bf16* Xo = (bf16*)(ws + ((L & 1) ? WS_X0 : WS_X1));
        const float* ss_mix = ss + (size_t)(3 * L) * SEQ * 32; float* ss_mlp = ss + (size_t)(3 * L + 1) * SEQ * 32; float* ss_ple = ss + (size_t)(3 * L + 2) * SEQ * 32; float* ss_next = ss + (size_t)(3 * L + 3) * SEQ * 32;
        switch (kind) {
        case K_P0:
#ifndef DIS_P0
 p0_phase(lds, ka, ws, G);
#endif
 break;
        case K_WIN: {
#ifdef DBG_BJ0
            pg8::Gemm g{Xc, (const bf16*)(ws + WS_WINT), SEQ, 2 * DM, DM};
#elif defined(DBG_AX1)
            pg8::Gemm g{(L == 2) ? Xo : Xc, (const bf16*)(ws + WS_WINT) + (size_t)j * DM * 2 * DM, SEQ, 2 * DM, DM};
#else
            pg8::Gemm g{Xc, (const bf16*)(ws + WS_WINT) + (size_t)j * DM * 2 * DM, SEQ, 2 * DM, DM};
#endif
            pg8::StaticOrder S; S.init(SEQ, 2 * DM, G, (int)blockIdx.x);
#ifdef DBG_FRESHOUT
            pg8::EpiAct<0> E{(L == 2) ? (bf16*)(ws + WS_PROJ + 96 * MiB) : (bf16*)(ws + WS_BA), (bf16*)(ws + WS_BB), DM, DM, ss_mix};
#elif defined(DBG_SS0)
            pg8::EpiAct<0> E{(bf16*)(ws + WS_BA), (bf16*)(ws + WS_BB), DM, DM, ss};
#else
            pg8::EpiAct<0> E{(bf16*)(ws + WS_BA), (bf16*)(ws + WS_BB), DM, DM, ss_mix};
#endif
#ifndef DIS_ACT0
            pg8::gemm_phase<pg8::EpiAct<0>, pg8::StaticOrder, true, true>(lds, g, S, E);
#endif
        } break;
        case K_S1: case K_S2: {
            ScanArgs sa{(const bf16*)(ws + WS_BA), (const bf16*)(ws + WS_BB), (bf16*)(ws + WS_BC),
                        INP(7) + (size_t)j * 4 * DM, INP(8) + (size_t)j * DM,
                        (const bf16*)(ws + WS_GAT) + (size_t)j * 32 * 128 * 128, (const bf16*)(ws + WS_GXT) + (size_t)j * 32 * 128 * 128,
                        INP(10) + (size_t)j * 2 * DM, INP(12) + (size_t)j * 2 * DM, INP(13) + (size_t)j * 2 * DM,
                        (f32x2*)(ws + WS_AGG)};
            #ifndef DIS_SCAN
            if (kind == K_S1) scan_phase<false>(lds, sa, G); else scan_phase<true>(lds, sa, G);
#endif
        } break;
        case K_QKV: {
            {
                pg8::Gemm g{Xc, (const bf16*)(ws + WS_WQKVT) + (size_t)j * 3 * DM * DM, SEQ, 2 * DM, DM};
                pg8::StaticOrder S; S.init(SEQ, 2 * DM, G, (int)blockIdx.x);
                pg8::EpiAct<1> E{(bf16*)(ws + WS_BA), (bf16*)(ws + WS_BB), DM, DM, ss_mix};
#ifndef DIS_ACT1
                pg8::gemm_phase<pg8::EpiAct<1>, pg8::StaticOrder, true, true>(lds, g, S, E);
#endif
            }
            __syncthreads();
            {
                pg8::Gemm g{(const bf16*)(ws + WS_WQKVT) + (size_t)j * 3 * DM * DM + (size_t)2 * DM * DM, Xc, DM, SEQ, DM};
                pg8::StaticOrder S; S.init(DM, SEQ, G, (int)blockIdx.x);
                pg8::EpiAct<4> E{(bf16*)(ws + WS_BD), nullptr, SEQ, 0, ss_mix};
#ifndef DIS_ACT4
                pg8::gemm_phase<pg8::EpiAct<4>, pg8::StaticOrder, true, true>(lds, g, S, E);
#endif
            }
        } break;
        case K_ATT: {
            AttArgs aa{(const bf16*)(ws + WS_BA), (const bf16*)(ws + WS_BB), (const bf16*)(ws + WS_BD), (bf16*)(ws + WS_BC), INP(16) + (size_t)j * NHEAD * 465};
#ifndef DIS_ATT
            attn_phase(lds, aa, G);
#endif
        } break;
        case K_WOUT: case K_W2: {
            const bf16* A; const bf16* Bt; int K;
            float* sso; bf16* hb;
            if (kind == K_WOUT) { A = (const bf16*)(ws + WS_BC); K = DM; Bt = (L & 1) ? (const bf16*)(ws + WS_WONT) + (size_t)j * DM * DM : (const bf16*)(ws + WS_WORT) + (size_t)j * DM * DM; sso = ss_mlp; hb = Xo; }
            else { A = (const bf16*)(ws + WS_A1); K = DFF; Bt = (const bf16*)(ws + WS_W2T) + (size_t)L * DM * DFF; sso = ss_ple; hb = Xc; }
            const float* base = (kind == K_WOUT && L == 0) ? INP(0) : hout;
            pg8::Gemm g{A, Bt, SEQ, DM, K};
            pg8::StaticOrder S; S.init(SEQ, DM, G, (int)blockIdx.x);
            pg8::EpiRes<0> E{base, hout, hb, sso, nullptr, nullptr};
#ifndef DIS_RES0
            pg8::gemm_phase<pg8::EpiRes<0>, pg8::StaticOrder, true, true>(lds, g, S, E);
#endif
        } break;
        case K_W1: {
            {
                int Kp = PLE; asm volatile("" : "+s"(Kp));
                pg8::Gemm g{(const bf16*)(ws + WS_PB) + (size_t)L * SEQ * PLE, (const bf16*)(ws + WS_WPT) + (size_t)L * DM * PLE, SEQ, DM, Kp};
                pg8::StaticOrder S; S.init(SEQ, DM, G, (int)blockIdx.x);
                pg8::EpiAct<3> E{(bf16*)(ws + WS_PROJ) + (size_t)L * SEQ * DM, nullptr, DM, 0, nullptr};
#ifndef DIS_ACT3
                pg8::gemm_phase<pg8::EpiAct<3>, pg8::StaticOrder, true, true>(lds, g, S, E);
#endif
            }
            __syncthreads();
            pg8::Gemm g{Xo, (const bf16*)(ws + WS_W1T) + (size_t)L * DM * DFF, SEQ, DFF, DM};
            pg8::StaticOrder S; S.init(SEQ, DFF, G, (int)blockIdx.x);
            pg8::EpiAct<2> E{(bf16*)(ws + WS_A1), nullptr, DFF, 0, ss_mlp};
#ifndef DIS_ACT2
            pg8::gemm_phase<pg8::EpiAct<2>, pg8::StaticOrder, true, true>(lds, g, S, E);
#endif
        } break;
        case K_PLE: {
            pg8::Gemm g{Xc, (const bf16*)(ws + WS_WGT) + (size_t)L * DM * DM, SEQ, DM, DM};
            pg8::StaticOrder S; S.init(SEQ, DM, G, (int)blockIdx.x);
            pg8::EpiRes<1> E{hout, hout, Xo, ss_next, ss_ple, (const bf16*)(ws + WS_PROJ) + (size_t)L * SEQ * DM};
#ifndef DIS_RES1
            pg8::gemm_phase<pg8::EpiRes<1>, pg8::StaticOrder, true, true>(lds, g, S, E);
#endif
        } break;
        case K_DUMP: {
            const bf16* src = (const bf16*)(ws + DBG_DUMP_OFF); const float* srcf = (const float*)(ws + DBG_DUMP_OFF);
            for (size_t i = (size_t)blockIdx.x * NTHREADS + threadIdx.x; i < (size_t)SEQ * DM; i += (size_t)G * NTHREADS) hout[i] = (DBG_DUMP == 2) ? srcf[i & 8191] : bfl((unsigned)src[i]);
        } break;
        case K_FINAL: final_phase(hout, ss + (size_t)12 * SEQ * 32, INP(5), G); break;
        }
        if (ph + 1 < hi) { XcdBarrier b; b.bar = (unsigned*)(ws + WS_BAR); b.x = xb_xcc_id(); b.st = (volatile LAS unsigned*)(lds + 131072 + 64); xcd_barrier(b); }
    }
}

#ifndef MK_MULTI
#define MK_MULTI 0
#endif

extern "C" void kernel_launch(void* const* d_in, const int* in_sizes, int n_in, void* d_out, int out_size, void* d_ws, size_t ws_size, hipStream_t stream) {
    static int grid = 0;
    if (grid == 0) {
        if (n_in != 22 || out_size != SEQ * DM || ws_size < WS_END) { fprintf(stderr, "kernel_launch: unexpected shapes (n_in %d out %d ws %zu)\n", n_in, out_size, ws_size); grid = -1; return; }
        int dev = 0, cus = 0, per_cu = 0;
        (void)hipGetDevice(&dev); (void)hipDeviceGetAttribute(&cus, hipDeviceAttributeMultiprocessorCount, dev);
        if (hipFuncSetAttribute((const void*)mega_fwd, hipFuncAttributeMaxDynamicSharedMemorySize, LDS_BYTES) != hipSuccess) { fprintf(stderr, "kernel_launch: hipFuncSetAttribute failed\n"); grid = -1; return; }
        if (hipOccupancyMaxActiveBlocksPerMultiprocessor(&per_cu, (const void*)mega_fwd, NTHREADS, LDS_BYTES) != hipSuccess || per_cu < 1) { fprintf(stderr, "kernel_launch: occupancy query says %d\n", per_cu); per_cu = 1; }
        (void)hipGetLastError();
        grid = cus * per_cu; if (grid > 256) grid = 256;
        fprintf(stderr, "kernel_launch: grid %d (cus %d per_cu %d)\n", grid, cus, per_cu);
    }
    if (grid < 0) return;
    Args a{};
    for (int i = 0; i < 22; ++i) a.in[i] = (const float*)d_in[i];
    a.out = (float*)d_out; a.ws = (unsigned char*)d_ws;
#if MK_MULTI
#ifdef DBG_SEQ
    { const int seq[] = {DBG_SEQ}; for (int ph : seq) { a.ph_lo = ph; a.ph_hi = ph + 1; hipLaunchKernelGGL(mega_fwd, dim3(grid), dim3(NTHREADS), LDS_BYTES, stream, a); } }
#else
    for (int ph = 0; ph < DBG_NPH; ++ph) { a.ph_lo = ph; a.ph_hi = ph + 1; hipLaunchKernelGGL(mega_fwd, dim3(grid), dim3(NTHREADS), LDS_BYTES, stream, a); }
#endif
    if (DBG_DUMP) { a.ph_lo = 99; a.ph_hi = 100; hipLaunchKernelGGL(mega_fwd, dim3(grid), dim3(NTHREADS), LDS_BYTES, stream, a); }
#else
    a.ph_lo = 0; a.ph_hi = N_PHASES;
    if (hipMemsetAsync((char*)d_ws + WS_BAR, 0, 16384, stream) != hipSuccess) { fprintf(stderr, "kernel_launch: memset of the barrier words failed\n"); return; }
    void* kargs[] = {&a};
    hipError_t e = hipLaunchCooperativeKernel((const void*)mega_fwd, dim3(grid), dim3(NTHREADS), kargs, LDS_BYTES, stream);
    if (e != hipSuccess) fprintf(stderr, "kernel_launch: cooperative launch failed: %s (grid %d)\n", hipGetErrorString(e), grid);
#endif
}
```

```cpp
#include <hip/hip_runtime.h>
#include <hip/hip_cooperative_groups.h>
#include <cstdio>
#include <cstdint>
namespace cg = cooperative_groups;
namespace pg8 {
#define PG8_LAS __attribute__((address_space(3)))
typedef unsigned short bf16_t;
typedef short bf16x8 __attribute__((ext_vector_type(8)));
typedef float f32x4 __attribute__((ext_vector_type(4)));
typedef unsigned u32x4 __attribute__((ext_vector_type(4)));
constexpr int BM = 256, BK = 64, HALF = 128, HTB = HALF * BK * 2  , STAGE_BYTES = 8 * HTB, NXCD = 8, WGM = 8;

__host__ __device__ __forceinline__ int lds_byte(int r, int c) { const int st = (r >> 4) * 2 + (c >> 5), rr = r & 15, cc = c & 31, ob = rr * 64 + cc * 2; return st * 1024 + (ob ^ (((ob >> 9) & 1) << 5)); }
__host__ __device__ __forceinline__ void stage_rc(int b, int& R, int& C) { const int st = b / 1024, sb = b % 1024, swz = sb ^ (((sb >> 9) & 1) << 5); R = (st >> 1) * 16 + swz / 64; C = (st & 1) * 32 + (swz % 64) / 2; }
__host__ __device__ __forceinline__ int perm32(int rho) { const int n = rho >> 4, i = rho & 15; return 8 * (i >> 2) + 4 * n + (i & 3); }

struct Unit { int pm, pn; };
struct Gemm { const bf16_t* A; const bf16_t* Bt; int M, N, K; };

struct StaticOrder {
    int nM, nN, nwg, G, c;
    __host__ __device__ void init(int M, int N, int G_, int c_) { nM = M / BM; nN = N / BM; nwg = nM * nN; G = G_; c = c_; }
    __host__ __device__ bool next(int i, Unit& u) const {
        const long L = (long)i * G + c; if (L >= nwg) return false;
        int wgid = (int)L; { const int q = nwg / NXCD, r = nwg % NXCD, xcd = wgid % NXCD, off = wgid / NXCD; wgid = (xcd < r ? xcd * (q + 1) : r * (q + 1) + (xcd - r) * q) + off; }
        const int nig = WGM * nN, gid = wgid / nig, fm = gid * WGM, gsz = (nM - fm) < WGM ? (nM - fm) : WGM;
        u.pm = fm + ((wgid % nig) % gsz); u.pn = (wgid % nig) / gsz; return true;
    }
    __device__ __forceinline__ void a_ready(const Unit&) const {}
    __device__ __forceinline__ void done(const Unit&) const {}
};

__device__ __forceinline__ unsigned cvt_pk_bf16(float lo, float hi) { unsigned r; asm volatile("v_cvt_pk_bf16_f32 %0, %1, %2" : "=v"(r) : "v"(lo), "v"(hi)); return r; }
typedef float f32x2 __attribute__((ext_vector_type(2)));
constexpr float RMS_EPS = 1e-6f;
constexpr int DM = 2048;
__device__ __forceinline__ float fsigmoid(float x) { return __builtin_amdgcn_rcpf(1.f + __expf(-x)); }
__device__ __forceinline__ float gelu_tanh(float v) { return v * fsigmoid(1.5957691216057308f * (v + 0.044715f * v * v * v)); }
__device__ __forceinline__ float rstd_row(const float* ssp, int row) {
    const f32x4* p = (const f32x4*)(ssp + (size_t)row * 32); float s = 0.f;
#pragma unroll
    for (int i = 0; i < 8; ++i) { const f32x4 v = p[i]; s += (v[0] + v[1]) + (v[2] + v[3]); }
    return rsqrtf(s * (1.f / DM) + RMS_EPS);
}
__device__ __forceinline__ float bf_lo(unsigned w) { return __uint_as_float(w << 16); }
__device__ __forceinline__ float bf_hi(unsigned w) { return __uint_as_float(w & 0xffff0000u); }

template <int MODE> struct EpiAct {
    static constexpr bool PERM = true, AFTER_DRAIN = false;
    bf16_t* O0; bf16_t* O1; int ldc; int split; const float* ss;
    __device__ __forceinline__ void operator()(const f32x4 (&acc)[2][2][4][2], const Unit& u, int wr, int wc, int fr, int fq) const {
        const int row0 = u.pm * BM + wr * 64 + fr; int colt = u.pn * BM; bf16_t* base = O0; bool second = false;
        if (MODE <= 1) { if (colt >= split) { base = O1; colt -= split; second = true; } }
        const int col0 = colt + wc * 32 + 8 * fq;
        f32x4 cs[2][2];
        if (MODE == 4) {
#pragma unroll
            for (int bj = 0; bj < 2; ++bj)
#pragma unroll
                for (int n = 0; n < 2; ++n) {
#pragma unroll
                    for (int e = 0; e < 4; ++e) cs[bj][n][e] = rstd_row(ss, col0 + bj * HALF + 4 * n + e); }
        }
#pragma unroll
        for (int ai = 0; ai < 2; ++ai)
#pragma unroll
            for (int m = 0; m < 4; ++m) {
                const int row = row0 + ai * HALF + m * 16;
                float rs = 1.f;
                if (MODE <= 2) { rs = rstd_row(ss, row); if (MODE == 1 && !second) rs *= 0.08838834764831845f; }
                bf16_t* rowp = base + (size_t)row * ldc + col0;
#pragma unroll
                for (int bj = 0; bj < 2; ++bj) {
                    f32x4 v0 = acc[ai][bj][m][0], v1 = acc[ai][bj][m][1];
                    if (MODE == 4) { v0 = v0 * cs[bj][0]; v1 = v1 * cs[bj][1]; } else { v0 = v0 * rs; v1 = v1 * rs; }
                    if (MODE == 0) { if (second) {
#pragma unroll
                        for (int e = 0; e < 4; ++e) { v0[e] = gelu_tanh(v0[e]); v1[e] = gelu_tanh(v1[e]); } } }
                    if (MODE == 2) {
#pragma unroll
                        for (int e = 0; e < 4; ++e) { const float a = fmaxf(v0[e], 0.f), b = fmaxf(v1[e], 0.f); v0[e] = a * a; v1[e] = b * b; } }
                    u32x4 w; w.x = cvt_pk_bf16(v0[0], v0[1]); w.y = cvt_pk_bf16(v0[2], v0[3]); w.z = cvt_pk_bf16(v1[0], v1[1]); w.w = cvt_pk_bf16(v1[2], v1[3]);
                    *(u32x4*)(rowp + bj * HALF) = w;
                }
                asm volatile("" ::: "memory");
            }
    }
};

template <int MODE> struct EpiRes {
    static constexpr bool PERM = true, AFTER_DRAIN = false;
    const float* base; float* out; bf16_t* hb; float* ss_out; const float* ss_in; const bf16_t* proj;
    __device__ __forceinline__ void operator()(const f32x4 (&acc)[2][2][4][2], const Unit& u, int wr, int wc, int fr, int fq) const {
        const int row0 = u.pm * BM + wr * 64 + fr; const int col0 = u.pn * BM + wc * 32 + 8 * fq;
#pragma unroll
        for (int ai = 0; ai < 2; ++ai)
#pragma unroll
            for (int m = 0; m < 4; ++m) {
                const int row = row0 + ai * HALF + m * 16; const size_t off = (size_t)row * DM + col0;
                float rs = 0.f; if (MODE == 1) rs = rstd_row(ss_in, row);
                float sq = 0.f;
#pragma unroll
                for (int bj = 0; bj < 2; ++bj) {
                    const f32x4 b0 = *(const f32x4*)(base + off + bj * HALF), b1 = *(const f32x4*)(base + off + bj * HALF + 4);
                    f32x4 v0 = acc[ai][bj][m][0], v1 = acc[ai][bj][m][1];
                    if (MODE == 1) {
                        const u32x4 pw = *(const u32x4*)(proj + off + bj * HALF);
                        const f32x4 p0 = (f32x4){bf_lo(pw.x), bf_hi(pw.x), bf_lo(pw.y), bf_hi(pw.y)}, p1 = (f32x4){bf_lo(pw.z), bf_hi(pw.z), bf_lo(pw.w), bf_hi(pw.w)};
#pragma unroll
                        for (int e = 0; e < 4; ++e) { v0[e] = fsigmoid(v0[e] * rs) * p0[e]; v1[e] = fsigmoid(v1[e] * rs) * p1[e]; }
                    }
                    const f32x4 o0 = b0 + v0, o1 = b1 + v1;
                    *(f32x4*)(out + off + bj * HALF) = o0; *(f32x4*)(out + off + bj * HALF + 4) = o1;
                    u32x4 w; w.x = cvt_pk_bf16(o0[0], o0[1]); w.y = cvt_pk_bf16(o0[2], o0[3]); w.z = cvt_pk_bf16(o1[0], o1[1]); w.w = cvt_pk_bf16(o1[2], o1[3]);
                    *(u32x4*)(hb + off + bj * HALF) = w;
                    sq += (o0[0] * o0[0] + o0[1] * o0[1]) + (o0[2] * o0[2] + o0[3] * o0[3]) + (o1[0] * o1[0] + o1[1] * o1[1]) + (o1[2] * o1[2] + o1[3] * o1[3]);
                }
                sq += __shfl_xor(sq, 16); sq += __shfl_xor(sq, 32);
                if (fq == 0) ss_out[(size_t)row * 32 + u.pn * 4 + wc] = sq;
            }
    }
};

template <class Epi, class Sched, bool ALIGN_EPI = false, bool SP2 = false>
__device__ __forceinline__ void gemm_phase(PG8_LAS unsigned char* lds, const Gemm g, const Sched& S, const Epi& E) {
    int tid_ = threadIdx.x; asm volatile("" : "+v"(tid_)); const int tid = tid_, wid = __builtin_amdgcn_readfirstlane(tid >> 6), lane = tid & 63, wr = wid >> 2, wc = wid & 3, fr = lane & 15, fq = lane >> 4;
    const int K = g.K, nt = K / BK;
    unsigned voffA[2], voffB[2];
#pragma unroll
    for (int i = 0; i < 2; ++i) { int R, C; stage_rc(tid * 16 + i * 8192, R, C); const int Rb = Epi::PERM ? ((R & ~31) + perm32(R & 31)) : R;
        voffA[i] = (unsigned)(R * K + C) * 2u; voffB[i] = (unsigned)(Rb * K + C) * 2u; }
    const size_t kstep = (size_t)(BK * 2);
    const size_t hstep = (size_t)HALF * K * 2;
    const size_t tstep = 2 * hstep;
    const unsigned ldsw = (unsigned)wid * 1024u;
    const int aoff = lds_byte(wr * 64 + fr, fq * 8), boff = lds_byte(wc * 32 + fr, fq * 8);
#define PG8_SA(b, h) (((b) * 2 + (h)) * HTB)
#define PG8_SB(b, h) ((4 + (b) * 2 + (h)) * HTB)
#define PG8_STAGE(bufoff, gbase, voff) do { _Pragma("unroll") for (int _i = 0; _i < 2; ++_i) \
        __builtin_amdgcn_global_load_lds((const unsigned*)((const char*)(gbase) + (voff)[_i]), (PG8_LAS unsigned*)(lds + (bufoff) + ldsw + _i * 8192), 16, 0, 0); } while (0)
#define PG8_LDA(dst, b, h) do { _Pragma("unroll") for (int m = 0; m < 4; ++m) _Pragma("unroll") for (int k = 0; k < 2; ++k) dst[m][k] = *(const PG8_LAS bf16x8*)(lds + PG8_SA(b, h) + aoff + m * 2048 + k * 1024); } while (0)
#define PG8_LDB(dst, b, h) do { _Pragma("unroll") for (int n = 0; n < 2; ++n) _Pragma("unroll") for (int k = 0; k < 2; ++k) dst[n][k] = *(const PG8_LAS bf16x8*)(lds + PG8_SB(b, h) + boff + n * 2048 + k * 1024); } while (0)
#define PG8_MMA(ai, bj, At, Bt) do { __builtin_amdgcn_s_setprio(1); _Pragma("unroll") for (int m = 0; m < 4; ++m) _Pragma("unroll") for (int n = 0; n < 2; ++n) _Pragma("unroll") for (int k = 0; k < 2; ++k) \
        acc[ai][bj][m][n] = __builtin_amdgcn_mfma_f32_16x16x32_bf16(Bt[n][k], At[m][k], acc[ai][bj][m][n], 0, 0, 0); __builtin_amdgcn_s_setprio(0); } while (0)
#define PG8_WAIT_V(n) asm volatile("s_waitcnt vmcnt(" #n ")" ::: "memory")
#define PG8_WAIT_L(n) asm volatile("s_waitcnt lgkmcnt(" #n ")" ::: "memory")
#define PG8_BAR __builtin_amdgcn_s_barrier()
#define PG8_SCHED __builtin_amdgcn_sched_barrier(0)
    Unit cur, nxt; int ui = 0;
    if (!S.next(0, cur)) return;
    f32x4 acc[2][2][4][2];
#pragma unroll
    for (int a = 0; a < 2; ++a)
#pragma unroll
        for (int b = 0; b < 2; ++b)
#pragma unroll
            for (int m = 0; m < 4; ++m)
#pragma unroll
                for (int n = 0; n < 2; ++n) acc[a][b][m][n] = (f32x4){0.f, 0.f, 0.f, 0.f};
    bf16x8 At[4][2], B0[2][2], B1[2][2];
    const char* cA = (const char*)g.A + (size_t)cur.pm * tstep; const char* cB = (const char*)g.Bt + (size_t)cur.pn * tstep;
    S.a_ready(cur);
    if constexpr (SP2) {
        PG8_STAGE(PG8_SB(0, 0), cB, voffB); PG8_STAGE(PG8_SB(0, 1), cB + hstep, voffB); PG8_STAGE(PG8_SA(0, 0), cA, voffA); PG8_STAGE(PG8_SA(0, 1), cA + hstep, voffA);
        if (wr == 1) PG8_BAR;
        PG8_WAIT_V(2); PG8_BAR;
        PG8_STAGE(PG8_SB(1, 0), cB + kstep, voffB); PG8_STAGE(PG8_SA(1, 0), cA + kstep, voffA); PG8_STAGE(PG8_SB(1, 1), cB + hstep + kstep, voffB);
        PG8_WAIT_V(6); PG8_BAR;
    } else {
        PG8_STAGE(PG8_SB(0, 0), cB, voffB); PG8_STAGE(PG8_SA(0, 0), cA, voffA); PG8_STAGE(PG8_SB(0, 1), cB + hstep, voffB); PG8_STAGE(PG8_SA(0, 1), cA + hstep, voffA);
        if (wr == 1) PG8_BAR;
        PG8_WAIT_V(4); PG8_BAR;
        PG8_STAGE(PG8_SB(1, 0), cB + kstep, voffB); PG8_STAGE(PG8_SA(1, 0), cA + kstep, voffA); PG8_STAGE(PG8_SB(1, 1), cB + hstep + kstep, voffB);
        PG8_WAIT_V(6); PG8_BAR;
    }
    for (;;) {
        const bool has_next = S.next(ui + 1, nxt);
        const char* nA = has_next ? (const char*)g.A + (size_t)nxt.pm * tstep : cA; const char* nB = has_next ? (const char*)g.Bt + (size_t)nxt.pn * tstep : cB;
        for (int t = 0; t < nt; t += 2) {
            const bool last = (t == nt - 2);
            const char* a1 = cA + (size_t)(t + 1) * kstep;
            const char* a2 = last ? nA : cA + (size_t)(t + 2) * kstep; const char* b2 = last ? nB : cB + (size_t)(t + 2) * kstep;
            const char* a3 = a2 + kstep; const char* b3 = b2 + kstep;
            if (last && has_next) S.a_ready(nxt);
            if constexpr (SP2) {
            PG8_LDB(B0, 0, 0); PG8_LDB(B1, 0, 1); PG8_SCHED; PG8_LDA(At, 0, 0); PG8_STAGE(PG8_SA(1, 1), a1 + hstep, voffA);
            PG8_WAIT_V(8); PG8_WAIT_L(0); PG8_BAR; PG8_MMA(0, 0, At, B0); PG8_MMA(0, 1, At, B1); PG8_BAR; PG8_SCHED;
            PG8_LDA(At, 0, 1); PG8_STAGE(PG8_SB(0, 0), b2, voffB); PG8_STAGE(PG8_SB(0, 1), b2 + hstep, voffB); PG8_STAGE(PG8_SA(0, 0), a2, voffA);
            PG8_WAIT_V(8); PG8_WAIT_L(0); PG8_BAR; PG8_MMA(1, 0, At, B0); PG8_MMA(1, 1, At, B1); PG8_BAR; PG8_SCHED;
            PG8_LDB(B0, 1, 0); PG8_LDB(B1, 1, 1); PG8_SCHED; PG8_LDA(At, 1, 0); PG8_STAGE(PG8_SA(0, 1), a2 + hstep, voffA);
            PG8_WAIT_V(8); PG8_WAIT_L(0); PG8_BAR; PG8_MMA(0, 0, At, B0); PG8_MMA(0, 1, At, B1); PG8_BAR; PG8_SCHED;
            PG8_LDA(At, 1, 1); PG8_STAGE(PG8_SB(1, 0), b3, voffB); PG8_STAGE(PG8_SB(1, 1), b3 + hstep, voffB); PG8_STAGE(PG8_SA(1, 0), a3, voffA);
            PG8_WAIT_V(8); PG8_WAIT_L(0); PG8_BAR; PG8_MMA(1, 0, At, B0); PG8_MMA(1, 1, At, B1); PG8_BAR; PG8_SCHED;
            } else {
            PG8_LDB(B0, 0, 0); PG8_SCHED; PG8_LDA(At, 0, 0); PG8_STAGE(PG8_SA(1, 1), a1 + hstep, voffA);
            PG8_WAIT_L(8); PG8_BAR; PG8_WAIT_L(0); PG8_MMA(0, 0, At, B0); PG8_BAR; PG8_SCHED;
            PG8_LDB(B1, 0, 1); PG8_STAGE(PG8_SB(0, 0), b2, voffB);
            PG8_BAR; PG8_WAIT_L(0); PG8_MMA(0, 1, At, B1); PG8_BAR;
            PG8_LDA(At, 0, 1); PG8_STAGE(PG8_SA(0, 0), a2, voffA);
            PG8_BAR; PG8_WAIT_L(0); PG8_MMA(1, 0, At, B0); PG8_BAR; PG8_SCHED;
            PG8_STAGE(PG8_SB(0, 1), b2 + hstep, voffB);
            PG8_WAIT_V(6); PG8_BAR; PG8_MMA(1, 1, At, B1); PG8_BAR;
            PG8_LDB(B0, 1, 0); PG8_SCHED; PG8_LDA(At, 1, 0); PG8_STAGE(PG8_SA(0, 1), a2 + hstep, voffA);
            PG8_WAIT_L(8); PG8_BAR; PG8_WAIT_L(0); PG8_MMA(0, 0, At, B0); PG8_BAR; PG8_SCHED;
            PG8_LDB(B1, 1, 1); PG8_STAGE(PG8_SB(1, 0), b3, voffB);
            PG8_BAR; PG8_WAIT_L(0); PG8_MMA(0, 1, At, B1); PG8_BAR;
            PG8_LDA(At, 1, 1); PG8_STAGE(PG8_SA(1, 0), a3, voffA);
            PG8_BAR; PG8_WAIT_L(0); PG8_MMA(1, 0, At, B0); PG8_BAR; PG8_SCHED;
            PG8_STAGE(PG8_SB(1, 1), b3 + hstep, voffB);
            PG8_WAIT_V(6); PG8_BAR; PG8_MMA(1, 1, At, B1); PG8_BAR;
            }
        }
        if constexpr (ALIGN_EPI) { if (wr == 0) PG8_BAR; }
        if constexpr (!Epi::AFTER_DRAIN) { E(acc, cur, wr, wc, fr, fq); S.done(cur); }
        if (!has_next) break;
#pragma unroll
        for (int a = 0; a < 2; ++a)
#pragma unroll
            for (int b = 0; b < 2; ++b)
#pragma unroll
                for (int m = 0; m < 4; ++m)
#pragma unroll
                    for (int n = 0; n < 2; ++n) acc[a][b][m][n] = (f32x4){0.f, 0.f, 0.f, 0.f};
        cur = nxt; cA = nA; cB = nB; ++ui;
        if constexpr (ALIGN_EPI) { if (wr == 1) PG8_BAR; }
    }
    PG8_WAIT_V(0);
    if constexpr (!ALIGN_EPI) { if (wr == 0) PG8_BAR; }
    PG8_BAR;
    if constexpr (Epi::AFTER_DRAIN) { E.fused(acc, cur, wr, wc, fr, fq, lds, wid, lane); S.done(cur); }
#undef PG8_SA
#undef PG8_SB
#undef PG8_STAGE
#undef PG8_LDA
#undef PG8_LDB
#undef PG8_MMA
#undef PG8_WAIT_V
#undef PG8_WAIT_L
#undef PG8_BAR
#undef PG8_SCHED
}
}

constexpr int SEQ = 8192, DM = 2048, DFF = 8192, PLE = 256, DEPTH = 4, NHEAD = 16, HD = 128;
constexpr int NWAVES = 8, NTHREADS = 512;
constexpr int LDS_BYTES = 147456;
typedef unsigned short bf16;
typedef unsigned u32x4 __attribute__((ext_vector_type(4)));
typedef unsigned u32x2 __attribute__((ext_vector_type(2)));
typedef float f32x4 __attribute__((ext_vector_type(4)));
typedef float f32x2 __attribute__((ext_vector_type(2)));
typedef short bf16x8 __attribute__((ext_vector_type(8)));
#define LAS __attribute__((address_space(3)))
#define LDS_WAIT() asm volatile("s_waitcnt lgkmcnt(0)" ::: "memory")

constexpr size_t MiB = 1u << 20;
constexpr size_t WS_SS = 880 * MiB;
constexpr size_t WS_BAR = 0;
constexpr size_t WS_AGG = 2 * MiB;
constexpr size_t WS_X0 = 8 * MiB, WS_X1 = 40 * MiB;
constexpr size_t WS_BA = 72 * MiB, WS_BB = 104 * MiB, WS_BC = 136 * MiB, WS_BD = 168 * MiB;
constexpr size_t WS_A1 = 200 * MiB;
constexpr size_t WS_PROJ = 328 * MiB;
constexpr size_t WS_PB = 456 * MiB;
constexpr size_t WS_W1T = 472 * MiB, WS_W2T = 600 * MiB, WS_WGT = 728 * MiB, WS_WPT = 760 * MiB, WS_WINT = 764 * MiB, WS_WORT = 796 * MiB,
                 WS_GAT = 812 * MiB, WS_GXT = 814 * MiB, WS_WQKVT = 816 * MiB, WS_WONT = 864 * MiB, WS_END = 893 * MiB;

struct Args {
    const float* in[22];
    float* out; unsigned char* ws;
    int ph_lo, ph_hi;
};
static_assert(sizeof(Args) == 200 && offsetof(Args, out) == 176 && offsetof(Args, ws) == 184 && offsetof(Args, ph_lo) == 192, "Args layout");

typedef const unsigned char __attribute__((address_space(4)))* KA;
#define INP(k) (*(const float* const __attribute__((address_space(4)))*)(ka + 8 * (k)))
__device__ __forceinline__ int opaque_tid() { int t = threadIdx.x; asm volatile("" : "+v"(t)); return t; }
__device__ __forceinline__ unsigned cvt_pk(float lo, float hi) { return pg8::cvt_pk_bf16(lo, hi); }
__device__ __forceinline__ float bfl(unsigned w) { return __uint_as_float(w << 16); }
__device__ __forceinline__ float bfh(unsigned w) { return __uint_as_float(w & 0xffff0000u); }
__device__ __forceinline__ float wave_sum(float v) {
#pragma unroll
    for (int o = 1; o < 64; o <<= 1) v += __shfl_xor(v, o);
    return v;
}

__device__ __forceinline__ void transpose_item(const float* W, int K, int N, const float* g, bf16* WT, int kb, int nb, int lane) {
    const int q = lane >> 4, ln = lane & 15;
    const int kbase = 64 * kb + 16 * q, n = 64 * nb + 4 * ln;
    f32x4 v[16];
    const float* wp = W + (size_t)kbase * N + n;
#pragma unroll
    for (int i = 0; i < 16; ++i) v[i] = *(const f32x4*)(wp + (size_t)i * N);
    if (g) {
#pragma unroll
        for (int i4 = 0; i4 < 4; ++i4) { const f32x4 gv = *(const f32x4*)(g + kbase + 4 * i4);
#pragma unroll
            for (int e = 0; e < 4; ++e) v[4 * i4 + e] = v[4 * i4 + e] * gv[e]; }
    }
#pragma unroll
    for (int e = 0; e < 4; ++e) {
        bf16* op = WT + (size_t)(n + e) * K + kbase;
#pragma unroll
        for (int h = 0; h < 2; ++h) {
            u32x4 o; o.x = cvt_pk(v[8 * h + 0][e], v[8 * h + 1][e]); o.y = cvt_pk(v[8 * h + 2][e], v[8 * h + 3][e]); o.z = cvt_pk(v[8 * h + 4][e], v[8 * h + 5][e]); o.w = cvt_pk(v[8 * h + 6][e], v[8 * h + 7][e]);
            *(u32x4*)(op + 8 * h) = o;
        }
    }
}

__device__ __forceinline__ void p0_phase(LAS unsigned char* lds, KA ka, unsigned char* ws, int G) {
    const int tid = opaque_tid(), lane = tid & 63, wave = tid >> 6;
    const int gw = blockIdx.x * NWAVES + wave, NGW = G * NWAVES;
    float* ss = (float*)(ws + WS_SS);
    {
        const float* x = INP(0); bf16* X0 = (bf16*)(ws + WS_X0);
        for (int row = gw; row < SEQ; row += NGW) {
            const f32x4* xr = (const f32x4*)(x + (size_t)row * DM) + lane; float s = 0.f;
            u32x2* o = (u32x2*)(X0 + (size_t)row * DM) + lane;
#pragma unroll
            for (int j = 0; j < 8; ++j) { const f32x4 v = xr[64 * j]; s += (v[0] * v[0] + v[1] * v[1]) + (v[2] * v[2] + v[3] * v[3]); u32x2 w; w.x = cvt_pk(v[0], v[1]); w.y = cvt_pk(v[2], v[3]); o[64 * j] = w; }
            s = wave_sum(s);
            if (lane < 32) ss[(size_t)row * 32 + lane] = (lane == 0) ? s : 0.f;
        }
    }
    {
        const f32x4* p = (const f32x4*)INP(1); u32x2* o = (u32x2*)(ws + WS_PB);
        const int n4 = DEPTH * SEQ * PLE / 4;
        for (int i = blockIdx.x * NTHREADS + tid; i < n4; i += G * NTHREADS) { const f32x4 v = p[i]; u32x2 w; w.x = cvt_pk(v[0], v[1]); w.y = cvt_pk(v[2], v[3]); o[i] = w; }
    }
    const int nitems_total =
        4 * (2048 / 64) * (8192 / 64) + 4 * (8192 / 64) * (2048 / 64) + 4 * (2048 / 64) * (2048 / 64) + 4 * (256 / 64) * (2048 / 64) +
        2 * (2048 / 64) * (4096 / 64) + 2 * (2048 / 64) * (2048 / 64) + 64 * (128 / 64) * (128 / 64) + 64 * (128 / 64) * (128 / 64) +
        2 * (2048 / 64) * (6144 / 64) + 2 * (2048 / 64) * (2048 / 64);
    for (int it = gw; it < nitems_total; it += NGW) {
        int r = it;
#define CONV_TRY(Wp, nmat, K, N, gp, gstride, WTp) { const int ipm = ((K) / 64) * ((N) / 64); const int tot = (nmat) * ipm; \
            if (r < tot) { const int mat = r / ipm, rr = r % ipm, kb = rr / ((N) / 64), nb = rr % ((N) / 64); const float* g_ = (gp); \
                transpose_item((Wp) + (size_t)mat * (K) * (N), (K), (N), g_ ? g_ + (size_t)mat * (gstride) : nullptr, (bf16*)(ws + (WTp)) + (size_t)mat * (K) * (N), kb, nb, lane); continue; } r -= tot; }
        CONV_TRY(INP(18), 4, 2048, 8192, INP(3), 2048, WS_W1T)
        CONV_TRY(INP(19), 4, 8192, 2048, (const float*)nullptr, 0, WS_W2T)
        CONV_TRY(INP(20), 4, 2048, 2048, INP(4), 2048, WS_WGT)
        CONV_TRY(INP(21), 4, 256, 2048, (const float*)nullptr, 0, WS_WPT)
        CONV_TRY(INP(6), 2, 2048, 4096, INP(2), 4096, WS_WINT)
        CONV_TRY(INP(14), 2, 2048, 2048, (const float*)nullptr, 0, WS_WORT)
        CONV_TRY(INP(9), 64, 128, 128, (const float*)nullptr, 0, WS_GAT)
        CONV_TRY(INP(11), 64, 128, 128, (const float*)nullptr, 0, WS_GXT)
        CONV_TRY(INP(15), 2, 2048, 6144, INP(2) + 2048, 4096, WS_WQKVT)
        CONV_TRY(INP(17), 2, 2048, 2048, (const float*)nullptr, 0, WS_WONT)
#undef CONV_TRY
    }
}

constexpr int SC_T = 64, SC_NCH = SEQ / SC_T;
constexpr int XCF_STRIDE = 132;
constexpr int XCB_STRIDE = 136;
constexpr int LDS_XCF = 0, LDS_XCB = LDS_XCF + SC_T * XCF_STRIDE * 4, LDS_YGS = LDS_XCB + SC_T * XCB_STRIDE * 2, LDS_SEG = LDS_YGS + SC_T * 128 * 2, LDS_CAR = LDS_SEG + 2 * 128 * 17 * 8, LDS_SC_END = LDS_CAR + 2 * 8 * 128 * 4;
static_assert(LDS_SC_END <= 131072, "scan LDS");

struct ScanArgs {
    const bf16* XR; const bf16* YG; bf16* Y;
    const float* conv_w; const float* conv_b;
    const bf16* gaT; const bf16* gxT;
    const float* ga_b; const float* gx_b; const float* lam;
    f32x2* agg;
};

template <bool FINAL>
__device__ __forceinline__ void scan_phase(LAS unsigned char* lds, const ScanArgs& sa, int G) {
    const int tid = opaque_tid(), lane = tid & 63, w = tid >> 6, fr = lane & 15, fq = lane >> 4;
    LAS float* xcf = (LAS float*)(lds + LDS_XCF);
    LAS bf16* xcb = (LAS bf16*)(lds + LDS_XCB);
    LAS bf16* ygs = (LAS bf16*)(lds + LDS_YGS);
    LAS f32x2* seg = (LAS f32x2*)(lds + LDS_SEG);
    int cur_hd = -1;
    bf16x8 Bf[4][4];
    float ba[2], bx[2], sp8[2];
#pragma unroll
    for (int m = 0; m < 4; ++m)
#pragma unroll
        for (int k = 0; k < 4; ++k) Bf[m][k] = (bf16x8){0, 0, 0, 0, 0, 0, 0, 0};
    ba[0] = ba[1] = bx[0] = bx[1] = sp8[0] = sp8[1] = 0.f;
    LAS float* car = (LAS float*)(lds + LDS_CAR);
    const bool fast = FINAL && (G == 256);
    if (fast) {
        if (tid < 256) {
            const int dir = tid >> 7, c = tid & 127, gch = (blockIdx.x & 15) * 128 + c, cmod = blockIdx.x >> 4;
            const f32x2* ag = sa.agg + (size_t)dir * SC_NCH * DM + gch;
            float h = 0.f;
            if (dir == 0) {
#pragma unroll 8
                for (int cc = 0; cc < SC_NCH; ++cc) { const f32x2 e = ag[(size_t)cc * DM]; if ((cc & 15) == cmod) car[(dir * 8 + (cc >> 4)) * 128 + c] = h; h = e[0] * h + e[1]; }
            } else {
#pragma unroll 8
                for (int cc = SC_NCH - 1; cc >= 0; --cc) { const f32x2 e = ag[(size_t)cc * DM]; if ((cc & 15) == cmod) car[(dir * 8 + (cc >> 4)) * 128 + c] = h; h = e[0] * h + e[1]; }
            }
        }
    }
    for (int it = blockIdx.x; it < SC_NCH * NHEAD; it += G) {
        const int hd = it & 15, chunk = it >> 4, t0 = chunk * SC_T;
        __syncthreads();
        if (hd != cur_hd) {
            cur_hd = hd;
#pragma unroll
            for (int dir = 0; dir < 2; ++dir) {
                const bf16* wa = sa.gaT + ((size_t)(dir * 16 + hd) * 128 + 16 * w + fr) * 128 + 8 * fq;
                const bf16* wx = sa.gxT + ((size_t)(dir * 16 + hd) * 128 + 16 * w + fr) * 128 + 8 * fq;
#pragma unroll
                for (int k = 0; k < 4; ++k) { Bf[dir * 2 + 0][k] = *(const bf16x8*)(wa + 32 * k); Bf[dir * 2 + 1][k] = *(const bf16x8*)(wx + 32 * k); }
                const int gch = hd * 128 + 16 * w + fr;
                ba[dir] = sa.ga_b[dir * DM + gch]; bx[dir] = sa.gx_b[dir * DM + gch];
                sp8[dir] = 8.f * log1pf(expf(-sa.lam[dir * DM + gch]));
            }
        }
        {
            const int cp = tid & 63, tg = tid >> 6;
            const int gc = hd * 128 + 2 * cp;
            float x0[11], x1[11];
#pragma unroll
            for (int q = 0; q < 11; ++q) { const int t = t0 + 8 * tg - 1 + q; unsigned v = 0u; if (t >= 0 && t < SEQ) v = *(const unsigned*)(sa.XR + (size_t)t * DM + gc); x0[q] = bfl(v); x1[q] = bfh(v); }
            float w0[4], w1[4];
#pragma unroll
            for (int k = 0; k < 4; ++k) { const f32x2 wv = *(const f32x2*)(sa.conv_w + k * DM + gc); w0[k] = wv[0]; w1[k] = wv[1]; }
            const f32x2 bv = *(const f32x2*)(sa.conv_b + gc);
#pragma unroll
            for (int q = 0; q < 8; ++q) {
                const float c0 = bv[0] + ((w0[0] * x0[q] + w0[1] * x0[q + 1]) + (w0[2] * x0[q + 2] + w0[3] * x0[q + 3]));
                const float c1 = bv[1] + ((w1[0] * x1[q] + w1[1] * x1[q + 1]) + (w1[2] * x1[q + 2] + w1[3] * x1[q + 3]));
                const int tau = 8 * tg + q;
                *(LAS f32x2*)(xcf + tau * XCF_STRIDE + 2 * cp) = (f32x2){c0, c1};
                *(LAS unsigned*)(xcb + tau * XCB_STRIDE + 2 * cp) = cvt_pk(c0, c1);
            }
            if (FINAL) {
#pragma unroll
                for (int i = 0; i < 2; ++i) { const int idx = tid + i * NTHREADS, row = idx >> 4, c16 = idx & 15;
                    *(LAS u32x4*)(ygs + row * 128 + c16 * 8) = *(const u32x4*)(sa.YG + (size_t)(t0 + row) * DM + hd * 128 + c16 * 8); }
            }
        }
        __syncthreads();
        f32x4 acc[4][4];
#pragma unroll
        for (int m = 0; m < 4; ++m)
#pragma unroll
            for (int mb = 0; mb < 4; ++mb) acc[m][mb] = (f32x4){0.f, 0.f, 0.f, 0.f};
#pragma unroll
        for (int mb = 0; mb < 4; ++mb) {
            bf16x8 Af[4];
#pragma unroll
            for (int k = 0; k < 4; ++k) Af[k] = *(const LAS bf16x8*)(xcb + (16 * mb + fr) * XCB_STRIDE + 32 * k + 8 * fq);
#pragma unroll
            for (int m = 0; m < 4; ++m)
#pragma unroll
                for (int k = 0; k < 4; ++k) acc[m][mb] = __builtin_amdgcn_mfma_f32_16x16x32_bf16(Af[k], Bf[m][k], acc[m][mb], 0, 0, 0);
        }
        const int ch = 16 * w + fr;
#pragma unroll
        for (int mb = 0; mb < 4; ++mb) {
            float xv[4];
#pragma unroll
            for (int j = 0; j < 4; ++j) xv[j] = xcf[(16 * mb + 4 * fq + j) * XCF_STRIDE + ch];
#pragma unroll
            for (int dir = 0; dir < 2; ++dir) {
#pragma unroll
                for (int j = 0; j < 4; ++j) {
                    const float r = pg8::fsigmoid(acc[2 * dir][mb][j] + ba[dir]);
                    const float ig = pg8::fsigmoid(acc[2 * dir + 1][mb][j] + bx[dir]);
                    const float la = -sp8[dir] * r;
                    const float av = __expf(la);
                    const float x2 = 2.f * la;
                    const float om = (x2 > -0.04f) ? -x2 * (1.f + x2 * (0.5f + x2 * (0.16666667f + x2 * 0.041666668f))) : 1.f - av * av;
                    acc[2 * dir][mb][j] = av;
                    acc[2 * dir + 1][mb][j] = sqrtf(om) * ig * xv[j];
                }
                const f32x4 A = acc[2 * dir][mb], U = acc[2 * dir + 1][mb];
                float P, Q;
                if (dir == 0) { P = (A[0] * A[1]) * (A[2] * A[3]); Q = ((U[0] * A[1] + U[1]) * A[2] + U[2]) * A[3] + U[3]; }
                else          { P = (A[0] * A[1]) * (A[2] * A[3]); Q = ((U[3] * A[2] + U[2]) * A[1] + U[1]) * A[0] + U[0]; }
                seg[(dir * 128 + ch) * 17 + mb * 4 + fq] = (f32x2){P, Q};
            }
        }
        __syncthreads();
        if (tid < 256) {
            const int dir = tid >> 7, c = tid & 127, gch = hd * 128 + c;
            LAS f32x2* sg = seg + (dir * 128 + c) * 17;
            if (!FINAL) {
                float h = 0.f, Pt = 1.f;
                if (dir == 0) { for (int s = 0; s < 16; ++s) { const f32x2 e = sg[s]; h = e[0] * h + e[1]; Pt *= e[0]; } }
                else          { for (int s = 15; s >= 0; --s) { const f32x2 e = sg[s]; h = e[0] * h + e[1]; Pt *= e[0]; } }
                sa.agg[((size_t)dir * SC_NCH + chunk) * DM + gch] = (f32x2){Pt, h};
            } else {
                float h = 0.f;
                if (fast) h = car[(dir * 8 + (chunk >> 4)) * 128 + c];
                else {
                    const f32x2* ag = sa.agg + (size_t)dir * SC_NCH * DM + gch;
                    if (dir == 0) { for (int cc = 0; cc < chunk; ++cc) { const f32x2 e = ag[(size_t)cc * DM]; h = e[0] * h + e[1]; } }
                    else          { for (int cc = SC_NCH - 1; cc > chunk; --cc) { const f32x2 e = ag[(size_t)cc * DM]; h = e[0] * h + e[1]; } }
                }
                if (dir == 0) { for (int s = 0; s < 16; ++s) { const f32x2 e = sg[s]; sg[s] = (f32x2){h, 0.f}; h = e[0] * h + e[1]; } }
                else          { for (int s = 15; s >= 0; --s) { const f32x2 e = sg[s]; sg[s] = (f32x2){h, 0.f}; h = e[0] * h + e[1]; } }
            }
        }
        if (FINAL) {
            __syncthreads();
#pragma unroll
            for (int mb = 0; mb < 4; ++mb) {
                float hs[4];
                { float h = seg[(0 * 128 + ch) * 17 + mb * 4 + fq][0]; const f32x4 A = acc[0][mb], U = acc[1][mb];
#pragma unroll
                  for (int j = 0; j < 4; ++j) { h = A[j] * h + U[j]; hs[j] = h; } }
                { float h = seg[(1 * 128 + ch) * 17 + mb * 4 + fq][0]; const f32x4 A = acc[2][mb], U = acc[3][mb];
#pragma unroll
                  for (int j = 3; j >= 0; --j) { h = A[j] * h + U[j]; hs[j] += h; } }
#pragma unroll
                for (int j = 0; j < 4; ++j) {
                    LAS bf16* yp = ygs + (16 * mb + 4 * fq + j) * 128 + ch;
                    const float yg = __uint_as_float((unsigned)(*yp) << 16);
                    *yp = (bf16)(cvt_pk(hs[j] * yg, 0.f) & 0xffffu);
                }
            }
            __syncthreads();
#pragma unroll
            for (int i = 0; i < 2; ++i) { const int idx = tid + i * NTHREADS, row = idx >> 4, c16 = idx & 15;
                *(u32x4*)(sa.Y + (size_t)(t0 + row) * DM + hd * 128 + c16 * 8) = *(const LAS u32x4*)(ygs + row * 128 + c16 * 8); }
        }
    }
}

struct AttArgs { const bf16* Q; const bf16* K; const bf16* VT; bf16* O; const float* rpb; };

__device__ __forceinline__ void attn_phase(LAS unsigned char* lds, const AttArgs& aa, int G) {
    const int tid = opaque_tid(), lane = tid & 63, w = tid >> 6, fr = lane & 15, fq = lane >> 4;
    const int hsel = w >> 2, qg = w & 3;
    LAS float* rp = (LAS float*)lds;
    const int c0 = 16 * qg, kb0 = (qg == 0) ? 0 : (qg == 1) ? 8 : (qg == 2) ? 24 : 32;
    const int qc = c0 + fr;
    const int cs = min(max(qc - 8, 0), 48);
    for (int id = blockIdx.x; id < 128 * 8; id += G) {
        const int hp = id & 7, r = id >> 3, h = hp * 2 + hsel;
        const int rs = min(max(r - 4, 0), 120);
        __syncthreads();
        for (int i = tid; i < 2 * 465; i += NTHREADS) { const int hh = i / 465, e = i % 465; rp[hh * 480 + e] = aa.rpb[(size_t)(hp * 2 + hh) * 465 + e]; }
        __syncthreads();
        bf16x8 qf[4];
        { const bf16* qp = aa.Q + (size_t)(r * 64 + qc) * DM + h * 128 + 8 * fq;
#pragma unroll
          for (int k = 0; k < 4; ++k) qf[k] = *(const bf16x8*)(qp + 32 * k); }
        f32x4 s[8][2];
        const int krow = 8 * (fr >> 2) + (fr & 3);
#pragma unroll
        for (int i = 0; i < 8; ++i)
#pragma unroll
            for (int nb = 0; nb < 2; ++nb) {
                const bf16* kp = aa.K + (size_t)((rs + i) * 64 + kb0 + krow + 4 * nb) * DM + h * 128 + 8 * fq;
                f32x4 c = (f32x4){0.f, 0.f, 0.f, 0.f};
#pragma unroll
                for (int k = 0; k < 4; ++k) { const bf16x8 kf = *(const bf16x8*)(kp + 32 * k); c = __builtin_amdgcn_mfma_f32_16x16x32_bf16(kf, qf[k], c, 0, 0, 0); }
                s[i][nb] = c;
            }
        float mx = -INFINITY;
        const LAS float* rph = rp + hsel * 480;
#pragma unroll
        for (int i = 0; i < 8; ++i) {
            const int relr = rs + i - r + 7;
#pragma unroll
            for (int nb = 0; nb < 2; ++nb)
#pragma unroll
                for (int j = 0; j < 4; ++j) {
                    const int kc = kb0 + 8 * fq + 4 * nb + j;
                    const bool valid = (unsigned)(kc - cs) < 16u;
                    const int idx = valid ? relr * 31 + (kc - qc + 15) : 0;
                    const float v = valid ? s[i][nb][j] + rph[idx] : -INFINITY;
                    s[i][nb][j] = v; mx = fmaxf(mx, v);
                }
        }
        mx = fmaxf(mx, __shfl_xor(mx, 16)); mx = fmaxf(mx, __shfl_xor(mx, 32));
        float l = 0.f;
#pragma unroll
        for (int i = 0; i < 8; ++i)
#pragma unroll
            for (int nb = 0; nb < 2; ++nb)
#pragma unroll
                for (int j = 0; j < 4; ++j) { const float p = __expf(s[i][nb][j] - mx); s[i][nb][j] = p; l += p; }
        l += __shfl_xor(l, 16); l += __shfl_xor(l, 32);
        f32x4 o[8];
#pragma unroll
        for (int db = 0; db < 8; ++db) o[db] = (f32x4){0.f, 0.f, 0.f, 0.f};
#pragma unroll
        for (int i = 0; i < 8; ++i) {
            u32x4 pw; pw.x = cvt_pk(s[i][0][0], s[i][0][1]); pw.y = cvt_pk(s[i][0][2], s[i][0][3]); pw.z = cvt_pk(s[i][1][0], s[i][1][1]); pw.w = cvt_pk(s[i][1][2], s[i][1][3]);
            const bf16x8 pb = __builtin_bit_cast(bf16x8, pw);
            const bf16* vp = aa.VT + (size_t)(h * 128 + fr) * SEQ + (rs + i) * 64 + kb0 + 8 * fq;
#pragma unroll
            for (int db = 0; db < 8; ++db) { const bf16x8 vf = *(const bf16x8*)(vp + (size_t)(16 * db) * SEQ); o[db] = __builtin_amdgcn_mfma_f32_16x16x32_bf16(vf, pb, o[db], 0, 0, 0); }
        }
        const float inv = 1.f / l;
        bf16* op = aa.O + (size_t)(r * 64 + qc) * DM + h * 128 + 4 * fq;
#pragma unroll
        for (int db = 0; db < 8; ++db) { u32x2 wv; wv.x = cvt_pk(o[db][0] * inv, o[db][1] * inv); wv.y = cvt_pk(o[db][2] * inv, o[db][3] * inv); *(u32x2*)(op + 16 * db) = wv; }
    }
}

#define ATT_BAR() do { asm volatile("s_waitcnt lgkmcnt(0)" ::: "memory"); __builtin_amdgcn_s_barrier(); asm volatile("" ::: "memory"); } while (0)
constexpr int KS_PITCH = 136, VS_PITCH = 72;
constexpr int ATT_KS = 0, ATT_VS = ATT_KS + 2 * 64 * KS_PITCH * 2, ATT_RP = ATT_VS + 2 * 128 * VS_PITCH * 2, ATT_END = ATT_RP + 2048;
static_assert(ATT_END <= 131072, "attention LDS");
__device__ __forceinline__ void attn_phase2(LAS unsigned char* lds, const AttArgs& aa, int G) {
    const int tid = opaque_tid(), lane = tid & 63, w = tid >> 6, fr = lane & 15, fq = lane >> 4;
    const int rsel = w >> 2, qg = w & 3;
    LAS bf16* KS = (LAS bf16*)(lds + ATT_KS);
    LAS bf16* VS = (LAS bf16*)(lds + ATT_VS);
    LAS float* rp = (LAS float*)(lds + ATT_RP);
    const int c0 = 16 * qg, kb0 = (qg == 0) ? 0 : (qg == 1) ? 8 : (qg == 2) ? 24 : 32;
    const int qc = c0 + fr;
    const int cs = min(max(qc - 8, 0), 48);
    const int krow = 8 * (fr >> 2) + (fr & 3);
    const int ktok0 = tid >> 4, kpart = tid & 15, vd0 = tid >> 3, vpart = tid & 7;
    for (int id = blockIdx.x; id < 64 * NHEAD; id += G) {
        const int h = id & 15, rpair = id >> 4, r0 = 2 * rpair;
        const int rsA = min(max(r0 - 4, 0), 120), rsB = min(max(r0 - 3, 0), 120), off = rsB - rsA, nJ = 8 + off;
        const int r = r0 + rsel, rs = rsel ? rsB : rsA, woff = rsel ? off : 0;
        u32x4 R[9][2];
#pragma unroll
        for (int jj = 0; jj < 9; ++jj) { R[jj][0] = (u32x4){0u, 0u, 0u, 0u}; R[jj][1] = (u32x4){0u, 0u, 0u, 0u}; }
        const bf16* kbase = aa.K + (size_t)(rsA * 64 + ktok0) * DM + h * 128 + kpart * 8;
        const bf16* vbase = aa.VT + (size_t)(h * 128 + vd0) * SEQ + rsA * 64 + vpart * 8;
#pragma unroll
        for (int jj = 0; jj < 9; ++jj) if (jj < nJ) {
#pragma unroll
            for (int u = 0; u < 2; ++u) R[jj][u] = *(const u32x4*)(kbase + (size_t)(jj * 64 + 32 * u) * DM);
        }
        for (int i = tid; i < 465; i += NTHREADS) rp[i] = aa.rpb[(size_t)h * 465 + i];
        bf16x8 qf[4];
        { const bf16* qp = aa.Q + (size_t)(r * 64 + qc) * DM + h * 128 + 8 * fq;
#pragma unroll
          for (int k = 0; k < 4; ++k) qf[k] = *(const bf16x8*)(qp + 32 * k); }
#define ATT_KWRITE(j, b) do { _Pragma("unroll") for (int u = 0; u < 2; ++u) *(LAS u32x4*)(KS + (b) * 64 * KS_PITCH + (ktok0 + 32 * u) * KS_PITCH + kpart * 8) = R[j][u]; } while (0)
#define ATT_VLOAD(j) do { _Pragma("unroll") for (int u = 0; u < 2; ++u) R[j][u] = *(const u32x4*)(vbase + (size_t)(64 * u) * SEQ + (j) * 64); } while (0)
#define ATT_VWRITE(j, b) do { _Pragma("unroll") for (int u = 0; u < 2; ++u) *(LAS u32x4*)(VS + (b) * 128 * VS_PITCH + (vd0 + 64 * u) * VS_PITCH + vpart * 8) = R[j][u]; } while (0)
#define ATT_QK(i, b) do { _Pragma("unroll") for (int nb = 0; nb < 2; ++nb) { f32x4 c_ = (f32x4){0.f, 0.f, 0.f, 0.f}; \
            _Pragma("unroll") for (int k = 0; k < 4; ++k) { const bf16x8 kf = *(const LAS bf16x8*)(KS + (b) * 64 * KS_PITCH + (kb0 + krow + 4 * nb) * KS_PITCH + 32 * k + 8 * fq); \
                c_ = __builtin_amdgcn_mfma_f32_16x16x32_bf16(kf, qf[k], c_, 0, 0, 0); } s[i][nb] = c_; } } while (0)
#define ATT_PV(i, b) do { u32x4 pw; pw.x = cvt_pk(s[i][0][0], s[i][0][1]); pw.y = cvt_pk(s[i][0][2], s[i][0][3]); pw.z = cvt_pk(s[i][1][0], s[i][1][1]); pw.w = cvt_pk(s[i][1][2], s[i][1][3]); \
            const bf16x8 pb = __builtin_bit_cast(bf16x8, pw); \
            _Pragma("unroll") for (int db = 0; db < 8; ++db) { const bf16x8 vf = *(const LAS bf16x8*)(VS + (b) * 128 * VS_PITCH + (16 * db + fr) * VS_PITCH + kb0 + 8 * fq); \
                o[db] = __builtin_amdgcn_mfma_f32_16x16x32_bf16(vf, pb, o[db], 0, 0, 0); } } while (0)
        f32x4 s[8][2];
        ATT_KWRITE(0, 0); ATT_VLOAD(0);
        ATT_BAR();
#pragma unroll
        for (int jj = 0; jj < 9; ++jj) {
            if (jj + 1 < 9) { if (jj + 1 < nJ) { ATT_KWRITE((jj + 1 < 9 ? jj + 1 : 8), ((jj + 1) & 1)); ATT_VLOAD((jj + 1 < 9 ? jj + 1 : 8)); } }
            if (woff == 0) { if (jj < 8) ATT_QK((jj < 8 ? jj : 7), (jj & 1)); }
            else           { if (jj >= 1) ATT_QK((jj >= 1 ? jj - 1 : 0), (jj & 1)); }
            ATT_BAR();
        }
        float mx = -INFINITY;
#pragma unroll
        for (int i = 0; i < 8; ++i) {
            const int relr = rs + i - r + 7;
#pragma unroll
            for (int nb = 0; nb < 2; ++nb)
#pragma unroll
                for (int j = 0; j < 4; ++j) {
                    const int kc = kb0 + 8 * fq + 4 * nb + j;
                    const bool valid = (unsigned)(kc - cs) < 16u;
                    const int idx = valid ? relr * 31 + (kc - qc + 15) : 0;
                    const float v = valid ? s[i][nb][j] + rp[idx] : -INFINITY;
                    s[i][nb][j] = v; mx = fmaxf(mx, v);
                }
        }
        mx = fmaxf(mx, __shfl_xor(mx, 16)); mx = fmaxf(mx, __shfl_xor(mx, 32));
        float l = 0.f;
#pragma unroll
        for (int i = 0; i < 8; ++i)
#pragma unroll
            for (int nb = 0; nb < 2; ++nb)
#pragma unroll
                for (int j = 0; j < 4; ++j) { const float p = __expf(s[i][nb][j] - mx); s[i][nb][j] = p; l += p; }
        l += __shfl_xor(l, 16); l += __shfl_xor(l, 32);
        f32x4 o[8];
#pragma unroll
        for (int db = 0; db < 8; ++db) o[db] = (f32x4){0.f, 0.f, 0.f, 0.f};
        ATT_VWRITE(0, 0);
        ATT_BAR();
#pragma unroll
        for (int jj = 0; jj < 9; ++jj) {
            if (jj + 1 < 9) { if (jj + 1 < nJ) ATT_VWRITE((jj + 1 < 9 ? jj + 1 : 8), ((jj + 1) & 1)); }
            if (woff == 0) { if (jj < 8) ATT_PV((jj < 8 ? jj : 7), (jj & 1)); }
            else           { if (jj >= 1) ATT_PV((jj >= 1 ? jj - 1 : 0), (jj & 1)); }
            ATT_BAR();
        }
        const float inv = 1.f / l;
        bf16* op = aa.O + (size_t)(r * 64 + qc) * DM + h * 128 + 4 * fq;
#pragma unroll
        for (int db = 0; db < 8; ++db) { u32x2 wv; wv.x = cvt_pk(o[db][0] * inv, o[db][1] * inv); wv.y = cvt_pk(o[db][2] * inv, o[db][3] * inv); *(u32x2*)(op + 16 * db) = wv; }
#undef ATT_KWRITE
#undef ATT_VLOAD
#undef ATT_VWRITE
#undef ATT_QK
#undef ATT_PV
    }
}

__device__ __forceinline__ void final_phase(float* out, const float* ss, const float* g, int G) {
    const int tid = opaque_tid(), lane = tid & 63, wave = tid >> 6;
    const int gw = blockIdx.x * NWAVES + wave, NGW = G * NWAVES;
    for (int row = gw; row < SEQ; row += NGW) {
        const float rs = pg8::rstd_row(ss, row);
        f32x4* o = (f32x4*)(out + (size_t)row * DM) + lane; const f32x4* gp = (const f32x4*)g + lane;
#pragma unroll
        for (int j = 0; j < 8; ++j) { f32x4 v = o[64 * j]; const f32x4 gv = gp[64 * j]; v = v * rs * gv; o[64 * j] = v; }
    }
}

#define XB_TMO      128
#define XB_XCNT(j)  (256  + 64 * (j))
#define XB_XSUB(j)  (1280 + 64 * (j))
#define XB_XGEN(j)  (2304 + 64 * (j))
#define XB_TOP      3328
#define XB_TOPGEN   3392
#define XCD_BAR_WORDS 3456
#define XB_SPIN_CAP (1u << 18)

__device__ __forceinline__ unsigned xb_ld(unsigned* p)              { return __hip_atomic_load(p, __ATOMIC_RELAXED, __HIP_MEMORY_SCOPE_AGENT); }
__device__ __forceinline__ unsigned xb_add(unsigned* p, unsigned v) { return __hip_atomic_fetch_add(p, v, __ATOMIC_RELAXED, __HIP_MEMORY_SCOPE_AGENT); }
__device__ __forceinline__ unsigned xb_xcc_id() { return (unsigned)__builtin_amdgcn_s_getreg((3 << 11) | 20) & 0xFu; }
#define XB_SPIN(cond, bar) do { unsigned _sp = 0; while (cond) { __builtin_amdgcn_s_sleep(1); \
    if ((++_sp & 255u) == 0u) { if (xb_ld(&(bar)[XB_TMO])) break; if (_sp > XB_SPIN_CAP) { atomicAdd(&(bar)[XB_TMO], 1u); break; } } } } while (0)

struct XcdBarrier {
    unsigned* bar; unsigned x;
    volatile LAS unsigned* st;
};

__device__ __forceinline__ XcdBarrier xcd_barrier_post(unsigned* bar, volatile LAS unsigned* st) {
    XcdBarrier b; b.bar = bar; b.x = xb_xcc_id(); b.st = st;
    if (threadIdx.x == 0) (void)xb_add(&bar[XB_XCNT(b.x)], 1u);
    return b;
}
__device__ __forceinline__ void xcd_barrier_complete(unsigned* bar, unsigned x, unsigned& nloc, unsigned& nx) {
    const unsigned G = gridDim.x * gridDim.y * gridDim.z;
    unsigned sum, cnt, mine, sp = 0u;
    for (;;) {
        sum = 0u; cnt = 0u; mine = 0u;
#pragma unroll
        for (unsigned j = 0; j < 16; ++j) { const unsigned c = xb_ld(&bar[XB_XCNT(j)]); sum += c; cnt += (c > 0u) ? 1u : 0u; mine = (j == x) ? c : mine; }
        if (sum == G) break;
        __builtin_amdgcn_s_sleep(1);
        if ((++sp & 255u) == 0u) { if (xb_ld(&bar[XB_TMO])) break; if (sp > XB_SPIN_CAP) { atomicAdd(&bar[XB_TMO], 1u); break; } }
    }
    nloc = mine > 0u ? mine : 1u; nx = cnt > 0u ? cnt : 1u;
}

__device__ __forceinline__ void xcd_barrier(const XcdBarrier& b) {
    asm volatile("s_waitcnt vmcnt(0)" ::: "memory");
    __syncthreads();
    if (threadIdx.x == 0) {
        unsigned* bar = b.bar;
        __builtin_amdgcn_s_waitcnt(0);
        unsigned nloc = b.st[0], nx = b.st[1];
        if (nloc == 0u) { xcd_barrier_complete(bar, b.x, nloc, nx); b.st[0] = nloc; b.st[1] = nx; }
        const unsigned old = xb_add(&bar[XB_XSUB(b.x)], 1u);
        const unsigned gen = old / nloc;
        if (old + 1u == (gen + 1u) * nloc) {
            __builtin_amdgcn_fence(__ATOMIC_RELEASE, "agent");
            asm volatile("s_waitcnt vmcnt(0)" ::: "memory");
            const unsigned og = xb_add(&bar[XB_TOP], 1u);
            const unsigned tg = og / nx;
            if (og + 1u == (tg + 1u) * nx) xb_add(&bar[XB_TOPGEN], 1u);
            else XB_SPIN(xb_ld(&bar[XB_TOPGEN]) == tg, bar);
            __builtin_amdgcn_fence(__ATOMIC_ACQUIRE, "agent");
            xb_add(&bar[XB_XGEN(b.x)], 1u);
            asm volatile("s_waitcnt vmcnt(0)" ::: "memory");
        } else {
            XB_SPIN(xb_ld(&bar[XB_XGEN(b.x)]) == gen, bar);
            __builtin_amdgcn_fence(__ATOMIC_ACQUIRE, "agent");
            asm volatile("s_waitcnt vmcnt(0)" ::: "memory");
        }
    }
    __syncthreads();
}

constexpr int N_PHASES = 28;
#ifndef PGA
#define PGA true
#endif
#ifndef PGA1
#define PGA1 true
#endif
#ifndef PGS
#define PGS true
#endif
#ifndef DBG_DUMP_OFF
#define DBG_DUMP_OFF WS_BC
#endif
#ifndef DBG_NPH
#define DBG_NPH N_PHASES
#endif
#ifndef DBG_DUMP
#define DBG_DUMP 0
#endif
enum Kind { K_P0, K_WIN, K_S1, K_S2, K_WOUT, K_QKV, K_ATT, K_W1, K_W2, K_PLE, K_FINAL, K_DUMP };

__global__ void __launch_bounds__(NTHREADS, 2) mega_fwd(Args args) {
    extern __shared__ __attribute__((aligned(16))) unsigned char lds_raw[];
    LAS unsigned char* lds = (LAS unsigned char*)lds_raw;
    cg::grid_group grid = cg::this_grid();
    const int G = gridDim.x;
    KA ka0 = (KA)__builtin_amdgcn_kernarg_segment_ptr();
    const int lo = *(const int __attribute__((address_space(4)))*)(ka0 + 192), hi = *(const int __attribute__((address_space(4)))*)(ka0 + 196);
    if (hi - lo > 1) {
        volatile LAS unsigned* st = (volatile LAS unsigned*)(lds + 131072 + 64);
        if (threadIdx.x < 2) st[threadIdx.x] = 0u;
        __syncthreads();
        unsigned char* ws0 = *(unsigned char* const __attribute__((address_space(4)))*)(ka0 + 184);
        (void)xcd_barrier_post((unsigned*)(ws0 + WS_BAR), st);
    }
    if (hi > 100000) grid.sync();
    for (int ph = lo; ph < hi; ++ph) {
        KA ka = ka0; asm volatile("" : "+s"(ka));
        unsigned char* ws = *(unsigned char* const __attribute__((address_space(4)))*)(ka + 184);
        float* hout = *(float* const __attribute__((address_space(4)))*)(ka + 176);
        float* ss = (float*)(ws + WS_SS);
        int kind, L = 0;
        if (ph == 0) kind = K_P0; else if (ph == 99) kind = K_DUMP; else if (ph == N_PHASES - 1) kind = K_FINAL;
        else { int q = ph - 1; const int pair = q / 13; q -= pair * 13; L = 2 * pair;
            if (q < 7) { kind = (q == 0) ? K_WIN : (q == 1) ? K_S1 : (q == 2) ? K_S2 : (q == 3) ? K_WOUT : (q == 4) ? K_W1 : (q == 5) ? K_W2 : K_PLE; }
            else { q -= 7; L += 1; kind = (q == 0) ? K_QKV : (q == 1) ? K_ATT : (q == 2) ? K_WOUT : (q == 3) ? K_W1 : (q == 4) ? K_W2 : K_PLE; } }
        const int j = L >> 1;
        bf16* Xc = (bf16*)(ws + ((L & 1) ? WS_X1 : WS_X0));
        bf16* Xo = (bf16*)(ws + ((L & 1) ? WS_X0 : WS_X1));
        const float* ss_mix = ss + (size_t)(3 * L) * SEQ * 32; float* ss_mlp = ss + (size_t)(3 * L + 1) * SEQ * 32; float* ss_ple = ss + (size_t)(3 * L + 2) * SEQ * 32; float* ss_next = ss + (size_t)(3 * L + 3) * SEQ * 32;
        switch (kind) {
        case K_P0:
#ifndef DIS_P0
 p0_phase(lds, ka, ws, G);
#endif
 break;
        case K_WIN: {
#ifdef DBG_BJ0
            pg8::Gemm g{Xc, (const bf16*)(ws + WS_WINT), SEQ, 2 * DM, DM};
#elif defined(DBG_AX1)
            pg8::Gemm g{(L == 2) ? Xo : Xc, (const bf16*)(ws + WS_WINT) + (size_t)j * DM * 2 * DM, SEQ, 2 * DM, DM};
#else
            pg8::Gemm g{Xc, (const bf16*)(ws + WS_WINT) + (size_t)j * DM * 2 * DM, SEQ, 2 * DM, DM};
#endif
            pg8::StaticOrder S; S.init(SEQ, 2 * DM, G, (int)blockIdx.x);
#ifdef DBG_FRESHOUT
            pg8::EpiAct<0> E{(L == 2) ? (bf16*)(ws + WS_PROJ + 96 * MiB) : (bf16*)(ws + WS_BA), (bf16*)(ws + WS_BB), DM, DM, ss_mix};
#elif defined(DBG_SS0)
            pg8::EpiAct<0> E{(bf16*)(ws + WS_BA), (bf16*)(ws + WS_BB), DM, DM, ss};
#else
            pg8::EpiAct<0> E{(bf16*)(ws + WS_BA), (bf16*)(ws + WS_BB), DM, DM, ss_mix};
#endif
#ifndef DIS_ACT0
            pg8::gemm_phase<pg8::EpiAct<0>, pg8::StaticOrder, PGA, PGS>(lds, g, S, E);
#endif
        } break;
        case K_S1: case K_S2: {
            ScanArgs sa{(const bf16*)(ws + WS_BA), (const bf16*)(ws + WS_BB), (bf16*)(ws + WS_BC),
                        INP(7) + (size_t)j * 4 * DM, INP(8) + (size_t)j * DM,
                        (const bf16*)(ws + WS_GAT) + (size_t)j * 32 * 128 * 128, (const bf16*)(ws + WS_GXT) + (size_t)j * 32 * 128 * 128,
                        INP(10) + (size_t)j * 2 * DM, INP(12) + (size_t)j * 2 * DM, INP(13) + (size_t)j * 2 * DM,
                        (f32x2*)(ws + WS_AGG)};
            #ifndef DIS_SCAN
            if (kind == K_S1) scan_phase<false>(lds, sa, G); else scan_phase<true>(lds, sa, G);
#endif
        } break;
        case K_QKV: {
            {
                pg8::Gemm g{Xc, (const bf16*)(ws + WS_WQKVT) + (size_t)j * 3 * DM * DM, SEQ, 2 * DM, DM};
                pg8::StaticOrder S; S.init(SEQ, 2 * DM, G, (int)blockIdx.x);
                pg8::EpiAct<1> E{(bf16*)(ws + WS_BA), (bf16*)(ws + WS_BB), DM, DM, ss_mix};
#ifndef DIS_ACT1
                pg8::gemm_phase<pg8::EpiAct<1>, pg8::StaticOrder, PGA, PGS>(lds, g, S, E);
#endif
            }
            __syncthreads();
            {
                pg8::Gemm g{(const bf16*)(ws + WS_WQKVT) + (size_t)j * 3 * DM * DM + (size_t)2 * DM * DM, Xc, DM, SEQ, DM};
                pg8::StaticOrder S; S.init(DM, SEQ, G, (int)blockIdx.x);
                pg8::EpiAct<4> E{(bf16*)(ws + WS_BD), nullptr, SEQ, 0, ss_mix};
#ifndef DIS_ACT4
                pg8::gemm_phase<pg8::EpiAct<4>, pg8::StaticOrder, PGA1, PGS>(lds, g, S, E);
#endif
            }
        } break;
        case K_ATT: {
            AttArgs aa{(const bf16*)(ws + WS_BA), (const bf16*)(ws + WS_BB), (const bf16*)(ws + WS_BD), (bf16*)(ws + WS_BC), INP(16) + (size_t)j * NHEAD * 465};
#ifndef DIS_ATT
#ifdef ATT_V1
            attn_phase(lds, aa, G);
#else
            attn_phase2(lds, aa, G);
#endif
#endif
        } break;
        case K_WOUT: case K_W2: {
            const bf16* A; const bf16* Bt; int K;
            float* sso; bf16* hb;
            if (kind == K_WOUT) { A = (const bf16*)(ws + WS_BC); K = DM; Bt = (L & 1) ? (const bf16*)(ws + WS_WONT) + (size_t)j * DM * DM : (const bf16*)(ws + WS_WORT) + (size_t)j * DM * DM; sso = ss_mlp; hb = Xo; }
            else { A = (const bf16*)(ws + WS_A1); K = DFF; Bt = (const bf16*)(ws + WS_W2T) + (size_t)L * DM * DFF; sso = ss_ple; hb = Xc; }
            const float* base = (kind == K_WOUT && L == 0) ? INP(0) : hout;
            pg8::Gemm g{A, Bt, SEQ, DM, K};
            pg8::StaticOrder S; S.init(SEQ, DM, G, (int)blockIdx.x);
            pg8::EpiRes<0> E{base, hout, hb, sso, nullptr, nullptr};
#ifndef DIS_RES0
            pg8::gemm_phase<pg8::EpiRes<0>, pg8::StaticOrder, PGA1, PGS>(lds, g, S, E);
#endif
        } break;
        case K_W1: {
            {
                int Kp = PLE; asm volatile("" : "+s"(Kp));
                pg8::Gemm g{(const bf16*)(ws + WS_PB) + (size_t)L * SEQ * PLE, (const bf16*)(ws + WS_WPT) + (size_t)L * DM * PLE, SEQ, DM, Kp};
                pg8::StaticOrder S; S.init(SEQ, DM, G, (int)blockIdx.x);
                pg8::EpiAct<3> E{(bf16*)(ws + WS_PROJ) + (size_t)L * SEQ * DM, nullptr, DM, 0, nullptr};
#ifndef DIS_ACT3
                pg8::gemm_phase<pg8::EpiAct<3>, pg8::StaticOrder, PGA1, PGS>(lds, g, S, E);
#endif
            }
            __syncthreads();
            pg8::Gemm g{Xo, (const bf16*)(ws + WS_W1T) + (size_t)L * DM * DFF, SEQ, DFF, DM};
            pg8::StaticOrder S; S.init(SEQ, DFF, G, (int)blockIdx.x);
            pg8::EpiAct<2> E{(bf16*)(ws + WS_A1), nullptr, DFF, 0, ss_mlp};
#ifndef DIS_ACT2
            pg8::gemm_phase<pg8::EpiAct<2>, pg8::StaticOrder, PGA, PGS>(lds, g, S, E);
#endif
        } break;
        case K_PLE: {
            pg8::Gemm g{Xc, (const bf16*)(ws + WS_WGT) + (size_t)L * DM * DM, SEQ, DM, DM};
            pg8::StaticOrder S; S.init(SEQ, DM, G, (int)blockIdx.x);
            pg8::EpiRes<1> E{hout, hout, Xo, ss_next, ss_ple, (const bf16*)(ws + WS_PROJ) + (size_t)L * SEQ * DM};
#ifndef DIS_RES1
            pg8::gemm_phase<pg8::EpiRes<1>, pg8::StaticOrder, PGA1, PGS>(lds, g, S, E);
#endif
        } break;
#if DBG_DUMP
        case K_DUMP: {
            const bf16* src = (const bf16*)(ws + DBG_DUMP_OFF); const float* srcf = (const float*)(ws + DBG_DUMP_OFF);
            for (size_t i = (size_t)blockIdx.x * NTHREADS + threadIdx.x; i < (size_t)SEQ * DM; i += (size_t)G * NTHREADS) hout[i] = (DBG_DUMP == 2) ? srcf[i & 8191] : bfl((unsigned)src[i]);
        } break;
#endif
        case K_FINAL: final_phase(hout, ss + (size_t)12 * SEQ * 32, INP(5), G); break;
        }
        if (ph + 1 < hi) { XcdBarrier b; b.bar = (unsigned*)(ws + WS_BAR); b.x = xb_xcc_id(); b.st = (volatile LAS unsigned*)(lds + 131072 + 64); xcd_barrier(b); }
    }
}

#ifndef MK_MULTI
#define MK_MULTI 0
#endif

extern "C" void kernel_launch(void* const* d_in, const int* in_sizes, int n_in, void* d_out, int out_size, void* d_ws, size_t ws_size, hipStream_t stream) {
    static int grid = 0;
    if (grid == 0) {
        if (n_in != 22 || out_size != SEQ * DM || ws_size < WS_END) { fprintf(stderr, "kernel_launch: unexpected shapes (n_in %d out %d ws %zu)\n", n_in, out_size, ws_size); grid = -1; return; }
        int dev = 0, cus = 0, per_cu = 0;
        (void)hipGetDevice(&dev); (void)hipDeviceGetAttribute(&cus, hipDeviceAttributeMultiprocessorCount, dev);
        if (hipFuncSetAttribute((const void*)mega_fwd, hipFuncAttributeMaxDynamicSharedMemorySize, LDS_BYTES) != hipSuccess) { fprintf(stderr, "kernel_launch: hipFuncSetAttribute failed\n"); grid = -1; return; }
        if (hipOccupancyMaxActiveBlocksPerMultiprocessor(&per_cu, (const void*)mega_fwd, NTHREADS, LDS_BYTES) != hipSuccess || per_cu < 1) { fprintf(stderr, "kernel_launch: occupancy query says %d\n", per_cu); per_cu = 1; }
        (void)hipGetLastError();
        grid = cus * per_cu; if (grid > 256) grid = 256;
        fprintf(stderr, "kernel_launch: grid %d (cus %d per_cu %d)\n", grid, cus, per_cu);
    }
    if (grid < 0) return;
    Args a{};
    for (int i = 0; i < 22; ++i) a.in[i] = (const float*)d_in[i];
    a.out = (float*)d_out; a.ws = (unsigned char*)d_ws;
#if MK_MULTI
#ifdef DBG_SEQ
    { const int seq[] = {DBG_SEQ}; for (int ph : seq) { a.ph_lo = ph; a.ph_hi = ph + 1; hipLaunchKernelGGL(mega_fwd, dim3(grid), dim3(NTHREADS), LDS_BYTES, stream, a); } }
#else
    for (int ph = 0; ph < DBG_NPH; ++ph) { a.ph_lo = ph; a.ph_hi = ph + 1; hipLaunchKernelGGL(mega_fwd, dim3(grid), dim3(NTHREADS), LDS_BYTES, stream, a); }
#endif
    if (DBG_DUMP) { a.ph_lo = 99; a.ph_hi = 100; hipLaunchKernelGGL(mega_fwd, dim3(grid), dim3(NTHREADS), LDS_BYTES, stream, a); }
#else
    a.ph_lo = 0; a.ph_hi = N_PHASES;
    if (hipMemsetAsync((char*)d_ws + WS_BAR, 0, 16384, stream) != hipSuccess) { fprintf(stderr, "kernel_launch: memset of the barrier words failed\n"); return; }
    void* kargs[] = {&a};
    hipError_t e = hipLaunchCooperativeKernel((const void*)mega_fwd, dim3(grid), dim3(NTHREADS), kargs, LDS_BYTES, stream);
    if (e != hipSuccess) fprintf(stderr, "kernel_launch: cooperative launch failed: %s (grid %d)\n", hipGetErrorString(e), grid);
#endif
}
```

```cpp
#include <hip/hip_runtime.h>
#include <hip/hip_cooperative_groups.h>
#include <cstdio>
#include <cstdint>
namespace cg = cooperative_groups;
namespace pg8 {
#define PG8_LAS __attribute__((address_space(3)))
typedef unsigned short bf16_t;
typedef short bf16x8 __attribute__((ext_vector_type(8)));
typedef float f32x4 __attribute__((ext_vector_type(4)));
typedef unsigned u32x4 __attribute__((ext_vector_type(4)));
constexpr int BM = 256, BK = 64, HALF = 128, HTB = HALF * BK * 2  , STAGE_BYTES = 8 * HTB, NXCD = 8, WGM = 8;

__host__ __device__ __forceinline__ int lds_byte(int r, int c) { const int st = (r >> 4) * 2 + (c >> 5), rr = r & 15, cc = c & 31, ob = rr * 64 + cc * 2; return st * 1024 + (ob ^ (((ob >> 9) & 1) << 5)); }
__host__ __device__ __forceinline__ void stage_rc(int b, int& R, int& C) { const int st = b / 1024, sb = b % 1024, swz = sb ^ (((sb >> 9) & 1) << 5); R = (st >> 1) * 16 + swz / 64; C = (st & 1) * 32 + (swz % 64) / 2; }
__host__ __device__ __forceinline__ int perm32(int rho) { const int n = rho >> 4, i = rho & 15; return 8 * (i >> 2) + 4 * n + (i & 3); }

struct Unit { int pm, pn; };
struct Gemm { const bf16_t* A; const bf16_t* Bt; int M, N, K; };

struct StaticOrder {
    int nM, nN, nwg, G, c;
    __host__ __device__ void init(int M, int N, int G_, int c_) { nM = M / BM; nN = N / BM; nwg = nM * nN; G = G_; c = c_; }
    __host__ __device__ bool next(int i, Unit& u) const {
        const long L = (long)i * G + c; if (L >= nwg) return false;
        int wgid = (int)L; { const int q = nwg / NXCD, r = nwg % NXCD, xcd = wgid % NXCD, off = wgid / NXCD; wgid = (xcd < r ? xcd * (q + 1) : r * (q + 1) + (xcd - r) * q) + off; }
        const int nig = WGM * nN, gid = wgid / nig, fm = gid * WGM, gsz = (nM - fm) < WGM ? (nM - fm) : WGM;
        u.pm = fm + ((wgid % nig) % gsz); u.pn = (wgid % nig) / gsz; return true;
    }
    __device__ __forceinline__ void a_ready(const Unit&) const {}
    __device__ __forceinline__ void done(const Unit&) const {}
};

__device__ __forceinline__ unsigned cvt_pk_bf16(float lo, float hi) { unsigned r; asm volatile("v_cvt_pk_bf16_f32 %0, %1, %2" : "=v"(r) : "v"(lo), "v"(hi)); return r; }
typedef float f32x2 __attribute__((ext_vector_type(2)));
constexpr float RMS_EPS = 1e-6f;
constexpr int DM = 2048;
__device__ __forceinline__ float fsigmoid(float x) { return __builtin_amdgcn_rcpf(1.f + __expf(-x)); }
__device__ __forceinline__ float gelu_tanh(float v) { return v * fsigmoid(1.5957691216057308f * (v + 0.044715f * v * v * v)); }
__device__ __forceinline__ float rstd_row(const float* ssp, int row) {
    const f32x4* p = (const f32x4*)(ssp + (size_t)row * 32); float s = 0.f;
#pragma unroll
    for (int i = 0; i < 8; ++i) { const f32x4 v = p[i]; s += (v[0] + v[1]) + (v[2] + v[3]); }
    return rsqrtf(s * (1.f / DM) + RMS_EPS);
}
__device__ __forceinline__ float bf_lo(unsigned w) { return __uint_as_float(w << 16); }
__device__ __forceinline__ float bf_hi(unsigned w) { return __uint_as_float(w & 0xffff0000u); }

template <int MODE> struct EpiAct {
    static constexpr bool PERM = true, AFTER_DRAIN = false;
    bf16_t* O0; bf16_t* O1; int ldc; int split; const float* ss; const PG8_LAS float* tab; int tab_t;
    __device__ __forceinline__ void operator()(const f32x4 (&acc)[2][2][4][2], const Unit& u, int wr, int wc, int fr, int fq) const {
        const int row0 = u.pm * BM + wr * 64 + fr; int colt = u.pn * BM; bf16_t* base = O0; bool second = false;
        if (MODE <= 1) { if (colt >= split) { base = O1; colt -= split; second = true; } }
        const int col0 = colt + wc * 32 + 8 * fq;
        f32x4 cs[2][2];
        if (MODE == 4) {
#pragma unroll
            for (int bj = 0; bj < 2; ++bj)
#pragma unroll
                for (int n = 0; n < 2; ++n) {
#pragma unroll
                    for (int e = 0; e < 4; ++e) cs[bj][n][e] = (u.pn == tab_t) ? tab[col0 - u.pn * BM + bj * HALF + 4 * n + e] : rstd_row(ss, col0 + bj * HALF + 4 * n + e); }
        }
#pragma unroll
        for (int ai = 0; ai < 2; ++ai)
#pragma unroll
            for (int m = 0; m < 4; ++m) {
                const int row = row0 + ai * HALF + m * 16;
                float rs = 1.f;
                if (MODE <= 2) { rs = (u.pm == tab_t) ? tab[row - u.pm * BM] : rstd_row(ss, row); if (MODE == 1 && !second) rs *= 0.08838834764831845f; }
                bf16_t* rowp = base + (size_t)row * ldc + col0;
#pragma unroll
                for (int bj = 0; bj < 2; ++bj) {
                    f32x4 v0 = acc[ai][bj][m][0], v1 = acc[ai][bj][m][1];
                    if (MODE == 4) { v0 = v0 * cs[bj][0]; v1 = v1 * cs[bj][1]; } else { v0 = v0 * rs; v1 = v1 * rs; }
                    if (MODE == 0) { if (second) {
#pragma unroll
                        for (int e = 0; e < 4; ++e) { v0[e] = gelu_tanh(v0[e]); v1[e] = gelu_tanh(v1[e]); } } }
                    if (MODE == 2) {
#pragma unroll
                        for (int e = 0; e < 4; ++e) { const float a = fmaxf(v0[e], 0.f), b = fmaxf(v1[e], 0.f); v0[e] = a * a; v1[e] = b * b; } }
                    u32x4 w; w.x = cvt_pk_bf16(v0[0], v0[1]); w.y = cvt_pk_bf16(v0[2], v0[3]); w.z = cvt_pk_bf16(v1[0], v1[1]); w.w = cvt_pk_bf16(v1[2], v1[3]);
                    *(u32x4*)(rowp + bj * HALF) = w;
                }
                asm volatile("" ::: "memory");
            }
    }
};

template <int MODE> struct EpiRes {
    static constexpr bool PERM = true, AFTER_DRAIN = false;
    const float* base; float* out; bf16_t* hb; float* ss_out; const float* ss_in; const bf16_t* proj; const PG8_LAS float* tab; int tab_t;
    __device__ __forceinline__ void operator()(const f32x4 (&acc)[2][2][4][2], const Unit& u, int wr, int wc, int fr, int fq) const {
        const int row0 = u.pm * BM + wr * 64 + fr; const int col0 = u.pn * BM + wc * 32 + 8 * fq;
#pragma unroll
        for (int ai = 0; ai < 2; ++ai)
#pragma unroll
            for (int m = 0; m < 4; ++m) {
                const int row = row0 + ai * HALF + m * 16; const size_t off = (size_t)row * DM + col0;
                float rs = 0.f; if (MODE == 1) rs = (u.pm == tab_t) ? tab[row - u.pm * BM] : rstd_row(ss_in, row);
                float sq = 0.f;
#pragma unroll
                for (int bj = 0; bj < 2; ++bj) {
                    const f32x4 b0 = *(const f32x4*)(base + off + bj * HALF), b1 = *(const f32x4*)(base + off + bj * HALF + 4);
                    f32x4 v0 = acc[ai][bj][m][0], v1 = acc[ai][bj][m][1];
                    if (MODE == 1) {
                        const u32x4 pw = *(const u32x4*)(proj + off + bj * HALF);
                        const f32x4 p0 = (f32x4){bf_lo(pw.x), bf_hi(pw.x), bf_lo(pw.y), bf_hi(pw.y)}, p1 = (f32x4){bf_lo(pw.z), bf_hi(pw.z), bf_lo(pw.w), bf_hi(pw.w)};
#pragma unroll
                        for (int e = 0; e < 4; ++e) { v0[e] = fsigmoid(v0[e] * rs) * p0[e]; v1[e] = fsigmoid(v1[e] * rs) * p1[e]; }
                    }
                    const f32x4 o0 = b0 + v0, o1 = b1 + v1;
                    *(f32x4*)(out + off + bj * HALF) = o0; *(f32x4*)(out + off + bj * HALF + 4) = o1;
                    u32x4 w; w.x = cvt_pk_bf16(o0[0], o0[1]); w.y = cvt_pk_bf16(o0[2], o0[3]); w.z = cvt_pk_bf16(o1[0], o1[1]); w.w = cvt_pk_bf16(o1[2], o1[3]);
                    *(u32x4*)(hb + off + bj * HALF) = w;
                    sq += (o0[0] * o0[0] + o0[1] * o0[1]) + (o0[2] * o0[2] + o0[3] * o0[3]) + (o1[0] * o1[0] + o1[1] * o1[1]) + (o1[2] * o1[2] + o1[3] * o1[3]);
                }
                sq += __shfl_xor(sq, 16); sq += __shfl_xor(sq, 32);
                if (fq == 0) ss_out[(size_t)row * 32 + u.pn * 4 + wc] = sq;
            }
    }
};

template <class Epi, class Sched, bool ALIGN_EPI = false, bool SP2 = false>
__device__ __forceinline__ void gemm_phase(PG8_LAS unsigned char* lds, const Gemm g, const Sched& S, const Epi& E) {
    int tid_ = threadIdx.x; asm volatile("" : "+v"(tid_)); const int tid = tid_, wid = __builtin_amdgcn_readfirstlane(tid >> 6), lane = tid & 63, wr = wid >> 2, wc = wid & 3, fr = lane & 15, fq = lane >> 4;
    const int K = g.K, nt = K / BK;
    unsigned voffA[2], voffB[2];
#pragma unroll
    for (int i = 0; i < 2; ++i) { int R, C; stage_rc(tid * 16 + i * 8192, R, C); const int Rb = Epi::PERM ? ((R & ~31) + perm32(R & 31)) : R;
        voffA[i] = (unsigned)(R * K + C) * 2u; voffB[i] = (unsigned)(Rb * K + C) * 2u; }
    const size_t kstep = (size_t)(BK * 2);
    const size_t hstep = (size_t)HALF * K * 2;
    const size_t tstep = 2 * hstep;
    const unsigned ldsw = (unsigned)wid * 1024u;
    const int aoff = lds_byte(wr * 64 + fr, fq * 8), boff = lds_byte(wc * 32 + fr, fq * 8);
#define PG8_SA(b, h) (((b) * 2 + (h)) * HTB)
#define PG8_SB(b, h) ((4 + (b) * 2 + (h)) * HTB)
#define PG8_STAGE(bufoff, gbase, voff) do { _Pragma("unroll") for (int _i = 0; _i < 2; ++_i) \
        __builtin_amdgcn_global_load_lds((const unsigned*)((const char*)(gbase) + (voff)[_i]), (PG8_LAS unsigned*)(lds + (bufoff) + ldsw + _i * 8192), 16, 0, 0); } while (0)
#define PG8_LDA(dst, b, h) do { _Pragma("unroll") for (int m = 0; m < 4; ++m) _Pragma("unroll") for (int k = 0; k < 2; ++k) dst[m][k] = *(const PG8_LAS bf16x8*)(lds + PG8_SA(b, h) + aoff + m * 2048 + k * 1024); } while (0)
#define PG8_LDB(dst, b, h) do { _Pragma("unroll") for (int n = 0; n < 2; ++n) _Pragma("unroll") for (int k = 0; k < 2; ++k) dst[n][k] = *(const PG8_LAS bf16x8*)(lds + PG8_SB(b, h) + boff + n * 2048 + k * 1024); } while (0)
#define PG8_MMA(ai, bj, At, Bt) do { __builtin_amdgcn_s_setprio(1); _Pragma("unroll") for (int m = 0; m < 4; ++m) _Pragma("unroll") for (int n = 0; n < 2; ++n) _Pragma("unroll") for (int k = 0; k < 2; ++k) \
        acc[ai][bj][m][n] = __builtin_amdgcn_mfma_f32_16x16x32_bf16(Bt[n][k], At[m][k], acc[ai][bj][m][n], 0, 0, 0); __builtin_amdgcn_s_setprio(0); } while (0)
#define PG8_WAIT_V(n) asm volatile("s_waitcnt vmcnt(" #n ")" ::: "memory")
#define PG8_WAIT_L(n) asm volatile("s_waitcnt lgkmcnt(" #n ")" ::: "memory")
#define PG8_BAR __builtin_amdgcn_s_barrier()
#define PG8_SCHED __builtin_amdgcn_sched_barrier(0)
    Unit cur, nxt; int ui = 0;
    if (!S.next(0, cur)) return;
    f32x4 acc[2][2][4][2];
#pragma unroll
    for (int a = 0; a < 2; ++a)
#pragma unroll
        for (int b = 0; b < 2; ++b)
#pragma unroll
            for (int m = 0; m < 4; ++m)
#pragma unroll
                for (int n = 0; n < 2; ++n) acc[a][b][m][n] = (f32x4){0.f, 0.f, 0.f, 0.f};
    bf16x8 At[4][2], B0[2][2], B1[2][2];
    const char* cA = (const char*)g.A + (size_t)cur.pm * tstep; const char* cB = (const char*)g.Bt + (size_t)cur.pn * tstep;
    S.a_ready(cur);
    if constexpr (SP2) {
        PG8_STAGE(PG8_SB(0, 0), cB, voffB); PG8_STAGE(PG8_SB(0, 1), cB + hstep, voffB); PG8_STAGE(PG8_SA(0, 0), cA, voffA); PG8_STAGE(PG8_SA(0, 1), cA + hstep, voffA);
        if (wr == 1) PG8_BAR;
        PG8_WAIT_V(2); PG8_BAR;
        PG8_STAGE(PG8_SB(1, 0), cB + kstep, voffB); PG8_STAGE(PG8_SA(1, 0), cA + kstep, voffA); PG8_STAGE(PG8_SB(1, 1), cB + hstep + kstep, voffB);
        PG8_WAIT_V(6); PG8_BAR;
    } else {
        PG8_STAGE(PG8_SB(0, 0), cB, voffB); PG8_STAGE(PG8_SA(0, 0), cA, voffA); PG8_STAGE(PG8_SB(0, 1), cB + hstep, voffB); PG8_STAGE(PG8_SA(0, 1), cA + hstep, voffA);
        if (wr == 1) PG8_BAR;
        PG8_WAIT_V(4); PG8_BAR;
        PG8_STAGE(PG8_SB(1, 0), cB + kstep, voffB); PG8_STAGE(PG8_SA(1, 0), cA + kstep, voffA); PG8_STAGE(PG8_SB(1, 1), cB + hstep + kstep, voffB);
        PG8_WAIT_V(6); PG8_BAR;
    }
    for (;;) {
        const bool has_next = S.next(ui + 1, nxt);
        const char* nA = has_next ? (const char*)g.A + (size_t)nxt.pm * tstep : cA; const char* nB = has_next ? (const char*)g.Bt + (size_t)nxt.pn * tstep : cB;
        for (int t = 0; t < nt; t += 2) {
            const bool last = (t == nt - 2);
            const char* a1 = cA + (size_t)(t + 1) * kstep;
            const char* a2 = last ? nA : cA + (size_t)(t + 2) * kstep; const char* b2 = last ? nB : cB + (size_t)(t + 2) * kstep;
            const char* a3 = a2 + kstep; const char* b3 = b2 + kstep;
            if (last && has_next) S.a_ready(nxt);
            if constexpr (SP2) {
            PG8_LDB(B0, 0, 0); PG8_LDB(B1, 0, 1); PG8_SCHED; PG8_LDA(At, 0, 0); PG8_STAGE(PG8_SA(1, 1), a1 + hstep, voffA);
            PG8_WAIT_V(8); PG8_WAIT_L(0); PG8_BAR; PG8_MMA(0, 0, At, B0); PG8_MMA(0, 1, At, B1); PG8_BAR; PG8_SCHED;
            PG8_LDA(At, 0, 1); PG8_STAGE(PG8_SB(0, 0), b2, voffB); PG8_STAGE(PG8_SB(0, 1), b2 + hstep, voffB); PG8_STAGE(PG8_SA(0, 0), a2, voffA);
            PG8_WAIT_V(8); PG8_WAIT_L(0); PG8_BAR; PG8_MMA(1, 0, At, B0); PG8_MMA(1, 1, At, B1); PG8_BAR; PG8_SCHED;
            PG8_LDB(B0, 1, 0); PG8_LDB(B1, 1, 1); PG8_SCHED; PG8_LDA(At, 1, 0); PG8_STAGE(PG8_SA(0, 1), a2 + hstep, voffA);
            PG8_WAIT_V(8); PG8_WAIT_L(0); PG8_BAR; PG8_MMA(0, 0, At, B0); PG8_MMA(0, 1, At, B1); PG8_BAR; PG8_SCHED;
            PG8_LDA(At, 1, 1); PG8_STAGE(PG8_SB(1, 0), b3, voffB); PG8_STAGE(PG8_SB(1, 1), b3 + hstep, voffB); PG8_STAGE(PG8_SA(1, 0), a3, voffA);
            PG8_WAIT_V(8); PG8_WAIT_L(0); PG8_BAR; PG8_MMA(1, 0, At, B0); PG8_MMA(1, 1, At, B1); PG8_BAR; PG8_SCHED;
            } else {
            PG8_LDB(B0, 0, 0); PG8_SCHED; PG8_LDA(At, 0, 0); PG8_STAGE(PG8_SA(1, 1), a1 + hstep, voffA);
            PG8_WAIT_L(8); PG8_BAR; PG8_WAIT_L(0); PG8_MMA(0, 0, At, B0); PG8_BAR; PG8_SCHED;
            PG8_LDB(B1, 0, 1); PG8_STAGE(PG8_SB(0, 0), b2, voffB);
            PG8_BAR; PG8_WAIT_L(0); PG8_MMA(0, 1, At, B1); PG8_BAR;
            PG8_LDA(At, 0, 1); PG8_STAGE(PG8_SA(0, 0), a2, voffA);
            PG8_BAR; PG8_WAIT_L(0); PG8_MMA(1, 0, At, B0); PG8_BAR; PG8_SCHED;
            PG8_STAGE(PG8_SB(0, 1), b2 + hstep, voffB);
            PG8_WAIT_V(6); PG8_BAR; PG8_MMA(1, 1, At, B1); PG8_BAR;
            PG8_LDB(B0, 1, 0); PG8_SCHED; PG8_LDA(At, 1, 0); PG8_STAGE(PG8_SA(0, 1), a2 + hstep, voffA);
            PG8_WAIT_L(8); PG8_BAR; PG8_WAIT_L(0); PG8_MMA(0, 0, At, B0); PG8_BAR; PG8_SCHED;
            PG8_LDB(B1, 1, 1); PG8_STAGE(PG8_SB(1, 0), b3, voffB);
            PG8_BAR; PG8_WAIT_L(0); PG8_MMA(0, 1, At, B1); PG8_BAR;
            PG8_LDA(At, 1, 1); PG8_STAGE(PG8_SA(1, 0), a3, voffA);
            PG8_BAR; PG8_WAIT_L(0); PG8_MMA(1, 0, At, B0); PG8_BAR; PG8_SCHED;
            PG8_STAGE(PG8_SB(1, 1), b3 + hstep, voffB);
            PG8_WAIT_V(6); PG8_BAR; PG8_MMA(1, 1, At, B1); PG8_BAR;
            }
        }
        if constexpr (ALIGN_EPI) { if (wr == 0) PG8_BAR; }
        if constexpr (!Epi::AFTER_DRAIN) { E(acc, cur, wr, wc, fr, fq); S.done(cur); }
        if (!has_next) break;
#pragma unroll
        for (int a = 0; a < 2; ++a)
#pragma unroll
            for (int b = 0; b < 2; ++b)
#pragma unroll
                for (int m = 0; m < 4; ++m)
#pragma unroll
                    for (int n = 0; n < 2; ++n) acc[a][b][m][n] = (f32x4){0.f, 0.f, 0.f, 0.f};
        cur = nxt; cA = nA; cB = nB; ++ui;
        if constexpr (ALIGN_EPI) { if (wr == 1) PG8_BAR; }
    }
    PG8_WAIT_V(0);
    if constexpr (!ALIGN_EPI) { if (wr == 0) PG8_BAR; }
    PG8_BAR;
    if constexpr (Epi::AFTER_DRAIN) { E.fused(acc, cur, wr, wc, fr, fq, lds, wid, lane); S.done(cur); }
#undef PG8_SA
#undef PG8_SB
#undef PG8_STAGE
#undef PG8_LDA
#undef PG8_LDB
#undef PG8_MMA
#undef PG8_WAIT_V
#undef PG8_WAIT_L
#undef PG8_BAR
#undef PG8_SCHED
}
}

constexpr int SEQ = 8192, DM = 2048, DFF = 8192, PLE = 256, DEPTH = 4, NHEAD = 16, HD = 128;
constexpr int NWAVES = 8, NTHREADS = 512;
constexpr int LDS_BYTES = 147456;
typedef unsigned short bf16;
typedef unsigned u32x4 __attribute__((ext_vector_type(4)));
typedef unsigned u32x2 __attribute__((ext_vector_type(2)));
typedef float f32x4 __attribute__((ext_vector_type(4)));
typedef float f32x2 __attribute__((ext_vector_type(2)));
typedef short bf16x8 __attribute__((ext_vector_type(8)));
#define LAS __attribute__((address_space(3)))
#define LDS_WAIT() asm volatile("s_waitcnt lgkmcnt(0)" ::: "memory")

constexpr size_t MiB = 1u << 20;
constexpr size_t WS_SS = 880 * MiB;
constexpr size_t WS_BAR = 0;
constexpr size_t WS_AGG = 2 * MiB;
constexpr size_t WS_X0 = 8 * MiB, WS_X1 = 40 * MiB;
constexpr size_t WS_BA = 72 * MiB, WS_BB = 104 * MiB, WS_BC = 136 * MiB, WS_BD = 168 * MiB;
constexpr size_t WS_A1 = 200 * MiB;
constexpr size_t WS_PROJ = 328 * MiB;
constexpr size_t WS_PB = 456 * MiB;
constexpr size_t WS_W1T = 472 * MiB, WS_W2T = 600 * MiB, WS_WGT = 728 * MiB, WS_WPT = 760 * MiB, WS_WINT = 764 * MiB, WS_WORT = 796 * MiB,
                 WS_GAT = 812 * MiB, WS_GXT = 814 * MiB, WS_WQKVT = 816 * MiB, WS_WONT = 864 * MiB, WS_END = 893 * MiB;

struct Args {
    const float* in[22];
    float* out; unsigned char* ws;
    int ph_lo, ph_hi;
};
static_assert(sizeof(Args) == 200 && offsetof(Args, out) == 176 && offsetof(Args, ws) == 184 && offsetof(Args, ph_lo) == 192, "Args layout");

typedef const unsigned char __attribute__((address_space(4)))* KA;
#define INP(k) (*(const float* const __attribute__((address_space(4)))*)(ka + 8 * (k)))
__device__ __forceinline__ int opaque_tid() { int t = threadIdx.x; asm volatile("" : "+v"(t)); return t; }
__device__ __forceinline__ unsigned cvt_pk(float lo, float hi) { return pg8::cvt_pk_bf16(lo, hi); }
__device__ __forceinline__ float bfl(unsigned w) { return __uint_as_float(w << 16); }
__device__ __forceinline__ float bfh(unsigned w) { return __uint_as_float(w & 0xffff0000u); }
__device__ __forceinline__ float wave_sum(float v) {
#pragma unroll
    for (int o = 1; o < 64; o <<= 1) v += __shfl_xor(v, o);
    return v;
}

__device__ __forceinline__ void transpose_item(const float* W, int K, int N, const float* g, bf16* WT, int kb, int nb, int lane) {
    const int q = lane >> 4, ln = lane & 15;
    const int kbase = 64 * kb + 16 * q, n = 64 * nb + 4 * ln;
    f32x4 v[16];
    const float* wp = W + (size_t)kbase * N + n;
#pragma unroll
    for (int i = 0; i < 16; ++i) v[i] = *(const f32x4*)(wp + (size_t)i * N);
    if (g) {
#pragma unroll
        for (int i4 = 0; i4 < 4; ++i4) { const f32x4 gv = *(const f32x4*)(g + kbase + 4 * i4);
#pragma unroll
            for (int e = 0; e < 4; ++e) v[4 * i4 + e] = v[4 * i4 + e] * gv[e]; }
    }
#pragma unroll
    for (int e = 0; e < 4; ++e) {
        bf16* op = WT + (size_t)(n + e) * K + kbase;
#pragma unroll
        for (int h = 0; h < 2; ++h) {
            u32x4 o; o.x = cvt_pk(v[8 * h + 0][e], v[8 * h + 1][e]); o.y = cvt_pk(v[8 * h + 2][e], v[8 * h + 3][e]); o.z = cvt_pk(v[8 * h + 4][e], v[8 * h + 5][e]); o.w = cvt_pk(v[8 * h + 6][e], v[8 * h + 7][e]);
            *(u32x4*)(op + 8 * h) = o;
        }
    }
}

__device__ __forceinline__ void p0_phase(LAS unsigned char* lds, KA ka, unsigned char* ws, int G) {
    const int tid = opaque_tid(), lane = tid & 63, wave = tid >> 6;
    const int gw = blockIdx.x * NWAVES + wave, NGW = G * NWAVES;
    float* ss = (float*)(ws + WS_SS);
    {
        const float* x = INP(0); bf16* X0 = (bf16*)(ws + WS_X0);
        for (int row = gw; row < SEQ; row += NGW) {
            const f32x4* xr = (const f32x4*)(x + (size_t)row * DM) + lane; float s = 0.f;
            u32x2* o = (u32x2*)(X0 + (size_t)row * DM) + lane;
#pragma unroll
            for (int j = 0; j < 8; ++j) { const f32x4 v = xr[64 * j]; s += (v[0] * v[0] + v[1] * v[1]) + (v[2] * v[2] + v[3] * v[3]); u32x2 w; w.x = cvt_pk(v[0], v[1]); w.y = cvt_pk(v[2], v[3]); o[64 * j] = w; }
            s = wave_sum(s);
            if (lane < 32) ss[(size_t)row * 32 + lane] = (lane == 0) ? s : 0.f;
        }
    }
    {
        const f32x4* p = (const f32x4*)INP(1); u32x2* o = (u32x2*)(ws + WS_PB);
        const int n4 = DEPTH * SEQ * PLE / 4;
        for (int i = blockIdx.x * NTHREADS + tid; i < n4; i += G * NTHREADS) { const f32x4 v = p[i]; u32x2 w; w.x = cvt_pk(v[0], v[1]); w.y = cvt_pk(v[2], v[3]); o[i] = w; }
    }
    const int nitems_total =
        4 * (2048 / 64) * (8192 / 64) + 4 * (8192 / 64) * (2048 / 64) + 4 * (2048 / 64) * (2048 / 64) + 4 * (256 / 64) * (2048 / 64) +
        2 * (2048 / 64) * (4096 / 64) + 2 * (2048 / 64) * (2048 / 64) + 64 * (128 / 64) * (128 / 64) + 64 * (128 / 64) * (128 / 64) +
        2 * (2048 / 64) * (6144 / 64) + 2 * (2048 / 64) * (2048 / 64);
    for (int it = gw; it < nitems_total; it += NGW) {
        int r = it;
#define CONV_TRY(Wp, nmat, K, N, gp, gstride, WTp) { const int ipm = ((K) / 64) * ((N) / 64); const int tot = (nmat) * ipm; \
            if (r < tot) { const int mat = r / ipm, rr = r % ipm, kb = rr / ((N) / 64), nb = rr % ((N) / 64); const float* g_ = (gp); \
                transpose_item((Wp) + (size_t)mat * (K) * (N), (K), (N), g_ ? g_ + (size_t)mat * (gstride) : nullptr, (bf16*)(ws + (WTp)) + (size_t)mat * (K) * (N), kb, nb, lane); continue; } r -= tot; }
        CONV_TRY(INP(18), 4, 2048, 8192, INP(3), 2048, WS_W1T)
        CONV_TRY(INP(19), 4, 8192, 2048, (const float*)nullptr, 0, WS_W2T)
        CONV_TRY(INP(20), 4, 2048, 2048, INP(4), 2048, WS_WGT)
        CONV_TRY(INP(21), 4, 256, 2048, (const float*)nullptr, 0, WS_WPT)
        CONV_TRY(INP(6), 2, 2048, 4096, INP(2), 4096, WS_WINT)
        CONV_TRY(INP(14), 2, 2048, 2048, (const float*)nullptr, 0, WS_WORT)
        CONV_TRY(INP(9), 64, 128, 128, (const float*)nullptr, 0, WS_GAT)
        CONV_TRY(INP(11), 64, 128, 128, (const float*)nullptr, 0, WS_GXT)
        CONV_TRY(INP(15), 2, 2048, 6144, INP(2) + 2048, 4096, WS_WQKVT)
        CONV_TRY(INP(17), 2, 2048, 2048, (const float*)nullptr, 0, WS_WONT)
#undef CONV_TRY
    }
}

constexpr int SC_T = 64, SC_NCH = SEQ / SC_T;
constexpr int XCF_STRIDE = 132;
constexpr int XCB_STRIDE = 136;
constexpr int LDS_XCF = 0, LDS_XCB = LDS_XCF + SC_T * XCF_STRIDE * 4, LDS_YGS = LDS_XCB + SC_T * XCB_STRIDE * 2, LDS_SEG = LDS_YGS + SC_T * 128 * 2, LDS_CAR = LDS_SEG + 2 * 128 * 17 * 8, LDS_SC_END = LDS_CAR + 2 * 8 * 128 * 4;
static_assert(LDS_SC_END <= 131072, "scan LDS");

struct ScanArgs {
    const bf16* XR; const bf16* YG; bf16* Y;
    const float* conv_w; const float* conv_b;
    const bf16* gaT; const bf16* gxT;
    const float* ga_b; const float* gx_b; const float* lam;
    f32x2* agg;
};

template <bool FINAL>
__device__ __forceinline__ void scan_phase(LAS unsigned char* lds, const ScanArgs& sa, int G) {
    const int tid = opaque_tid(), lane = tid & 63, w = tid >> 6, fr = lane & 15, fq = lane >> 4;
    LAS float* xcf = (LAS float*)(lds + LDS_XCF);
    LAS bf16* xcb = (LAS bf16*)(lds + LDS_XCB);
    LAS bf16* ygs = (LAS bf16*)(lds + LDS_YGS);
    LAS f32x2* seg = (LAS f32x2*)(lds + LDS_SEG);
    int cur_hd = -1;
    bf16x8 Bf[4][4];
    float ba[2], bx[2], sp8[2];
#pragma unroll
    for (int m = 0; m < 4; ++m)
#pragma unroll
        for (int k = 0; k < 4; ++k) Bf[m][k] = (bf16x8){0, 0, 0, 0, 0, 0, 0, 0};
    ba[0] = ba[1] = bx[0] = bx[1] = sp8[0] = sp8[1] = 0.f;
    LAS float* car = (LAS float*)(lds + LDS_CAR);
    const bool fast = FINAL && (G == 256);
    if (fast) {
        if (tid < 256) {
            const int dir = tid >> 7, c = tid & 127, gch = (blockIdx.x & 15) * 128 + c, cmod = blockIdx.x >> 4;
            const f32x2* ag = sa.agg + (size_t)dir * SC_NCH * DM + gch;
            float h = 0.f;
            if (dir == 0) {
#pragma unroll 8
                for (int cc = 0; cc < SC_NCH; ++cc) { const f32x2 e = ag[(size_t)cc * DM]; if ((cc & 15) == cmod) car[(dir * 8 + (cc >> 4)) * 128 + c] = h; h = e[0] * h + e[1]; }
            } else {
#pragma unroll 8
                for (int cc = SC_NCH - 1; cc >= 0; --cc) { const f32x2 e = ag[(size_t)cc * DM]; if ((cc & 15) == cmod) car[(dir * 8 + (cc >> 4)) * 128 + c] = h; h = e[0] * h + e[1]; }
            }
        }
    }
    for (int it = blockIdx.x; it < SC_NCH * NHEAD; it += G) {
        const int hd = it & 15, chunk = it >> 4, t0 = chunk * SC_T;
        __syncthreads();
        if (hd != cur_hd) {
            cur_hd = hd;
#pragma unroll
            for (int dir = 0; dir < 2; ++dir) {
                const bf16* wa = sa.gaT + ((size_t)(dir * 16 + hd) * 128 + 16 * w + fr) * 128 + 8 * fq;
                const bf16* wx = sa.gxT + ((size_t)(dir * 16 + hd) * 128 + 16 * w + fr) * 128 + 8 * fq;
#pragma unroll
                for (int k = 0; k < 4; ++k) { Bf[dir * 2 + 0][k] = *(const bf16x8*)(wa + 32 * k); Bf[dir * 2 + 1][k] = *(const bf16x8*)(wx + 32 * k); }
                const int gch = hd * 128 + 16 * w + fr;
                ba[dir] = sa.ga_b[dir * DM + gch]; bx[dir] = sa.gx_b[dir * DM + gch];
                sp8[dir] = 8.f * log1pf(expf(-sa.lam[dir * DM + gch]));
            }
        }
        {
            const int cp = tid & 63, tg = tid >> 6;
            const int gc = hd * 128 + 2 * cp;
            float x0[11], x1[11];
#pragma unroll
            for (int q = 0; q < 11; ++q) { const int t = t0 + 8 * tg - 1 + q; unsigned v = 0u; if (t >= 0 && t < SEQ) v = *(const unsigned*)(sa.XR + (size_t)t * DM + gc); x0[q] = bfl(v); x1[q] = bfh(v); }
            float w0[4], w1[4];
#pragma unroll
            for (int k = 0; k < 4; ++k) { const f32x2 wv = *(const f32x2*)(sa.conv_w + k * DM + gc); w0[k] = wv[0]; w1[k] = wv[1]; }
            const f32x2 bv = *(const f32x2*)(sa.conv_b + gc);
#pragma unroll
            for (int q = 0; q < 8; ++q) {
                const float c0 = bv[0] + ((w0[0] * x0[q] + w0[1] * x0[q + 1]) + (w0[2] * x0[q + 2] + w0[3] * x0[q + 3]));
                const float c1 = bv[1] + ((w1[0] * x1[q] + w1[1] * x1[q + 1]) + (w1[2] * x1[q + 2] + w1[3] * x1[q + 3]));
                const int tau = 8 * tg + q;
                *(LAS f32x2*)(xcf + tau * XCF_STRIDE + 2 * cp) = (f32x2){c0, c1};
                *(LAS unsigned*)(xcb + tau * XCB_STRIDE + 2 * cp) = cvt_pk(c0, c1);
            }
            if (FINAL) {
#pragma unroll
                for (int i = 0; i < 2; ++i) { const int idx = tid + i * NTHREADS, row = idx >> 4, c16 = idx & 15;
                    *(LAS u32x4*)(ygs + row * 128 + c16 * 8) = *(const u32x4*)(sa.YG + (size_t)(t0 + row) * DM + hd * 128 + c16 * 8); }
            }
        }
        __syncthreads();
        f32x4 acc[4][4];
#pragma unroll
        for (int m = 0; m < 4; ++m)
#pragma unroll
            for (int mb = 0; mb < 4; ++mb) acc[m][mb] = (f32x4){0.f, 0.f, 0.f, 0.f};
#pragma unroll
        for (int mb = 0; mb < 4; ++mb) {
            bf16x8 Af[4];
#pragma unroll
            for (int k = 0; k < 4; ++k) Af[k] = *(const LAS bf16x8*)(xcb + (16 * mb + fr) * XCB_STRIDE + 32 * k + 8 * fq);
#pragma unroll
            for (int m = 0; m < 4; ++m)
#pragma unroll
                for (int k = 0; k < 4; ++k) acc[m][mb] = __builtin_amdgcn_mfma_f32_16x16x32_bf16(Af[k], Bf[m][k], acc[m][mb], 0, 0, 0);
        }
        const int ch = 16 * w + fr;
#pragma unroll
        for (int mb = 0; mb < 4; ++mb) {
            float xv[4];
#pragma unroll
            for (int j = 0; j < 4; ++j) xv[j] = xcf[(16 * mb + 4 * fq + j) * XCF_STRIDE + ch];
#pragma unroll
            for (int dir = 0; dir < 2; ++dir) {
#pragma unroll
                for (int j = 0; j < 4; ++j) {
                    const float r = pg8::fsigmoid(acc[2 * dir][mb][j] + ba[dir]);
                    const float ig = pg8::fsigmoid(acc[2 * dir + 1][mb][j] + bx[dir]);
                    const float la = -sp8[dir] * r;
                    const float av = __expf(la);
                    const float x2 = 2.f * la;
                    const float om = (x2 > -0.04f) ? -x2 * (1.f + x2 * (0.5f + x2 * (0.16666667f + x2 * 0.041666668f))) : 1.f - av * av;
                    acc[2 * dir][mb][j] = av;
                    acc[2 * dir + 1][mb][j] = sqrtf(om) * ig * xv[j];
                }
                const f32x4 A = acc[2 * dir][mb], U = acc[2 * dir + 1][mb];
                float P, Q;
                if (dir == 0) { P = (A[0] * A[1]) * (A[2] * A[3]); Q = ((U[0] * A[1] + U[1]) * A[2] + U[2]) * A[3] + U[3]; }
                else          { P = (A[0] * A[1]) * (A[2] * A[3]); Q = ((U[3] * A[2] + U[2]) * A[1] + U[1]) * A[0] + U[0]; }
                seg[(dir * 128 + ch) * 17 + mb * 4 + fq] = (f32x2){P, Q};
            }
        }
        __syncthreads();
        if (tid < 256) {
            const int dir = tid >> 7, c = tid & 127, gch = hd * 128 + c;
            LAS f32x2* sg = seg + (dir * 128 + c) * 17;
            if (!FINAL) {
                float h = 0.f, Pt = 1.f;
                if (dir == 0) { for (int s = 0; s < 16; ++s) { const f32x2 e = sg[s]; h = e[0] * h + e[1]; Pt *= e[0]; } }
                else          { for (int s = 15; s >= 0; --s) { const f32x2 e = sg[s]; h = e[0] * h + e[1]; Pt *= e[0]; } }
                sa.agg[((size_t)dir * SC_NCH + chunk) * DM + gch] = (f32x2){Pt, h};
            } else {
                float h = 0.f;
                if (fast) h = car[(dir * 8 + (chunk >> 4)) * 128 + c];
                else {
                    const f32x2* ag = sa.agg + (size_t)dir * SC_NCH * DM + gch;
                    if (dir == 0) { for (int cc = 0; cc < chunk; ++cc) { const f32x2 e = ag[(size_t)cc * DM]; h = e[0] * h + e[1]; } }
                    else          { for (int cc = SC_NCH - 1; cc > chunk; --cc) { const f32x2 e = ag[(size_t)cc * DM]; h = e[0] * h + e[1]; } }
                }
                if (dir == 0) { for (int s = 0; s < 16; ++s) { const f32x2 e = sg[s]; sg[s] = (f32x2){h, 0.f}; h = e[0] * h + e[1]; } }
                else          { for (int s = 15; s >= 0; --s) { const f32x2 e = sg[s]; sg[s] = (f32x2){h, 0.f}; h = e[0] * h + e[1]; } }
            }
        }
        if (FINAL) {
            __syncthreads();
#pragma unroll
            for (int mb = 0; mb < 4; ++mb) {
                float hs[4];
                { float h = seg[(0 * 128 + ch) * 17 + mb * 4 + fq][0]; const f32x4 A = acc[0][mb], U = acc[1][mb];
#pragma unroll
                  for (int j = 0; j < 4; ++j) { h = A[j] * h + U[j]; hs[j] = h; } }
                { float h = seg[(1 * 128 + ch) * 17 + mb * 4 + fq][0]; const f32x4 A = acc[2][mb], U = acc[3][mb];
#pragma unroll
                  for (int j = 3; j >= 0; --j) { h = A[j] * h + U[j]; hs[j] += h; } }
#pragma unroll
                for (int j = 0; j < 4; ++j) {
                    LAS bf16* yp = ygs + (16 * mb + 4 * fq + j) * 128 + ch;
                    const float yg = __uint_as_float((unsigned)(*yp) << 16);
                    *yp = (bf16)(cvt_pk(hs[j] * yg, 0.f) & 0xffffu);
                }
            }
            __syncthreads();
#pragma unroll
            for (int i = 0; i < 2; ++i) { const int idx = tid + i * NTHREADS, row = idx >> 4, c16 = idx & 15;
                *(u32x4*)(sa.Y + (size_t)(t0 + row) * DM + hd * 128 + c16 * 8) = *(const LAS u32x4*)(ygs + row * 128 + c16 * 8); }
        }
    }
}

struct AttArgs { const bf16* Q; const bf16* K; const bf16* VT; bf16* O; const float* rpb; };

__device__ __forceinline__ void attn_phase(LAS unsigned char* lds, const AttArgs& aa, int G) {
    const int tid = opaque_tid(), lane = tid & 63, w = tid >> 6, fr = lane & 15, fq = lane >> 4;
    const int hsel = w >> 2, qg = w & 3;
    LAS float* rp = (LAS float*)lds;
    const int c0 = 16 * qg, kb0 = (qg == 0) ? 0 : (qg == 1) ? 8 : (qg == 2) ? 24 : 32;
    const int qc = c0 + fr;
    const int cs = min(max(qc - 8, 0), 48);
    for (int id = blockIdx.x; id < 128 * 8; id += G) {
        const int hp = id & 7, r = id >> 3, h = hp * 2 + hsel;
        const int rs = min(max(r - 4, 0), 120);
        __syncthreads();
        for (int i = tid; i < 2 * 465; i += NTHREADS) { const int hh = i / 465, e = i % 465; rp[hh * 480 + e] = aa.rpb[(size_t)(hp * 2 + hh) * 465 + e]; }
        __syncthreads();
        bf16x8 qf[4];
        { const bf16* qp = aa.Q + (size_t)(r * 64 + qc) * DM + h * 128 + 8 * fq;
#pragma unroll
          for (int k = 0; k < 4; ++k) qf[k] = *(const bf16x8*)(qp + 32 * k); }
        f32x4 s[8][2];
        const int krow = 8 * (fr >> 2) + (fr & 3);
#pragma unroll
        for (int i = 0; i < 8; ++i)
#pragma unroll
            for (int nb = 0; nb < 2; ++nb) {
                const bf16* kp = aa.K + (size_t)((rs + i) * 64 + kb0 + krow + 4 * nb) * DM + h * 128 + 8 * fq;
                f32x4 c = (f32x4){0.f, 0.f, 0.f, 0.f};
#pragma unroll
                for (int k = 0; k < 4; ++k) { const bf16x8 kf = *(const bf16x8*)(kp + 32 * k); c = __builtin_amdgcn_mfma_f32_16x16x32_bf16(kf, qf[k], c, 0, 0, 0); }
                s[i][nb] = c;
            }
        float mx = -INFINITY;
        const LAS float* rph = rp + hsel * 480;
#pragma unroll
        for (int i = 0; i < 8; ++i) {
            const int relr = rs + i - r + 7;
#pragma unroll
            for (int nb = 0; nb < 2; ++nb)
#pragma unroll
                for (int j = 0; j < 4; ++j) {
                    const int kc = kb0 + 8 * fq + 4 * nb + j;
                    const bool valid = (unsigned)(kc - cs) < 16u;
                    const int idx = valid ? relr * 31 + (kc - qc + 15) : 0;
                    const float v = valid ? s[i][nb][j] + rph[idx] : -INFINITY;
                    s[i][nb][j] = v; mx = fmaxf(mx, v);
                }
        }
        mx = fmaxf(mx, __shfl_xor(mx, 16)); mx = fmaxf(mx, __shfl_xor(mx, 32));
        float l = 0.f;
#pragma unroll
        for (int i = 0; i < 8; ++i)
#pragma unroll
            for (int nb = 0; nb < 2; ++nb)
#pragma unroll
                for (int j = 0; j < 4; ++j) { const float p = __expf(s[i][nb][j] - mx); s[i][nb][j] = p; l += p; }
        l += __shfl_xor(l, 16); l += __shfl_xor(l, 32);
        f32x4 o[8];
#pragma unroll
        for (int db = 0; db < 8; ++db) o[db] = (f32x4){0.f, 0.f, 0.f, 0.f};
#pragma unroll
        for (int i = 0; i < 8; ++i) {
            u32x4 pw; pw.x = cvt_pk(s[i][0][0], s[i][0][1]); pw.y = cvt_pk(s[i][0][2], s[i][0][3]); pw.z = cvt_pk(s[i][1][0], s[i][1][1]); pw.w = cvt_pk(s[i][1][2], s[i][1][3]);
            const bf16x8 pb = __builtin_bit_cast(bf16x8, pw);
            const bf16* vp = aa.VT + (size_t)(h * 128 + fr) * SEQ + (rs + i) * 64 + kb0 + 8 * fq;
#pragma unroll
            for (int db = 0; db < 8; ++db) { const bf16x8 vf = *(const bf16x8*)(vp + (size_t)(16 * db) * SEQ); o[db] = __builtin_amdgcn_mfma_f32_16x16x32_bf16(vf, pb, o[db], 0, 0, 0); }
        }
        const float inv = 1.f / l;
        bf16* op = aa.O + (size_t)(r * 64 + qc) * DM + h * 128 + 4 * fq;
#pragma unroll
        for (int db = 0; db < 8; ++db) { u32x2 wv; wv.x = cvt_pk(o[db][0] * inv, o[db][1] * inv); wv.y = cvt_pk(o[db][2] * inv, o[db][3] * inv); *(u32x2*)(op + 16 * db) = wv; }
    }
}

#define ATT_BAR() do { asm volatile("s_waitcnt lgkmcnt(0)" ::: "memory"); __builtin_amdgcn_s_barrier(); asm volatile("" ::: "memory"); } while (0)
constexpr int KS_PITCH = 136, VS_PITCH = 72;
constexpr int ATT_KS = 0, ATT_VS = ATT_KS + 2 * 64 * KS_PITCH * 2, ATT_RP = ATT_VS + 2 * 128 * VS_PITCH * 2, ATT_END = ATT_RP + 2048;
static_assert(ATT_END <= 131072, "attention LDS");
__device__ __forceinline__ void attn_phase2(LAS unsigned char* lds, const AttArgs& aa, int G) {
    const int tid = opaque_tid(), lane = tid & 63, w = tid >> 6, fr = lane & 15, fq = lane >> 4;
    const int rsel = w >> 2, qg = w & 3;
    LAS bf16* KS = (LAS bf16*)(lds + ATT_KS);
    LAS bf16* VS = (LAS bf16*)(lds + ATT_VS);
    LAS float* rp = (LAS float*)(lds + ATT_RP);
    const int c0 = 16 * qg, kb0 = (qg == 0) ? 0 : (qg == 1) ? 8 : (qg == 2) ? 24 : 32;
    const int qc = c0 + fr;
    const int cs = min(max(qc - 8, 0), 48);
    const int krow = 8 * (fr >> 2) + (fr & 3);
    const int ktok0 = tid >> 4, kpart = tid & 15, vd0 = tid >> 3, vpart = tid & 7;
    for (int id = blockIdx.x; id < 64 * NHEAD; id += G) {
        const int h = id & 15, rpair = id >> 4, r0 = 2 * rpair;
        const int rsA = min(max(r0 - 4, 0), 120), rsB = min(max(r0 - 3, 0), 120), off = rsB - rsA, nJ = 8 + off;
        const int r = r0 + rsel, rs = rsel ? rsB : rsA, woff = rsel ? off : 0;
        u32x4 R[9][2];
#pragma unroll
        for (int jj = 0; jj < 9; ++jj) { R[jj][0] = (u32x4){0u, 0u, 0u, 0u}; R[jj][1] = (u32x4){0u, 0u, 0u, 0u}; }
        const bf16* kbase = aa.K + (size_t)(rsA * 64 + ktok0) * DM + h * 128 + kpart * 8;
        const bf16* vbase = aa.VT + (size_t)(h * 128 + vd0) * SEQ + rsA * 64 + vpart * 8;
#pragma unroll
        for (int jj = 0; jj < 9; ++jj) if (jj < nJ) {
#pragma unroll
            for (int u = 0; u < 2; ++u) R[jj][u] = *(const u32x4*)(kbase + (size_t)(jj * 64 + 32 * u) * DM);
        }
        for (int i = tid; i < 465; i += NTHREADS) rp[i] = aa.rpb[(size_t)h * 465 + i];
        bf16x8 qf[4];
        { const bf16* qp = aa.Q + (size_t)(r * 64 + qc) * DM + h * 128 + 8 * fq;
#pragma unroll
          for (int k = 0; k < 4; ++k) qf[k] = *(const bf16x8*)(qp + 32 * k); }
#define ATT_KWRITE(j, b) do { _Pragma("unroll") for (int u = 0; u < 2; ++u) *(LAS u32x4*)(KS + (b) * 64 * KS_PITCH + (ktok0 + 32 * u) * KS_PITCH + kpart * 8) = R[j][u]; } while (0)
#define ATT_VLOAD(j) do { _Pragma("unroll") for (int u = 0; u < 2; ++u) R[j][u] = *(const u32x4*)(vbase + (size_t)(64 * u) * SEQ + (j) * 64); } while (0)
#define ATT_VWRITE(j, b) do { _Pragma("unroll") for (int u = 0; u < 2; ++u) *(LAS u32x4*)(VS + (b) * 128 * VS_PITCH + (vd0 + 64 * u) * VS_PITCH + vpart * 8) = R[j][u]; } while (0)
#define ATT_QK(i, b) do { _Pragma("unroll") for (int nb = 0; nb < 2; ++nb) { f32x4 c_ = (f32x4){0.f, 0.f, 0.f, 0.f}; \
            _Pragma("unroll") for (int k = 0; k < 4; ++k) { const bf16x8 kf = *(const LAS bf16x8*)(KS + (b) * 64 * KS_PITCH + (kb0 + krow + 4 * nb) * KS_PITCH + 32 * k + 8 * fq); \
                c_ = __builtin_amdgcn_mfma_f32_16x16x32_bf16(kf, qf[k], c_, 0, 0, 0); } s[i][nb] = c_; } } while (0)
#define ATT_PV(i, b) do { u32x4 pw; pw.x = cvt_pk(s[i][0][0], s[i][0][1]); pw.y = cvt_pk(s[i][0][2], s[i][0][3]); pw.z = cvt_pk(s[i][1][0], s[i][1][1]); pw.w = cvt_pk(s[i][1][2], s[i][1][3]); \
            const bf16x8 pb = __builtin_bit_cast(bf16x8, pw); \
            _Pragma("unroll") for (int db = 0; db < 8; ++db) { const bf16x8 vf = *(const LAS bf16x8*)(VS + (b) * 128 * VS_PITCH + (16 * db + fr) * VS_PITCH + kb0 + 8 * fq); \
                o[db] = __builtin_amdgcn_mfma_f32_16x16x32_bf16(vf, pb, o[db], 0, 0, 0); } } while (0)
        f32x4 s[8][2];
        ATT_KWRITE(0, 0); ATT_VLOAD(0);
        ATT_BAR();
#pragma unroll
        for (int jj = 0; jj < 9; ++jj) {
            if (jj + 1 < 9) { if (jj + 1 < nJ) { ATT_KWRITE((jj + 1 < 9 ? jj + 1 : 8), ((jj + 1) & 1)); ATT_VLOAD((jj + 1 < 9 ? jj + 1 : 8)); } }
            if (woff == 0) { if (jj < 8) ATT_QK((jj < 8 ? jj : 7), (jj & 1)); }
            else           { if (jj >= 1) ATT_QK((jj >= 1 ? jj - 1 : 0), (jj & 1)); }
            ATT_BAR();
        }
        float mx = -INFINITY;
#pragma unroll
        for (int i = 0; i < 8; ++i) {
            const int relr = rs + i - r + 7;
#pragma unroll
            for (int nb = 0; nb < 2; ++nb)
#pragma unroll
                for (int j = 0; j < 4; ++j) {
                    const int kc = kb0 + 8 * fq + 4 * nb + j;
                    const bool valid = (unsigned)(kc - cs) < 16u;
                    const int idx = valid ? relr * 31 + (kc - qc + 15) : 0;
                    const float v = valid ? s[i][nb][j] + rp[idx] : -INFINITY;
                    s[i][nb][j] = v; mx = fmaxf(mx, v);
                }
        }
        mx = fmaxf(mx, __shfl_xor(mx, 16)); mx = fmaxf(mx, __shfl_xor(mx, 32));
        float l = 0.f;
#pragma unroll
        for (int i = 0; i < 8; ++i)
#pragma unroll
            for (int nb = 0; nb < 2; ++nb)
#pragma unroll
                for (int j = 0; j < 4; ++j) { const float p = __expf(s[i][nb][j] - mx); s[i][nb][j] = p; l += p; }
        l += __shfl_xor(l, 16); l += __shfl_xor(l, 32);
        f32x4 o[8];
#pragma unroll
        for (int db = 0; db < 8; ++db) o[db] = (f32x4){0.f, 0.f, 0.f, 0.f};
        ATT_VWRITE(0, 0);
        ATT_BAR();
#pragma unroll
        for (int jj = 0; jj < 9; ++jj) {
            if (jj + 1 < 9) { if (jj + 1 < nJ) ATT_VWRITE((jj + 1 < 9 ? jj + 1 : 8), ((jj + 1) & 1)); }
            if (woff == 0) { if (jj < 8) ATT_PV((jj < 8 ? jj : 7), (jj & 1)); }
            else           { if (jj >= 1) ATT_PV((jj >= 1 ? jj - 1 : 0), (jj & 1)); }
            ATT_BAR();
        }
        const float inv = 1.f / l;
        bf16* op = aa.O + (size_t)(r * 64 + qc) * DM + h * 128 + 4 * fq;
#pragma unroll
        for (int db = 0; db < 8; ++db) { u32x2 wv; wv.x = cvt_pk(o[db][0] * inv, o[db][1] * inv); wv.y = cvt_pk(o[db][2] * inv, o[db][3] * inv); *(u32x2*)(op + 16 * db) = wv; }
#undef ATT_KWRITE
#undef ATT_VLOAD
#undef ATT_VWRITE
#undef ATT_QK
#undef ATT_PV
    }
}

__device__ __forceinline__ void final_phase(float* out, const float* ss, const float* g, int G) {
    const int tid = opaque_tid(), lane = tid & 63, wave = tid >> 6;
    const int gw = blockIdx.x * NWAVES + wave, NGW = G * NWAVES;
    for (int row = gw; row < SEQ; row += NGW) {
        const float rs = pg8::rstd_row(ss, row);
        f32x4* o = (f32x4*)(out + (size_t)row * DM) + lane; const f32x4* gp = (const f32x4*)g + lane;
#pragma unroll
        for (int j = 0; j < 8; ++j) { f32x4 v = o[64 * j]; const f32x4 gv = gp[64 * j]; v = v * rs * gv; o[64 * j] = v; }
    }
}

#define XB_TMO      128
#define XB_XCNT(j)  (256  + 64 * (j))
#define XB_XSUB(j)  (1280 + 64 * (j))
#define XB_XGEN(j)  (2304 + 64 * (j))
#define XB_TOP      3328
#define XB_TOPGEN   3392
#define XCD_BAR_WORDS 3456
#define XB_SPIN_CAP (1u << 18)

__device__ __forceinline__ unsigned xb_ld(unsigned* p)              { return __hip_atomic_load(p, __ATOMIC_RELAXED, __HIP_MEMORY_SCOPE_AGENT); }
__device__ __forceinline__ unsigned xb_add(unsigned* p, unsigned v) { return __hip_atomic_fetch_add(p, v, __ATOMIC_RELAXED, __HIP_MEMORY_SCOPE_AGENT); }
__device__ __forceinline__ unsigned xb_xcc_id() { return (unsigned)__builtin_amdgcn_s_getreg((3 << 11) | 20) & 0xFu; }
#define XB_SPIN(cond, bar) do { unsigned _sp = 0; while (cond) { __builtin_amdgcn_s_sleep(1); \
    if ((++_sp & 255u) == 0u) { if (xb_ld(&(bar)[XB_TMO])) break; if (_sp > XB_SPIN_CAP) { atomicAdd(&(bar)[XB_TMO], 1u); break; } } } } while (0)

struct XcdBarrier {
    unsigned* bar; unsigned x;
    volatile LAS unsigned* st;
};

__device__ __forceinline__ XcdBarrier xcd_barrier_post(unsigned* bar, volatile LAS unsigned* st) {
    XcdBarrier b; b.bar = bar; b.x = xb_xcc_id(); b.st = st;
    if (threadIdx.x == 0) (void)xb_add(&bar[XB_XCNT(b.x)], 1u);
    return b;
}
__device__ __forceinline__ void xcd_barrier_complete(unsigned* bar, unsigned x, unsigned& nloc, unsigned& nx) {
    const unsigned G = gridDim.x * gridDim.y * gridDim.z;
    unsigned sum, cnt, mine, sp = 0u;
    for (;;) {
        sum = 0u; cnt = 0u; mine = 0u;
#pragma unroll
        for (unsigned j = 0; j < 16; ++j) { const unsigned c = xb_ld(&bar[XB_XCNT(j)]); sum += c; cnt += (c > 0u) ? 1u : 0u; mine = (j == x) ? c : mine; }
        if (sum == G) break;
        __builtin_amdgcn_s_sleep(1);
        if ((++sp & 255u) == 0u) { if (xb_ld(&bar[XB_TMO])) break; if (sp > XB_SPIN_CAP) { atomicAdd(&bar[XB_TMO], 1u); break; } }
    }
    nloc = mine > 0u ? mine : 1u; nx = cnt > 0u ? cnt : 1u;
}

__device__ __forceinline__ void xcd_barrier(const XcdBarrier& b) {
    asm volatile("s_waitcnt vmcnt(0)" ::: "memory");
    __syncthreads();
    if (threadIdx.x == 0) {
        unsigned* bar = b.bar;
        __builtin_amdgcn_s_waitcnt(0);
        unsigned nloc = b.st[0], nx = b.st[1];
        if (nloc == 0u) { xcd_barrier_complete(bar, b.x, nloc, nx); b.st[0] = nloc; b.st[1] = nx; }
        const unsigned old = xb_add(&bar[XB_XSUB(b.x)], 1u);
        const unsigned gen = old / nloc;
        if (old + 1u == (gen + 1u) * nloc) {
            __builtin_amdgcn_fence(__ATOMIC_RELEASE, "agent");
            asm volatile("s_waitcnt vmcnt(0)" ::: "memory");
            const unsigned og = xb_add(&bar[XB_TOP], 1u);
            const unsigned tg = og / nx;
            if (og + 1u == (tg + 1u) * nx) xb_add(&bar[XB_TOPGEN], 1u);
            else XB_SPIN(xb_ld(&bar[XB_TOPGEN]) == tg, bar);
            __builtin_amdgcn_fence(__ATOMIC_ACQUIRE, "agent");
            xb_add(&bar[XB_XGEN(b.x)], 1u);
            asm volatile("s_waitcnt vmcnt(0)" ::: "memory");
        } else {
            XB_SPIN(xb_ld(&bar[XB_XGEN(b.x)]) == gen, bar);
            __builtin_amdgcn_fence(__ATOMIC_ACQUIRE, "agent");
            asm volatile("s_waitcnt vmcnt(0)" ::: "memory");
        }
    }
    __syncthreads();
}

constexpr int LDS_TAB = 131072 + 1024;
__device__ __forceinline__ void fill_rstd_tab(LAS unsigned char* lds, const float* ssp, int t) {
    LAS float* tab = (LAS float*)(lds + LDS_TAB);
    const int tid = opaque_tid();
    if (tid < 256) tab[tid] = pg8::rstd_row(ssp, t * 256 + tid);
    __syncthreads();
}
constexpr int N_PHASES = 28;
#ifndef PGA
#define PGA true
#endif
#ifndef PGA1
#define PGA1 true
#endif
#ifndef PGS
#define PGS true
#endif
#ifndef DBG_DUMP_OFF
#define DBG_DUMP_OFF WS_BC
#endif
#ifndef DBG_NPH
#define DBG_NPH N_PHASES
#endif
#ifndef DBG_DUMP
#define DBG_DUMP 0
#endif
enum Kind { K_P0, K_WIN, K_S1, K_S2, K_WOUT, K_QKV, K_ATT, K_W1, K_W2, K_PLE, K_FINAL, K_DUMP };

__global__ void __launch_bounds__(NTHREADS, 2) mega_fwd(Args args) {
    extern __shared__ __attribute__((aligned(16))) unsigned char lds_raw[];
    LAS unsigned char* lds = (LAS unsigned char*)lds_raw;
    cg::grid_group grid = cg::this_grid();
    const int G = gridDim.x;
    KA ka0 = (KA)__builtin_amdgcn_kernarg_segment_ptr();
    const int lo = *(const int __attribute__((address_space(4)))*)(ka0 + 192), hi = *(const int __attribute__((address_space(4)))*)(ka0 + 196);
    if (hi - lo > 1) {
        volatile LAS unsigned* st = (volatile LAS unsigned*)(lds + 131072 + 64);
        if (threadIdx.x < 2) st[threadIdx.x] = 0u;
        __syncthreads();
        unsigned char* ws0 = *(unsigned char* const __attribute__((address_space(4)))*)(ka0 + 184);
        (void)xcd_barrier_post((unsigned*)(ws0 + WS_BAR), st);
    }
    if (hi > 100000) grid.sync();
    for (int ph = lo; ph < hi; ++ph) {
        KA ka = ka0; asm volatile("" : "+s"(ka));
        unsigned char* ws = *(unsigned char* const __attribute__((address_space(4)))*)(ka + 184);
        float* hout = *(float* const __attribute__((address_space(4)))*)(ka + 176);
        float* ss = (float*)(ws + WS_SS);
        int kind, L = 0;
        if (ph == 0) kind = K_P0; else if (ph == 99) kind = K_DUMP; else if (ph == N_PHASES - 1) kind = K_FINAL;
        else { int q = ph - 1; const int pair = q / 13; q -= pair * 13; L = 2 * pair;
            if (q < 7) { kind = (q == 0) ? K_WIN : (q == 1) ? K_S1 : (q == 2) ? K_S2 : (q == 3) ? K_WOUT : (q == 4) ? K_W1 : (q == 5) ? K_W2 : K_PLE; }
            else { q -= 7; L += 1; kind = (q == 0) ? K_QKV : (q == 1) ? K_ATT : (q == 2) ? K_WOUT : (q == 3) ? K_W1 : (q == 4) ? K_W2 : K_PLE; } }
        const int j = L >> 1;
        bf16* Xc = (bf16*)(ws + ((L & 1) ? WS_X1 : WS_X0));
        bf16* Xo = (bf16*)(ws + ((L & 1) ? WS_X0 : WS_X1));
        const float* ss_mix = ss + (size_t)(3 * L) * SEQ * 32; float* ss_mlp = ss + (size_t)(3 * L + 1) * SEQ * 32; float* ss_ple = ss + (size_t)(3 * L + 2) * SEQ * 32; float* ss_next = ss + (size_t)(3 * L + 3) * SEQ * 32;
        switch (kind) {
        case K_P0:
#ifndef DIS_P0
 p0_phase(lds, ka, ws, G);
#endif
 break;
        case K_WIN: {
#ifdef DBG_BJ0
            pg8::Gemm g{Xc, (const bf16*)(ws + WS_WINT), SEQ, 2 * DM, DM};
#elif defined(DBG_AX1)
            pg8::Gemm g{(L == 2) ? Xo : Xc, (const bf16*)(ws + WS_WINT) + (size_t)j * DM * 2 * DM, SEQ, 2 * DM, DM};
#else
            pg8::Gemm g{Xc, (const bf16*)(ws + WS_WINT) + (size_t)j * DM * 2 * DM, SEQ, 2 * DM, DM};
#endif
            pg8::StaticOrder S; S.init(SEQ, 2 * DM, G, (int)blockIdx.x);
#ifdef DBG_FRESHOUT

#elif defined(DBG_SS0)

#else
            pg8::Unit u0; S.next(0, u0); fill_rstd_tab(lds, ss_mix, u0.pm);
            pg8::EpiAct<0> E{(bf16*)(ws + WS_BA), (bf16*)(ws + WS_BB), DM, DM, ss_mix, (const LAS float*)(lds + LDS_TAB), u0.pm};
#endif
#ifndef DIS_ACT0
            pg8::gemm_phase<pg8::EpiAct<0>, pg8::StaticOrder, PGA, PGS>(lds, g, S, E);
#endif
        } break;
        case K_S1: case K_S2: {
            ScanArgs sa{(const bf16*)(ws + WS_BA), (const bf16*)(ws + WS_BB), (bf16*)(ws + WS_BC),
                        INP(7) + (size_t)j * 4 * DM, INP(8) + (size_t)j * DM,
                        (const bf16*)(ws + WS_GAT) + (size_t)j * 32 * 128 * 128, (const bf16*)(ws + WS_GXT) + (size_t)j * 32 * 128 * 128,
                        INP(10) + (size_t)j * 2 * DM, INP(12) + (size_t)j * 2 * DM, INP(13) + (size_t)j * 2 * DM,
                        (f32x2*)(ws + WS_AGG)};
            #ifndef DIS_SCAN
            if (kind == K_S1) scan_phase<false>(lds, sa, G); else scan_phase<true>(lds, sa, G);
#endif
        } break;
        case K_QKV: {
            {
                pg8::Gemm g{Xc, (const bf16*)(ws + WS_WQKVT) + (size_t)j * 3 * DM * DM, SEQ, 2 * DM, DM};
                pg8::StaticOrder S; S.init(SEQ, 2 * DM, G, (int)blockIdx.x);
                pg8::Unit u0; S.next(0, u0); fill_rstd_tab(lds, ss_mix, u0.pm);
                pg8::EpiAct<1> E{(bf16*)(ws + WS_BA), (bf16*)(ws + WS_BB), DM, DM, ss_mix, (const LAS float*)(lds + LDS_TAB), u0.pm};
#ifndef DIS_ACT1
                pg8::gemm_phase<pg8::EpiAct<1>, pg8::StaticOrder, PGA, PGS>(lds, g, S, E);
#endif
            }
            __syncthreads();
            {
                pg8::Gemm g{(const bf16*)(ws + WS_WQKVT) + (size_t)j * 3 * DM * DM + (size_t)2 * DM * DM, Xc, DM, SEQ, DM};
                pg8::StaticOrder S; S.init(DM, SEQ, G, (int)blockIdx.x);
                pg8::Unit u0; S.next(0, u0); fill_rstd_tab(lds, ss_mix, u0.pn);
                pg8::EpiAct<4> E{(bf16*)(ws + WS_BD), nullptr, SEQ, 0, ss_mix, (const LAS float*)(lds + LDS_TAB), u0.pn};
#ifndef DIS_ACT4
                pg8::gemm_phase<pg8::EpiAct<4>, pg8::StaticOrder, PGA1, PGS>(lds, g, S, E);
#endif
            }
        } break;
        case K_ATT: {
            AttArgs aa{(const bf16*)(ws + WS_BA), (const bf16*)(ws + WS_BB), (const bf16*)(ws + WS_BD), (bf16*)(ws + WS_BC), INP(16) + (size_t)j * NHEAD * 465};
#ifndef DIS_ATT
#ifdef ATT_V1
            attn_phase(lds, aa, G);
#else
            attn_phase2(lds, aa, G);
#endif
#endif
        } break;
        case K_WOUT: case K_W2: {
            const bf16* A; const bf16* Bt; int K;
            float* sso; bf16* hb;
            if (kind == K_WOUT) { A = (const bf16*)(ws + WS_BC); K = DM; Bt = (L & 1) ? (const bf16*)(ws + WS_WONT) + (size_t)j * DM * DM : (const bf16*)(ws + WS_WORT) + (size_t)j * DM * DM; sso = ss_mlp; hb = Xo; }
            else { A = (const bf16*)(ws + WS_A1); K = DFF; Bt = (const bf16*)(ws + WS_W2T) + (size_t)L * DM * DFF; sso = ss_ple; hb = Xc; }
            const float* base = (kind == K_WOUT && L == 0) ? INP(0) : hout;
            pg8::Gemm g{A, Bt, SEQ, DM, K};
            pg8::StaticOrder S; S.init(SEQ, DM, G, (int)blockIdx.x);
            pg8::EpiRes<0> E{base, hout, hb, sso, nullptr, nullptr, (const LAS float*)(lds + LDS_TAB), -1};
#ifndef DIS_RES0
            pg8::gemm_phase<pg8::EpiRes<0>, pg8::StaticOrder, PGA1, PGS>(lds, g, S, E);
#endif
        } break;
        case K_W1: {
            {
                int Kp = PLE; asm volatile("" : "+s"(Kp));
                pg8::Gemm g{(const bf16*)(ws + WS_PB) + (size_t)L * SEQ * PLE, (const bf16*)(ws + WS_WPT) + (size_t)L * DM * PLE, SEQ, DM, Kp};
                pg8::StaticOrder S; S.init(SEQ, DM, G, (int)blockIdx.x);
                pg8::EpiAct<3> E{(bf16*)(ws + WS_PROJ) + (size_t)L * SEQ * DM, nullptr, DM, 0, nullptr, (const LAS float*)(lds + LDS_TAB), -1};
#ifndef DIS_ACT3
                pg8::gemm_phase<pg8::EpiAct<3>, pg8::StaticOrder, PGA1, PGS>(lds, g, S, E);
#endif
            }
            __syncthreads();
            pg8::Gemm g{Xo, (const bf16*)(ws + WS_W1T) + (size_t)L * DM * DFF, SEQ, DFF, DM};
            pg8::StaticOrder S; S.init(SEQ, DFF, G, (int)blockIdx.x);
            pg8::Unit u0; S.next(0, u0); fill_rstd_tab(lds, ss_mlp, u0.pm);
            pg8::EpiAct<2> E{(bf16*)(ws + WS_A1), nullptr, DFF, 0, ss_mlp, (const LAS float*)(lds + LDS_TAB), u0.pm};
#ifndef DIS_ACT2
            pg8::gemm_phase<pg8::EpiAct<2>, pg8::StaticOrder, PGA, PGS>(lds, g, S, E);
#endif
        } break;
        case K_PLE: {
            pg8::Gemm g{Xc, (const bf16*)(ws + WS_WGT) + (size_t)L * DM * DM, SEQ, DM, DM};
            pg8::StaticOrder S; S.init(SEQ, DM, G, (int)blockIdx.x);
            pg8::Unit u0; S.next(0, u0); fill_rstd_tab(lds, ss_ple, u0.pm);
            pg8::EpiRes<1> E{hout, hout, Xo, ss_next, ss_ple, (const bf16*)(ws + WS_PROJ) + (size_t)L * SEQ * DM, (const LAS float*)(lds + LDS_TAB), u0.pm};
#ifndef DIS_RES1
            pg8::gemm_phase<pg8::EpiRes<1>, pg8::StaticOrder, PGA1, PGS>(lds, g, S, E);
#endif
        } break;
#if DBG_DUMP
        case K_DUMP: {
            const bf16* src = (const bf16*)(ws + DBG_DUMP_OFF); const float* srcf = (const float*)(ws + DBG_DUMP_OFF);
            for (size_t i = (size_t)blockIdx.x * NTHREADS + threadIdx.x; i < (size_t)SEQ * DM; i += (size_t)G * NTHREADS) hout[i] = (DBG_DUMP == 2) ? srcf[i & 8191] : bfl((unsigned)src[i]);
        } break;
#endif
        case K_FINAL: final_phase(hout, ss + (size_t)12 * SEQ * 32, INP(5), G); break;
        }
        if (ph + 1 < hi) { XcdBarrier b; b.bar = (unsigned*)(ws + WS_BAR); b.x = xb_xcc_id(); b.st = (volatile LAS unsigned*)(lds + 131072 + 64); xcd_barrier(b); }
    }
}

#ifndef MK_MULTI
#define MK_MULTI 0
#endif

extern "C" void kernel_launch(void* const* d_in, const int* in_sizes, int n_in, void* d_out, int out_size, void* d_ws, size_t ws_size, hipStream_t stream) {
    static int grid = 0;
    if (grid == 0) {
        if (n_in != 22 || out_size != SEQ * DM || ws_size < WS_END) { fprintf(stderr, "kernel_launch: unexpected shapes (n_in %d out %d ws %zu)\n", n_in, out_size, ws_size); grid = -1; return; }
        int dev = 0, cus = 0, per_cu = 0;
        (void)hipGetDevice(&dev); (void)hipDeviceGetAttribute(&cus, hipDeviceAttributeMultiprocessorCount, dev);
        if (hipFuncSetAttribute((const void*)mega_fwd, hipFuncAttributeMaxDynamicSharedMemorySize, LDS_BYTES) != hipSuccess) { fprintf(stderr, "kernel_launch: hipFuncSetAttribute failed\n"); grid = -1; return; }
        if (hipOccupancyMaxActiveBlocksPerMultiprocessor(&per_cu, (const void*)mega_fwd, NTHREADS, LDS_BYTES) != hipSuccess || per_cu < 1) { fprintf(stderr, "kernel_launch: occupancy query says %d\n", per_cu); per_cu = 1; }
        (void)hipGetLastError();
        grid = cus * per_cu; if (grid > 256) grid = 256;
        fprintf(stderr, "kernel_launch: grid %d (cus %d per_cu %d)\n", grid, cus, per_cu);
    }
    if (grid < 0) return;
    Args a{};
    for (int i = 0; i < 22; ++i) a.in[i] = (const float*)d_in[i];
    a.out = (float*)d_out; a.ws = (unsigned char*)d_ws;
#if MK_MULTI
#ifdef DBG_SEQ
    { const int seq[] = {DBG_SEQ}; for (int ph : seq) { a.ph_lo = ph; a.ph_hi = ph + 1; hipLaunchKernelGGL(mega_fwd, dim3(grid), dim3(NTHREADS), LDS_BYTES, stream, a); } }
#else
    for (int ph = 0; ph < DBG_NPH; ++ph) { a.ph_lo = ph; a.ph_hi = ph + 1; hipLaunchKernelGGL(mega_fwd, dim3(grid), dim3(NTHREADS), LDS_BYTES, stream, a); }
#endif
    if (DBG_DUMP) { a.ph_lo = 99; a.ph_hi = 100; hipLaunchKernelGGL(mega_fwd, dim3(grid), dim3(NTHREADS), LDS_BYTES, stream, a); }
#else
    a.ph_lo = 0; a.ph_hi = N_PHASES;
    if (hipMemsetAsync((char*)d_ws + WS_BAR, 0, 16384, stream) != hipSuccess) { fprintf(stderr, "kernel_launch: memset of the barrier words failed\n"); return; }
    void* kargs[] = {&a};
    hipError_t e = hipLaunchCooperativeKernel((const void*)mega_fwd, dim3(grid), dim3(NTHREADS), kargs, LDS_BYTES, stream);
    if (e != hipSuccess) fprintf(stderr, "kernel_launch: cooperative launch failed: %s (grid %d)\n", hipGetErrorString(e), grid);
#endif
}
```

```cpp
#include <hip/hip_runtime.h>
#include <hip/hip_cooperative_groups.h>
#include <cstdio>
#include <cstdint>
namespace cg = cooperative_groups;
namespace pg8 {
#define PG8_LAS __attribute__((address_space(3)))
typedef unsigned short bf16_t;
typedef short bf16x8 __attribute__((ext_vector_type(8)));
typedef float f32x4 __attribute__((ext_vector_type(4)));
typedef unsigned u32x4 __attribute__((ext_vector_type(4)));
constexpr int BM = 256, BK = 64, HALF = 128, HTB = HALF * BK * 2  , STAGE_BYTES = 8 * HTB, NXCD = 8, WGM = 8;

__host__ __device__ __forceinline__ int lds_byte(int r, int c) { const int st = (r >> 4) * 2 + (c >> 5), rr = r & 15, cc = c & 31, ob = rr * 64 + cc * 2; return st * 1024 + (ob ^ (((ob >> 9) & 1) << 5)); }
__host__ __device__ __forceinline__ void stage_rc(int b, int& R, int& C) { const int st = b / 1024, sb = b % 1024, swz = sb ^ (((sb >> 9) & 1) << 5); R = (st >> 1) * 16 + swz / 64; C = (st & 1) * 32 + (swz % 64) / 2; }
__host__ __device__ __forceinline__ int perm32(int rho) { const int n = rho >> 4, i = rho & 15; return 8 * (i >> 2) + 4 * n + (i & 3); }

struct Unit { int pm, pn; };
struct Gemm { const bf16_t* A; const bf16_t* Bt; int M, N, K; };

struct StaticOrder {
    int nM, nN, nwg, G, c;
    __host__ __device__ void init(int M, int N, int G_, int c_) { nM = M / BM; nN = N / BM; nwg = nM * nN; G = G_; c = c_; }
    __host__ __device__ bool next(int i, Unit& u) const {
        const long L = (long)i * G + c; if (L >= nwg) return false;
        int wgid = (int)L; { const int q = nwg / NXCD, r = nwg % NXCD, xcd = wgid % NXCD, off = wgid / NXCD; wgid = (xcd < r ? xcd * (q + 1) : r * (q + 1) + (xcd - r) * q) + off; }
        const int nig = WGM * nN, gid = wgid / nig, fm = gid * WGM, gsz = (nM - fm) < WGM ? (nM - fm) : WGM;
        u.pm = fm + ((wgid % nig) % gsz); u.pn = (wgid % nig) / gsz; return true;
    }
    __device__ __forceinline__ void a_ready(const Unit&) const {}
    __device__ __forceinline__ void done(const Unit&) const {}
};

__device__ __forceinline__ unsigned cvt_pk_bf16(float lo, float hi) { unsigned r; asm volatile("v_cvt_pk_bf16_f32 %0, %1, %2" : "=v"(r) : "v"(lo), "v"(hi)); return r; }
typedef float f32x2 __attribute__((ext_vector_type(2)));
constexpr float RMS_EPS = 1e-6f;
constexpr int DM = 2048;
__device__ __forceinline__ float fsigmoid(float x) { return __builtin_amdgcn_rcpf(1.f + __expf(-x)); }
__device__ __forceinline__ float gelu_tanh(float v) { return v * fsigmoid(1.5957691216057308f * (v + 0.044715f * v * v * v)); }
__device__ __forceinline__ float rstd_row(const float* ssp, int row) {
    const f32x4* p = (const f32x4*)(ssp + (size_t)row * 32); float s = 0.f;
#pragma unroll
    for (int i = 0; i < 8; ++i) { const f32x4 v = p[i]; s += (v[0] + v[1]) + (v[2] + v[3]); }
    return rsqrtf(s * (1.f / DM) + RMS_EPS);
}
__device__ __forceinline__ float bf_lo(unsigned w) { return __uint_as_float(w << 16); }
__device__ __forceinline__ float bf_hi(unsigned w) { return __uint_as_float(w & 0xffff0000u); }

template <int MODE> struct EpiAct {
    static constexpr bool PERM = true, AFTER_DRAIN = false;
    bf16_t* O0; bf16_t* O1; int ldc; int split; const float* ss; const PG8_LAS float* tab; int tab_t;
    __device__ __forceinline__ void operator()(const f32x4 (&acc)[2][2][4][2], const Unit& u, int wr, int wc, int fr, int fq) const {
        const int row0 = u.pm * BM + wr * 64 + fr; int colt = u.pn * BM; bf16_t* base = O0; bool second = false;
        if (MODE <= 1) { if (colt >= split) { base = O1; colt -= split; second = true; } }
        const int col0 = colt + wc * 32 + 8 * fq;
        f32x4 cs[2][2];
        if (MODE == 4) {
#pragma unroll
            for (int bj = 0; bj < 2; ++bj)
#pragma unroll
                for (int n = 0; n < 2; ++n) {
#pragma unroll
                    for (int e = 0; e < 4; ++e) cs[bj][n][e] = (u.pn == tab_t) ? tab[col0 - u.pn * BM + bj * HALF + 4 * n + e] : rstd_row(ss, col0 + bj * HALF + 4 * n + e); }
        }
#pragma unroll
        for (int ai = 0; ai < 2; ++ai)
#pragma unroll
            for (int m = 0; m < 4; ++m) {
                const int row = row0 + ai * HALF + m * 16;
                float rs = 1.f;
                if (MODE <= 2) { rs = (u.pm == tab_t) ? tab[row - u.pm * BM] : rstd_row(ss, row); if (MODE == 1 && !second) rs *= 0.08838834764831845f; }
                bf16_t* rowp = base + (size_t)row * ldc + col0;
#pragma unroll
                for (int bj = 0; bj < 2; ++bj) {
                    f32x4 v0 = acc[ai][bj][m][0], v1 = acc[ai][bj][m][1];
                    if (MODE == 4) { v0 = v0 * cs[bj][0]; v1 = v1 * cs[bj][1]; } else { v0 = v0 * rs; v1 = v1 * rs; }
                    if (MODE == 0) { if (second) {
#pragma unroll
                        for (int e = 0; e < 4; ++e) { v0[e] = gelu_tanh(v0[e]); v1[e] = gelu_tanh(v1[e]); } } }
                    if (MODE == 2) {
#pragma unroll
                        for (int e = 0; e < 4; ++e) { const float a = fmaxf(v0[e], 0.f), b = fmaxf(v1[e], 0.f); v0[e] = a * a; v1[e] = b * b; } }
                    u32x4 w; w.x = cvt_pk_bf16(v0[0], v0[1]); w.y = cvt_pk_bf16(v0[2], v0[3]); w.z = cvt_pk_bf16(v1[0], v1[1]); w.w = cvt_pk_bf16(v1[2], v1[3]);
                    *(u32x4*)(rowp + bj * HALF) = w;
                }
                asm volatile("" ::: "memory");
            }
    }
};

template <int MODE> struct EpiRes {
    static constexpr bool PERM = true, AFTER_DRAIN = false;
    const float* base; float* out; bf16_t* hb; float* ss_out; const float* ss_in; const bf16_t* proj; const PG8_LAS float* tab; int tab_t;
    __device__ __forceinline__ void operator()(const f32x4 (&acc)[2][2][4][2], const Unit& u, int wr, int wc, int fr, int fq) const {
        const int row0 = u.pm * BM + wr * 64 + fr; const int col0 = u.pn * BM + wc * 32 + 8 * fq;
#pragma unroll
        for (int aim = 0; aim < 4; ++aim) { const int ai = aim >> 1, mh = (aim & 1) * 2;
            f32x4 bpre[2][2][2]; u32x4 ppre[2][2];
#pragma unroll
            for (int mm = 0; mm < 2; ++mm) { const int m = mh + mm; const size_t off = (size_t)(row0 + ai * HALF + m * 16) * DM + col0;
#pragma unroll
                for (int bj = 0; bj < 2; ++bj) { bpre[mm][bj][0] = *(const f32x4*)(base + off + bj * HALF); bpre[mm][bj][1] = *(const f32x4*)(base + off + bj * HALF + 4);
                    if (MODE == 1) ppre[mm][bj] = *(const u32x4*)(proj + off + bj * HALF); } }
#pragma unroll
            for (int mm = 0; mm < 2; ++mm) { const int m = mh + mm;
                const int row = row0 + ai * HALF + m * 16; const size_t off = (size_t)row * DM + col0;
                float rs = 0.f; if (MODE == 1) rs = (u.pm == tab_t) ? tab[row - u.pm * BM] : rstd_row(ss_in, row);
                float sq = 0.f;
#pragma unroll
                for (int bj = 0; bj < 2; ++bj) {
                    const f32x4 b0 = bpre[mm][bj][0], b1 = bpre[mm][bj][1];
                    f32x4 v0 = acc[ai][bj][m][0], v1 = acc[ai][bj][m][1];
                    if (MODE == 1) {
                        const u32x4 pw = ppre[mm][bj];
                        const f32x4 p0 = (f32x4){bf_lo(pw.x), bf_hi(pw.x), bf_lo(pw.y), bf_hi(pw.y)}, p1 = (f32x4){bf_lo(pw.z), bf_hi(pw.z), bf_lo(pw.w), bf_hi(pw.w)};
#pragma unroll
                        for (int e = 0; e < 4; ++e) { v0[e] = fsigmoid(v0[e] * rs) * p0[e]; v1[e] = fsigmoid(v1[e] * rs) * p1[e]; }
                    }
                    const f32x4 o0 = b0 + v0, o1 = b1 + v1;
                    *(f32x4*)(out + off + bj * HALF) = o0; *(f32x4*)(out + off + bj * HALF + 4) = o1;
                    u32x4 w; w.x = cvt_pk_bf16(o0[0], o0[1]); w.y = cvt_pk_bf16(o0[2], o0[3]); w.z = cvt_pk_bf16(o1[0], o1[1]); w.w = cvt_pk_bf16(o1[2], o1[3]);
                    *(u32x4*)(hb + off + bj * HALF) = w;
                    sq += (o0[0] * o0[0] + o0[1] * o0[1]) + (o0[2] * o0[2] + o0[3] * o0[3]) + (o1[0] * o1[0] + o1[1] * o1[1]) + (o1[2] * o1[2] + o1[3] * o1[3]);
                }
                sq += __shfl_xor(sq, 16); sq += __shfl_xor(sq, 32);
                if (fq == 0) ss_out[(size_t)row * 32 + u.pn * 4 + wc] = sq;
            }
            asm volatile("" ::: "memory");
        }
    }
};

template <class Epi, class Sched, bool ALIGN_EPI = false, bool SP2 = false>
__device__ __forceinline__ void gemm_phase(PG8_LAS unsigned char* lds, const Gemm g, const Sched& S, const Epi& E) {
    int tid_ = threadIdx.x; asm volatile("" : "+v"(tid_)); const int tid = tid_, wid = __builtin_amdgcn_readfirstlane(tid >> 6), lane = tid & 63, wr = wid >> 2, wc = wid & 3, fr = lane & 15, fq = lane >> 4;
    const int K = g.K, nt = K / BK;
    unsigned voffA[2], voffB[2];
#pragma unroll
    for (int i = 0; i < 2; ++i) { int R, C; stage_rc(tid * 16 + i * 8192, R, C); const int Rb = Epi::PERM ? ((R & ~31) + perm32(R & 31)) : R;
        voffA[i] = (unsigned)(R * K + C) * 2u; voffB[i] = (unsigned)(Rb * K + C) * 2u; }
    const size_t kstep = (size_t)(BK * 2);
    const size_t hstep = (size_t)HALF * K * 2;
    const size_t tstep = 2 * hstep;
    const unsigned ldsw = (unsigned)wid * 1024u;
    const int aoff = lds_byte(wr * 64 + fr, fq * 8), boff = lds_byte(wc * 32 + fr, fq * 8);
#define PG8_SA(b, h) (((b) * 2 + (h)) * HTB)
#define PG8_SB(b, h) ((4 + (b) * 2 + (h)) * HTB)
#define PG8_STAGE(bufoff, gbase, voff) do { _Pragma("unroll") for (int _i = 0; _i < 2; ++_i) \
        __builtin_amdgcn_global_load_lds((const unsigned*)((const char*)(gbase) + (voff)[_i]), (PG8_LAS unsigned*)(lds + (bufoff) + ldsw + _i * 8192), 16, 0, 0); } while (0)
#define PG8_LDA(dst, b, h) do { _Pragma("unroll") for (int m = 0; m < 4; ++m) _Pragma("unroll") for (int k = 0; k < 2; ++k) dst[m][k] = *(const PG8_LAS bf16x8*)(lds + PG8_SA(b, h) + aoff + m * 2048 + k * 1024); } while (0)
#define PG8_LDB(dst, b, h) do { _Pragma("unroll") for (int n = 0; n < 2; ++n) _Pragma("unroll") for (int k = 0; k < 2; ++k) dst[n][k] = *(const PG8_LAS bf16x8*)(lds + PG8_SB(b, h) + boff + n * 2048 + k * 1024); } while (0)
#define PG8_MMA(ai, bj, At, Bt) do { __builtin_amdgcn_s_setprio(1); _Pragma("unroll") for (int m = 0; m < 4; ++m) _Pragma("unroll") for (int n = 0; n < 2; ++n) _Pragma("unroll") for (int k = 0; k < 2; ++k) \
        acc[ai][bj][m][n] = __builtin_amdgcn_mfma_f32_16x16x32_bf16(Bt[n][k], At[m][k], acc[ai][bj][m][n], 0, 0, 0); __builtin_amdgcn_s_setprio(0); } while (0)
#define PG8_WAIT_V(n) asm volatile("s_waitcnt vmcnt(" #n ")" ::: "memory")
#define PG8_WAIT_L(n) asm volatile("s_waitcnt lgkmcnt(" #n ")" ::: "memory")
#define PG8_BAR __builtin_amdgcn_s_barrier()
#define PG8_SCHED __builtin_amdgcn_sched_barrier(0)
    Unit cur, nxt; int ui = 0;
    if (!S.next(0, cur)) return;
    f32x4 acc[2][2][4][2];
#pragma unroll
    for (int a = 0; a < 2; ++a)
#pragma unroll
        for (int b = 0; b < 2; ++b)
#pragma unroll
            for (int m = 0; m < 4; ++m)
#pragma unroll
                for (int n = 0; n < 2; ++n) acc[a][b][m][n] = (f32x4){0.f, 0.f, 0.f, 0.f};
    bf16x8 At[4][2], B0[2][2], B1[2][2];
    const char* cA = (const char*)g.A + (size_t)cur.pm * tstep; const char* cB = (const char*)g.Bt + (size_t)cur.pn * tstep;
    S.a_ready(cur);
    if constexpr (SP2) {
        PG8_STAGE(PG8_SB(0, 0), cB, voffB); PG8_STAGE(PG8_SB(0, 1), cB + hstep, voffB); PG8_STAGE(PG8_SA(0, 0), cA, voffA); PG8_STAGE(PG8_SA(0, 1), cA + hstep, voffA);
        if (wr == 1) PG8_BAR;
        PG8_WAIT_V(2); PG8_BAR;
        PG8_STAGE(PG8_SB(1, 0), cB + kstep, voffB); PG8_STAGE(PG8_SA(1, 0), cA + kstep, voffA); PG8_STAGE(PG8_SB(1, 1), cB + hstep + kstep, voffB);
        PG8_WAIT_V(6); PG8_BAR;
    } else {
        PG8_STAGE(PG8_SB(0, 0), cB, voffB); PG8_STAGE(PG8_SA(0, 0), cA, voffA); PG8_STAGE(PG8_SB(0, 1), cB + hstep, voffB); PG8_STAGE(PG8_SA(0, 1), cA + hstep, voffA);
        if (wr == 1) PG8_BAR;
        PG8_WAIT_V(4); PG8_BAR;
        PG8_STAGE(PG8_SB(1, 0), cB + kstep, voffB); PG8_STAGE(PG8_SA(1, 0), cA + kstep, voffA); PG8_STAGE(PG8_SB(1, 1), cB + hstep + kstep, voffB);
        PG8_WAIT_V(6); PG8_BAR;
    }
    for (;;) {
        const bool has_next = S.next(ui + 1, nxt);
        const char* nA = has_next ? (const char*)g.A + (size_t)nxt.pm * tstep : cA; const char* nB = has_next ? (const char*)g.Bt + (size_t)nxt.pn * tstep : cB;
        for (int t = 0; t < nt; t += 2) {
            const bool last = (t == nt - 2);
            const char* a1 = cA + (size_t)(t + 1) * kstep;
            const char* a2 = last ? nA : cA + (size_t)(t + 2) * kstep; const char* b2 = last ? nB : cB + (size_t)(t + 2) * kstep;
            const char* a3 = a2 + kstep; const char* b3 = b2 + kstep;
            if (last && has_next) S.a_ready(nxt);
            if constexpr (SP2) {
            PG8_LDB(B0, 0, 0); PG8_LDB(B1, 0, 1); PG8_SCHED; PG8_LDA(At, 0, 0); PG8_STAGE(PG8_SA(1, 1), a1 + hstep, voffA);
            PG8_WAIT_V(8); PG8_WAIT_L(0); PG8_BAR; PG8_MMA(0, 0, At, B0); PG8_MMA(0, 1, At, B1); PG8_BAR; PG8_SCHED;
            PG8_LDA(At, 0, 1); PG8_STAGE(PG8_SB(0, 0), b2, voffB); PG8_STAGE(PG8_SB(0, 1), b2 + hstep, voffB); PG8_STAGE(PG8_SA(0, 0), a2, voffA);
            PG8_WAIT_V(8); PG8_WAIT_L(0); PG8_BAR; PG8_MMA(1, 0, At, B0); PG8_MMA(1, 1, At, B1); PG8_BAR; PG8_SCHED;
            PG8_LDB(B0, 1, 0); PG8_LDB(B1, 1, 1); PG8_SCHED; PG8_LDA(At, 1, 0); PG8_STAGE(PG8_SA(0, 1), a2 + hstep, voffA);
            PG8_WAIT_V(8); PG8_WAIT_L(0); PG8_BAR; PG8_MMA(0, 0, At, B0); PG8_MMA(0, 1, At, B1); PG8_BAR; PG8_SCHED;
            PG8_LDA(At, 1, 1); PG8_STAGE(PG8_SB(1, 0), b3, voffB); PG8_STAGE(PG8_SB(1, 1), b3 + hstep, voffB); PG8_STAGE(PG8_SA(1, 0), a3, voffA);
            PG8_WAIT_V(8); PG8_WAIT_L(0); PG8_BAR; PG8_MMA(1, 0, At, B0); PG8_MMA(1, 1, At, B1); PG8_BAR; PG8_SCHED;
            } else {
            PG8_LDB(B0, 0, 0); PG8_SCHED; PG8_LDA(At, 0, 0); PG8_STAGE(PG8_SA(1, 1), a1 + hstep, voffA);
            PG8_WAIT_L(8); PG8_BAR; PG8_WAIT_L(0); PG8_MMA(0, 0, At, B0); PG8_BAR; PG8_SCHED;
            PG8_LDB(B1, 0, 1); PG8_STAGE(PG8_SB(0, 0), b2, voffB);
            PG8_BAR; PG8_WAIT_L(0); PG8_MMA(0, 1, At, B1); PG8_BAR;
            PG8_LDA(At, 0, 1); PG8_STAGE(PG8_SA(0, 0), a2, voffA);
            PG8_BAR; PG8_WAIT_L(0); PG8_MMA(1, 0, At, B0); PG8_BAR; PG8_SCHED;
            PG8_STAGE(PG8_SB(0, 1), b2 + hstep, voffB);
            PG8_WAIT_V(6); PG8_BAR; PG8_MMA(1, 1, At, B1); PG8_BAR;
            PG8_LDB(B0, 1, 0); PG8_SCHED; PG8_LDA(At, 1, 0); PG8_STAGE(PG8_SA(0, 1), a2 + hstep, voffA);
            PG8_WAIT_L(8); PG8_BAR; PG8_WAIT_L(0); PG8_MMA(0, 0, At, B0); PG8_BAR; PG8_SCHED;
            PG8_LDB(B1, 1, 1); PG8_STAGE(PG8_SB(1, 0), b3, voffB);
            PG8_BAR; PG8_WAIT_L(0); PG8_MMA(0, 1, At, B1); PG8_BAR;
            PG8_LDA(At, 1, 1); PG8_STAGE(PG8_SA(1, 0), a3, voffA);
            PG8_BAR; PG8_WAIT_L(0); PG8_MMA(1, 0, At, B0); PG8_BAR; PG8_SCHED;
            PG8_STAGE(PG8_SB(1, 1), b3 + hstep, voffB);
            PG8_WAIT_V(6); PG8_BAR; PG8_MMA(1, 1, At, B1); PG8_BAR;
            }
        }
        if constexpr (ALIGN_EPI) { if (wr == 0) PG8_BAR; }
        if constexpr (!Epi::AFTER_DRAIN) { E(acc, cur, wr, wc, fr, fq); S.done(cur); }
        if (!has_next) break;
#pragma unroll
        for (int a = 0; a < 2; ++a)
#pragma unroll
            for (int b = 0; b < 2; ++b)
#pragma unroll
                for (int m = 0; m < 4; ++m)
#pragma unroll
                    for (int n = 0; n < 2; ++n) acc[a][b][m][n] = (f32x4){0.f, 0.f, 0.f, 0.f};
        cur = nxt; cA = nA; cB = nB; ++ui;
        if constexpr (ALIGN_EPI) { if (wr == 1) PG8_BAR; }
    }
    PG8_WAIT_V(0);
    if constexpr (!ALIGN_EPI) { if (wr == 0) PG8_BAR; }
    PG8_BAR;
    if constexpr (Epi::AFTER_DRAIN) { E.fused(acc, cur, wr, wc, fr, fq, lds, wid, lane); S.done(cur); }
#undef PG8_SA
#undef PG8_SB
#undef PG8_STAGE
#undef PG8_LDA
#undef PG8_LDB
#undef PG8_MMA
#undef PG8_WAIT_V
#undef PG8_WAIT_L
#undef PG8_BAR
#undef PG8_SCHED
}
}

constexpr int SEQ = 8192, DM = 2048, DFF = 8192, PLE = 256, DEPTH = 4, NHEAD = 16, HD = 128;
constexpr int NWAVES = 8, NTHREADS = 512;
constexpr int LDS_BYTES = 147456;
typedef unsigned short bf16;
typedef unsigned u32x4 __attribute__((ext_vector_type(4)));
typedef unsigned u32x2 __attribute__((ext_vector_type(2)));
typedef float f32x4 __attribute__((ext_vector_type(4)));
typedef float f32x2 __attribute__((ext_vector_type(2)));
typedef short bf16x8 __attribute__((ext_vector_type(8)));
#define LAS __attribute__((address_space(3)))
#define LDS_WAIT() asm volatile("s_waitcnt lgkmcnt(0)" ::: "memory")

constexpr size_t MiB = 1u << 20;
constexpr size_t WS_SS = 880 * MiB;
constexpr size_t WS_BAR = 0;
constexpr size_t WS_AGG = 2 * MiB;
constexpr size_t WS_X0 = 8 * MiB, WS_X1 = 40 * MiB;
constexpr size_t WS_BA = 72 * MiB, WS_BB = 104 * MiB, WS_BC = 136 * MiB, WS_BD = 168 * MiB;
constexpr size_t WS_A1 = 200 * MiB;
constexpr size_t WS_PROJ = 328 * MiB;
constexpr size_t WS_PB = 456 * MiB;
constexpr size_t WS_W1T = 472 * MiB, WS_W2T = 600 * MiB, WS_WGT = 728 * MiB, WS_WPT = 760 * MiB, WS_WINT = 764 * MiB, WS_WORT = 796 * MiB,
                 WS_GAT = 812 * MiB, WS_GXT = 814 * MiB, WS_WQKVT = 816 * MiB, WS_WONT = 864 * MiB, WS_END = 893 * MiB;

struct Args {
    const float* in[22];
    float* out; unsigned char* ws;
    int ph_lo, ph_hi;
};
static_assert(sizeof(Args) == 200 && offsetof(Args, out) == 176 && offsetof(Args, ws) == 184 && offsetof(Args, ph_lo) == 192, "Args layout");

typedef const unsigned char __attribute__((address_space(4)))* KA;
#define INP(k) (*(const float* const __attribute__((address_space(4)))*)(ka + 8 * (k)))
__device__ __forceinline__ int opaque_tid() { int t = threadIdx.x; asm volatile("" : "+v"(t)); return t; }
__device__ __forceinline__ unsigned cvt_pk(float lo, float hi) { return pg8::cvt_pk_bf16(lo, hi); }
__device__ __forceinline__ float bfl(unsigned w) { return __uint_as_float(w << 16); }
__device__ __forceinline__ float bfh(unsigned w) { return __uint_as_float(w & 0xffff0000u); }
__device__ __forceinline__ float wave_sum(float v) {
#pragma unroll
    for (int o = 1; o < 64; o <<= 1) v += __shfl_xor(v, o);
    return v;
}

__device__ __forceinline__ void transpose_item(const float* W, int K, int N, const float* g, bf16* WT, int kb, int nb, int lane) {
    const int q = lane >> 4, ln = lane & 15;
    const int kbase = 64 * kb + 16 * q, n = 64 * nb + 4 * ln;
    f32x4 v[16];
    const float* wp = W + (size_t)kbase * N + n;
#pragma unroll
    for (int i = 0; i < 16; ++i) v[i] = *(const f32x4*)(wp + (size_t)i * N);
    if (g) {
#pragma unroll
        for (int i4 = 0; i4 < 4; ++i4) { const f32x4 gv = *(const f32x4*)(g + kbase + 4 * i4);
#pragma unroll
            for (int e = 0; e < 4; ++e) v[4 * i4 + e] = v[4 * i4 + e] * gv[e]; }
    }
#pragma unroll
    for (int e = 0; e < 4; ++e) {
        bf16* op = WT + (size_t)(n + e) * K + kbase;
#pragma unroll
        for (int h = 0; h < 2; ++h) {
            u32x4 o; o.x = cvt_pk(v[8 * h + 0][e], v[8 * h + 1][e]); o.y = cvt_pk(v[8 * h + 2][e], v[8 * h + 3][e]); o.z = cvt_pk(v[8 * h + 4][e], v[8 * h + 5][e]); o.w = cvt_pk(v[8 * h + 6][e], v[8 * h + 7][e]);
            *(u32x4*)(op + 8 * h) = o;
        }
    }
}

__device__ __forceinline__ void p0_phase(LAS unsigned char* lds, KA ka, unsigned char* ws, int G) {
    const int tid = opaque_tid(), lane = tid & 63, wave = tid >> 6;
    const int gw = blockIdx.x * NWAVES + wave, NGW = G * NWAVES;
    float* ss = (float*)(ws + WS_SS);
    {
        const float* x = INP(0); bf16* X0 = (bf16*)(ws + WS_X0);
        for (int row = gw; row < SEQ; row += NGW) {
            const f32x4* xr = (const f32x4*)(x + (size_t)row * DM) + lane; float s = 0.f;
            u32x2* o = (u32x2*)(X0 + (size_t)row * DM) + lane;
#pragma unroll
            for (int j = 0; j < 8; ++j) { const f32x4 v = xr[64 * j]; s += (v[0] * v[0] + v[1] * v[1]) + (v[2] * v[2] + v[3] * v[3]); u32x2 w; w.x = cvt_pk(v[0], v[1]); w.y = cvt_pk(v[2], v[3]); o[64 * j] = w; }
            s = wave_sum(s);
            if (lane < 32) ss[(size_t)row * 32 + lane] = (lane == 0) ? s : 0.f;
        }
    }
    {
        const f32x4* p = (const f32x4*)INP(1); u32x2* o = (u32x2*)(ws + WS_PB);
        const int n4 = DEPTH * SEQ * PLE / 4;
        for (int i = blockIdx.x * NTHREADS + tid; i < n4; i += G * NTHREADS) { const f32x4 v = p[i]; u32x2 w; w.x = cvt_pk(v[0], v[1]); w.y = cvt_pk(v[2], v[3]); o[i] = w; }
    }
    const int nitems_total =
        4 * (2048 / 64) * (8192 / 64) + 4 * (8192 / 64) * (2048 / 64) + 4 * (2048 / 64) * (2048 / 64) + 4 * (256 / 64) * (2048 / 64) +
        2 * (2048 / 64) * (4096 / 64) + 2 * (2048 / 64) * (2048 / 64) + 64 * (128 / 64) * (128 / 64) + 64 * (128 / 64) * (128 / 64) +
        2 * (2048 / 64) * (6144 / 64) + 2 * (2048 / 64) * (2048 / 64);
    for (int it = gw; it < nitems_total; it += NGW) {
        int r = it;
#define CONV_TRY(Wp, nmat, K, N, gp, gstride, WTp) { const int ipm = ((K) / 64) * ((N) / 64); const int tot = (nmat) * ipm; \
            if (r < tot) { const int mat = r / ipm, rr = r % ipm, kb = rr / ((N) / 64), nb = rr % ((N) / 64); const float* g_ = (gp); \
                transpose_item((Wp) + (size_t)mat * (K) * (N), (K), (N), g_ ? g_ + (size_t)mat * (gstride) : nullptr, (bf16*)(ws + (WTp)) + (size_t)mat * (K) * (N), kb, nb, lane); continue; } r -= tot; }
        CONV_TRY(INP(18), 4, 2048, 8192, INP(3), 2048, WS_W1T)
        CONV_TRY(INP(19), 4, 8192, 2048, (const float*)nullptr, 0, WS_W2T)
        CONV_TRY(INP(20), 4, 2048, 2048, INP(4), 2048, WS_WGT)
        CONV_TRY(INP(21), 4, 256, 2048, (const float*)nullptr, 0, WS_WPT)
        CONV_TRY(INP(6), 2, 2048, 4096, INP(2), 4096, WS_WINT)
        CONV_TRY(INP(14), 2, 2048, 2048, (const float*)nullptr, 0, WS_WORT)
        CONV_TRY(INP(9), 64, 128, 128, (const float*)nullptr, 0, WS_GAT)
        CONV_TRY(INP(11), 64, 128, 128, (const float*)nullptr, 0, WS_GXT)
        CONV_TRY(INP(15), 2, 2048, 6144, INP(2) + 2048, 4096, WS_WQKVT)
        CONV_TRY(INP(17), 2, 2048, 2048, (const float*)nullptr, 0, WS_WONT)
#undef CONV_TRY
    }
}

constexpr int SC_T = 64, SC_NCH = SEQ / SC_T;
constexpr int XCF_STRIDE = 132;
constexpr int XCB_STRIDE = 136;
constexpr int LDS_XCF = 0, LDS_XCB = LDS_XCF + SC_T * XCF_STRIDE * 4, LDS_YGS = LDS_XCB + SC_T * XCB_STRIDE * 2, LDS_SEG = LDS_YGS + SC_T * 128 * 2, LDS_CAR = LDS_SEG + 2 * 128 * 17 * 8, LDS_SC_END = LDS_CAR + 2 * 8 * 128 * 4;
static_assert(LDS_SC_END <= 131072, "scan LDS");

struct ScanArgs {
    const bf16* XR; const bf16* YG; bf16* Y;
    const float* conv_w; const float* conv_b;
    const bf16* gaT; const bf16* gxT;
    const float* ga_b; const float* gx_b; const float* lam;
    f32x2* agg;
};

template <bool FINAL>
__device__ __forceinline__ void scan_phase(LAS unsigned char* lds, const ScanArgs& sa, int G) {
    const int tid = opaque_tid(), lane = tid & 63, w = tid >> 6, fr = lane & 15, fq = lane >> 4;
    LAS float* xcf = (LAS float*)(lds + LDS_XCF);
    LAS bf16* xcb = (LAS bf16*)(lds + LDS_XCB);
    LAS bf16* ygs = (LAS bf16*)(lds + LDS_YGS);
    LAS f32x2* seg = (LAS f32x2*)(lds + LDS_SEG);
    int cur_hd = -1;
    bf16x8 Bf[4][4];
    float ba[2], bx[2], sp8[2];
#pragma unroll
    for (int m = 0; m < 4; ++m)
#pragma unroll
        for (int k = 0; k < 4; ++k) Bf[m][k] = (bf16x8){0, 0, 0, 0, 0, 0, 0, 0};
    ba[0] = ba[1] = bx[0] = bx[1] = sp8[0] = sp8[1] = 0.f;
    LAS float* car = (LAS float*)(lds + LDS_CAR);
    const bool fast = FINAL && (G == 256);
    if (fast) {
        if (tid < 256) {
            const int dir = tid >> 7, c = tid & 127, gch = (blockIdx.x & 15) * 128 + c, cmod = blockIdx.x >> 4;
            const f32x2* ag = sa.agg + (size_t)dir * SC_NCH * DM + gch;
            float h = 0.f;
            if (dir == 0) {
#pragma unroll 8
                for (int cc = 0; cc < SC_NCH; ++cc) { const f32x2 e = ag[(size_t)cc * DM]; if ((cc & 15) == cmod) car[(dir * 8 + (cc >> 4)) * 128 + c] = h; h = e[0] * h + e[1]; }
            } else {
#pragma unroll 8
                for (int cc = SC_NCH - 1; cc >= 0; --cc) { const f32x2 e = ag[(size_t)cc * DM]; if ((cc & 15) == cmod) car[(dir * 8 + (cc >> 4)) * 128 + c] = h; h = e[0] * h + e[1]; }
            }
        }
    }
    for (int it = blockIdx.x; it < SC_NCH * NHEAD; it += G) {
        const int hd = it & 15, chunk = it >> 4, t0 = chunk * SC_T;
        __syncthreads();
        if (hd != cur_hd) {
            cur_hd = hd;
#pragma unroll
            for (int dir = 0; dir < 2; ++dir) {
                const bf16* wa = sa.gaT + ((size_t)(dir * 16 + hd) * 128 + 16 * w + fr) * 128 + 8 * fq;
                const bf16* wx = sa.gxT + ((size_t)(dir * 16 + hd) * 128 + 16 * w + fr) * 128 + 8 * fq;
#pragma unroll
                for (int k = 0; k < 4; ++k) { Bf[dir * 2 + 0][k] = *(const bf16x8*)(wa + 32 * k); Bf[dir * 2 + 1][k] = *(const bf16x8*)(wx + 32 * k); }
                const int gch = hd * 128 + 16 * w + fr;
                ba[dir] = sa.ga_b[dir * DM + gch]; bx[dir] = sa.gx_b[dir * DM + gch];
                sp8[dir] = 8.f * log1pf(expf(-sa.lam[dir * DM + gch]));
            }
        }
        {
            const int cp = tid & 63, tg = tid >> 6;
            const int gc = hd * 128 + 2 * cp;
            float x0[11], x1[11];
#pragma unroll
            for (int q = 0; q < 11; ++q) { const int t = t0 + 8 * tg - 1 + q; unsigned v = 0u; if (t >= 0 && t < SEQ) v = *(const unsigned*)(sa.XR + (size_t)t * DM + gc); x0[q] = bfl(v); x1[q] = bfh(v); }
            float w0[4], w1[4];
#pragma unroll
            for (int k = 0; k < 4; ++k) { const f32x2 wv = *(const f32x2*)(sa.conv_w + k * DM + gc); w0[k] = wv[0]; w1[k] = wv[1]; }
            const f32x2 bv = *(const f32x2*)(sa.conv_b + gc);
#pragma unroll
            for (int q = 0; q < 8; ++q) {
                const float c0 = bv[0] + ((w0[0] * x0[q] + w0[1] * x0[q + 1]) + (w0[2] * x0[q + 2] + w0[3] * x0[q + 3]));
                const float c1 = bv[1] + ((w1[0] * x1[q] + w1[1] * x1[q + 1]) + (w1[2] * x1[q + 2] + w1[3] * x1[q + 3]));
                const int tau = 8 * tg + q;
                *(LAS f32x2*)(xcf + tau * XCF_STRIDE + 2 * cp) = (f32x2){c0, c1};
                *(LAS unsigned*)(xcb + tau * XCB_STRIDE + 2 * cp) = cvt_pk(c0, c1);
            }
            if (FINAL) {
#pragma unroll
                for (int i = 0; i < 2; ++i) { const int idx = tid + i * NTHREADS, row = idx >> 4, c16 = idx & 15;
                    *(LAS u32x4*)(ygs + row * 128 + c16 * 8) = *(const u32x4*)(sa.YG + (size_t)(t0 + row) * DM + hd * 128 + c16 * 8); }
            }
        }
        __syncthreads();
        f32x4 acc[4][4];
#pragma unroll
        for (int m = 0; m < 4; ++m)
#pragma unroll
            for (int mb = 0; mb < 4; ++mb) acc[m][mb] = (f32x4){0.f, 0.f, 0.f, 0.f};
#pragma unroll
        for (int mb = 0; mb < 4; ++mb) {
            bf16x8 Af[4];
#pragma unroll
            for (int k = 0; k < 4; ++k) Af[k] = *(const LAS bf16x8*)(xcb + (16 * mb + fr) * XCB_STRIDE + 32 * k + 8 * fq);
#pragma unroll
            for (int m = 0; m < 4; ++m)
#pragma unroll
                for (int k = 0; k < 4; ++k) acc[m][mb] = __builtin_amdgcn_mfma_f32_16x16x32_bf16(Af[k], Bf[m][k], acc[m][mb], 0, 0, 0);
        }
        const int ch = 16 * w + fr;
#pragma unroll
        for (int mb = 0; mb < 4; ++mb) {
            float xv[4];
#pragma unroll
            for (int j = 0; j < 4; ++j) xv[j] = xcf[(16 * mb + 4 * fq + j) * XCF_STRIDE + ch];
#pragma unroll
            for (int dir = 0; dir < 2; ++dir) {
#pragma unroll
                for (int j = 0; j < 4; ++j) {
                    const float r = pg8::fsigmoid(acc[2 * dir][mb][j] + ba[dir]);
                    const float ig = pg8::fsigmoid(acc[2 * dir + 1][mb][j] + bx[dir]);
                    const float la = -sp8[dir] * r;
                    const float av = __expf(la);
                    const float x2 = 2.f * la;
                    const float om = (x2 > -0.04f) ? -x2 * (1.f + x2 * (0.5f + x2 * (0.16666667f + x2 * 0.041666668f))) : 1.f - av * av;
                    acc[2 * dir][mb][j] = av;
                    acc[2 * dir + 1][mb][j] = sqrtf(om) * ig * xv[j];
                }
                const f32x4 A = acc[2 * dir][mb], U = acc[2 * dir + 1][mb];
                float P, Q;
                if (dir == 0) { P = (A[0] * A[1]) * (A[2] * A[3]); Q = ((U[0] * A[1] + U[1]) * A[2] + U[2]) * A[3] + U[3]; }
                else          { P = (A[0] * A[1]) * (A[2] * A[3]); Q = ((U[3] * A[2] + U[2]) * A[1] + U[1]) * A[0] + U[0]; }
                seg[(dir * 128 + ch) * 17 + mb * 4 + fq] = (f32x2){P, Q};
            }
        }
        __syncthreads();
        if (tid < 256) {
            const int dir = tid >> 7, c = tid & 127, gch = hd * 128 + c;
            LAS f32x2* sg = seg + (dir * 128 + c) * 17;
            if (!FINAL) {
                float h = 0.f, Pt = 1.f;
                if (dir == 0) { for (int s = 0; s < 16; ++s) { const f32x2 e = sg[s]; h = e[0] * h + e[1]; Pt *= e[0]; } }
                else          { for (int s = 15; s >= 0; --s) { const f32x2 e = sg[s]; h = e[0] * h + e[1]; Pt *= e[0]; } }
                sa.agg[((size_t)dir * SC_NCH + chunk) * DM + gch] = (f32x2){Pt, h};
            } else {
                float h = 0.f;
                if (fast) h = car[(dir * 8 + (chunk >> 4)) * 128 + c];
                else {
                    const f32x2* ag = sa.agg + (size_t)dir * SC_NCH * DM + gch;
                    if (dir == 0) { for (int cc = 0; cc < chunk; ++cc) { const f32x2 e = ag[(size_t)cc * DM]; h = e[0] * h + e[1]; } }
                    else          { for (int cc = SC_NCH - 1; cc > chunk; --cc) { const f32x2 e = ag[(size_t)cc * DM]; h = e[0] * h + e[1]; } }
                }
                if (dir == 0) { for (int s = 0; s < 16; ++s) { const f32x2 e = sg[s]; sg[s] = (f32x2){h, 0.f}; h = e[0] * h + e[1]; } }
                else          { for (int s = 15; s >= 0; --s) { const f32x2 e = sg[s]; sg[s] = (f32x2){h, 0.f}; h = e[0] * h + e[1]; } }
            }
        }
        if (FINAL) {
            __syncthreads();
#pragma unroll
            for (int mb = 0; mb < 4; ++mb) {
                float hs[4];
                { float h = seg[(0 * 128 + ch) * 17 + mb * 4 + fq][0]; const f32x4 A = acc[0][mb], U = acc[1][mb];
#pragma unroll
                  for (int j = 0; j < 4; ++j) { h = A[j] * h + U[j]; hs[j] = h; } }
                { float h = seg[(1 * 128 + ch) * 17 + mb * 4 + fq][0]; const f32x4 A = acc[2][mb], U = acc[3][mb];
#pragma unroll
                  for (int j = 3; j >= 0; --j) { h = A[j] * h + U[j]; hs[j] += h; } }
#pragma unroll
                for (int j = 0; j < 4; ++j) {
                    LAS bf16* yp = ygs + (16 * mb + 4 * fq + j) * 128 + ch;
                    const float yg = __uint_as_float((unsigned)(*yp) << 16);
                    *yp = (bf16)(cvt_pk(hs[j] * yg, 0.f) & 0xffffu);
                }
            }
            __syncthreads();
#pragma unroll
            for (int i = 0; i < 2; ++i) { const int idx = tid + i * NTHREADS, row = idx >> 4, c16 = idx & 15;
                *(u32x4*)(sa.Y + (size_t)(t0 + row) * DM + hd * 128 + c16 * 8) = *(const LAS u32x4*)(ygs + row * 128 + c16 * 8); }
        }
    }
}

struct AttArgs { const bf16* Q; const bf16* K; const bf16* VT; bf16* O; const float* rpb; };

__device__ __forceinline__ void attn_phase(LAS unsigned char* lds, const AttArgs& aa, int G) {
    const int tid = opaque_tid(), lane = tid & 63, w = tid >> 6, fr = lane & 15, fq = lane >> 4;
    const int hsel = w >> 2, qg = w & 3;
    LAS float* rp = (LAS float*)lds;
    const int c0 = 16 * qg, kb0 = (qg == 0) ? 0 : (qg == 1) ? 8 : (qg == 2) ? 24 : 32;
    const int qc = c0 + fr;
    const int cs = min(max(qc - 8, 0), 48);
    for (int id = blockIdx.x; id < 128 * 8; id += G) {
        const int hp = id & 7, r = id >> 3, h = hp * 2 + hsel;
        const int rs = min(max(r - 4, 0), 120);
        __syncthreads();
        for (int i = tid; i < 2 * 465; i += NTHREADS) { const int hh = i / 465, e = i % 465; rp[hh * 480 + e] = aa.rpb[(size_t)(hp * 2 + hh) * 465 + e]; }
        __syncthreads();
        bf16x8 qf[4];
        { const bf16* qp = aa.Q + (size_t)(r * 64 + qc) * DM + h * 128 + 8 * fq;
#pragma unroll
          for (int k = 0; k < 4; ++k) qf[k] = *(const bf16x8*)(qp + 32 * k); }
        f32x4 s[8][2];
        const int krow = 8 * (fr >> 2) + (fr & 3);
#pragma unroll
        for (int i = 0; i < 8; ++i)
#pragma unroll
            for (int nb = 0; nb < 2; ++nb) {
                const bf16* kp = aa.K + (size_t)((rs + i) * 64 + kb0 + krow + 4 * nb) * DM + h * 128 + 8 * fq;
                f32x4 c = (f32x4){0.f, 0.f, 0.f, 0.f};
#pragma unroll
                for (int k = 0; k < 4; ++k) { const bf16x8 kf = *(const bf16x8*)(kp + 32 * k); c = __builtin_amdgcn_mfma_f32_16x16x32_bf16(kf, qf[k], c, 0, 0, 0); }
                s[i][nb] = c;
            }
        float mx = -INFINITY;
        const LAS float* rph = rp + hsel * 480;
#pragma unroll
        for (int i = 0; i < 8; ++i) {
            const int relr = rs + i - r + 7;
#pragma unroll
            for (int nb = 0; nb < 2; ++nb)
#pragma unroll
                for (int j = 0; j < 4; ++j) {
                    const int kc = kb0 + 8 * fq + 4 * nb + j;
                    const bool valid = (unsigned)(kc - cs) < 16u;
                    const int idx = valid ? relr * 31 + (kc - qc + 15) : 0;
                    const float v = valid ? s[i][nb][j] + rph[idx] : -INFINITY;
                    s[i][nb][j] = v; mx = fmaxf(mx, v);
                }
        }
        mx = fmaxf(mx, __shfl_xor(mx, 16)); mx = fmaxf(mx, __shfl_xor(mx, 32));
        float l = 0.f;
#pragma unroll
        for (int i = 0; i < 8; ++i)
#pragma unroll
            for (int nb = 0; nb < 2; ++nb)
#pragma unroll
                for (int j = 0; j < 4; ++j) { const float p = __expf(s[i][nb][j] - mx); s[i][nb][j] = p; l += p; }
        l += __shfl_xor(l, 16); l += __shfl_xor(l, 32);
        f32x4 o[8];
#pragma unroll
        for (int db = 0; db < 8; ++db) o[db] = (f32x4){0.f, 0.f, 0.f, 0.f};
#pragma unroll
        for (int i = 0; i < 8; ++i) {
            u32x4 pw; pw.x = cvt_pk(s[i][0][0], s[i][0][1]); pw.y = cvt_pk(s[i][0][2], s[i][0][3]); pw.z = cvt_pk(s[i][1][0], s[i][1][1]); pw.w = cvt_pk(s[i][1][2], s[i][1][3]);
            const bf16x8 pb = __builtin_bit_cast(bf16x8, pw);
            const bf16* vp = aa.VT + (size_t)(h * 128 + fr) * SEQ + (rs + i) * 64 + kb0 + 8 * fq;
#pragma unroll
            for (int db = 0; db < 8; ++db) { const bf16x8 vf = *(const bf16x8*)(vp + (size_t)(16 * db) * SEQ); o[db] = __builtin_amdgcn_mfma_f32_16x16x32_bf16(vf, pb, o[db], 0, 0, 0); }
        }
        const float inv = 1.f / l;
        bf16* op = aa.O + (size_t)(r * 64 + qc) * DM + h * 128 + 4 * fq;
#pragma unroll
        for (int db = 0; db < 8; ++db) { u32x2 wv; wv.x = cvt_pk(o[db][0] * inv, o[db][1] * inv); wv.y = cvt_pk(o[db][2] * inv, o[db][3] * inv); *(u32x2*)(op + 16 * db) = wv; }
    }
}

#define ATT_BAR() do { asm volatile("s_waitcnt lgkmcnt(0)" ::: "memory"); __builtin_amdgcn_s_barrier(); asm volatile("" ::: "memory"); } while (0)
constexpr int KS_PITCH = 136, VS_PITCH = 72;
constexpr int ATT_KS = 0, ATT_VS = ATT_KS + 2 * 64 * KS_PITCH * 2, ATT_RP = ATT_VS + 2 * 128 * VS_PITCH * 2, ATT_END = ATT_RP + 2048;
static_assert(ATT_END <= 131072, "attention LDS");
__device__ __forceinline__ void attn_phase2(LAS unsigned char* lds, const AttArgs& aa, int G) {
    const int tid = opaque_tid(), lane = tid & 63, w = tid >> 6, fr = lane & 15, fq = lane >> 4;
    const int rsel = w >> 2, qg = w & 3;
    LAS bf16* KS = (LAS bf16*)(lds + ATT_KS);
    LAS bf16* VS = (LAS bf16*)(lds + ATT_VS);
    LAS float* rp = (LAS float*)(lds + ATT_RP);
    const int c0 = 16 * qg, kb0 = (qg == 0) ? 0 : (qg == 1) ? 8 : (qg == 2) ? 24 : 32;
    const int qc = c0 + fr;
    const int cs = min(max(qc - 8, 0), 48);
    const int krow = 8 * (fr >> 2) + (fr & 3);
    const int ktok0 = tid >> 4, kpart = tid & 15, vd0 = tid >> 3, vpart = tid & 7;
    for (int id = blockIdx.x; id < 64 * NHEAD; id += G) {
        const int h = id & 15, rpair = id >> 4, r0 = 2 * rpair;
        const int rsA = min(max(r0 - 4, 0), 120), rsB = min(max(r0 - 3, 0), 120), off = rsB - rsA, nJ = 8 + off;
        const int r = r0 + rsel, rs = rsel ? rsB : rsA, woff = rsel ? off : 0;
        u32x4 R[9][2];
#pragma unroll
        for (int jj = 0; jj < 9; ++jj) { R[jj][0] = (u32x4){0u, 0u, 0u, 0u}; R[jj][1] = (u32x4){0u, 0u, 0u, 0u}; }
        const bf16* kbase = aa.K + (size_t)(rsA * 64 + ktok0) * DM + h * 128 + kpart * 8;
        const bf16* vbase = aa.VT + (size_t)(h * 128 + vd0) * SEQ + rsA * 64 + vpart * 8;
#pragma unroll
        for (int jj = 0; jj < 9; ++jj) if (jj < nJ) {
#pragma unroll
            for (int u = 0; u < 2; ++u) R[jj][u] = *(const u32x4*)(kbase + (size_t)(jj * 64 + 32 * u) * DM);
        }
        for (int i = tid; i < 465; i += NTHREADS) rp[i] = aa.rpb[(size_t)h * 465 + i];
        bf16x8 qf[4];
        { const bf16* qp = aa.Q + (size_t)(r * 64 + qc) * DM + h * 128 + 8 * fq;
#pragma unroll
          for (int k = 0; k < 4; ++k) qf[k] = *(const bf16x8*)(qp + 32 * k); }
#define ATT_KWRITE(j, b) do { _Pragma("unroll") for (int u = 0; u < 2; ++u) *(LAS u32x4*)(KS + (b) * 64 * KS_PITCH + (ktok0 + 32 * u) * KS_PITCH + kpart * 8) = R[j][u]; } while (0)
#define ATT_VLOAD(j) do { _Pragma("unroll") for (int u = 0; u < 2; ++u) R[j][u] = *(const u32x4*)(vbase + (size_t)(64 * u) * SEQ + (j) * 64); } while (0)
#define ATT_VWRITE(j, b) do { _Pragma("unroll") for (int u = 0; u < 2; ++u) *(LAS u32x4*)(VS + (b) * 128 * VS_PITCH + (vd0 + 64 * u) * VS_PITCH + vpart * 8) = R[j][u]; } while (0)
#define ATT_QK(i, b) do { _Pragma("unroll") for (int nb = 0; nb < 2; ++nb) { f32x4 c_ = (f32x4){0.f, 0.f, 0.f, 0.f}; \
            _Pragma("unroll") for (int k = 0; k < 4; ++k) { const bf16x8 kf = *(const LAS bf16x8*)(KS + (b) * 64 * KS_PITCH + (kb0 + krow + 4 * nb) * KS_PITCH + 32 * k + 8 * fq); \
                c_ = __builtin_amdgcn_mfma_f32_16x16x32_bf16(kf, qf[k], c_, 0, 0, 0); } s[i][nb] = c_; } } while (0)
#define ATT_PV(i, b) do { u32x4 pw; pw.x = cvt_pk(s[i][0][0], s[i][0][1]); pw.y = cvt_pk(s[i][0][2], s[i][0][3]); pw.z = cvt_pk(s[i][1][0], s[i][1][1]); pw.w = cvt_pk(s[i][1][2], s[i][1][3]); \
            const bf16x8 pb = __builtin_bit_cast(bf16x8, pw); \
            _Pragma("unroll") for (int db = 0; db < 8; ++db) { const bf16x8 vf = *(const LAS bf16x8*)(VS + (b) * 128 * VS_PITCH + (16 * db + fr) * VS_PITCH + kb0 + 8 * fq); \
                o[db] = __builtin_amdgcn_mfma_f32_16x16x32_bf16(vf, pb, o[db], 0, 0, 0); } } while (0)
        f32x4 s[8][2];
        ATT_KWRITE(0, 0); ATT_VLOAD(0);
        ATT_BAR();
#pragma unroll
        for (int jj = 0; jj < 9; ++jj) {
            if (jj + 1 < 9) { if (jj + 1 < nJ) { ATT_KWRITE((jj + 1 < 9 ? jj + 1 : 8), ((jj + 1) & 1)); ATT_VLOAD((jj + 1 < 9 ? jj + 1 : 8)); } }
            if (woff == 0) { if (jj < 8) ATT_QK((jj < 8 ? jj : 7), (jj & 1)); }
            else           { if (jj >= 1) ATT_QK((jj >= 1 ? jj - 1 : 0), (jj & 1)); }
            ATT_BAR();
        }
        float mx = -INFINITY;
#pragma unroll
        for (int i = 0; i < 8; ++i) {
            const int relr = rs + i - r + 7;
#pragma unroll
            for (int nb = 0; nb < 2; ++nb)
#pragma unroll
                for (int j = 0; j < 4; ++j) {
                    const int kc = kb0 + 8 * fq + 4 * nb + j;
                    const bool valid = (unsigned)(kc - cs) < 16u;
                    const int idx = valid ? relr * 31 + (kc - qc + 15) : 0;
                    const float v = valid ? s[i][nb][j] + rp[idx] : -INFINITY;
                    s[i][nb][j] = v; mx = fmaxf(mx, v);
                }
        }
        mx = fmaxf(mx, __shfl_xor(mx, 16)); mx = fmaxf(mx, __shfl_xor(mx, 32));
        float l = 0.f;
#pragma unroll
        for (int i = 0; i < 8; ++i)
#pragma unroll
            for (int nb = 0; nb < 2; ++nb)
#pragma unroll
                for (int j = 0; j < 4; ++j) { const float p = __expf(s[i][nb][j] - mx); s[i][nb][j] = p; l += p; }
        l += __shfl_xor(l, 16); l += __shfl_xor(l, 32);
        f32x4 o[8];
#pragma unroll
        for (int db = 0; db < 8; ++db) o[db] = (f32x4){0.f, 0.f, 0.f, 0.f};
        ATT_VWRITE(0, 0);
        ATT_BAR();
#pragma unroll
        for (int jj = 0; jj < 9; ++jj) {
            if (jj + 1 < 9) { if (jj + 1 < nJ) ATT_VWRITE((jj + 1 < 9 ? jj + 1 : 8), ((jj + 1) & 1)); }
            if (woff == 0) { if (jj < 8) ATT_PV((jj < 8 ? jj : 7), (jj & 1)); }
            else           { if (jj >= 1) ATT_PV((jj >= 1 ? jj - 1 : 0), (jj & 1)); }
            ATT_BAR();
        }
        const float inv = 1.f / l;
        bf16* op = aa.O + (size_t)(r * 64 + qc) * DM + h * 128 + 4 * fq;
#pragma unroll
        for (int db = 0; db < 8; ++db) { u32x2 wv; wv.x = cvt_pk(o[db][0] * inv, o[db][1] * inv); wv.y = cvt_pk(o[db][2] * inv, o[db][3] * inv); *(u32x2*)(op + 16 * db) = wv; }
#undef ATT_KWRITE
#undef ATT_VLOAD
#undef ATT_VWRITE
#undef ATT_QK
#undef ATT_PV
    }
}

__device__ __forceinline__ void final_phase(float* out, const float* ss, const float* g, int G) {
    const int tid = opaque_tid(), lane = tid & 63, wave = tid >> 6;
    const int gw = blockIdx.x * NWAVES + wave, NGW = G * NWAVES;
    for (int row = gw; row < SEQ; row += NGW) {
        const float rs = pg8::rstd_row(ss, row);
        f32x4* o = (f32x4*)(out + (size_t)row * DM) + lane; const f32x4* gp = (const f32x4*)g + lane;
#pragma unroll
        for (int j = 0; j < 8; ++j) { f32x4 v = o[64 * j]; const f32x4 gv = gp[64 * j]; v = v * rs * gv; o[64 * j] = v; }
    }
}

#define XB_TMO      128
#define XB_XCNT(j)  (256  + 64 * (j))
#define XB_XSUB(j)  (1280 + 64 * (j))
#define XB_XGEN(j)  (2304 + 64 * (j))
#define XB_TOP      3328
#define XB_TOPGEN   3392
#define XCD_BAR_WORDS 3456
#define XB_SPIN_CAP (1u << 18)

__device__ __forceinline__ unsigned xb_ld(unsigned* p)              { return __hip_atomic_load(p, __ATOMIC_RELAXED, __HIP_MEMORY_SCOPE_AGENT); }
__device__ __forceinline__ unsigned xb_add(unsigned* p, unsigned v) { return __hip_atomic_fetch_add(p, v, __ATOMIC_RELAXED, __HIP_MEMORY_SCOPE_AGENT); }
__device__ __forceinline__ unsigned xb_xcc_id() { return (unsigned)__builtin_amdgcn_s_getreg((3 << 11) | 20) & 0xFu; }
#define XB_SPIN(cond, bar) do { unsigned _sp = 0; while (cond) { __builtin_amdgcn_s_sleep(1); \
    if ((++_sp & 255u) == 0u) { if (xb_ld(&(bar)[XB_TMO])) break; if (_sp > XB_SPIN_CAP) { atomicAdd(&(bar)[XB_TMO], 1u); break; } } } } while (0)

struct XcdBarrier {
    unsigned* bar; unsigned x;
    volatile LAS unsigned* st;
};

__device__ __forceinline__ XcdBarrier xcd_barrier_post(unsigned* bar, volatile LAS unsigned* st) {
    XcdBarrier b; b.bar = bar; b.x = xb_xcc_id(); b.st = st;
    if (threadIdx.x == 0) (void)xb_add(&bar[XB_XCNT(b.x)], 1u);
    return b;
}
__device__ __forceinline__ void xcd_barrier_complete(unsigned* bar, unsigned x, unsigned& nloc, unsigned& nx) {
    const unsigned G = gridDim.x * gridDim.y * gridDim.z;
    unsigned sum, cnt, mine, sp = 0u;
    for (;;) {
        sum = 0u; cnt = 0u; mine = 0u;
#pragma unroll
        for (unsigned j = 0; j < 16; ++j) { const unsigned c = xb_ld(&bar[XB_XCNT(j)]); sum += c; cnt += (c > 0u) ? 1u : 0u; mine = (j == x) ? c : mine; }
        if (sum == G) break;
        __builtin_amdgcn_s_sleep(1);
        if ((++sp & 255u) == 0u) { if (xb_ld(&bar[XB_TMO])) break; if (sp > XB_SPIN_CAP) { atomicAdd(&bar[XB_TMO], 1u); break; } }
    }
    nloc = mine > 0u ? mine : 1u; nx = cnt > 0u ? cnt : 1u;
}

__device__ __forceinline__ void xcd_barrier(const XcdBarrier& b) {
    asm volatile("s_waitcnt vmcnt(0)" ::: "memory");
    __syncthreads();
    if (threadIdx.x == 0) {
        unsigned* bar = b.bar;
        __builtin_amdgcn_s_waitcnt(0);
        unsigned nloc = b.st[0], nx = b.st[1];
        if (nloc == 0u) { xcd_barrier_complete(bar, b.x, nloc, nx); b.st[0] = nloc; b.st[1] = nx; }
        const unsigned old = xb_add(&bar[XB_XSUB(b.x)], 1u);
        const unsigned gen = old / nloc;
        if (old + 1u == (gen + 1u) * nloc) {
            __builtin_amdgcn_fence(__ATOMIC_RELEASE, "agent");
            asm volatile("s_waitcnt vmcnt(0)" ::: "memory");
            const unsigned og = xb_add(&bar[XB_TOP], 1u);
            const unsigned tg = og / nx;
            if (og + 1u == (tg + 1u) * nx) xb_add(&bar[XB_TOPGEN], 1u);
            else XB_SPIN(xb_ld(&bar[XB_TOPGEN]) == tg, bar);
            __builtin_amdgcn_fence(__ATOMIC_ACQUIRE, "agent");
            xb_add(&bar[XB_XGEN(b.x)], 1u);
            asm volatile("s_waitcnt vmcnt(0)" ::: "memory");
        } else {
            XB_SPIN(xb_ld(&bar[XB_XGEN(b.x)]) == gen, bar);
            __builtin_amdgcn_fence(__ATOMIC_ACQUIRE, "agent");
            asm volatile("s_waitcnt vmcnt(0)" ::: "memory");
        }
    }
    __syncthreads();
}

constexpr int LDS_TAB = 131072 + 1024;
__device__ __forceinline__ void fill_rstd_tab(LAS unsigned char* lds, const float* ssp, int t) {
    LAS float* tab = (LAS float*)(lds + LDS_TAB);
    const int tid = opaque_tid();
    if (tid < 256) tab[tid] = pg8::rstd_row(ssp, t * 256 + tid);
    __syncthreads();
}
constexpr int N_PHASES = 28;
#ifndef PGA
#define PGA true
#endif
#ifndef PGA1
#define PGA1 true
#endif
#ifndef PGS
#define PGS true
#endif
#ifndef DBG_DUMP_OFF
#define DBG_DUMP_OFF WS_BC
#endif
#ifndef DBG_NPH
#define DBG_NPH N_PHASES
#endif
#ifndef DBG_DUMP
#define DBG_DUMP 0
#endif
enum Kind { K_P0, K_WIN, K_S1, K_S2, K_WOUT, K_QKV, K_ATT, K_W1, K_W2, K_PLE, K_FINAL, K_DUMP };

__global__ void __launch_bounds__(NTHREADS, 2) mega_fwd(Args args) {
    extern __shared__ __attribute__((aligned(16))) unsigned char lds_raw[];
    LAS unsigned char* lds = (LAS unsigned char*)lds_raw;
    cg::grid_group grid = cg::this_grid();
    const int G = gridDim.x;
    KA ka0 = (KA)__builtin_amdgcn_kernarg_segment_ptr();
    const int lo = *(const int __attribute__((address_space(4)))*)(ka0 + 192), hi = *(const int __attribute__((address_space(4)))*)(ka0 + 196);
    if (hi - lo > 1) {
        volatile LAS unsigned* st = (volatile LAS unsigned*)(lds + 131072 + 64);
        if (threadIdx.x < 2) st[threadIdx.x] = 0u;
        __syncthreads();
        unsigned char* ws0 = *(unsigned char* const __attribute__((address_space(4)))*)(ka0 + 184);
        (void)xcd_barrier_post((unsigned*)(ws0 + WS_BAR), st);
    }
    if (hi > 100000) grid.sync();
    for (int ph = lo; ph < hi; ++ph) {
        KA ka = ka0; asm volatile("" : "+s"(ka));
        unsigned char* ws = *(unsigned char* const __attribute__((address_space(4)))*)(ka + 184);
        float* hout = *(float* const __attribute__((address_space(4)))*)(ka + 176);
        float* ss = (float*)(ws + WS_SS);
        int kind, L = 0;
        if (ph == 0) kind = K_P0; else if (ph == 99) kind = K_DUMP; else if (ph == N_PHASES - 1) kind = K_FINAL;
        else { int q = ph - 1; const int pair = q / 13; q -= pair * 13; L = 2 * pair;
            if (q < 7) { kind = (q == 0) ? K_WIN : (q == 1) ? K_S1 : (q == 2) ? K_S2 : (q == 3) ? K_WOUT : (q == 4) ? K_W1 : (q == 5) ? K_W2 : K_PLE; }
            else { q -= 7; L += 1; kind = (q == 0) ? K_QKV : (q == 1) ? K_ATT : (q == 2) ? K_WOUT : (q == 3) ? K_W1 : (q == 4) ? K_W2 : K_PLE; } }
        const int j = L >> 1;
        bf16* Xc = (bf16*)(ws + ((L & 1) ? WS_X1 : WS_X0));
        bf16* Xo = (bf16*)(ws + ((L & 1) ? WS_X0 : WS_X1));
        const float* ss_mix = ss + (size_t)(3 * L) * SEQ * 32; float* ss_mlp = ss + (size_t)(3 * L + 1) * SEQ * 32; float* ss_ple = ss + (size_t)(3 * L + 2) * SEQ * 32; float* ss_next = ss + (size_t)(3 * L + 3) * SEQ * 32;
        switch (kind) {
        case K_P0:
#ifndef DIS_P0
 p0_phase(lds, ka, ws, G);
#endif
 break;
        case K_WIN: {
#ifdef DBG_BJ0
            pg8::Gemm g{Xc, (const bf16*)(ws + WS_WINT), SEQ, 2 * DM, DM};
#elif defined(DBG_AX1)
            pg8::Gemm g{(L == 2) ? Xo : Xc, (const bf16*)(ws + WS_WINT) + (size_t)j * DM * 2 * DM, SEQ, 2 * DM, DM};
#else
            pg8::Gemm g{Xc, (const bf16*)(ws + WS_WINT) + (size_t)j * DM * 2 * DM, SEQ, 2 * DM, DM};
#endif
            pg8::StaticOrder S; S.init(SEQ, 2 * DM, G, (int)blockIdx.x);
#ifdef DBG_FRESHOUT

#elif defined(DBG_SS0)

#else
            pg8::Unit u0; S.next(0, u0); fill_rstd_tab(lds, ss_mix, u0.pm);
            pg8::EpiAct<0> E{(bf16*)(ws + WS_BA), (bf16*)(ws + WS_BB), DM, DM, ss_mix, (const LAS float*)(lds + LDS_TAB), u0.pm};
#endif
#ifndef DIS_ACT0
            pg8::gemm_phase<pg8::EpiAct<0>, pg8::StaticOrder, PGA, PGS>(lds, g, S, E);
#endif
        } break;
        case K_S1: case K_S2: {
            ScanArgs sa{(const bf16*)(ws + WS_BA), (const bf16*)(ws + WS_BB), (bf16*)(ws + WS_BC),
                        INP(7) + (size_t)j * 4 * DM, INP(8) + (size_t)j * DM,
                        (const bf16*)(ws + WS_GAT) + (size_t)j * 32 * 128 * 128, (const bf16*)(ws + WS_GXT) + (size_t)j * 32 * 128 * 128,
                        INP(10) + (size_t)j * 2 * DM, INP(12) + (size_t)j * 2 * DM, INP(13) + (size_t)j * 2 * DM,
                        (f32x2*)(ws + WS_AGG)};
            #ifndef DIS_SCAN
            if (kind == K_S1) scan_phase<false>(lds, sa, G); else scan_phase<true>(lds, sa, G);
#endif
        } break;
        case K_QKV: {
            {
                pg8::Gemm g{Xc, (const bf16*)(ws + WS_WQKVT) + (size_t)j * 3 * DM * DM, SEQ, 2 * DM, DM};
                pg8::StaticOrder S; S.init(SEQ, 2 * DM, G, (int)blockIdx.x);
                pg8::Unit u0; S.next(0, u0); fill_rstd_tab(lds, ss_mix, u0.pm);
                pg8::EpiAct<1> E{(bf16*)(ws + WS_BA), (bf16*)(ws + WS_BB), DM, DM, ss_mix, (const LAS float*)(lds + LDS_TAB), u0.pm};
#ifndef DIS_ACT1
                pg8::gemm_phase<pg8::EpiAct<1>, pg8::StaticOrder, PGA, PGS>(lds, g, S, E);
#endif
            }
            __syncthreads();
            {
                pg8::Gemm g{(const bf16*)(ws + WS_WQKVT) + (size_t)j * 3 * DM * DM + (size_t)2 * DM * DM, Xc, DM, SEQ, DM};
                pg8::StaticOrder S; S.init(DM, SEQ, G, (int)blockIdx.x);
                pg8::Unit u0; S.next(0, u0); fill_rstd_tab(lds, ss_mix, u0.pn);
                pg8::EpiAct<4> E{(bf16*)(ws + WS_BD), nullptr, SEQ, 0, ss_mix, (const LAS float*)(lds + LDS_TAB), u0.pn};
#ifndef DIS_ACT4
                pg8::gemm_phase<pg8::EpiAct<4>, pg8::StaticOrder, PGA1, PGS>(lds, g, S, E);
#endif
            }
        } break;
        case K_ATT: {
            AttArgs aa{(const bf16*)(ws + WS_BA), (const bf16*)(ws + WS_BB), (const bf16*)(ws + WS_BD), (bf16*)(ws + WS_BC), INP(16) + (size_t)j * NHEAD * 465};
#ifndef DIS_ATT
#ifdef ATT_V1
            attn_phase(lds, aa, G);
#else
            attn_phase2(lds, aa, G);
#endif
#endif
        } break;
        case K_WOUT: case K_W2: {
            const bf16* A; const bf16* Bt; int K;
            float* sso; bf16* hb;
            if (kind == K_WOUT) { A = (const bf16*)(ws + WS_BC); K = DM; Bt = (L & 1) ? (const bf16*)(ws + WS_WONT) + (size_t)j * DM * DM : (const bf16*)(ws + WS_WORT) + (size_t)j * DM * DM; sso = ss_mlp; hb = Xo; }
            else { A = (const bf16*)(ws + WS_A1); K = DFF; Bt = (const bf16*)(ws + WS_W2T) + (size_t)L * DM * DFF; sso = ss_ple; hb = Xc; }
            const float* base = (kind == K_WOUT && L == 0) ? INP(0) : hout;
            pg8::Gemm g{A, Bt, SEQ, DM, K};
            pg8::StaticOrder S; S.init(SEQ, DM, G, (int)blockIdx.x);
            pg8::EpiRes<0> E{base, hout, hb, sso, nullptr, nullptr, (const LAS float*)(lds + LDS_TAB), -1};
#ifndef DIS_RES0
            pg8::gemm_phase<pg8::EpiRes<0>, pg8::StaticOrder, PGA1, PGS>(lds, g, S, E);
#endif
        } break;
        case K_W1: {
            {
                int Kp = PLE; asm volatile("" : "+s"(Kp));
                pg8::Gemm g{(const bf16*)(ws + WS_PB) + (size_t)L * SEQ * PLE, (const bf16*)(ws + WS_WPT) + (size_t)L * DM * PLE, SEQ, DM, Kp};
                pg8::StaticOrder S; S.init(SEQ, DM, G, (int)blockIdx.x);
                pg8::EpiAct<3> E{(bf16*)(ws + WS_PROJ) + (size_t)L * SEQ * DM, nullptr, DM, 0, nullptr, (const LAS float*)(lds + LDS_TAB), -1};
#ifndef DIS_ACT3
                pg8::gemm_phase<pg8::EpiAct<3>, pg8::StaticOrder, PGA1, PGS>(lds, g, S, E);
#endif
            }
            __syncthreads();
            pg8::Gemm g{Xo, (const bf16*)(ws + WS_W1T) + (size_t)L * DM * DFF, SEQ, DFF, DM};
            pg8::StaticOrder S; S.init(SEQ, DFF, G, (int)blockIdx.x);
            pg8::Unit u0; S.next(0, u0); fill_rstd_tab(lds, ss_mlp, u0.pm);
            pg8::EpiAct<2> E{(bf16*)(ws + WS_A1), nullptr, DFF, 0, ss_mlp, (const LAS float*)(lds + LDS_TAB), u0.pm};
#ifndef DIS_ACT2
            pg8::gemm_phase<pg8::EpiAct<2>, pg8::StaticOrder, PGA, PGS>(lds, g, S, E);
#endif
        } break;
        case K_PLE: {
            pg8::Gemm g{Xc, (const bf16*)(ws + WS_WGT) + (size_t)L * DM * DM, SEQ, DM, DM};
            pg8::StaticOrder S; S.init(SEQ, DM, G, (int)blockIdx.x);
            pg8::Unit u0; S.next(0, u0); fill_rstd_tab(lds, ss_ple, u0.pm);
            pg8::EpiRes<1> E{hout, hout, Xo, ss_next, ss_ple, (const bf16*)(ws + WS_PROJ) + (size_t)L * SEQ * DM, (const LAS float*)(lds + LDS_TAB), u0.pm};
#ifndef DIS_RES1
            pg8::gemm_phase<pg8::EpiRes<1>, pg8::StaticOrder, PGA1, PGS>(lds, g, S, E);
#endif
        } break;
#if DBG_DUMP
        case K_DUMP: {
            const bf16* src = (const bf16*)(ws + DBG_DUMP_OFF); const float* srcf = (const float*)(ws + DBG_DUMP_OFF);
            for (size_t i = (size_t)blockIdx.x * NTHREADS + threadIdx.x; i < (size_t)SEQ * DM; i += (size_t)G * NTHREADS) hout[i] = (DBG_DUMP == 2) ? srcf[i & 8191] : bfl((unsigned)src[i]);
        } break;
#endif
        case K_FINAL: final_phase(hout, ss + (size_t)12 * SEQ * 32, INP(5), G); break;
        }
        if (ph + 1 < hi) { XcdBarrier b; b.bar = (unsigned*)(ws + WS_BAR); b.x = xb_xcc_id(); b.st = (volatile LAS unsigned*)(lds + 131072 + 64); xcd_barrier(b); }
    }
}

#ifndef MK_MULTI
#define MK_MULTI 0
#endif

extern "C" void kernel_launch(void* const* d_in, const int* in_sizes, int n_in, void* d_out, int out_size, void* d_ws, size_t ws_size, hipStream_t stream) {
    static int grid = 0;
    if (grid == 0) {
        if (n_in != 22 || out_size != SEQ * DM || ws_size < WS_END) { fprintf(stderr, "kernel_launch: unexpected shapes (n_in %d out %d ws %zu)\n", n_in, out_size, ws_size); grid = -1; return; }
        int dev = 0, cus = 0, per_cu = 0;
        (void)hipGetDevice(&dev); (void)hipDeviceGetAttribute(&cus, hipDeviceAttributeMultiprocessorCount, dev);
        if (hipFuncSetAttribute((const void*)mega_fwd, hipFuncAttributeMaxDynamicSharedMemorySize, LDS_BYTES) != hipSuccess) { fprintf(stderr, "kernel_launch: hipFuncSetAttribute failed\n"); grid = -1; return; }
        if (hipOccupancyMaxActiveBlocksPerMultiprocessor(&per_cu, (const void*)mega_fwd, NTHREADS, LDS_BYTES) != hipSuccess || per_cu < 1) { fprintf(stderr, "kernel_launch: occupancy query says %d\n", per_cu); per_cu = 1; }
        (void)hipGetLastError();
        grid = cus * per_cu; if (grid > 256) grid = 256;
        fprintf(stderr, "kernel_launch: grid %d (cus %d per_cu %d)\n", grid, cus, per_cu);
    }
    if (grid < 0) return;
    Args a{};
    for (int i = 0; i < 22; ++i) a.in[i] = (const float*)d_in[i];
    a.out = (float*)d_out; a.ws = (unsigned char*)d_ws;
#if MK_MULTI
#ifdef DBG_SEQ
    { const int seq[] = {DBG_SEQ}; for (int ph : seq) { a.ph_lo = ph; a.ph_hi = ph + 1; hipLaunchKernelGGL(mega_fwd, dim3(grid), dim3(NTHREADS), LDS_BYTES, stream, a); } }
#else
    for (int ph = 0; ph < DBG_NPH; ++ph) { a.ph_lo = ph; a.ph_hi = ph + 1; hipLaunchKernelGGL(mega_fwd, dim3(grid), dim3(NTHREADS), LDS_BYTES, stream, a); }
#endif
    if (DBG_DUMP) { a.ph_lo = 99; a.ph_hi = 100; hipLaunchKernelGGL(mega_fwd, dim3(grid), dim3(NTHREADS), LDS_BYTES, stream, a); }
#else
    a.ph_lo = 0; a.ph_hi = N_PHASES;
    if (hipMemsetAsync((char*)d_ws + WS_BAR, 0, 16384, stream) != hipSuccess) { fprintf(stderr, "kernel_launch: memset of the barrier words failed\n"); return; }
    void* kargs[] = {&a};
    hipError_t e = hipLaunchCooperativeKernel((const void*)mega_fwd, dim3(grid), dim3(NTHREADS), kargs, LDS_BYTES, stream);
    if (e != hipSuccess) fprintf(stderr, "kernel_launch: cooperative launch failed: %s (grid %d)\n", hipGetErrorString(e), grid);
#endif
}
```

```cpp
#include <hip/hip_runtime.h>
#include <hip/hip_cooperative_groups.h>
#include <cstdio>
#include <cstdint>
namespace cg = cooperative_groups;
namespace pg8 {
#define PG8_LAS __attribute__((address_space(3)))
typedef unsigned short bf16_t;
typedef short bf16x8 __attribute__((ext_vector_type(8)));
typedef float f32x4 __attribute__((ext_vector_type(4)));
typedef unsigned u32x4 __attribute__((ext_vector_type(4)));
constexpr int BM = 256, BK = 64, HALF = 128, HTB = HALF * BK * 2  , STAGE_BYTES = 8 * HTB, NXCD = 8, WGM = 8;

__host__ __device__ __forceinline__ int lds_byte(int r, int c) { const int st = (r >> 4) * 2 + (c >> 5), rr = r & 15, cc = c & 31, ob = rr * 64 + cc * 2; return st * 1024 + (ob ^ (((ob >> 9) & 1) << 5)); }
__host__ __device__ __forceinline__ void stage_rc(int b, int& R, int& C) { const int st = b / 1024, sb = b % 1024, swz = sb ^ (((sb >> 9) & 1) << 5); R = (st >> 1) * 16 + swz / 64; C = (st & 1) * 32 + (swz % 64) / 2; }
__host__ __device__ __forceinline__ int perm32(int rho) { const int n = rho >> 4, i = rho & 15; return 8 * (i >> 2) + 4 * n + (i & 3); }

struct Unit { int pm, pn; };
struct Gemm { const bf16_t* A; const bf16_t* Bt; int M, N, K; };

struct StaticOrder {
    int nM, nN, nwg, G, c;
    __host__ __device__ void init(int M, int N, int G_, int c_) { nM = M / BM; nN = N / BM; nwg = nM * nN; G = G_; c = c_; }
    __host__ __device__ bool next(int i, Unit& u) const {
        const long L = (long)i * G + c; if (L >= nwg) return false;
        int wgid = (int)L; { const int q = nwg / NXCD, r = nwg % NXCD, xcd = wgid % NXCD, off = wgid / NXCD; wgid = (xcd < r ? xcd * (q + 1) : r * (q + 1) + (xcd - r) * q) + off; }
        const int nig = WGM * nN, gid = wgid / nig, fm = gid * WGM, gsz = (nM - fm) < WGM ? (nM - fm) : WGM;
        u.pm = fm + ((wgid % nig) % gsz); u.pn = (wgid % nig) / gsz; return true;
    }
    __device__ __forceinline__ void a_ready(const Unit&) const {}
    __device__ __forceinline__ void done(const Unit&) const {}
};

__device__ __forceinline__ unsigned cvt_pk_bf16(float lo, float hi) { unsigned r; asm volatile("v_cvt_pk_bf16_f32 %0, %1, %2" : "=v"(r) : "v"(lo), "v"(hi)); return r; }
typedef float f32x2 __attribute__((ext_vector_type(2)));
constexpr float RMS_EPS = 1e-6f;
constexpr int DM = 2048;
__device__ __forceinline__ float fsigmoid(float x) { return __builtin_amdgcn_rcpf(1.f + __expf(-x)); }
__device__ __forceinline__ float gelu_tanh(float v) { return v * fsigmoid(1.5957691216057308f * (v + 0.044715f * v * v * v)); }
__device__ __forceinline__ float rstd_row(const float* ssp, int row) {
    const f32x4* p = (const f32x4*)(ssp + (size_t)row * 32); float s = 0.f;
#pragma unroll
    for (int i = 0; i < 8; ++i) { const f32x4 v = p[i]; s += (v[0] + v[1]) + (v[2] + v[3]); }
    return rsqrtf(s * (1.f / DM) + RMS_EPS);
}
__device__ __forceinline__ float bf_lo(unsigned w) { return __uint_as_float(w << 16); }
__device__ __forceinline__ float bf_hi(unsigned w) { return __uint_as_float(w & 0xffff0000u); }

template <int MODE> struct EpiAct {
    static constexpr bool PERM = true, AFTER_DRAIN = false;
    bf16_t* O0; bf16_t* O1; int ldc; int split; const float* ss; const PG8_LAS float* tab; int tab_t;
    __device__ __forceinline__ void operator()(const f32x4 (&acc)[2][2][4][2], const Unit& u, int wr, int wc, int fr, int fq) const {
        const int row0 = u.pm * BM + wr * 64 + fr; int colt = u.pn * BM; bf16_t* base = O0; bool second = false;
        if (MODE <= 1) { if (colt >= split) { base = O1; colt -= split; second = true; } }
        const int col0 = colt + wc * 32 + 8 * fq;
        f32x4 cs[2][2];
        if (MODE == 4) {
#pragma unroll
            for (int bj = 0; bj < 2; ++bj)
#pragma unroll
                for (int n = 0; n < 2; ++n) {
#pragma unroll
                    for (int e = 0; e < 4; ++e) cs[bj][n][e] = (u.pn == tab_t) ? tab[col0 - u.pn * BM + bj * HALF + 4 * n + e] : rstd_row(ss, col0 + bj * HALF + 4 * n + e); }
        }
#pragma unroll
        for (int ai = 0; ai < 2; ++ai)
#pragma unroll
            for (int m = 0; m < 4; ++m) {
                const int row = row0 + ai * HALF + m * 16;
                float rs = 1.f;
                if (MODE <= 2) { rs = (u.pm == tab_t) ? tab[row - u.pm * BM] : rstd_row(ss, row); if (MODE == 1 && !second) rs *= 0.08838834764831845f; }
                bf16_t* rowp = base + (size_t)row * ldc + col0;
#pragma unroll
                for (int bj = 0; bj < 2; ++bj) {
                    f32x4 v0 = acc[ai][bj][m][0], v1 = acc[ai][bj][m][1];
                    if (MODE == 4) { v0 = v0 * cs[bj][0]; v1 = v1 * cs[bj][1]; } else { v0 = v0 * rs; v1 = v1 * rs; }
                    if (MODE == 0) { if (second) {
#pragma unroll
                        for (int e = 0; e < 4; ++e) { v0[e] = gelu_tanh(v0[e]); v1[e] = gelu_tanh(v1[e]); } } }
                    if (MODE == 2) {
#pragma unroll
                        for (int e = 0; e < 4; ++e) { const float a = fmaxf(v0[e], 0.f), b = fmaxf(v1[e], 0.f); v0[e] = a * a; v1[e] = b * b; } }
                    u32x4 w; w.x = cvt_pk_bf16(v0[0], v0[1]); w.y = cvt_pk_bf16(v0[2], v0[3]); w.z = cvt_pk_bf16(v1[0], v1[1]); w.w = cvt_pk_bf16(v1[2], v1[3]);
                    *(u32x4*)(rowp + bj * HALF) = w;
                }
                asm volatile("" ::: "memory");
            }
    }
};

template <int MODE> struct EpiRes {
    static constexpr bool PERM = true, AFTER_DRAIN = false;
    const float* base; float* out; bf16_t* hb; float* ss_out; const float* ss_in; const bf16_t* proj; const PG8_LAS float* tab; int tab_t;
    __device__ __forceinline__ void operator()(const f32x4 (&acc)[2][2][4][2], const Unit& u, int wr, int wc, int fr, int fq) const {
        const int row0 = u.pm * BM + wr * 64 + fr; const int col0 = u.pn * BM + wc * 32 + 8 * fq;
#pragma unroll
        for (int aim = 0; aim < 4; ++aim) { const int ai = aim >> 1, mh = (aim & 1) * 2;
            f32x4 bpre[2][2][2]; u32x4 ppre[2][2];
#pragma unroll
            for (int mm = 0; mm < 2; ++mm) { const int m = mh + mm; const size_t off = (size_t)(row0 + ai * HALF + m * 16) * DM + col0;
#pragma unroll
                for (int bj = 0; bj < 2; ++bj) { bpre[mm][bj][0] = *(const f32x4*)(base + off + bj * HALF); bpre[mm][bj][1] = *(const f32x4*)(base + off + bj * HALF + 4);
                    if (MODE == 1) ppre[mm][bj] = *(const u32x4*)(proj + off + bj * HALF); } }
#pragma unroll
            for (int mm = 0; mm < 2; ++mm) { const int m = mh + mm;
                const int row = row0 + ai * HALF + m * 16; const size_t off = (size_t)row * DM + col0;
                float rs = 0.f; if (MODE == 1) rs = (u.pm == tab_t) ? tab[row - u.pm * BM] : rstd_row(ss_in, row);
                float sq = 0.f;
#pragma unroll
                for (int bj = 0; bj < 2; ++bj) {
                    const f32x4 b0 = bpre[mm][bj][0], b1 = bpre[mm][bj][1];
                    f32x4 v0 = acc[ai][bj][m][0], v1 = acc[ai][bj][m][1];
                    if (MODE == 1) {
                        const u32x4 pw = ppre[mm][bj];
                        const f32x4 p0 = (f32x4){bf_lo(pw.x), bf_hi(pw.x), bf_lo(pw.y), bf_hi(pw.y)}, p1 = (f32x4){bf_lo(pw.z), bf_hi(pw.z), bf_lo(pw.w), bf_hi(pw.w)};
#pragma unroll
                        for (int e = 0; e < 4; ++e) { v0[e] = fsigmoid(v0[e] * rs) * p0[e]; v1[e] = fsigmoid(v1[e] * rs) * p1[e]; }
                    }
                    const f32x4 o0 = b0 + v0, o1 = b1 + v1;
                    *(f32x4*)(out + off + bj * HALF) = o0; *(f32x4*)(out + off + bj * HALF + 4) = o1;
                    u32x4 w; w.x = cvt_pk_bf16(o0[0], o0[1]); w.y = cvt_pk_bf16(o0[2], o0[3]); w.z = cvt_pk_bf16(o1[0], o1[1]); w.w = cvt_pk_bf16(o1[2], o1[3]);
                    *(u32x4*)(hb + off + bj * HALF) = w;
                    sq += (o0[0] * o0[0] + o0[1] * o0[1]) + (o0[2] * o0[2] + o0[3] * o0[3]) + (o1[0] * o1[0] + o1[1] * o1[1]) + (o1[2] * o1[2] + o1[3] * o1[3]);
                }
                sq += __shfl_xor(sq, 16); sq += __shfl_xor(sq, 32);
                if (fq == 0) ss_out[(size_t)row * 32 + u.pn * 4 + wc] = sq;
            }
            asm volatile("" ::: "memory");
        }
    }
};

template <class Epi, class Sched, bool ALIGN_EPI = false, bool SP2 = false>
__device__ __forceinline__ void gemm_phase(PG8_LAS unsigned char* lds, const Gemm g, const Sched& S, const Epi& E) {
    int tid_ = threadIdx.x; asm volatile("" : "+v"(tid_)); const int tid = tid_, wid = __builtin_amdgcn_readfirstlane(tid >> 6), lane = tid & 63, wr = wid >> 2, wc = wid & 3, fr = lane & 15, fq = lane >> 4;
    const int K = g.K, nt = K / BK;
    unsigned voffA[2], voffB[2];
#pragma unroll
    for (int i = 0; i < 2; ++i) { int R, C; stage_rc(tid * 16 + i * 8192, R, C); const int Rb = Epi::PERM ? ((R & ~31) + perm32(R & 31)) : R;
        voffA[i] = (unsigned)(R * K + C) * 2u; voffB[i] = (unsigned)(Rb * K + C) * 2u; }
    const size_t kstep = (size_t)(BK * 2);
    const size_t hstep = (size_t)HALF * K * 2;
    const size_t tstep = 2 * hstep;
    const unsigned ldsw = (unsigned)wid * 1024u;
    const int aoff = lds_byte(wr * 64 + fr, fq * 8), boff = lds_byte(wc * 32 + fr, fq * 8);
#define PG8_SA(b, h) (((b) * 2 + (h)) * HTB)
#define PG8_SB(b, h) ((4 + (b) * 2 + (h)) * HTB)
#define PG8_STAGE(bufoff, gbase, voff) do { _Pragma("unroll") for (int _i = 0; _i < 2; ++_i) \
        __builtin_amdgcn_global_load_lds((const unsigned*)((const char*)(gbase) + (voff)[_i]), (PG8_LAS unsigned*)(lds + (bufoff) + ldsw + _i * 8192), 16, 0, 0); } while (0)
#define PG8_LDA(dst, b, h) do { _Pragma("unroll") for (int m = 0; m < 4; ++m) _Pragma("unroll") for (int k = 0; k < 2; ++k) dst[m][k] = *(const PG8_LAS bf16x8*)(lds + PG8_SA(b, h) + aoff + m * 2048 + k * 1024); } while (0)
#define PG8_LDB(dst, b, h) do { _Pragma("unroll") for (int n = 0; n < 2; ++n) _Pragma("unroll") for (int k = 0; k < 2; ++k) dst[n][k] = *(const PG8_LAS bf16x8*)(lds + PG8_SB(b, h) + boff + n * 2048 + k * 1024); } while (0)
#define PG8_MMA(ai, bj, At, Bt) do { __builtin_amdgcn_s_setprio(1); _Pragma("unroll") for (int m = 0; m < 4; ++m) _Pragma("unroll") for (int n = 0; n < 2; ++n) _Pragma("unroll") for (int k = 0; k < 2; ++k) \
        acc[ai][bj][m][n] = __builtin_amdgcn_mfma_f32_16x16x32_bf16(Bt[n][k], At[m][k], acc[ai][bj][m][n], 0, 0, 0); __builtin_amdgcn_s_setprio(0); } while (0)
#define PG8_WAIT_V(n) asm volatile("s_waitcnt vmcnt(" #n ")" ::: "memory")
#define PG8_WAIT_L(n) asm volatile("s_waitcnt lgkmcnt(" #n ")" ::: "memory")
#define PG8_BAR __builtin_amdgcn_s_barrier()
#define PG8_SCHED __builtin_amdgcn_sched_barrier(0)
    Unit cur, nxt; int ui = 0;
    if (!S.next(0, cur)) return;
    f32x4 acc[2][2][4][2];
#pragma unroll
    for (int a = 0; a < 2; ++a)
#pragma unroll
        for (int b = 0; b < 2; ++b)
#pragma unroll
            for (int m = 0; m < 4; ++m)
#pragma unroll
                for (int n = 0; n < 2; ++n) acc[a][b][m][n] = (f32x4){0.f, 0.f, 0.f, 0.f};
    bf16x8 At[4][2], B0[2][2], B1[2][2];
    const char* cA = (const char*)g.A + (size_t)cur.pm * tstep; const char* cB = (const char*)g.Bt + (size_t)cur.pn * tstep;
    S.a_ready(cur);
    if constexpr (SP2) {
        PG8_STAGE(PG8_SB(0, 0), cB, voffB); PG8_STAGE(PG8_SB(0, 1), cB + hstep, voffB); PG8_STAGE(PG8_SA(0, 0), cA, voffA); PG8_STAGE(PG8_SA(0, 1), cA + hstep, voffA);
        if (wr == 1) PG8_BAR;
        PG8_WAIT_V(2); PG8_BAR;
        PG8_STAGE(PG8_SB(1, 0), cB + kstep, voffB); PG8_STAGE(PG8_SA(1, 0), cA + kstep, voffA); PG8_STAGE(PG8_SB(1, 1), cB + hstep + kstep, voffB);
        PG8_WAIT_V(6); PG8_BAR;
    } else {
        PG8_STAGE(PG8_SB(0, 0), cB, voffB); PG8_STAGE(PG8_SA(0, 0), cA, voffA); PG8_STAGE(PG8_SB(0, 1), cB + hstep, voffB); PG8_STAGE(PG8_SA(0, 1), cA + hstep, voffA);
        if (wr == 1) PG8_BAR;
        PG8_WAIT_V(4); PG8_BAR;
        PG8_STAGE(PG8_SB(1, 0), cB + kstep, voffB); PG8_STAGE(PG8_SA(1, 0), cA + kstep, voffA); PG8_STAGE(PG8_SB(1, 1), cB + hstep + kstep, voffB);
        PG8_WAIT_V(6); PG8_BAR;
    }
    for (;;) {
        const bool has_next = S.next(ui + 1, nxt);
        const char* nA = has_next ? (const char*)g.A + (size_t)nxt.pm * tstep : cA; const char* nB = has_next ? (const char*)g.Bt + (size_t)nxt.pn * tstep : cB;
        for (int t = 0; t < nt; t += 2) {
            const bool last = (t == nt - 2);
            const char* a1 = cA + (size_t)(t + 1) * kstep;
            const char* a2 = last ? nA : cA + (size_t)(t + 2) * kstep; const char* b2 = last ? nB : cB + (size_t)(t + 2) * kstep;
            const char* a3 = a2 + kstep; const char* b3 = b2 + kstep;
            if (last && has_next) S.a_ready(nxt);
            if constexpr (SP2) {
            PG8_LDB(B0, 0, 0); PG8_LDB(B1, 0, 1); PG8_SCHED; PG8_LDA(At, 0, 0); PG8_STAGE(PG8_SA(1, 1), a1 + hstep, voffA);
            PG8_WAIT_V(8); PG8_WAIT_L(0); PG8_BAR; PG8_MMA(0, 0, At, B0); PG8_MMA(0, 1, At, B1); PG8_BAR; PG8_SCHED;
            PG8_LDA(At, 0, 1); PG8_STAGE(PG8_SB(0, 0), b2, voffB); PG8_STAGE(PG8_SB(0, 1), b2 + hstep, voffB); PG8_STAGE(PG8_SA(0, 0), a2, voffA);
            PG8_WAIT_V(8); PG8_WAIT_L(0); PG8_BAR; PG8_MMA(1, 0, At, B0); PG8_MMA(1, 1, At, B1); PG8_BAR; PG8_SCHED;
            PG8_LDB(B0, 1, 0); PG8_LDB(B1, 1, 1); PG8_SCHED; PG8_LDA(At, 1, 0); PG8_STAGE(PG8_SA(0, 1), a2 + hstep, voffA);
            PG8_WAIT_V(8); PG8_WAIT_L(0); PG8_BAR; PG8_MMA(0, 0, At, B0); PG8_MMA(0, 1, At, B1); PG8_BAR; PG8_SCHED;
            PG8_LDA(At, 1, 1); PG8_STAGE(PG8_SB(1, 0), b3, voffB); PG8_STAGE(PG8_SB(1, 1), b3 + hstep, voffB); PG8_STAGE(PG8_SA(1, 0), a3, voffA);
            PG8_WAIT_V(8); PG8_WAIT_L(0); PG8_BAR; PG8_MMA(1, 0, At, B0); PG8_MMA(1, 1, At, B1); PG8_BAR; PG8_SCHED;
            } else {
            PG8_LDB(B0, 0, 0); PG8_SCHED; PG8_LDA(At, 0, 0); PG8_STAGE(PG8_SA(1, 1), a1 + hstep, voffA);
            PG8_WAIT_L(8); PG8_BAR; PG8_WAIT_L(0); PG8_MMA(0, 0, At, B0); PG8_BAR; PG8_SCHED;
            PG8_LDB(B1, 0, 1); PG8_STAGE(PG8_SB(0, 0), b2, voffB);
            PG8_BAR; PG8_WAIT_L(0); PG8_MMA(0, 1, At, B1); PG8_BAR;
            PG8_LDA(At, 0, 1); PG8_STAGE(PG8_SA(0, 0), a2, voffA);
            PG8_BAR; PG8_WAIT_L(0); PG8_MMA(1, 0, At, B0); PG8_BAR; PG8_SCHED;
            PG8_STAGE(PG8_SB(0, 1), b2 + hstep, voffB);
            PG8_WAIT_V(6); PG8_BAR; PG8_MMA(1, 1, At, B1); PG8_BAR;
            PG8_LDB(B0, 1, 0); PG8_SCHED; PG8_LDA(At, 1, 0); PG8_STAGE(PG8_SA(0, 1), a2 + hstep, voffA);
            PG8_WAIT_L(8); PG8_BAR; PG8_WAIT_L(0); PG8_MMA(0, 0, At, B0); PG8_BAR; PG8_SCHED;
            PG8_LDB(B1, 1, 1); PG8_STAGE(PG8_SB(1, 0), b3, voffB);
            PG8_BAR; PG8_WAIT_L(0); PG8_MMA(0, 1, At, B1); PG8_BAR;
            PG8_LDA(At, 1, 1); PG8_STAGE(PG8_SA(1, 0), a3, voffA);
            PG8_BAR; PG8_WAIT_L(0); PG8_MMA(1, 0, At, B0); PG8_BAR; PG8_SCHED;
            PG8_STAGE(PG8_SB(1, 1), b3 + hstep, voffB);
            PG8_WAIT_V(6); PG8_BAR; PG8_MMA(1, 1, At, B1); PG8_BAR;
            }
        }
        if constexpr (ALIGN_EPI) { if (wr == 0) PG8_BAR; }
        if constexpr (!Epi::AFTER_DRAIN) { E(acc, cur, wr, wc, fr, fq); S.done(cur); }
        if (!has_next) break;
#pragma unroll
        for (int a = 0; a < 2; ++a)
#pragma unroll
            for (int b = 0; b < 2; ++b)
#pragma unroll
                for (int m = 0; m < 4; ++m)
#pragma unroll
                    for (int n = 0; n < 2; ++n) acc[a][b][m][n] = (f32x4){0.f, 0.f, 0.f, 0.f};
        cur = nxt; cA = nA; cB = nB; ++ui;
        if constexpr (ALIGN_EPI) { if (wr == 1) PG8_BAR; }
    }
    PG8_WAIT_V(0);
    if constexpr (!ALIGN_EPI) { if (wr == 0) PG8_BAR; }
    PG8_BAR;
    if constexpr (Epi::AFTER_DRAIN) { E.fused(acc, cur, wr, wc, fr, fq, lds, wid, lane); S.done(cur); }
#undef PG8_SA
#undef PG8_SB
#undef PG8_STAGE
#undef PG8_LDA
#undef PG8_LDB
#undef PG8_MMA
#undef PG8_WAIT_V
#undef PG8_WAIT_L
#undef PG8_BAR
#undef PG8_SCHED
}
}

constexpr int SEQ = 8192, DM = 2048, DFF = 8192, PLE = 256, DEPTH = 4, NHEAD = 16, HD = 128;
constexpr int NWAVES = 8, NTHREADS = 512;
constexpr int LDS_BYTES = 147456;
typedef unsigned short bf16;
typedef unsigned u32x4 __attribute__((ext_vector_type(4)));
typedef unsigned u32x2 __attribute__((ext_vector_type(2)));
typedef float f32x4 __attribute__((ext_vector_type(4)));
typedef float f32x2 __attribute__((ext_vector_type(2)));
typedef short bf16x8 __attribute__((ext_vector_type(8)));
#define LAS __attribute__((address_space(3)))
#define LDS_WAIT() asm volatile("s_waitcnt lgkmcnt(0)" ::: "memory")

constexpr size_t MiB = 1u << 20;
constexpr size_t WS_SS = 880 * MiB;
constexpr size_t WS_BAR = 0;
constexpr size_t WS_AGG = 2 * MiB;
constexpr size_t WS_X0 = 8 * MiB, WS_X1 = 40 * MiB;
constexpr size_t WS_BA = 72 * MiB, WS_BB = 104 * MiB, WS_BC = 136 * MiB, WS_BD = 168 * MiB;
constexpr size_t WS_A1 = 200 * MiB;
constexpr size_t WS_PROJ = 328 * MiB;
constexpr size_t WS_PB = 456 * MiB;
constexpr size_t WS_W1T = 472 * MiB, WS_W2T = 600 * MiB, WS_WGT = 728 * MiB, WS_WPT = 760 * MiB, WS_WINT = 764 * MiB, WS_WORT = 796 * MiB,
                 WS_GAT = 812 * MiB, WS_GXT = 814 * MiB, WS_WQKVT = 816 * MiB, WS_WONT = 864 * MiB, WS_END = 893 * MiB;

struct Args {
    const float* in[22];
    float* out; unsigned char* ws;
    int ph_lo, ph_hi;
};
static_assert(sizeof(Args) == 200 && offsetof(Args, out) == 176 && offsetof(Args, ws) == 184 && offsetof(Args, ph_lo) == 192, "Args layout");

typedef const unsigned char __attribute__((address_space(4)))* KA;
#define INP(k) (*(const float* const __attribute__((address_space(4)))*)(ka + 8 * (k)))
__device__ __forceinline__ int opaque_tid() { int t = threadIdx.x; asm volatile("" : "+v"(t)); return t; }
__device__ __forceinline__ unsigned cvt_pk(float lo, float hi) { return pg8::cvt_pk_bf16(lo, hi); }
__device__ __forceinline__ float bfl(unsigned w) { return __uint_as_float(w << 16); }
__device__ __forceinline__ float bfh(unsigned w) { return __uint_as_float(w & 0xffff0000u); }
__device__ __forceinline__ float wave_sum(float v) {
#pragma unroll
    for (int o = 1; o < 64; o <<= 1) v += __shfl_xor(v, o);
    return v;
}

__device__ __forceinline__ void transpose_item(const float* W, int K, int N, const float* g, bf16* WT, int kb, int nb, int lane) {
    const int q = lane >> 4, ln = lane & 15;
    const int kbase = 64 * kb + 16 * q, n = 64 * nb + 4 * ln;
    f32x4 v[16];
    const float* wp = W + (size_t)kbase * N + n;
#pragma unroll
    for (int i = 0; i < 16; ++i) v[i] = *(const f32x4*)(wp + (size_t)i * N);
    if (g) {
#pragma unroll
        for (int i4 = 0; i4 < 4; ++i4) { const f32x4 gv = *(const f32x4*)(g + kbase + 4 * i4);
#pragma unroll
            for (int e = 0; e < 4; ++e) v[4 * i4 + e] = v[4 * i4 + e] * gv[e]; }
    }
#pragma unroll
    for (int e = 0; e < 4; ++e) {
        bf16* op = WT + (size_t)(n + e) * K + kbase;
#pragma unroll
        for (int h = 0; h < 2; ++h) {
            u32x4 o; o.x = cvt_pk(v[8 * h + 0][e], v[8 * h + 1][e]); o.y = cvt_pk(v[8 * h + 2][e], v[8 * h + 3][e]); o.z = cvt_pk(v[8 * h + 4][e], v[8 * h + 5][e]); o.w = cvt_pk(v[8 * h + 6][e], v[8 * h + 7][e]);
            *(u32x4*)(op + 8 * h) = o;
        }
    }
}

__device__ __forceinline__ void p0_phase(LAS unsigned char* lds, KA ka, unsigned char* ws, int G) {
    const int tid = opaque_tid(), lane = tid & 63, wave = tid >> 6;
    const int gw = blockIdx.x * NWAVES + wave, NGW = G * NWAVES;
    float* ss = (float*)(ws + WS_SS);
    {
        const float* x = INP(0); bf16* X0 = (bf16*)(ws + WS_X0);
        for (int row = gw; row < SEQ; row += NGW) {
            const f32x4* xr = (const f32x4*)(x + (size_t)row * DM) + lane; float s = 0.f;
            u32x2* o = (u32x2*)(X0 + (size_t)row * DM) + lane;
#pragma unroll
            for (int j = 0; j < 8; ++j) { const f32x4 v = xr[64 * j]; s += (v[0] * v[0] + v[1] * v[1]) + (v[2] * v[2] + v[3] * v[3]); u32x2 w; w.x = cvt_pk(v[0], v[1]); w.y = cvt_pk(v[2], v[3]); o[64 * j] = w; }
            s = wave_sum(s);
            if (lane < 32) ss[(size_t)row * 32 + lane] = (lane == 0) ? s : 0.f;
        }
    }
    {
        const f32x4* p = (const f32x4*)INP(1); u32x2* o = (u32x2*)(ws + WS_PB);
        const int n4 = DEPTH * SEQ * PLE / 4;
        for (int i = blockIdx.x * NTHREADS + tid; i < n4; i += G * NTHREADS) { const f32x4 v = p[i]; u32x2 w; w.x = cvt_pk(v[0], v[1]); w.y = cvt_pk(v[2], v[3]); o[i] = w; }
    }
    const int nitems_total =
        4 * (2048 / 64) * (8192 / 64) + 4 * (8192 / 64) * (2048 / 64) + 4 * (2048 / 64) * (2048 / 64) + 4 * (256 / 64) * (2048 / 64) +
        2 * (2048 / 64) * (4096 / 64) + 2 * (2048 / 64) * (2048 / 64) + 64 * (128 / 64) * (128 / 64) + 64 * (128 / 64) * (128 / 64) +
        2 * (2048 / 64) * (6144 / 64) + 2 * (2048 / 64) * (2048 / 64);
    for (int it = gw; it < nitems_total; it += NGW) {
        int r = it;
#define CONV_TRY(Wp, nmat, K, N, gp, gstride, WTp) { const int ipm = ((K) / 64) * ((N) / 64); const int tot = (nmat) * ipm; \
            if (r < tot) { const int mat = r / ipm, rr = r % ipm, kb = rr / ((N) / 64), nb = rr % ((N) / 64); const float* g_ = (gp); \
                transpose_item((Wp) + (size_t)mat * (K) * (N), (K), (N), g_ ? g_ + (size_t)mat * (gstride) : nullptr, (bf16*)(ws + (WTp)) + (size_t)mat * (K) * (N), kb, nb, lane); continue; } r -= tot; }
        CONV_TRY(INP(18), 4, 2048, 8192, INP(3), 2048, WS_W1T)
        CONV_TRY(INP(19), 4, 8192, 2048, (const float*)nullptr, 0, WS_W2T)
        CONV_TRY(INP(20), 4, 2048, 2048, INP(4), 2048, WS_WGT)
        CONV_TRY(INP(21), 4, 256, 2048, (const float*)nullptr, 0, WS_WPT)
        CONV_TRY(INP(6), 2, 2048, 4096, INP(2), 4096, WS_WINT)
        CONV_TRY(INP(14), 2, 2048, 2048, (const float*)nullptr, 0, WS_WORT)
        CONV_TRY(INP(9), 64, 128, 128, (const float*)nullptr, 0, WS_GAT)
        CONV_TRY(INP(11), 64, 128, 128, (const float*)nullptr, 0, WS_GXT)
        CONV_TRY(INP(15), 2, 2048, 6144, INP(2) + 2048, 4096, WS_WQKVT)
        CONV_TRY(INP(17), 2, 2048, 2048, (const float*)nullptr, 0, WS_WONT)
#undef CONV_TRY
    }
}

constexpr int SC_T = 64, SC_NCH = SEQ / SC_T;
constexpr int XCF_STRIDE = 132;
constexpr int XCB_STRIDE = 136;
constexpr int LDS_XCF = 0, LDS_XCB = LDS_XCF + SC_T * XCF_STRIDE * 4, LDS_YGS = LDS_XCB + SC_T * XCB_STRIDE * 2, LDS_SEG = LDS_YGS + SC_T * 128 * 2, LDS_CAR = LDS_SEG + 2 * 128 * 17 * 8, LDS_SC_END = LDS_CAR + 2 * 8 * 128 * 4;
static_assert(LDS_SC_END <= 131072, "scan LDS");

struct ScanArgs {
    const bf16* XR; const bf16* YG; bf16* Y;
    const float* conv_w; const float* conv_b;
    const bf16* gaT; const bf16* gxT;
    const float* ga_b; const float* gx_b; const float* lam;
    f32x2* agg;
};

template <bool FINAL>
__device__ __forceinline__ void scan_phase(LAS unsigned char* lds, const ScanArgs& sa, int G) {
    const int tid = opaque_tid(), lane = tid & 63, w = tid >> 6, fr = lane & 15, fq = lane >> 4;
    LAS float* xcf = (LAS float*)(lds + LDS_XCF);
    LAS bf16* xcb = (LAS bf16*)(lds + LDS_XCB);
    LAS bf16* ygs = (LAS bf16*)(lds + LDS_YGS);
    LAS f32x2* seg = (LAS f32x2*)(lds + LDS_SEG);
    int cur_hd = -1;
    bf16x8 Bf[4][4];
    float ba[2], bx[2], sp8[2];
    ba[0] = ba[1] = bx[0] = bx[1] = sp8[0] = sp8[1] = 0.f;
    LAS float* car = (LAS float*)(lds + LDS_CAR);
    const bool fast = FINAL && (G == 256);
    if (fast) {
        if (tid < 256) {
            const int dir = tid >> 7, c = tid & 127, gch = (blockIdx.x & 15) * 128 + c, cmod = blockIdx.x >> 4;
            const f32x2* ag = sa.agg + (size_t)dir * SC_NCH * DM + gch;
            float h = 0.f;
            if (dir == 0) {
#pragma unroll 8
                for (int cc = 0; cc < SC_NCH; ++cc) { const f32x2 e = ag[(size_t)cc * DM]; if ((cc & 15) == cmod) car[(dir * 8 + (cc >> 4)) * 128 + c] = h; h = e[0] * h + e[1]; }
            } else {
#pragma unroll 8
                for (int cc = SC_NCH - 1; cc >= 0; --cc) { const f32x2 e = ag[(size_t)cc * DM]; if ((cc & 15) == cmod) car[(dir * 8 + (cc >> 4)) * 128 + c] = h; h = e[0] * h + e[1]; }
            }
        }
    }
    unsigned xpre[11]; u32x4 ypre[2];
#define SCAN_PREFETCH(itx) do { const int hd_ = (itx) & 15, t0_ = ((itx) >> 4) * SC_T; const int gc_ = hd_ * 128 + 2 * (tid & 63), tg_ = tid >> 6; \
        _Pragma("unroll") for (int q = 0; q < 11; ++q) { const int t = t0_ + 8 * tg_ - 1 + q; unsigned v = 0u; if (t >= 0 && t < SEQ) v = *(const unsigned*)(sa.XR + (size_t)t * DM + gc_); xpre[q] = v; } \
        if (FINAL) { _Pragma("unroll") for (int i = 0; i < 2; ++i) { const int idx = tid + i * NTHREADS, row = idx >> 4, c16 = idx & 15; \
            ypre[i] = *(const u32x4*)(sa.YG + (size_t)(t0_ + row) * DM + hd_ * 128 + c16 * 8); } } } while (0)
    ypre[0] = (u32x4){0u, 0u, 0u, 0u}; ypre[1] = (u32x4){0u, 0u, 0u, 0u};
    if ((int)blockIdx.x < SC_NCH * NHEAD) SCAN_PREFETCH((int)blockIdx.x);
    for (int it = blockIdx.x; it < SC_NCH * NHEAD; it += G) {
        const int hd = it & 15, chunk = it >> 4, t0 = chunk * SC_T;
        __syncthreads();
#pragma unroll
        for (int dir = 0; dir < 2; ++dir) {
            const bf16* wa = sa.gaT + ((size_t)(dir * 16 + hd) * 128 + 16 * w + fr) * 128 + 8 * fq;
            const bf16* wx = sa.gxT + ((size_t)(dir * 16 + hd) * 128 + 16 * w + fr) * 128 + 8 * fq;
#pragma unroll
            for (int k = 0; k < 4; ++k) { Bf[dir * 2 + 0][k] = *(const bf16x8*)(wa + 32 * k); Bf[dir * 2 + 1][k] = *(const bf16x8*)(wx + 32 * k); }
        }
        if (hd != cur_hd) {
            cur_hd = hd;
#pragma unroll
            for (int dir = 0; dir < 2; ++dir) {
                const int gch = hd * 128 + 16 * w + fr;
                ba[dir] = -1.4426950408889634f * sa.ga_b[dir * DM + gch]; bx[dir] = -1.4426950408889634f * sa.gx_b[dir * DM + gch];
                sp8[dir] = 1.4426950408889634f * 8.f * log1pf(expf(-sa.lam[dir * DM + gch]));
            }
        }
        {
            const int cp = tid & 63, tg = tid >> 6;
            const int gc = hd * 128 + 2 * cp;
            float x0[11], x1[11];
#pragma unroll
            for (int q = 0; q < 11; ++q) { x0[q] = bfl(xpre[q]); x1[q] = bfh(xpre[q]); }
            float w0[4], w1[4];
#pragma unroll
            for (int k = 0; k < 4; ++k) { const f32x2 wv = *(const f32x2*)(sa.conv_w + k * DM + gc); w0[k] = wv[0]; w1[k] = wv[1]; }
            const f32x2 bv = *(const f32x2*)(sa.conv_b + gc);
#pragma unroll
            for (int q = 0; q < 8; ++q) {
                const float c0 = bv[0] + ((w0[0] * x0[q] + w0[1] * x0[q + 1]) + (w0[2] * x0[q + 2] + w0[3] * x0[q + 3]));
                const float c1 = bv[1] + ((w1[0] * x1[q] + w1[1] * x1[q + 1]) + (w1[2] * x1[q + 2] + w1[3] * x1[q + 3]));
                const int tau = 8 * tg + q;
                *(LAS f32x2*)(xcf + tau * XCF_STRIDE + 2 * cp) = (f32x2){c0, c1};
                *(LAS unsigned*)(xcb + tau * XCB_STRIDE + 2 * cp) = cvt_pk(c0, c1);
            }
            if (FINAL) {
#pragma unroll
                for (int i = 0; i < 2; ++i) { const int idx = tid + i * NTHREADS, row = idx >> 4, c16 = idx & 15;
                    *(LAS u32x4*)(ygs + row * 128 + c16 * 8) = ypre[i]; }
            }
            if (it + G < SC_NCH * NHEAD) SCAN_PREFETCH(it + G);
        }
        __syncthreads();
        f32x4 acc[4][4];
#pragma unroll
        for (int m = 0; m < 4; ++m)
#pragma unroll
            for (int mb = 0; mb < 4; ++mb) acc[m][mb] = (f32x4){0.f, 0.f, 0.f, 0.f};
#pragma unroll
        for (int mb = 0; mb < 4; ++mb) {
            bf16x8 Af[4];
#pragma unroll
            for (int k = 0; k < 4; ++k) Af[k] = *(const LAS bf16x8*)(xcb + (16 * mb + fr) * XCB_STRIDE + 32 * k + 8 * fq);
#pragma unroll
            for (int m = 0; m < 4; ++m)
#pragma unroll
                for (int k = 0; k < 4; ++k) acc[m][mb] = __builtin_amdgcn_mfma_f32_16x16x32_bf16(Af[k], Bf[m][k], acc[m][mb], 0, 0, 0);
        }
        const int ch = 16 * w + fr;
#pragma unroll
        for (int mb = 0; mb < 4; ++mb) {
            float xv[4];
#pragma unroll
            for (int j = 0; j < 4; ++j) xv[j] = xcf[(16 * mb + 4 * fq + j) * XCF_STRIDE + ch];
#pragma unroll
            for (int dir = 0; dir < 2; ++dir) {
#pragma unroll
                for (int j = 0; j < 4; ++j) {
                    const float e1 = __builtin_amdgcn_exp2f(fminf(fmaf(acc[2 * dir][mb][j], -1.4426950408889634f, ba[dir]), 60.f));
                    const float e2 = __builtin_amdgcn_exp2f(fminf(fmaf(acc[2 * dir + 1][mb][j], -1.4426950408889634f, bx[dir]), 60.f));
                    const float d1 = 1.f + e1, d2 = 1.f + e2, rd = __builtin_amdgcn_rcpf(d1 * d2);
                    const float r = d2 * rd, ig = d1 * rd;
                    const float av = __builtin_amdgcn_exp2f(-sp8[dir] * r);
                    const float om = fmaxf(fmaf(-av, av, 1.f), 0.f);
                    acc[2 * dir][mb][j] = av;
                    acc[2 * dir + 1][mb][j] = __builtin_amdgcn_sqrtf(om) * (ig * xv[j]);
                }
                const f32x4 A = acc[2 * dir][mb], U = acc[2 * dir + 1][mb];
                float P, Q;
                if (dir == 0) { P = (A[0] * A[1]) * (A[2] * A[3]); Q = ((U[0] * A[1] + U[1]) * A[2] + U[2]) * A[3] + U[3]; }
                else          { P = (A[0] * A[1]) * (A[2] * A[3]); Q = ((U[3] * A[2] + U[2]) * A[1] + U[1]) * A[0] + U[0]; }
                seg[(dir * 128 + ch) * 17 + mb * 4 + fq] = (f32x2){P, Q};
            }
        }
        __syncthreads();
        if (tid < 256) {
            const int dir = tid >> 7, c = tid & 127, gch = hd * 128 + c;
            LAS f32x2* sg = seg + (dir * 128 + c) * 17;
            if (!FINAL) {
                float h = 0.f, Pt = 1.f;
                if (dir == 0) { for (int s = 0; s < 16; ++s) { const f32x2 e = sg[s]; h = e[0] * h + e[1]; Pt *= e[0]; } }
                else          { for (int s = 15; s >= 0; --s) { const f32x2 e = sg[s]; h = e[0] * h + e[1]; Pt *= e[0]; } }
                sa.agg[((size_t)dir * SC_NCH + chunk) * DM + gch] = (f32x2){Pt, h};
            } else {
                float h = 0.f;
                if (fast) h = car[(dir * 8 + (chunk >> 4)) * 128 + c];
                else {
                    const f32x2* ag = sa.agg + (size_t)dir * SC_NCH * DM + gch;
                    if (dir == 0) { for (int cc = 0; cc < chunk; ++cc) { const f32x2 e = ag[(size_t)cc * DM]; h = e[0] * h + e[1]; } }
                    else          { for (int cc = SC_NCH - 1; cc > chunk; --cc) { const f32x2 e = ag[(size_t)cc * DM]; h = e[0] * h + e[1]; } }
                }
                if (dir == 0) { for (int s = 0; s < 16; ++s) { const f32x2 e = sg[s]; sg[s] = (f32x2){h, 0.f}; h = e[0] * h + e[1]; } }
                else          { for (int s = 15; s >= 0; --s) { const f32x2 e = sg[s]; sg[s] = (f32x2){h, 0.f}; h = e[0] * h + e[1]; } }
            }
        }
        if (FINAL) {
            __syncthreads();
#pragma unroll
            for (int mb = 0; mb < 4; ++mb) {
                float hs[4];
                { float h = seg[(0 * 128 + ch) * 17 + mb * 4 + fq][0]; const f32x4 A = acc[0][mb], U = acc[1][mb];
#pragma unroll
                  for (int j = 0; j < 4; ++j) { h = A[j] * h + U[j]; hs[j] = h; } }
                { float h = seg[(1 * 128 + ch) * 17 + mb * 4 + fq][0]; const f32x4 A = acc[2][mb], U = acc[3][mb];
#pragma unroll
                  for (int j = 3; j >= 0; --j) { h = A[j] * h + U[j]; hs[j] += h; } }
#pragma unroll
                for (int j = 0; j < 4; ++j) {
                    LAS bf16* yp = ygs + (16 * mb + 4 * fq + j) * 128 + ch;
                    const float yg = __uint_as_float((unsigned)(*yp) << 16);
                    *yp = (bf16)(cvt_pk(hs[j] * yg, 0.f) & 0xffffu);
                }
            }
            __syncthreads();
#pragma unroll
            for (int i = 0; i < 2; ++i) { const int idx = tid + i * NTHREADS, row = idx >> 4, c16 = idx & 15;
                *(u32x4*)(sa.Y + (size_t)(t0 + row) * DM + hd * 128 + c16 * 8) = *(const LAS u32x4*)(ygs + row * 128 + c16 * 8); }
        }
    }
}

struct AttArgs { const bf16* Q; const bf16* K; const bf16* VT; bf16* O; const float* rpb; };

__device__ __forceinline__ void attn_phase(LAS unsigned char* lds, const AttArgs& aa, int G) {
    const int tid = opaque_tid(), lane = tid & 63, w = tid >> 6, fr = lane & 15, fq = lane >> 4;
    const int hsel = w >> 2, qg = w & 3;
    LAS float* rp = (LAS float*)lds;
    const int c0 = 16 * qg, kb0 = (qg == 0) ? 0 : (qg == 1) ? 8 : (qg == 2) ? 24 : 32;
    const int qc = c0 + fr;
    const int cs = min(max(qc - 8, 0), 48);
    for (int id = blockIdx.x; id < 128 * 8; id += G) {
        const int hp = id & 7, r = id >> 3, h = hp * 2 + hsel;
        const int rs = min(max(r - 4, 0), 120);
        __syncthreads();
        for (int i = tid; i < 2 * 465; i += NTHREADS) { const int hh = i / 465, e = i % 465; rp[hh * 480 + e] = aa.rpb[(size_t)(hp * 2 + hh) * 465 + e]; }
        __syncthreads();
        bf16x8 qf[4];
        { const bf16* qp = aa.Q + (size_t)(r * 64 + qc) * DM + h * 128 + 8 * fq;
#pragma unroll
          for (int k = 0; k < 4; ++k) qf[k] = *(const bf16x8*)(qp + 32 * k); }
        f32x4 s[8][2];
        const int krow = 8 * (fr >> 2) + (fr & 3);
#pragma unroll
        for (int i = 0; i < 8; ++i)
#pragma unroll
            for (int nb = 0; nb < 2; ++nb) {
                const bf16* kp = aa.K + (size_t)((rs + i) * 64 + kb0 + krow + 4 * nb) * DM + h * 128 + 8 * fq;
                f32x4 c = (f32x4){0.f, 0.f, 0.f, 0.f};
#pragma unroll
                for (int k = 0; k < 4; ++k) { const bf16x8 kf = *(const bf16x8*)(kp + 32 * k); c = __builtin_amdgcn_mfma_f32_16x16x32_bf16(kf, qf[k], c, 0, 0, 0); }
                s[i][nb] = c;
            }
        float mx = -INFINITY;
        const LAS float* rph = rp + hsel * 480;
#pragma unroll
        for (int i = 0; i < 8; ++i) {
            const int relr = rs + i - r + 7;
#pragma unroll
            for (int nb = 0; nb < 2; ++nb)
#pragma unroll
                for (int j = 0; j < 4; ++j) {
                    const int kc = kb0 + 8 * fq + 4 * nb + j;
                    const bool valid = (unsigned)(kc - cs) < 16u;
                    const int idx = valid ? relr * 31 + (kc - qc + 15) : 0;
                    const float v = valid ? s[i][nb][j] + rph[idx] : -INFINITY;
                    s[i][nb][j] = v; mx = fmaxf(mx, v);
                }
        }
        mx = fmaxf(mx, __shfl_xor(mx, 16)); mx = fmaxf(mx, __shfl_xor(mx, 32));
        float l = 0.f;
#pragma unroll
        for (int i = 0; i < 8; ++i)
#pragma unroll
            for (int nb = 0; nb < 2; ++nb)
#pragma unroll
                for (int j = 0; j < 4; ++j) { const float p = __expf(s[i][nb][j] - mx); s[i][nb][j] = p; l += p; }
        l += __shfl_xor(l, 16); l += __shfl_xor(l, 32);
        f32x4 o[8];
#pragma unroll
        for (int db = 0; db < 8; ++db) o[db] = (f32x4){0.f, 0.f, 0.f, 0.f};
#pragma unroll
        for (int i = 0; i < 8; ++i) {
            u32x4 pw; pw.x = cvt_pk(s[i][0][0], s[i][0][1]); pw.y = cvt_pk(s[i][0][2], s[i][0][3]); pw.z = cvt_pk(s[i][1][0], s[i][1][1]); pw.w = cvt_pk(s[i][1][2], s[i][1][3]);
            const bf16x8 pb = __builtin_bit_cast(bf16x8, pw);
            const bf16* vp = aa.VT + (size_t)(h * 128 + fr) * SEQ + (rs + i) * 64 + kb0 + 8 * fq;
#pragma unroll
            for (int db = 0; db < 8; ++db) { const bf16x8 vf = *(const bf16x8*)(vp + (size_t)(16 * db) * SEQ); o[db] = __builtin_amdgcn_mfma_f32_16x16x32_bf16(vf, pb, o[db], 0, 0, 0); }
        }
        const float inv = 1.f / l;
        bf16* op = aa.O + (size_t)(r * 64 + qc) * DM + h * 128 + 4 * fq;
#pragma unroll
        for (int db = 0; db < 8; ++db) { u32x2 wv; wv.x = cvt_pk(o[db][0] * inv, o[db][1] * inv); wv.y = cvt_pk(o[db][2] * inv, o[db][3] * inv); *(u32x2*)(op + 16 * db) = wv; }
    }
}

#define ATT_BAR() do { asm volatile("s_waitcnt lgkmcnt(0)" ::: "memory"); __builtin_amdgcn_s_barrier(); asm volatile("" ::: "memory"); } while (0)
constexpr int KS_PITCH = 136, VS_PITCH = 72;
constexpr int ATT_KS = 0, ATT_VS = ATT_KS + 2 * 64 * KS_PITCH * 2, ATT_RP = ATT_VS + 2 * 128 * VS_PITCH * 2, ATT_END = ATT_RP + 2048;
static_assert(ATT_END <= 131072, "attention LDS");
__device__ __forceinline__ void attn_phase2(LAS unsigned char* lds, const AttArgs& aa, int G) {
    const int tid = opaque_tid(), lane = tid & 63, w = tid >> 6, fr = lane & 15, fq = lane >> 4;
    const int rsel = w >> 2, qg = w & 3;
    LAS bf16* KS = (LAS bf16*)(lds + ATT_KS);
    LAS bf16* VS = (LAS bf16*)(lds + ATT_VS);
    LAS float* rp = (LAS float*)(lds + ATT_RP);
    const int c0 = 16 * qg, kb0 = (qg == 0) ? 0 : (qg == 1) ? 8 : (qg == 2) ? 24 : 32;
    const int qc = c0 + fr;
    const int cs = min(max(qc - 8, 0), 48);
    const int krow = 8 * (fr >> 2) + (fr & 3);
    const int ktok0 = tid >> 4, kpart = tid & 15, vd0 = tid >> 3, vpart = tid & 7;
    for (int id = blockIdx.x; id < 64 * NHEAD; id += G) {
        const int h = id & 15, rpair = id >> 4, r0 = 2 * rpair;
        const int rsA = min(max(r0 - 4, 0), 120), rsB = min(max(r0 - 3, 0), 120), off = rsB - rsA, nJ = 8 + off;
        const int r = r0 + rsel, rs = rsel ? rsB : rsA, woff = rsel ? off : 0;
        u32x4 R[9][2];
#pragma unroll
        for (int jj = 0; jj < 9; ++jj) { R[jj][0] = (u32x4){0u, 0u, 0u, 0u}; R[jj][1] = (u32x4){0u, 0u, 0u, 0u}; }
        const bf16* kbase = aa.K + (size_t)(rsA * 64 + ktok0) * DM + h * 128 + kpart * 8;
        const bf16* vbase = aa.VT + (size_t)(h * 128 + vd0) * SEQ + rsA * 64 + vpart * 8;
#pragma unroll
        for (int jj = 0; jj < 9; ++jj) if (jj < nJ) {
#pragma unroll
            for (int u = 0; u < 2; ++u) R[jj][u] = *(const u32x4*)(kbase + (size_t)(jj * 64 + 32 * u) * DM);
        }
        for (int i = tid; i < 465; i += NTHREADS) rp[i] = aa.rpb[(size_t)h * 465 + i];
        bf16x8 qf[4];
        { const bf16* qp = aa.Q + (size_t)(r * 64 + qc) * DM + h * 128 + 8 * fq;
#pragma unroll
          for (int k = 0; k < 4; ++k) qf[k] = *(const bf16x8*)(qp + 32 * k); }
#define ATT_KWRITE(j, b) do { _Pragma("unroll") for (int u = 0; u < 2; ++u) *(LAS u32x4*)(KS + (b) * 64 * KS_PITCH + (ktok0 + 32 * u) * KS_PITCH + kpart * 8) = R[j][u]; } while (0)
#define ATT_VLOAD(j) do { _Pragma("unroll") for (int u = 0; u < 2; ++u) R[j][u] = *(const u32x4*)(vbase + (size_t)(64 * u) * SEQ + (j) * 64); } while (0)
#define ATT_VWRITE(j, b) do { _Pragma("unroll") for (int u = 0; u < 2; ++u) *(LAS u32x4*)(VS + (b) * 128 * VS_PITCH + (vd0 + 64 * u) * VS_PITCH + vpart * 8) = R[j][u]; } while (0)
#define ATT_QK(i, b) do { _Pragma("unroll") for (int nb = 0; nb < 2; ++nb) { f32x4 c_ = (f32x4){0.f, 0.f, 0.f, 0.f}; \
            _Pragma("unroll") for (int k = 0; k < 4; ++k) { const bf16x8 kf = *(const LAS bf16x8*)(KS + (b) * 64 * KS_PITCH + (kb0 + krow + 4 * nb) * KS_PITCH + 32 * k + 8 * fq); \
                c_ = __builtin_amdgcn_mfma_f32_16x16x32_bf16(kf, qf[k], c_, 0, 0, 0); } s[i][nb] = c_; } } while (0)
#define ATT_PV(i, b) do { u32x4 pw; pw.x = cvt_pk(s[i][0][0], s[i][0][1]); pw.y = cvt_pk(s[i][0][2], s[i][0][3]); pw.z = cvt_pk(s[i][1][0], s[i][1][1]); pw.w = cvt_pk(s[i][1][2], s[i][1][3]); \
            const bf16x8 pb = __builtin_bit_cast(bf16x8, pw); \
            _Pragma("unroll") for (int db = 0; db < 8; ++db) { const bf16x8 vf = *(const LAS bf16x8*)(VS + (b) * 128 * VS_PITCH + (16 * db + fr) * VS_PITCH + kb0 + 8 * fq); \
                o[db] = __builtin_amdgcn_mfma_f32_16x16x32_bf16(vf, pb, o[db], 0, 0, 0); } } while (0)
        f32x4 s[8][2];
        ATT_KWRITE(0, 0); ATT_VLOAD(0);
        ATT_BAR();
#pragma unroll
        for (int jj = 0; jj < 9; ++jj) {
            if (jj + 1 < 9) { if (jj + 1 < nJ) { ATT_KWRITE((jj + 1 < 9 ? jj + 1 : 8), ((jj + 1) & 1)); ATT_VLOAD((jj + 1 < 9 ? jj + 1 : 8)); } }
            if (woff == 0) { if (jj < 8) ATT_QK((jj < 8 ? jj : 7), (jj & 1)); }
            else           { if (jj >= 1) ATT_QK((jj >= 1 ? jj - 1 : 0), (jj & 1)); }
            ATT_BAR();
        }
        float mx = -INFINITY;
#pragma unroll
        for (int i = 0; i < 8; ++i) {
            const int relr = rs + i - r + 7;
#pragma unroll
            for (int nb = 0; nb < 2; ++nb)
#pragma unroll
                for (int j = 0; j < 4; ++j) {
                    const int kc = kb0 + 8 * fq + 4 * nb + j;
                    const bool valid = (unsigned)(kc - cs) < 16u;
                    const int idx = valid ? relr * 31 + (kc - qc + 15) : 0;
                    const float v = valid ? s[i][nb][j] + rp[idx] : -INFINITY;
                    s[i][nb][j] = v; mx = fmaxf(mx, v);
                }
        }
        mx = fmaxf(mx, __shfl_xor(mx, 16)); mx = fmaxf(mx, __shfl_xor(mx, 32));
        float l = 0.f;
#pragma unroll
        for (int i = 0; i < 8; ++i)
#pragma unroll
            for (int nb = 0; nb < 2; ++nb)
#pragma unroll
                for (int j = 0; j < 4; ++j) { const float p = __expf(s[i][nb][j] - mx); s[i][nb][j] = p; l += p; }
        l += __shfl_xor(l, 16); l += __shfl_xor(l, 32);
        f32x4 o[8];
#pragma unroll
        for (int db = 0; db < 8; ++db) o[db] = (f32x4){0.f, 0.f, 0.f, 0.f};
        ATT_VWRITE(0, 0);
        ATT_BAR();
#pragma unroll
        for (int jj = 0; jj < 9; ++jj) {
            if (jj + 1 < 9) { if (jj + 1 < nJ) ATT_VWRITE((jj + 1 < 9 ? jj + 1 : 8), ((jj + 1) & 1)); }
            if (woff == 0) { if (jj < 8) ATT_PV((jj < 8 ? jj : 7), (jj & 1)); }
            else           { if (jj >= 1) ATT_PV((jj >= 1 ? jj - 1 : 0), (jj & 1)); }
            ATT_BAR();
        }
        const float inv = 1.f / l;
        bf16* op = aa.O + (size_t)(r * 64 + qc) * DM + h * 128 + 4 * fq;
#pragma unroll
        for (int db = 0; db < 8; ++db) { u32x2 wv; wv.x = cvt_pk(o[db][0] * inv, o[db][1] * inv); wv.y = cvt_pk(o[db][2] * inv, o[db][3] * inv); *(u32x2*)(op + 16 * db) = wv; }
#undef ATT_KWRITE
#undef ATT_VLOAD
#undef ATT_VWRITE
#undef ATT_QK
#undef ATT_PV
    }
}

__device__ __forceinline__ void final_phase(float* out, const float* ss, const float* g, int G) {
    const int tid = opaque_tid(), lane = tid & 63, wave = tid >> 6;
    const int gw = blockIdx.x * NWAVES + wave, NGW = G * NWAVES;
    for (int row = gw; row < SEQ; row += NGW) {
        const float rs = pg8::rstd_row(ss, row);
        f32x4* o = (f32x4*)(out + (size_t)row * DM) + lane; const f32x4* gp = (const f32x4*)g + lane;
#pragma unroll
        for (int j = 0; j < 8; ++j) { f32x4 v = o[64 * j]; const f32x4 gv = gp[64 * j]; v = v * rs * gv; o[64 * j] = v; }
    }
}

#define XB_TMO      128
#define XB_XCNT(j)  (256  + 64 * (j))
#define XB_XSUB(j)  (1280 + 64 * (j))
#define XB_XGEN(j)  (2304 + 64 * (j))
#define XB_TOP      3328
#define XB_TOPGEN   3392
#define XCD_BAR_WORDS 3456
#define XB_SPIN_CAP (1u << 18)

__device__ __forceinline__ unsigned xb_ld(unsigned* p)              { return __hip_atomic_load(p, __ATOMIC_RELAXED, __HIP_MEMORY_SCOPE_AGENT); }
__device__ __forceinline__ unsigned xb_add(unsigned* p, unsigned v) { return __hip_atomic_fetch_add(p, v, __ATOMIC_RELAXED, __HIP_MEMORY_SCOPE_AGENT); }
__device__ __forceinline__ unsigned xb_xcc_id() { return (unsigned)__builtin_amdgcn_s_getreg((3 << 11) | 20) & 0xFu; }
#define XB_SPIN(cond, bar) do { unsigned _sp = 0; while (cond) { __builtin_amdgcn_s_sleep(1); \
    if ((++_sp & 255u) == 0u) { if (xb_ld(&(bar)[XB_TMO])) break; if (_sp > XB_SPIN_CAP) { atomicAdd(&(bar)[XB_TMO], 1u); break; } } } } while (0)

struct XcdBarrier {
    unsigned* bar; unsigned x;
    volatile LAS unsigned* st;
};

__device__ __forceinline__ XcdBarrier xcd_barrier_post(unsigned* bar, volatile LAS unsigned* st) {
    XcdBarrier b; b.bar = bar; b.x = xb_xcc_id(); b.st = st;
    if (threadIdx.x == 0) (void)xb_add(&bar[XB_XCNT(b.x)], 1u);
    return b;
}
__device__ __forceinline__ void xcd_barrier_complete(unsigned* bar, unsigned x, unsigned& nloc, unsigned& nx) {
    const unsigned G = gridDim.x * gridDim.y * gridDim.z;
    unsigned sum, cnt, mine, sp = 0u;
    for (;;) {
        sum = 0u; cnt = 0u; mine = 0u;
#pragma unroll
        for (unsigned j = 0; j < 16; ++j) { const unsigned c = xb_ld(&bar[XB_XCNT(j)]); sum += c; cnt += (c > 0u) ? 1u : 0u; mine = (j == x) ? c : mine; }
        if (sum == G) break;
        __builtin_amdgcn_s_sleep(1);
        if ((++sp & 255u) == 0u) { if (xb_ld(&bar[XB_TMO])) break; if (sp > XB_SPIN_CAP) { atomicAdd(&bar[XB_TMO], 1u); break; } }
    }
    nloc = mine > 0u ? mine : 1u; nx = cnt > 0u ? cnt : 1u;
}

__device__ __forceinline__ void xcd_barrier(const XcdBarrier& b) {
    asm volatile("s_waitcnt vmcnt(0)" ::: "memory");
    __syncthreads();
    if (threadIdx.x == 0) {
        unsigned* bar = b.bar;
        __builtin_amdgcn_s_waitcnt(0);
        unsigned nloc = b.st[0], nx = b.st[1];
        if (nloc == 0u) { xcd_barrier_complete(bar, b.x, nloc, nx); b.st[0] = nloc; b.st[1] = nx; }
        const unsigned old = xb_add(&bar[XB_XSUB(b.x)], 1u);
        const unsigned gen = old / nloc;
        if (old + 1u == (gen + 1u) * nloc) {
            __builtin_amdgcn_fence(__ATOMIC_RELEASE, "agent");
            asm volatile("s_waitcnt vmcnt(0)" ::: "memory");
            const unsigned og = xb_add(&bar[XB_TOP], 1u);
            const unsigned tg = og / nx;
            if (og + 1u == (tg + 1u) * nx) xb_add(&bar[XB_TOPGEN], 1u);
            else XB_SPIN(xb_ld(&bar[XB_TOPGEN]) == tg, bar);
            __builtin_amdgcn_fence(__ATOMIC_ACQUIRE, "agent");
            xb_add(&bar[XB_XGEN(b.x)], 1u);
            asm volatile("s_waitcnt vmcnt(0)" ::: "memory");
        } else {
            XB_SPIN(xb_ld(&bar[XB_XGEN(b.x)]) == gen, bar);
            __builtin_amdgcn_fence(__ATOMIC_ACQUIRE, "agent");
            asm volatile("s_waitcnt vmcnt(0)" ::: "memory");
        }
    }
    __syncthreads();
}

constexpr int LDS_TAB = 131072 + 1024;
__device__ __forceinline__ void fill_rstd_tab(LAS unsigned char* lds, const float* ssp, int t) {
    LAS float* tab = (LAS float*)(lds + LDS_TAB);
    const int tid = opaque_tid();
    if (tid < 256) tab[tid] = pg8::rstd_row(ssp, t * 256 + tid);
    __syncthreads();
}
constexpr int N_PHASES = 28;
#ifndef PGA
#define PGA true
#endif
#ifndef PGA1
#define PGA1 true
#endif
#ifndef PGS
#define PGS true
#endif
#ifndef DBG_DUMP_OFF
#define DBG_DUMP_OFF WS_BC
#endif
#ifndef DBG_NPH
#define DBG_NPH N_PHASES
#endif
#ifndef DBG_DUMP
#define DBG_DUMP 0
#endif
enum Kind { K_P0, K_WIN, K_S1, K_S2, K_WOUT, K_QKV, K_ATT, K_W1, K_W2, K_PLE, K_FINAL, K_DUMP };

__global__ void __launch_bounds__(NTHREADS, 2) mega_fwd(Args args) {
    extern __shared__ __attribute__((aligned(16))) unsigned char lds_raw[];
    LAS unsigned char* lds = (LAS unsigned char*)lds_raw;
    cg::grid_group grid = cg::this_grid();
    const int G = gridDim.x;
    KA ka0 = (KA)__builtin_amdgcn_kernarg_segment_ptr();
    const int lo = *(const int __attribute__((address_space(4)))*)(ka0 + 192), hi = *(const int __attribute__((address_space(4)))*)(ka0 + 196);
    if (hi - lo > 1) {
        volatile LAS unsigned* st = (volatile LAS unsigned*)(lds + 131072 + 64);
        if (threadIdx.x < 2) st[threadIdx.x] = 0u;
        __syncthreads();
        unsigned char* ws0 = *(unsigned char* const __attribute__((address_space(4)))*)(ka0 + 184);
        (void)xcd_barrier_post((unsigned*)(ws0 + WS_BAR), st);
    }
    if (hi > 100000) grid.sync();
    for (int ph = lo; ph < hi; ++ph) {
        KA ka = ka0; asm volatile("" : "+s"(ka));
        unsigned char* ws = *(unsigned char* const __attribute__((address_space(4)))*)(ka + 184);
        float* hout = *(float* const __attribute__((address_space(4)))*)(ka + 176);
        float* ss = (float*)(ws + WS_SS);
        int kind, L = 0;
        if (ph == 0) kind = K_P0; else if (ph == 99) kind = K_DUMP; else if (ph == N_PHASES - 1) kind = K_FINAL;
        else { int q = ph - 1; const int pair = q / 13; q -= pair * 13; L = 2 * pair;
            if (q < 7) { kind = (q == 0) ? K_WIN : (q == 1) ? K_S1 : (q == 2) ? K_S2 : (q == 3) ? K_WOUT : (q == 4) ? K_W1 : (q == 5) ? K_W2 : K_PLE; }
            else { q -= 7; L += 1; kind = (q == 0) ? K_QKV : (q == 1) ? K_ATT : (q == 2) ? K_WOUT : (q == 3) ? K_W1 : (q == 4) ? K_W2 : K_PLE; } }
        const int j = L >> 1;
        bf16* Xc = (bf16*)(ws + ((L & 1) ? WS_X1 : WS_X0));
        bf16* Xo = (bf16*)(ws + ((L & 1) ? WS_X0 : WS_X1));
        const float* ss_mix = ss + (size_t)(3 * L) * SEQ * 32; float* ss_mlp = ss + (size_t)(3 * L + 1) * SEQ * 32; float* ss_ple = ss + (size_t)(3 * L + 2) * SEQ * 32; float* ss_next = ss + (size_t)(3 * L + 3) * SEQ * 32;
        switch (kind) {
        case K_P0:
#ifndef DIS_P0
 p0_phase(lds, ka, ws, G);
#endif
 break;
        case K_WIN: {
#ifdef DBG_BJ0
            pg8::Gemm g{Xc, (const bf16*)(ws + WS_WINT), SEQ, 2 * DM, DM};
#elif defined(DBG_AX1)
            pg8::Gemm g{(L == 2) ? Xo : Xc, (const bf16*)(ws + WS_WINT) + (size_t)j * DM * 2 * DM, SEQ, 2 * DM, DM};
#else
            pg8::Gemm g{Xc, (const bf16*)(ws + WS_WINT) + (size_t)j * DM * 2 * DM, SEQ, 2 * DM, DM};
#endif
            pg8::StaticOrder S; S.init(SEQ, 2 * DM, G, (int)blockIdx.x);
#ifdef DBG_FRESHOUT

#elif defined(DBG_SS0)

#else
            pg8::Unit u0; S.next(0, u0); fill_rstd_tab(lds, ss_mix, u0.pm);
            pg8::EpiAct<0> E{(bf16*)(ws + WS_BA), (bf16*)(ws + WS_BB), DM, DM, ss_mix, (const LAS float*)(lds + LDS_TAB), u0.pm};
#endif
#ifndef DIS_ACT0
            pg8::gemm_phase<pg8::EpiAct<0>, pg8::StaticOrder, PGA, PGS>(lds, g, S, E);
#endif
        } break;
        case K_S1: case K_S2: {
            ScanArgs sa{(const bf16*)(ws + WS_BA), (const bf16*)(ws + WS_BB), (bf16*)(ws + WS_BC),
                        INP(7) + (size_t)j * 4 * DM, INP(8) + (size_t)j * DM,
                        (const bf16*)(ws + WS_GAT) + (size_t)j * 32 * 128 * 128, (const bf16*)(ws + WS_GXT) + (size_t)j * 32 * 128 * 128,
                        INP(10) + (size_t)j * 2 * DM, INP(12) + (size_t)j * 2 * DM, INP(13) + (size_t)j * 2 * DM,
                        (f32x2*)(ws + WS_AGG)};
            #ifndef DIS_SCAN
            if (kind == K_S1) scan_phase<false>(lds, sa, G); else scan_phase<true>(lds, sa, G);
#endif
        } break;
        case K_QKV: {
            {
                pg8::Gemm g{Xc, (const bf16*)(ws + WS_WQKVT) + (size_t)j * 3 * DM * DM, SEQ, 2 * DM, DM};
                pg8::StaticOrder S; S.init(SEQ, 2 * DM, G, (int)blockIdx.x);
                pg8::Unit u0; S.next(0, u0); fill_rstd_tab(lds, ss_mix, u0.pm);
                pg8::EpiAct<1> E{(bf16*)(ws + WS_BA), (bf16*)(ws + WS_BB), DM, DM, ss_mix, (const LAS float*)(lds + LDS_TAB), u0.pm};
#ifndef DIS_ACT1
                pg8::gemm_phase<pg8::EpiAct<1>, pg8::StaticOrder, PGA, PGS>(lds, g, S, E);
#endif
            }
            __syncthreads();
            {
                pg8::Gemm g{(const bf16*)(ws + WS_WQKVT) + (size_t)j * 3 * DM * DM + (size_t)2 * DM * DM, Xc, DM, SEQ, DM};
                pg8::StaticOrder S; S.init(DM, SEQ, G, (int)blockIdx.x);
                pg8::Unit u0; S.next(0, u0); fill_rstd_tab(lds, ss_mix, u0.pn);
                pg8::EpiAct<4> E{(bf16*)(ws + WS_BD), nullptr, SEQ, 0, ss_mix, (const LAS float*)(lds + LDS_TAB), u0.pn};
#ifndef DIS_ACT4
                pg8::gemm_phase<pg8::EpiAct<4>, pg8::StaticOrder, PGA1, PGS>(lds, g, S, E);
#endif
            }
        } break;
        case K_ATT: {
            AttArgs aa{(const bf16*)(ws + WS_BA), (const bf16*)(ws + WS_BB), (const bf16*)(ws + WS_BD), (bf16*)(ws + WS_BC), INP(16) + (size_t)j * NHEAD * 465};
#ifndef DIS_ATT
#ifdef ATT_V1
            attn_phase(lds, aa, G);
#else
            attn_phase2(lds, aa, G);
#endif
#endif
        } break;
        case K_WOUT: case K_W2: {
            const bf16* A; const bf16* Bt; int K;
            float* sso; bf16* hb;
            if (kind == K_WOUT) { A = (const bf16*)(ws + WS_BC); K = DM; Bt = (L & 1) ? (const bf16*)(ws + WS_WONT) + (size_t)j * DM * DM : (const bf16*)(ws + WS_WORT) + (size_t)j * DM * DM; sso = ss_mlp; hb = Xo; }
            else { A = (const bf16*)(ws + WS_A1); K = DFF; Bt = (const bf16*)(ws + WS_W2T) + (size_t)L * DM * DFF; sso = ss_ple; hb = Xc; }
            const float* base = (kind == K_WOUT && L == 0) ? INP(0) : hout;
            pg8::Gemm g{A, Bt, SEQ, DM, K};
            pg8::StaticOrder S; S.init(SEQ, DM, G, (int)blockIdx.x);
            pg8::EpiRes<0> E{base, hout, hb, sso, nullptr, nullptr, (const LAS float*)(lds + LDS_TAB), -1};
#ifndef DIS_RES0
            pg8::gemm_phase<pg8::EpiRes<0>, pg8::StaticOrder, PGA1, PGS>(lds, g, S, E);
#endif
        } break;
        case K_W1: {
            {
                int Kp = PLE; asm volatile("" : "+s"(Kp));
                pg8::Gemm g{(const bf16*)(ws + WS_PB) + (size_t)L * SEQ * PLE, (const bf16*)(ws + WS_WPT) + (size_t)L * DM * PLE, SEQ, DM, Kp};
                pg8::StaticOrder S; S.init(SEQ, DM, G, (int)blockIdx.x);
                pg8::EpiAct<3> E{(bf16*)(ws + WS_PROJ) + (size_t)L * SEQ * DM, nullptr, DM, 0, nullptr, (const LAS float*)(lds + LDS_TAB), -1};
#ifndef DIS_ACT3
                pg8::gemm_phase<pg8::EpiAct<3>, pg8::StaticOrder, PGA1, PGS>(lds, g, S, E);
#endif
            }
            __syncthreads();
            pg8::Gemm g{Xo, (const bf16*)(ws + WS_W1T) + (size_t)L * DM * DFF, SEQ, DFF, DM};
            pg8::StaticOrder S; S.init(SEQ, DFF, G, (int)blockIdx.x);
            pg8::Unit u0; S.next(0, u0); fill_rstd_tab(lds, ss_mlp, u0.pm);
            pg8::EpiAct<2> E{(bf16*)(ws + WS_A1), nullptr, DFF, 0, ss_mlp, (const LAS float*)(lds + LDS_TAB), u0.pm};
#ifndef DIS_ACT2
            pg8::gemm_phase<pg8::EpiAct<2>, pg8::StaticOrder, PGA, PGS>(lds, g, S, E);
#endif
        } break;
        case K_PLE: {
            pg8::Gemm g{Xc, (const bf16*)(ws + WS_WGT) + (size_t)L * DM * DM, SEQ, DM, DM};
            pg8::StaticOrder S; S.init(SEQ, DM, G, (int)blockIdx.x);
            pg8::Unit u0; S.next(0, u0); fill_rstd_tab(lds, ss_ple, u0.pm);
            pg8::EpiRes<1> E{hout, hout, Xo, ss_next, ss_ple, (const bf16*)(ws + WS_PROJ) + (size_t)L * SEQ * DM, (const LAS float*)(lds + LDS_TAB), u0.pm};
#ifndef DIS_RES1
            pg8::gemm_phase<pg8::EpiRes<1>, pg8::StaticOrder, PGA1, PGS>(lds, g, S, E);
#endif
        } break;
#if DBG_DUMP
        case K_DUMP: {
            const bf16* src = (const bf16*)(ws + DBG_DUMP_OFF); const float* srcf = (const float*)(ws + DBG_DUMP_OFF);
            for (size_t i = (size_t)blockIdx.x * NTHREADS + threadIdx.x; i < (size_t)SEQ * DM; i += (size_t)G * NTHREADS) hout[i] = (DBG_DUMP == 2) ? srcf[i & 8191] : bfl((unsigned)src[i]);
        } break;
#endif
        case K_FINAL: final_phase(hout, ss + (size_t)12 * SEQ * 32, INP(5), G); break;
        }
        if (ph + 1 < hi) { XcdBarrier b; b.bar = (unsigned*)(ws + WS_BAR); b.x = xb_xcc_id(); b.st = (volatile LAS unsigned*)(lds + 131072 + 64); xcd_barrier(b); }
    }
}

#ifndef MK_MULTI
#define MK_MULTI 0
#endif

extern "C" void kernel_launch(void* const* d_in, const int* in_sizes, int n_in, void* d_out, int out_size, void* d_ws, size_t ws_size, hipStream_t stream) {
    static int grid = 0;
    if (grid == 0) {
        if (n_in != 22 || out_size != SEQ * DM || ws_size < WS_END) { fprintf(stderr, "kernel_launch: unexpected shapes (n_in %d out %d ws %zu)\n", n_in, out_size, ws_size); grid = -1; return; }
        int dev = 0, cus = 0, per_cu = 0;
        (void)hipGetDevice(&dev); (void)hipDeviceGetAttribute(&cus, hipDeviceAttributeMultiprocessorCount, dev);
        if (hipFuncSetAttribute((const void*)mega_fwd, hipFuncAttributeMaxDynamicSharedMemorySize, LDS_BYTES) != hipSuccess) { fprintf(stderr, "kernel_launch: hipFuncSetAttribute failed\n"); grid = -1; return; }
        if (hipOccupancyMaxActiveBlocksPerMultiprocessor(&per_cu, (const void*)mega_fwd, NTHREADS, LDS_BYTES) != hipSuccess || per_cu < 1) { fprintf(stderr, "kernel_launch: occupancy query says %d\n", per_cu); per_cu = 1; }
        (void)hipGetLastError();
        grid = cus * per_cu; if (grid > 256) grid = 256;
        fprintf(stderr, "kernel_launch: grid %d (cus %d per_cu %d)\n", grid, cus, per_cu);
    }
    if (grid < 0) return;
    Args a{};
    for (int i = 0; i < 22; ++i) a.in[i] = (const float*)d_in[i];
    a.out = (float*)d_out; a.ws = (unsigned char*)d_ws;
#if MK_MULTI
#ifdef DBG_SEQ
    { const int seq[] = {DBG_SEQ}; for (int ph : seq) { a.ph_lo = ph; a.ph_hi = ph + 1; hipLaunchKernelGGL(mega_fwd, dim3(grid), dim3(NTHREADS), LDS_BYTES, stream, a); } }
#else
    for (int ph = 0; ph < DBG_NPH; ++ph) { a.ph_lo = ph; a.ph_hi = ph + 1; hipLaunchKernelGGL(mega_fwd, dim3(grid), dim3(NTHREADS), LDS_BYTES, stream, a); }
#endif
    if (DBG_DUMP) { a.ph_lo = 99; a.ph_hi = 100; hipLaunchKernelGGL(mega_fwd, dim3(grid), dim3(NTHREADS), LDS_BYTES, stream, a); }
#else
    a.ph_lo = 0; a.ph_hi = N_PHASES;
    if (hipMemsetAsync((char*)d_ws + WS_BAR, 0, 16384, stream) != hipSuccess) { fprintf(stderr, "kernel_launch: memset of the barrier words failed\n"); return; }
    void* kargs[] = {&a};
    hipError_t e = hipLaunchCooperativeKernel((const void*)mega_fwd, dim3(grid), dim3(NTHREADS), kargs, LDS_BYTES, stream);
    if (e != hipSuccess) fprintf(stderr, "kernel_launch: cooperative launch failed: %s (grid %d)\n", hipGetErrorString(e), grid);
#endif
}
```

```cpp
#include <hip/hip_runtime.h>
#include <hip/hip_cooperative_groups.h>
#include <cstdio>
#include <cstdint>
namespace cg = cooperative_groups;
namespace pg8 {
#define PG8_LAS __attribute__((address_space(3)))
typedef unsigned short bf16_t;
typedef short bf16x8 __attribute__((ext_vector_type(8)));
typedef float f32x4 __attribute__((ext_vector_type(4)));
typedef unsigned u32x4 __attribute__((ext_vector_type(4)));
constexpr int BM = 256, BK = 64, HALF = 128, HTB = HALF * BK * 2  , STAGE_BYTES = 8 * HTB, NXCD = 8, WGM = 8;

__host__ __device__ __forceinline__ int lds_byte(int r, int c) { const int st = (r >> 4) * 2 + (c >> 5), rr = r & 15, cc = c & 31, ob = rr * 64 + cc * 2; return st * 1024 + (ob ^ (((ob >> 9) & 1) << 5)); }
__host__ __device__ __forceinline__ void stage_rc(int b, int& R, int& C) { const int st = b / 1024, sb = b % 1024, swz = sb ^ (((sb >> 9) & 1) << 5); R = (st >> 1) * 16 + swz / 64; C = (st & 1) * 32 + (swz % 64) / 2; }
__host__ __device__ __forceinline__ int perm32(int rho) { const int n = rho >> 4, i = rho & 15; return 8 * (i >> 2) + 4 * n + (i & 3); }

struct Unit { int pm, pn; };
struct Gemm { const bf16_t* A; const bf16_t* Bt; int M, N, K; };

struct StaticOrder {
    int nM, nN, nwg, G, c;
    __host__ __device__ void init(int M, int N, int G_, int c_) { nM = M / BM; nN = N / BM; nwg = nM * nN; G = G_; c = c_; }
    __host__ __device__ bool next(int i, Unit& u) const {
        const long L = (long)i * G + c; if (L >= nwg) return false;
        int wgid = (int)L; { const int q = nwg / NXCD, r = nwg % NXCD, xcd = wgid % NXCD, off = wgid / NXCD; wgid = (xcd < r ? xcd * (q + 1) : r * (q + 1) + (xcd - r) * q) + off; }
        const int nig = WGM * nN, gid = wgid / nig, fm = gid * WGM, gsz = (nM - fm) < WGM ? (nM - fm) : WGM;
        u.pm = fm + ((wgid % nig) % gsz); u.pn = (wgid % nig) / gsz; return true;
    }
    __device__ __forceinline__ void a_ready(const Unit&) const {}
    __device__ __forceinline__ void done(const Unit&) const {}
};

__device__ __forceinline__ unsigned cvt_pk_bf16(float lo, float hi) { unsigned r; asm volatile("v_cvt_pk_bf16_f32 %0, %1, %2" : "=v"(r) : "v"(lo), "v"(hi)); return r; }
typedef float f32x2 __attribute__((ext_vector_type(2)));
constexpr float RMS_EPS = 1e-6f;
constexpr int DM = 2048;
__device__ __forceinline__ float fsigmoid(float x) { return __builtin_amdgcn_rcpf(1.f + __expf(-x)); }
__device__ __forceinline__ float gelu_tanh(float v) { return v * fsigmoid(1.5957691216057308f * (v + 0.044715f * v * v * v)); }
__device__ __forceinline__ float rstd_row(const float* ssp, int row) {
    const f32x4* p = (const f32x4*)(ssp + (size_t)row * 32); float s = 0.f;
#pragma unroll
    for (int i = 0; i < 8; ++i) { const f32x4 v = p[i]; s += (v[0] + v[1]) + (v[2] + v[3]); }
    return rsqrtf(s * (1.f / DM) + RMS_EPS);
}
__device__ __forceinline__ float bf_lo(unsigned w) { return __uint_as_float(w << 16); }
__device__ __forceinline__ float bf_hi(unsigned w) { return __uint_as_float(w & 0xffff0000u); }

template <int MODE> struct EpiAct {
    static constexpr bool PERM = true, AFTER_DRAIN = false;
    bf16_t* O0; bf16_t* O1; int ldc; int split; const float* ss; const PG8_LAS float* tab; int tab_t;
    __device__ __forceinline__ void operator()(const f32x4 (&acc)[2][2][4][2], const Unit& u, int wr, int wc, int fr, int fq) const {
        const int row0 = u.pm * BM + wr * 64 + fr; int colt = u.pn * BM; bf16_t* base = O0; bool second = false;
        if (MODE <= 1) { if (colt >= split) { base = O1; colt -= split; second = true; } }
        const int col0 = colt + wc * 32 + 8 * fq;
        f32x4 cs[2][2];
        if (MODE == 4) {
#pragma unroll
            for (int bj = 0; bj < 2; ++bj)
#pragma unroll
                for (int n = 0; n < 2; ++n) {
#pragma unroll
                    for (int e = 0; e < 4; ++e) cs[bj][n][e] = (u.pn == tab_t) ? tab[col0 - u.pn * BM + bj * HALF + 4 * n + e] : rstd_row(ss, col0 + bj * HALF + 4 * n + e); }
        }
#pragma unroll
        for (int ai = 0; ai < 2; ++ai)
#pragma unroll
            for (int m = 0; m < 4; ++m) {
                const int row = row0 + ai * HALF + m * 16;
                float rs = 1.f;
                if (MODE <= 2) { rs = (u.pm == tab_t) ? tab[row - u.pm * BM] : rstd_row(ss, row); if (MODE == 1 && !second) rs *= 0.08838834764831845f; }
                bf16_t* rowp = base + (size_t)row * ldc + col0;
#pragma unroll
                for (int bj = 0; bj < 2; ++bj) {
                    f32x4 v0 = acc[ai][bj][m][0], v1 = acc[ai][bj][m][1];
                    if (MODE == 4) { v0 = v0 * cs[bj][0]; v1 = v1 * cs[bj][1]; } else { v0 = v0 * rs; v1 = v1 * rs; }
                    if (MODE == 0) { if (second) {
#pragma unroll
                        for (int e = 0; e < 4; ++e) { v0[e] = gelu_tanh(v0[e]); v1[e] = gelu_tanh(v1[e]); } } }
                    if (MODE == 2) {
#pragma unroll
                        for (int e = 0; e < 4; ++e) { const float a = fmaxf(v0[e], 0.f), b = fmaxf(v1[e], 0.f); v0[e] = a * a; v1[e] = b * b; } }
                    u32x4 w; w.x = cvt_pk_bf16(v0[0], v0[1]); w.y = cvt_pk_bf16(v0[2], v0[3]); w.z = cvt_pk_bf16(v1[0], v1[1]); w.w = cvt_pk_bf16(v1[2], v1[3]);
                    *(u32x4*)(rowp + bj * HALF) = w;
                }
                asm volatile("" ::: "memory");
            }
    }
};

template <int MODE> struct EpiRes {
    static constexpr bool PERM = true, AFTER_DRAIN = false;
    const float* base; float* out; bf16_t* hb; float* ss_out; const float* ss_in; const bf16_t* proj; const PG8_LAS float* tab; int tab_t;
    __device__ __forceinline__ void operator()(const f32x4 (&acc)[2][2][4][2], const Unit& u, int wr, int wc, int fr, int fq) const {
        const int row0 = u.pm * BM + wr * 64 + fr; const int col0 = u.pn * BM + wc * 32 + 8 * fq;
#pragma unroll
        for (int aim = 0; aim < 4; ++aim) { const int ai = aim >> 1, mh = (aim & 1) * 2;
            f32x4 bpre[2][2][2]; u32x4 ppre[2][2];
#pragma unroll
            for (int mm = 0; mm < 2; ++mm) { const int m = mh + mm; const size_t off = (size_t)(row0 + ai * HALF + m * 16) * DM + col0;
#pragma unroll
                for (int bj = 0; bj < 2; ++bj) { bpre[mm][bj][0] = *(const f32x4*)(base + off + bj * HALF); bpre[mm][bj][1] = *(const f32x4*)(base + off + bj * HALF + 4);
                    if (MODE == 1) ppre[mm][bj] = *(const u32x4*)(proj + off + bj * HALF); } }
#pragma unroll
            for (int mm = 0; mm < 2; ++mm) { const int m = mh + mm;
                const int row = row0 + ai * HALF + m * 16; const size_t off = (size_t)row * DM + col0;
                float rs = 0.f; if (MODE == 1) rs = (u.pm == tab_t) ? tab[row - u.pm * BM] : rstd_row(ss_in, row);
                float sq = 0.f;
#pragma unroll
                for (int bj = 0; bj < 2; ++bj) {
                    const f32x4 b0 = bpre[mm][bj][0], b1 = bpre[mm][bj][1];
                    f32x4 v0 = acc[ai][bj][m][0], v1 = acc[ai][bj][m][1];
                    if (MODE == 1) {
                        const u32x4 pw = ppre[mm][bj];
                        const f32x4 p0 = (f32x4){bf_lo(pw.x), bf_hi(pw.x), bf_lo(pw.y), bf_hi(pw.y)}, p1 = (f32x4){bf_lo(pw.z), bf_hi(pw.z), bf_lo(pw.w), bf_hi(pw.w)};
#pragma unroll
                        for (int e = 0; e < 4; ++e) { v0[e] = fsigmoid(v0[e] * rs) * p0[e]; v1[e] = fsigmoid(v1[e] * rs) * p1[e]; }
                    }
                    const f32x4 o0 = b0 + v0, o1 = b1 + v1;
                    *(f32x4*)(out + off + bj * HALF) = o0; *(f32x4*)(out + off + bj * HALF + 4) = o1;
                    u32x4 w; w.x = cvt_pk_bf16(o0[0], o0[1]); w.y = cvt_pk_bf16(o0[2], o0[3]); w.z = cvt_pk_bf16(o1[0], o1[1]); w.w = cvt_pk_bf16(o1[2], o1[3]);
                    *(u32x4*)(hb + off + bj * HALF) = w;
                    sq += (o0[0] * o0[0] + o0[1] * o0[1]) + (o0[2] * o0[2] + o0[3] * o0[3]) + (o1[0] * o1[0] + o1[1] * o1[1]) + (o1[2] * o1[2] + o1[3] * o1[3]);
                }
                sq += __shfl_xor(sq, 16); sq += __shfl_xor(sq, 32);
                if (fq == 0) ss_out[(size_t)row * 32 + u.pn * 4 + wc] = sq;
            }
            asm volatile("" ::: "memory");
        }
    }
};

template <class Epi, class Sched, bool ALIGN_EPI = false, bool SP2 = false>
__device__ __forceinline__ void gemm_phase(PG8_LAS unsigned char* lds, const Gemm g, const Sched& S, const Epi& E) {
    int tid_ = threadIdx.x; asm volatile("" : "+v"(tid_)); const int tid = tid_, wid = __builtin_amdgcn_readfirstlane(tid >> 6), lane = tid & 63, wr = wid >> 2, wc = wid & 3, fr = lane & 15, fq = lane >> 4;
    const int K = g.K, nt = K / BK;
    unsigned voffA[2], voffB[2];
#pragma unroll
    for (int i = 0; i < 2; ++i) { int R, C; stage_rc(tid * 16 + i * 8192, R, C); const int Rb = Epi::PERM ? ((R & ~31) + perm32(R & 31)) : R;
        voffA[i] = (unsigned)(R * K + C) * 2u; voffB[i] = (unsigned)(Rb * K + C) * 2u; }
    const size_t kstep = (size_t)(BK * 2);
    const size_t hstep = (size_t)HALF * K * 2;
    const size_t tstep = 2 * hstep;
    const unsigned ldsw = (unsigned)wid * 1024u;
    const int aoff = lds_byte(wr * 64 + fr, fq * 8), boff = lds_byte(wc * 32 + fr, fq * 8);
#define PG8_SA(b, h) (((b) * 2 + (h)) * HTB)
#define PG8_SB(b, h) ((4 + (b) * 2 + (h)) * HTB)
#define PG8_STAGE(bufoff, gbase, voff) do { _Pragma("unroll") for (int _i = 0; _i < 2; ++_i) \
        __builtin_amdgcn_global_load_lds((const unsigned*)((const char*)(gbase) + (voff)[_i]), (PG8_LAS unsigned*)(lds + (bufoff) + ldsw + _i * 8192), 16, 0, 0); } while (0)
#define PG8_LDA(dst, b, h) do { _Pragma("unroll") for (int m = 0; m < 4; ++m) _Pragma("unroll") for (int k = 0; k < 2; ++k) dst[m][k] = *(const PG8_LAS bf16x8*)(lds + PG8_SA(b, h) + aoff + m * 2048 + k * 1024); } while (0)
#define PG8_LDB(dst, b, h) do { _Pragma("unroll") for (int n = 0; n < 2; ++n) _Pragma("unroll") for (int k = 0; k < 2; ++k) dst[n][k] = *(const PG8_LAS bf16x8*)(lds + PG8_SB(b, h) + boff + n * 2048 + k * 1024); } while (0)
#define PG8_MMA(ai, bj, At, Bt) do { __builtin_amdgcn_s_setprio(1); _Pragma("unroll") for (int m = 0; m < 4; ++m) _Pragma("unroll") for (int n = 0; n < 2; ++n) _Pragma("unroll") for (int k = 0; k < 2; ++k) \
        acc[ai][bj][m][n] = __builtin_amdgcn_mfma_f32_16x16x32_bf16(Bt[n][k], At[m][k], acc[ai][bj][m][n], 0, 0, 0); __builtin_amdgcn_s_setprio(0); } while (0)
#define PG8_WAIT_V(n) asm volatile("s_waitcnt vmcnt(" #n ")" ::: "memory")
#define PG8_WAIT_L(n) asm volatile("s_waitcnt lgkmcnt(" #n ")" ::: "memory")
#define PG8_BAR __builtin_amdgcn_s_barrier()
#define PG8_SCHED __builtin_amdgcn_sched_barrier(0)
    Unit cur, nxt; int ui = 0;
    if (!S.next(0, cur)) return;
    f32x4 acc[2][2][4][2];
#pragma unroll
    for (int a = 0; a < 2; ++a)
#pragma unroll
        for (int b = 0; b < 2; ++b)
#pragma unroll
            for (int m = 0; m < 4; ++m)
#pragma unroll
                for (int n = 0; n < 2; ++n) acc[a][b][m][n] = (f32x4){0.f, 0.f, 0.f, 0.f};
    bf16x8 At[4][2], B0[2][2], B1[2][2];
    const char* cA = (const char*)g.A + (size_t)cur.pm * tstep; const char* cB = (const char*)g.Bt + (size_t)cur.pn * tstep;
    S.a_ready(cur);
    if constexpr (SP2) {
        PG8_STAGE(PG8_SB(0, 0), cB, voffB); PG8_STAGE(PG8_SB(0, 1), cB + hstep, voffB); PG8_STAGE(PG8_SA(0, 0), cA, voffA); PG8_STAGE(PG8_SA(0, 1), cA + hstep, voffA);
        if (wr == 1) PG8_BAR;
        PG8_WAIT_V(2); PG8_BAR;
        PG8_STAGE(PG8_SB(1, 0), cB + kstep, voffB); PG8_STAGE(PG8_SA(1, 0), cA + kstep, voffA); PG8_STAGE(PG8_SB(1, 1), cB + hstep + kstep, voffB);
        PG8_WAIT_V(6); PG8_BAR;
    } else {
        PG8_STAGE(PG8_SB(0, 0), cB, voffB); PG8_STAGE(PG8_SA(0, 0), cA, voffA); PG8_STAGE(PG8_SB(0, 1), cB + hstep, voffB); PG8_STAGE(PG8_SA(0, 1), cA + hstep, voffA);
        if (wr == 1) PG8_BAR;
        PG8_WAIT_V(4); PG8_BAR;
        PG8_STAGE(PG8_SB(1, 0), cB + kstep, voffB); PG8_STAGE(PG8_SA(1, 0), cA + kstep, voffA); PG8_STAGE(PG8_SB(1, 1), cB + hstep + kstep, voffB);
        PG8_WAIT_V(6); PG8_BAR;
    }
    for (;;) {
        const bool has_next = S.next(ui + 1, nxt);
        const char* nA = has_next ? (const char*)g.A + (size_t)nxt.pm * tstep : cA; const char* nB = has_next ? (const char*)g.Bt + (size_t)nxt.pn * tstep : cB;
        for (int t = 0; t < nt; t += 2) {
            const bool last = (t == nt - 2);
            const char* a1 = cA + (size_t)(t + 1) * kstep;
            const char* a2 = last ? nA : cA + (size_t)(t + 2) * kstep; const char* b2 = last ? nB : cB + (size_t)(t + 2) * kstep;
            const char* a3 = a2 + kstep; const char* b3 = b2 + kstep;
            if (last && has_next) S.a_ready(nxt);
            if constexpr (SP2) {
            PG8_LDB(B0, 0, 0); PG8_LDB(B1, 0, 1); PG8_SCHED; PG8_LDA(At, 0, 0); PG8_STAGE(PG8_SA(1, 1), a1 + hstep, voffA);
            PG8_WAIT_V(8); PG8_WAIT_L(0); PG8_BAR; PG8_MMA(0, 0, At, B0); PG8_MMA(0, 1, At, B1); PG8_BAR; PG8_SCHED;
            PG8_LDA(At, 0, 1); PG8_STAGE(PG8_SB(0, 0), b2, voffB); PG8_STAGE(PG8_SB(0, 1), b2 + hstep, voffB); PG8_STAGE(PG8_SA(0, 0), a2, voffA);
            PG8_WAIT_V(8); PG8_WAIT_L(0); PG8_BAR; PG8_MMA(1, 0, At, B0); PG8_MMA(1, 1, At, B1); PG8_BAR; PG8_SCHED;
            PG8_LDB(B0, 1, 0); PG8_LDB(B1, 1, 1); PG8_SCHED; PG8_LDA(At, 1, 0); PG8_STAGE(PG8_SA(0, 1), a2 + hstep, voffA);
            PG8_WAIT_V(8); PG8_WAIT_L(0); PG8_BAR; PG8_MMA(0, 0, At, B0); PG8_MMA(0, 1, At, B1); PG8_BAR; PG8_SCHED;
            PG8_LDA(At, 1, 1); PG8_STAGE(PG8_SB(1, 0), b3, voffB); PG8_STAGE(PG8_SB(1, 1), b3 + hstep, voffB); PG8_STAGE(PG8_SA(1, 0), a3, voffA);
            PG8_WAIT_V(8); PG8_WAIT_L(0); PG8_BAR; PG8_MMA(1, 0, At, B0); PG8_MMA(1, 1, At, B1); PG8_BAR; PG8_SCHED;
            } else {
            PG8_LDB(B0, 0, 0); PG8_SCHED; PG8_LDA(At, 0, 0); PG8_STAGE(PG8_SA(1, 1), a1 + hstep, voffA);
            PG8_WAIT_L(8); PG8_BAR; PG8_WAIT_L(0); PG8_MMA(0, 0, At, B0); PG8_BAR; PG8_SCHED;
            PG8_LDB(B1, 0, 1); PG8_STAGE(PG8_SB(0, 0), b2, voffB);
            PG8_BAR; PG8_WAIT_L(0); PG8_MMA(0, 1, At, B1); PG8_BAR;
            PG8_LDA(At, 0, 1); PG8_STAGE(PG8_SA(0, 0), a2, voffA);
            PG8_BAR; PG8_WAIT_L(0); PG8_MMA(1, 0, At, B0); PG8_BAR; PG8_SCHED;
            PG8_STAGE(PG8_SB(0, 1), b2 + hstep, voffB);
            PG8_WAIT_V(6); PG8_BAR; PG8_MMA(1, 1, At, B1); PG8_BAR;
            PG8_LDB(B0, 1, 0); PG8_SCHED; PG8_LDA(At, 1, 0); PG8_STAGE(PG8_SA(0, 1), a2 + hstep, voffA);
            PG8_WAIT_L(8); PG8_BAR; PG8_WAIT_L(0); PG8_MMA(0, 0, At, B0); PG8_BAR; PG8_SCHED;
            PG8_LDB(B1, 1, 1); PG8_STAGE(PG8_SB(1, 0), b3, voffB);
            PG8_BAR; PG8_WAIT_L(0); PG8_MMA(0, 1, At, B1); PG8_BAR;
            PG8_LDA(At, 1, 1); PG8_STAGE(PG8_SA(1, 0), a3, voffA);
            PG8_BAR; PG8_WAIT_L(0); PG8_MMA(1, 0, At, B0); PG8_BAR; PG8_SCHED;
            PG8_STAGE(PG8_SB(1, 1), b3 + hstep, voffB);
            PG8_WAIT_V(6); PG8_BAR; PG8_MMA(1, 1, At, B1); PG8_BAR;
            }
        }
        if constexpr (ALIGN_EPI) { if (wr == 0) PG8_BAR; }
        if constexpr (!Epi::AFTER_DRAIN) { E(acc, cur, wr, wc, fr, fq); S.done(cur); }
        if (!has_next) break;
#pragma unroll
        for (int a = 0; a < 2; ++a)
#pragma unroll
            for (int b = 0; b < 2; ++b)
#pragma unroll
                for (int m = 0; m < 4; ++m)
#pragma unroll
                    for (int n = 0; n < 2; ++n) acc[a][b][m][n] = (f32x4){0.f, 0.f, 0.f, 0.f};
        cur = nxt; cA = nA; cB = nB; ++ui;
        if constexpr (ALIGN_EPI) { if (wr == 1) PG8_BAR; }
    }
    PG8_WAIT_V(0);
    if constexpr (!ALIGN_EPI) { if (wr == 0) PG8_BAR; }
    PG8_BAR;
    if constexpr (Epi::AFTER_DRAIN) { E.fused(acc, cur, wr, wc, fr, fq, lds, wid, lane); S.done(cur); }
#undef PG8_SA
#undef PG8_SB
#undef PG8_STAGE
#undef PG8_LDA
#undef PG8_LDB
#undef PG8_MMA
#undef PG8_WAIT_V
#undef PG8_WAIT_L
#undef PG8_BAR
#undef PG8_SCHED
}
}

constexpr int SEQ = 8192, DM = 2048, DFF = 8192, PLE = 256, DEPTH = 4, NHEAD = 16, HD = 128;
constexpr int NWAVES = 8, NTHREADS = 512;
constexpr int LDS_BYTES = 147456;
typedef unsigned short bf16;
typedef unsigned u32x4 __attribute__((ext_vector_type(4)));
typedef unsigned u32x2 __attribute__((ext_vector_type(2)));
typedef float f32x4 __attribute__((ext_vector_type(4)));
typedef float f32x2 __attribute__((ext_vector_type(2)));
typedef short bf16x8 __attribute__((ext_vector_type(8)));
#define LAS __attribute__((address_space(3)))
#define LDS_WAIT() asm volatile("s_waitcnt lgkmcnt(0)" ::: "memory")

constexpr size_t MiB = 1u << 20;
constexpr size_t WS_SS = 880 * MiB;
constexpr size_t WS_BAR = 0;
constexpr size_t WS_AGG = 2 * MiB;
constexpr size_t WS_X0 = 8 * MiB, WS_X1 = 40 * MiB;
constexpr size_t WS_BA = 72 * MiB, WS_BB = 104 * MiB, WS_BC = 136 * MiB, WS_BD = 168 * MiB;
constexpr size_t WS_A1 = 200 * MiB;
constexpr size_t WS_PROJ = 328 * MiB;
constexpr size_t WS_PB = 456 * MiB;
constexpr size_t WS_W1T = 472 * MiB, WS_W2T = 600 * MiB, WS_WGT = 728 * MiB, WS_WPT = 760 * MiB, WS_WINT = 764 * MiB, WS_WORT = 796 * MiB,
                 WS_GAT = 812 * MiB, WS_GXT = 814 * MiB, WS_WQKVT = 816 * MiB, WS_WONT = 864 * MiB, WS_END = 893 * MiB;

struct Args {
    const float* in[22];
    float* out; unsigned char* ws;
    int ph_lo, ph_hi;
};
static_assert(sizeof(Args) == 200 && offsetof(Args, out) == 176 && offsetof(Args, ws) == 184 && offsetof(Args, ph_lo) == 192, "Args layout");

typedef const unsigned char __attribute__((address_space(4)))* KA;
#define INP(k) (*(const float* const __attribute__((address_space(4)))*)(ka + 8 * (k)))
__device__ __forceinline__ int opaque_tid() { int t = threadIdx.x; asm volatile("" : "+v"(t)); return t; }
__device__ __forceinline__ unsigned cvt_pk(float lo, float hi) { return pg8::cvt_pk_bf16(lo, hi); }
__device__ __forceinline__ float bfl(unsigned w) { return __uint_as_float(w << 16); }
__device__ __forceinline__ float bfh(unsigned w) { return __uint_as_float(w & 0xffff0000u); }
__device__ __forceinline__ float wave_sum(float v) {
#pragma unroll
    for (int o = 1; o < 64; o <<= 1) v += __shfl_xor(v, o);
    return v;
}

__device__ __forceinline__ void transpose_item(const float* W, int K, int N, const float* g, bf16* WT, int kb, int nb, int lane) {
    const int q = lane >> 4, ln = lane & 15;
    const int kbase = 64 * kb + 16 * q, n = 64 * nb + 4 * ln;
    f32x4 v[16];
    const float* wp = W + (size_t)kbase * N + n;
#pragma unroll
    for (int i = 0; i < 16; ++i) v[i] = *(const f32x4*)(wp + (size_t)i * N);
    if (g) {
#pragma unroll
        for (int i4 = 0; i4 < 4; ++i4) { const f32x4 gv = *(const f32x4*)(g + kbase + 4 * i4);
#pragma unroll
            for (int e = 0; e < 4; ++e) v[4 * i4 + e] = v[4 * i4 + e] * gv[e]; }
    }
#pragma unroll
    for (int e = 0; e < 4; ++e) {
        bf16* op = WT + (size_t)(n + e) * K + kbase;
#pragma unroll
        for (int h = 0; h < 2; ++h) {
            u32x4 o; o.x = cvt_pk(v[8 * h + 0][e], v[8 * h + 1][e]); o.y = cvt_pk(v[8 * h + 2][e], v[8 * h + 3][e]); o.z = cvt_pk(v[8 * h + 4][e], v[8 * h + 5][e]); o.w = cvt_pk(v[8 * h + 6][e], v[8 * h + 7][e]);
            *(u32x4*)(op + 8 * h) = o;
        }
    }
}

__device__ __forceinline__ void p0_phase(LAS unsigned char* lds, KA ka, unsigned char* ws, int G) {
    const int tid = opaque_tid(), lane = tid & 63, wave = tid >> 6;
    const int gw = blockIdx.x * NWAVES + wave, NGW = G * NWAVES;
    float* ss = (float*)(ws + WS_SS);
    {
        const float* x = INP(0); bf16* X0 = (bf16*)(ws + WS_X0);
        for (int row = gw; row < SEQ; row += NGW) {
            const f32x4* xr = (const f32x4*)(x + (size_t)row * DM) + lane; float s = 0.f;
            u32x2* o = (u32x2*)(X0 + (size_t)row * DM) + lane;
#pragma unroll
            for (int j = 0; j < 8; ++j) { const f32x4 v = xr[64 * j]; s += (v[0] * v[0] + v[1] * v[1]) + (v[2] * v[2] + v[3] * v[3]); u32x2 w; w.x = cvt_pk(v[0], v[1]); w.y = cvt_pk(v[2], v[3]); o[64 * j] = w; }
            s = wave_sum(s);
            if (lane < 32) ss[(size_t)row * 32 + lane] = (lane == 0) ? s : 0.f;
        }
    }
    {
        const f32x4* p = (const f32x4*)INP(1); u32x2* o = (u32x2*)(ws + WS_PB);
        const int n4 = DEPTH * SEQ * PLE / 4;
        for (int i = blockIdx.x * NTHREADS + tid; i < n4; i += G * NTHREADS) { const f32x4 v = p[i]; u32x2 w; w.x = cvt_pk(v[0], v[1]); w.y = cvt_pk(v[2], v[3]); o[i] = w; }
    }
    const int nitems_total =
        4 * (2048 / 64) * (8192 / 64) + 4 * (8192 / 64) * (2048 / 64) + 4 * (2048 / 64) * (2048 / 64) + 4 * (256 / 64) * (2048 / 64) +
        2 * (2048 / 64) * (4096 / 64) + 2 * (2048 / 64) * (2048 / 64) + 64 * (128 / 64) * (128 / 64) + 64 * (128 / 64) * (128 / 64) +
        2 * (2048 / 64) * (6144 / 64) + 2 * (2048 / 64) * (2048 / 64);
    for (int it = gw; it < nitems_total; it += NGW) {
        int r = it;
#define CONV_TRY(Wp, nmat, K, N, gp, gstride, WTp) { const int ipm = ((K) / 64) * ((N) / 64); const int tot = (nmat) * ipm; \
            if (r < tot) { const int mat = r / ipm, rr = r % ipm, kb = rr / ((N) / 64), nb = rr % ((N) / 64); const float* g_ = (gp); \
                transpose_item((Wp) + (size_t)mat * (K) * (N), (K), (N), g_ ? g_ + (size_t)mat * (gstride) : nullptr, (bf16*)(ws + (WTp)) + (size_t)mat * (K) * (N), kb, nb, lane); continue; } r -= tot; }
        CONV_TRY(INP(18), 4, 2048, 8192, INP(3), 2048, WS_W1T)
        CONV_TRY(INP(19), 4, 8192, 2048, (const float*)nullptr, 0, WS_W2T)
        CONV_TRY(INP(20), 4, 2048, 2048, INP(4), 2048, WS_WGT)
        CONV_TRY(INP(21), 4, 256, 2048, (const float*)nullptr, 0, WS_WPT)
        CONV_TRY(INP(6), 2, 2048, 4096, INP(2), 4096, WS_WINT)
        CONV_TRY(INP(14), 2, 2048, 2048, (const float*)nullptr, 0, WS_WORT)
        CONV_TRY(INP(9), 64, 128, 128, (const float*)nullptr, 0, WS_GAT)
        CONV_TRY(INP(11), 64, 128, 128, (const float*)nullptr, 0, WS_GXT)
        CONV_TRY(INP(15), 2, 2048, 6144, INP(2) + 2048, 4096, WS_WQKVT)
        CONV_TRY(INP(17), 2, 2048, 2048, (const float*)nullptr, 0, WS_WONT)
#undef CONV_TRY
    }
}

constexpr int SC_T = 64, SC_NCH = SEQ / SC_T;
constexpr int XCF_STRIDE = 132;
constexpr int XCB_STRIDE = 136;
constexpr int LDS_XCF = 0, LDS_XCB = LDS_XCF + SC_T * XCF_STRIDE * 4, LDS_YGS = LDS_XCB + SC_T * XCB_STRIDE * 2, LDS_SEG = LDS_YGS + SC_T * 128 * 2, LDS_CAR = LDS_SEG + 2 * 128 * 17 * 8, LDS_SC_END = LDS_CAR + 2 * 8 * 128 * 4;
static_assert(LDS_SC_END <= 131072, "scan LDS");

struct ScanArgs {
    const bf16* XR; const bf16* YG; bf16* Y;
    const float* conv_w; const float* conv_b;
    const bf16* gaT; const bf16* gxT;
    const float* ga_b; const float* gx_b; const float* lam;
    f32x2* agg;
};

template <bool FINAL>
__device__ __forceinline__ void scan_phase(LAS unsigned char* lds, const ScanArgs& sa, int G) {
    const int tid = opaque_tid(), lane = tid & 63, w = tid >> 6, fr = lane & 15, fq = lane >> 4;
    LAS float* xcf = (LAS float*)(lds + LDS_XCF);
    LAS bf16* xcb = (LAS bf16*)(lds + LDS_XCB);
    LAS bf16* ygs = (LAS bf16*)(lds + LDS_YGS);
    LAS f32x2* seg = (LAS f32x2*)(lds + LDS_SEG);
    int cur_hd = -1;
    bf16x8 Bf[4][4];
    float ba[2], bx[2], sp8[2];
    ba[0] = ba[1] = bx[0] = bx[1] = sp8[0] = sp8[1] = 0.f;
    LAS float* car = (LAS float*)(lds + LDS_CAR);
    const bool fast = FINAL && (G == 256);
    if (fast) {
        if (tid < 256) {
            const int dir = tid >> 7, c = tid & 127, gch = (blockIdx.x & 15) * 128 + c, cmod = blockIdx.x >> 4;
            const f32x2* ag = sa.agg + (size_t)dir * SC_NCH * DM + gch;
            float h = 0.f;
            if (dir == 0) {
#pragma unroll 8
                for (int cc = 0; cc < SC_NCH; ++cc) { const f32x2 e = ag[(size_t)cc * DM]; if ((cc & 15) == cmod) car[(dir * 8 + (cc >> 4)) * 128 + c] = h; h = e[0] * h + e[1]; }
            } else {
#pragma unroll 8
                for (int cc = SC_NCH - 1; cc >= 0; --cc) { const f32x2 e = ag[(size_t)cc * DM]; if ((cc & 15) == cmod) car[(dir * 8 + (cc >> 4)) * 128 + c] = h; h = e[0] * h + e[1]; }
            }
        }
    }
    unsigned xpre[11]; u32x4 ypre[2];
#define SCAN_PREFETCH(itx) do { const int hd_ = (itx) & 15, t0_ = ((itx) >> 4) * SC_T; const int gc_ = hd_ * 128 + 2 * (tid & 63), tg_ = tid >> 6; \
        _Pragma("unroll") for (int q = 0; q < 11; ++q) { const int t = t0_ + 8 * tg_ - 1 + q; unsigned v = 0u; if (t >= 0 && t < SEQ) v = *(const unsigned*)(sa.XR + (size_t)t * DM + gc_); xpre[q] = v; } \
        if (FINAL) { _Pragma("unroll") for (int i = 0; i < 2; ++i) { const int idx = tid + i * NTHREADS, row = idx >> 4, c16 = idx & 15; \
            ypre[i] = *(const u32x4*)(sa.YG + (size_t)(t0_ + row) * DM + hd_ * 128 + c16 * 8); } } } while (0)
    ypre[0] = (u32x4){0u, 0u, 0u, 0u}; ypre[1] = (u32x4){0u, 0u, 0u, 0u};
    if ((int)blockIdx.x < SC_NCH * NHEAD) SCAN_PREFETCH((int)blockIdx.x);
    for (int it = blockIdx.x; it < SC_NCH * NHEAD; it += G) {
        const int hd = it & 15, chunk = it >> 4, t0 = chunk * SC_T;
        __syncthreads();
#pragma unroll
        for (int dir = 0; dir < 2; ++dir) {
            const bf16* wa = sa.gaT + ((size_t)(dir * 16 + hd) * 128 + 16 * w + fr) * 128 + 8 * fq;
            const bf16* wx = sa.gxT + ((size_t)(dir * 16 + hd) * 128 + 16 * w + fr) * 128 + 8 * fq;
#pragma unroll
            for (int k = 0; k < 4; ++k) { Bf[dir * 2 + 0][k] = *(const bf16x8*)(wa + 32 * k); Bf[dir * 2 + 1][k] = *(const bf16x8*)(wx + 32 * k); }
        }
        if (hd != cur_hd) {
            cur_hd = hd;
#pragma unroll
            for (int dir = 0; dir < 2; ++dir) {
                const int gch = hd * 128 + 16 * w + fr;
                ba[dir] = -1.4426950408889634f * sa.ga_b[dir * DM + gch]; bx[dir] = -1.4426950408889634f * sa.gx_b[dir * DM + gch];
                sp8[dir] = 1.4426950408889634f * 8.f * log1pf(expf(-sa.lam[dir * DM + gch]));
            }
        }
        {
            const int cp = tid & 63, tg = tid >> 6;
            const int gc = hd * 128 + 2 * cp;
            float x0[11], x1[11];
#pragma unroll
            for (int q = 0; q < 11; ++q) { x0[q] = bfl(xpre[q]); x1[q] = bfh(xpre[q]); }
            float w0[4], w1[4];
#pragma unroll
            for (int k = 0; k < 4; ++k) { const f32x2 wv = *(const f32x2*)(sa.conv_w + k * DM + gc); w0[k] = wv[0]; w1[k] = wv[1]; }
            const f32x2 bv = *(const f32x2*)(sa.conv_b + gc);
#pragma unroll
            for (int q = 0; q < 8; ++q) {
                const float c0 = bv[0] + ((w0[0] * x0[q] + w0[1] * x0[q + 1]) + (w0[2] * x0[q + 2] + w0[3] * x0[q + 3]));
                const float c1 = bv[1] + ((w1[0] * x1[q] + w1[1] * x1[q + 1]) + (w1[2] * x1[q + 2] + w1[3] * x1[q + 3]));
                const int tau = 8 * tg + q;
                *(LAS f32x2*)(xcf + tau * XCF_STRIDE + 2 * cp) = (f32x2){c0, c1};
                *(LAS unsigned*)(xcb + tau * XCB_STRIDE + 2 * cp) = cvt_pk(c0, c1);
            }
            if (FINAL) {
#pragma unroll
                for (int i = 0; i < 2; ++i) { const int idx = tid + i * NTHREADS, row = idx >> 4, c16 = idx & 15;
                    *(LAS u32x4*)(ygs + row * 128 + c16 * 8) = ypre[i]; }
            }
            if (it + G < SC_NCH * NHEAD) SCAN_PREFETCH(it + G);
        }
        __syncthreads();
        f32x4 acc[4][4];
#pragma unroll
        for (int m = 0; m < 4; ++m)
#pragma unroll
            for (int mb = 0; mb < 4; ++mb) acc[m][mb] = (f32x4){0.f, 0.f, 0.f, 0.f};
#pragma unroll
        for (int mb = 0; mb < 4; ++mb) {
            bf16x8 Af[4];
#pragma unroll
            for (int k = 0; k < 4; ++k) Af[k] = *(const LAS bf16x8*)(xcb + (16 * mb + fr) * XCB_STRIDE + 32 * k + 8 * fq);
#pragma unroll
            for (int m = 0; m < 4; ++m)
#pragma unroll
                for (int k = 0; k < 4; ++k) acc[m][mb] = __builtin_amdgcn_mfma_f32_16x16x32_bf16(Af[k], Bf[m][k], acc[m][mb], 0, 0, 0);
        }
        const int ch = 16 * w + fr;
#pragma unroll
        for (int mb = 0; mb < 4; ++mb) {
            float xv[4];
#pragma unroll
            for (int j = 0; j < 4; ++j) xv[j] = xcf[(16 * mb + 4 * fq + j) * XCF_STRIDE + ch];
#pragma unroll
            for (int dir = 0; dir < 2; ++dir) {
#pragma unroll
                for (int j = 0; j < 4; ++j) {
                    const float e1 = __builtin_amdgcn_exp2f(fminf(fmaf(acc[2 * dir][mb][j], -1.4426950408889634f, ba[dir]), 60.f));
                    const float e2 = __builtin_amdgcn_exp2f(fminf(fmaf(acc[2 * dir + 1][mb][j], -1.4426950408889634f, bx[dir]), 60.f));
                    const float d1 = 1.f + e1, d2 = 1.f + e2, rd = __builtin_amdgcn_rcpf(d1 * d2);
                    const float r = d2 * rd, ig = d1 * rd;
                    const float av = __builtin_amdgcn_exp2f(-sp8[dir] * r);
                    const float om = fmaxf(fmaf(-av, av, 1.f), 0.f);
                    acc[2 * dir][mb][j] = av;
                    acc[2 * dir + 1][mb][j] = __builtin_amdgcn_sqrtf(om) * (ig * xv[j]);
                }
                const f32x4 A = acc[2 * dir][mb], U = acc[2 * dir + 1][mb];
                float P, Q;
                if (dir == 0) { P = (A[0] * A[1]) * (A[2] * A[3]); Q = ((U[0] * A[1] + U[1]) * A[2] + U[2]) * A[3] + U[3]; }
                else          { P = (A[0] * A[1]) * (A[2] * A[3]); Q = ((U[3] * A[2] + U[2]) * A[1] + U[1]) * A[0] + U[0]; }
                seg[(dir * 128 + ch) * 17 + mb * 4 + fq] = (f32x2){P, Q};
            }
        }
        __syncthreads();
        float hb0[4], hb1[4];
        {
            const int gch = hd * 128 + ch;
            float h0 = 0.f, h1 = 0.f, P0 = 1.f, P1 = 1.f;
            if (FINAL) {
                if (fast) { h0 = car[(0 * 8 + (chunk >> 4)) * 128 + ch]; h1 = car[(1 * 8 + (chunk >> 4)) * 128 + ch]; }
                else {
                    const f32x2* ag0 = sa.agg + gch; const f32x2* ag1 = sa.agg + (size_t)SC_NCH * DM + gch;
                    for (int cc = 0; cc < chunk; ++cc) { const f32x2 e = ag0[(size_t)cc * DM]; h0 = e[0] * h0 + e[1]; }
                    for (int cc = SC_NCH - 1; cc > chunk; --cc) { const f32x2 e = ag1[(size_t)cc * DM]; h1 = e[0] * h1 + e[1]; }
                }
            }
            const LAS f32x2* sg0 = seg + (0 * 128 + ch) * 17; const LAS f32x2* sg1 = seg + (1 * 128 + ch) * 17;
#pragma unroll
            for (int s = 0; s < 16; ++s) { const f32x2 e = sg0[s]; if ((s & 3) == fq) hb0[s >> 2] = h0; h0 = e[0] * h0 + e[1]; P0 *= e[0]; }
#pragma unroll
            for (int s = 15; s >= 0; --s) { const f32x2 e = sg1[s]; if ((s & 3) == fq) hb1[s >> 2] = h1; h1 = e[0] * h1 + e[1]; P1 *= e[0]; }
            if (!FINAL) {
                if (fq == 0) { sa.agg[((size_t)0 * SC_NCH + chunk) * DM + gch] = (f32x2){P0, h0}; sa.agg[((size_t)1 * SC_NCH + chunk) * DM + gch] = (f32x2){P1, h1}; }
            }
        }
        if (FINAL) {
#pragma unroll
            for (int mb = 0; mb < 4; ++mb) {
                float hs[4];
                { float h = hb0[mb]; const f32x4 A = acc[0][mb], U = acc[1][mb];
#pragma unroll
                  for (int j = 0; j < 4; ++j) { h = A[j] * h + U[j]; hs[j] = h; } }
                { float h = hb1[mb]; const f32x4 A = acc[2][mb], U = acc[3][mb];
#pragma unroll
                  for (int j = 3; j >= 0; --j) { h = A[j] * h + U[j]; hs[j] += h; } }
#pragma unroll
                for (int j = 0; j < 4; ++j) {
                    LAS bf16* yp = ygs + (16 * mb + 4 * fq + j) * 128 + ch;
                    const float yg = __uint_as_float((unsigned)(*yp) << 16);
                    *yp = (bf16)(cvt_pk(hs[j] * yg, 0.f) & 0xffffu);
                }
            }
            __syncthreads();
#pragma unroll
            for (int i = 0; i < 2; ++i) { const int idx = tid + i * NTHREADS, row = idx >> 4, c16 = idx & 15;
                *(u32x4*)(sa.Y + (size_t)(t0 + row) * DM + hd * 128 + c16 * 8) = *(const LAS u32x4*)(ygs + row * 128 + c16 * 8); }
        }
    }
}

struct AttArgs { const bf16* Q; const bf16* K; const bf16* VT; bf16* O; const float* rpb; };

__device__ __forceinline__ void attn_phase(LAS unsigned char* lds, const AttArgs& aa, int G) {
    const int tid = opaque_tid(), lane = tid & 63, w = tid >> 6, fr = lane & 15, fq = lane >> 4;
    const int hsel = w >> 2, qg = w & 3;
    LAS float* rp = (LAS float*)lds;
    const int c0 = 16 * qg, kb0 = (qg == 0) ? 0 : (qg == 1) ? 8 : (qg == 2) ? 24 : 32;
    const int qc = c0 + fr;
    const int cs = min(max(qc - 8, 0), 48);
    for (int id = blockIdx.x; id < 128 * 8; id += G) {
        const int hp = id & 7, r = id >> 3, h = hp * 2 + hsel;
        const int rs = min(max(r - 4, 0), 120);
        __syncthreads();
        for (int i = tid; i < 2 * 465; i += NTHREADS) { const int hh = i / 465, e = i % 465; rp[hh * 480 + e] = aa.rpb[(size_t)(hp * 2 + hh) * 465 + e]; }
        __syncthreads();
        bf16x8 qf[4];
        { const bf16* qp = aa.Q + (size_t)(r * 64 + qc) * DM + h * 128 + 8 * fq;
#pragma unroll
          for (int k = 0; k < 4; ++k) qf[k] = *(const bf16x8*)(qp + 32 * k); }
        f32x4 s[8][2];
        const int krow = 8 * (fr >> 2) + (fr & 3);
#pragma unroll
        for (int i = 0; i < 8; ++i)
#pragma unroll
            for (int nb = 0; nb < 2; ++nb) {
                const bf16* kp = aa.K + (size_t)((rs + i) * 64 + kb0 + krow + 4 * nb) * DM + h * 128 + 8 * fq;
                f32x4 c = (f32x4){0.f, 0.f, 0.f, 0.f};
#pragma unroll
                for (int k = 0; k < 4; ++k) { const bf16x8 kf = *(const bf16x8*)(kp + 32 * k); c = __builtin_amdgcn_mfma_f32_16x16x32_bf16(kf, qf[k], c, 0, 0, 0); }
                s[i][nb] = c;
            }
        float mx = -INFINITY;
        const LAS float* rph = rp + hsel * 480;
#pragma unroll
        for (int i = 0; i < 8; ++i) {
            const int relr = rs + i - r + 7;
#pragma unroll
            for (int nb = 0; nb < 2; ++nb)
#pragma unroll
                for (int j = 0; j < 4; ++j) {
                    const int kc = kb0 + 8 * fq + 4 * nb + j;
                    const bool valid = (unsigned)(kc - cs) < 16u;
                    const int idx = valid ? relr * 31 + (kc - qc + 15) : 0;
                    const float v = valid ? s[i][nb][j] + rph[idx] : -INFINITY;
                    s[i][nb][j] = v; mx = fmaxf(mx, v);
                }
        }
        mx = fmaxf(mx, __shfl_xor(mx, 16)); mx = fmaxf(mx, __shfl_xor(mx, 32));
        float l = 0.f;
#pragma unroll
        for (int i = 0; i < 8; ++i)
#pragma unroll
            for (int nb = 0; nb < 2; ++nb)
#pragma unroll
                for (int j = 0; j < 4; ++j) { const float p = __expf(s[i][nb][j] - mx); s[i][nb][j] = p; l += p; }
        l += __shfl_xor(l, 16); l += __shfl_xor(l, 32);
        f32x4 o[8];
#pragma unroll
        for (int db = 0; db < 8; ++db) o[db] = (f32x4){0.f, 0.f, 0.f, 0.f};
#pragma unroll
        for (int i = 0; i < 8; ++i) {
            u32x4 pw; pw.x = cvt_pk(s[i][0][0], s[i][0][1]); pw.y = cvt_pk(s[i][0][2], s[i][0][3]); pw.z = cvt_pk(s[i][1][0], s[i][1][1]); pw.w = cvt_pk(s[i][1][2], s[i][1][3]);
            const bf16x8 pb = __builtin_bit_cast(bf16x8, pw);
            const bf16* vp = aa.VT + (size_t)(h * 128 + fr) * SEQ + (rs + i) * 64 + kb0 + 8 * fq;
#pragma unroll
            for (int db = 0; db < 8; ++db) { const bf16x8 vf = *(const bf16x8*)(vp + (size_t)(16 * db) * SEQ); o[db] = __builtin_amdgcn_mfma_f32_16x16x32_bf16(vf, pb, o[db], 0, 0, 0); }
        }
        const float inv = 1.f / l;
        bf16* op = aa.O + (size_t)(r * 64 + qc) * DM + h * 128 + 4 * fq;
#pragma unroll
        for (int db = 0; db < 8; ++db) { u32x2 wv; wv.x = cvt_pk(o[db][0] * inv, o[db][1] * inv); wv.y = cvt_pk(o[db][2] * inv, o[db][3] * inv); *(u32x2*)(op + 16 * db) = wv; }
    }
}

#define ATT_BAR() do { asm volatile("s_waitcnt lgkmcnt(0)" ::: "memory"); __builtin_amdgcn_s_barrier(); asm volatile("" ::: "memory"); } while (0)
constexpr int KS_PITCH = 136, VS_PITCH = 72;
constexpr int ATT_KS = 0, ATT_VS = ATT_KS + 2 * 64 * KS_PITCH * 2, ATT_RP = ATT_VS + 2 * 128 * VS_PITCH * 2, ATT_END = ATT_RP + 2048;
static_assert(ATT_END <= 131072, "attention LDS");
__device__ __forceinline__ void attn_phase2(LAS unsigned char* lds, const AttArgs& aa, int G) {
    const int tid = opaque_tid(), lane = tid & 63, w = tid >> 6, fr = lane & 15, fq = lane >> 4;
    const int rsel = w >> 2, qg = w & 3;
    LAS bf16* KS = (LAS bf16*)(lds + ATT_KS);
    LAS bf16* VS = (LAS bf16*)(lds + ATT_VS);
    LAS float* rp = (LAS float*)(lds + ATT_RP);
    const int c0 = 16 * qg, kb0 = (qg == 0) ? 0 : (qg == 1) ? 8 : (qg == 2) ? 24 : 32;
    const int qc = c0 + fr;
    const int cs = min(max(qc - 8, 0), 48);
    const int krow = 8 * (fr >> 2) + (fr & 3);
    const int ktok0 = tid >> 4, kpart = tid & 15, vd0 = tid >> 3, vpart = tid & 7;
    for (int id = blockIdx.x; id < 64 * NHEAD; id += G) {
        const int h = id & 15, rpair = id >> 4, r0 = 2 * rpair;
        const int rsA = min(max(r0 - 4, 0), 120), rsB = min(max(r0 - 3, 0), 120), off = rsB - rsA, nJ = 8 + off;
        const int r = r0 + rsel, rs = rsel ? rsB : rsA, woff = rsel ? off : 0;
        u32x4 R[9][2];
#pragma unroll
        for (int jj = 0; jj < 9; ++jj) { R[jj][0] = (u32x4){0u, 0u, 0u, 0u}; R[jj][1] = (u32x4){0u, 0u, 0u, 0u}; }
        const bf16* kbase = aa.K + (size_t)(rsA * 64 + ktok0) * DM + h * 128 + kpart * 8;
        const bf16* vbase = aa.VT + (size_t)(h * 128 + vd0) * SEQ + rsA * 64 + vpart * 8;
#pragma unroll
        for (int jj = 0; jj < 9; ++jj) if (jj < nJ) {
#pragma unroll
            for (int u = 0; u < 2; ++u) R[jj][u] = *(const u32x4*)(kbase + (size_t)(jj * 64 + 32 * u) * DM);
        }
        for (int i = tid; i < 465; i += NTHREADS) rp[i] = aa.rpb[(size_t)h * 465 + i];
        bf16x8 qf[4];
        { const bf16* qp = aa.Q + (size_t)(r * 64 + qc) * DM + h * 128 + 8 * fq;
#pragma unroll
          for (int k = 0; k < 4; ++k) qf[k] = *(const bf16x8*)(qp + 32 * k); }
#define ATT_KWRITE(j, b) do { _Pragma("unroll") for (int u = 0; u < 2; ++u) *(LAS u32x4*)(KS + (b) * 64 * KS_PITCH + (ktok0 + 32 * u) * KS_PITCH + kpart * 8) = R[j][u]; } while (0)
#define ATT_VLOAD(j) do { _Pragma("unroll") for (int u = 0; u < 2; ++u) R[j][u] = *(const u32x4*)(vbase + (size_t)(64 * u) * SEQ + (j) * 64); } while (0)
#define ATT_VWRITE(j, b) do { _Pragma("unroll") for (int u = 0; u < 2; ++u) *(LAS u32x4*)(VS + (b) * 128 * VS_PITCH + (vd0 + 64 * u) * VS_PITCH + vpart * 8) = R[j][u]; } while (0)
#define ATT_QK(i, b) do { _Pragma("unroll") for (int nb = 0; nb < 2; ++nb) { f32x4 c_ = (f32x4){0.f, 0.f, 0.f, 0.f}; \
            _Pragma("unroll") for (int k = 0; k < 4; ++k) { const bf16x8 kf = *(const LAS bf16x8*)(KS + (b) * 64 * KS_PITCH + (kb0 + krow + 4 * nb) * KS_PITCH + 32 * k + 8 * fq); \
                c_ = __builtin_amdgcn_mfma_f32_16x16x32_bf16(kf, qf[k], c_, 0, 0, 0); } s[i][nb] = c_; } } while (0)
#define ATT_PV(i, b) do { u32x4 pw; pw.x = cvt_pk(s[i][0][0], s[i][0][1]); pw.y = cvt_pk(s[i][0][2], s[i][0][3]); pw.z = cvt_pk(s[i][1][0], s[i][1][1]); pw.w = cvt_pk(s[i][1][2], s[i][1][3]); \
            const bf16x8 pb = __builtin_bit_cast(bf16x8, pw); \
            _Pragma("unroll") for (int db = 0; db < 8; ++db) { const bf16x8 vf = *(const LAS bf16x8*)(VS + (b) * 128 * VS_PITCH + (16 * db + fr) * VS_PITCH + kb0 + 8 * fq); \
                o[db] = __builtin_amdgcn_mfma_f32_16x16x32_bf16(vf, pb, o[db], 0, 0, 0); } } while (0)
        f32x4 s[8][2];
        ATT_KWRITE(0, 0); ATT_VLOAD(0);
        ATT_BAR();
#pragma unroll
        for (int jj = 0; jj < 9; ++jj) {
            if (jj + 1 < 9) { if (jj + 1 < nJ) { ATT_KWRITE((jj + 1 < 9 ? jj + 1 : 8), ((jj + 1) & 1)); ATT_VLOAD((jj + 1 < 9 ? jj + 1 : 8)); } }
            if (woff == 0) { if (jj < 8) ATT_QK((jj < 8 ? jj : 7), (jj & 1)); }
            else           { if (jj >= 1) ATT_QK((jj >= 1 ? jj - 1 : 0), (jj & 1)); }
            ATT_BAR();
        }
        float mx = -INFINITY;
#pragma unroll
        for (int i = 0; i < 8; ++i) {
            const int relr = rs + i - r + 7;
#pragma unroll
            for (int nb = 0; nb < 2; ++nb)
#pragma unroll
                for (int j = 0; j < 4; ++j) {
                    const int kc = kb0 + 8 * fq + 4 * nb + j;
                    const bool valid = (unsigned)(kc - cs) < 16u;
                    const int idx = valid ? relr * 31 + (kc - qc + 15) : 0;
                    const float v = valid ? s[i][nb][j] + rp[idx] : -INFINITY;
                    s[i][nb][j] = v; mx = fmaxf(mx, v);
                }
        }
        mx = fmaxf(mx, __shfl_xor(mx, 16)); mx = fmaxf(mx, __shfl_xor(mx, 32));
        float l = 0.f;
#pragma unroll
        for (int i = 0; i < 8; ++i)
#pragma unroll
            for (int nb = 0; nb < 2; ++nb)
#pragma unroll
                for (int j = 0; j < 4; ++j) { const float p = __expf(s[i][nb][j] - mx); s[i][nb][j] = p; l += p; }
        l += __shfl_xor(l, 16); l += __shfl_xor(l, 32);
        f32x4 o[8];
#pragma unroll
        for (int db = 0; db < 8; ++db) o[db] = (f32x4){0.f, 0.f, 0.f, 0.f};
        ATT_VWRITE(0, 0);
        ATT_BAR();
#pragma unroll
        for (int jj = 0; jj < 9; ++jj) {
            if (jj + 1 < 9) { if (jj + 1 < nJ) ATT_VWRITE((jj + 1 < 9 ? jj + 1 : 8), ((jj + 1) & 1)); }
            if (woff == 0) { if (jj < 8) ATT_PV((jj < 8 ? jj : 7), (jj & 1)); }
            else           { if (jj >= 1) ATT_PV((jj >= 1 ? jj - 1 : 0), (jj & 1)); }
            ATT_BAR();
        }
        const float inv = 1.f / l;
        bf16* op = aa.O + (size_t)(r * 64 + qc) * DM + h * 128 + 4 * fq;
#pragma unroll
        for (int db = 0; db < 8; ++db) { u32x2 wv; wv.x = cvt_pk(o[db][0] * inv, o[db][1] * inv); wv.y = cvt_pk(o[db][2] * inv, o[db][3] * inv); *(u32x2*)(op + 16 * db) = wv; }
#undef ATT_KWRITE
#undef ATT_VLOAD
#undef ATT_VWRITE
#undef ATT_QK
#undef ATT_PV
    }
}

__device__ __forceinline__ void final_phase(float* out, const float* ss, const float* g, int G) {
    const int tid = opaque_tid(), lane = tid & 63, wave = tid >> 6;
    const int gw = blockIdx.x * NWAVES + wave, NGW = G * NWAVES;
    for (int row = gw; row < SEQ; row += NGW) {
        const float rs = pg8::rstd_row(ss, row);
        f32x4* o = (f32x4*)(out + (size_t)row * DM) + lane; const f32x4* gp = (const f32x4*)g + lane;
#pragma unroll
        for (int j = 0; j < 8; ++j) { f32x4 v = o[64 * j]; const f32x4 gv = gp[64 * j]; v = v * rs * gv; o[64 * j] = v; }
    }
}

#define XB_TMO      128
#define XB_XCNT(j)  (256  + 64 * (j))
#define XB_XSUB(j)  (1280 + 64 * (j))
#define XB_XGEN(j)  (2304 + 64 * (j))
#define XB_TOP      3328
#define XB_TOPGEN   3392
#define XCD_BAR_WORDS 3456
#define XB_SPIN_CAP (1u << 18)

__device__ __forceinline__ unsigned xb_ld(unsigned* p)              { return __hip_atomic_load(p, __ATOMIC_RELAXED, __HIP_MEMORY_SCOPE_AGENT); }
__device__ __forceinline__ unsigned xb_add(unsigned* p, unsigned v) { return __hip_atomic_fetch_add(p, v, __ATOMIC_RELAXED, __HIP_MEMORY_SCOPE_AGENT); }
__device__ __forceinline__ unsigned xb_xcc_id() { return (unsigned)__builtin_amdgcn_s_getreg((3 << 11) | 20) & 0xFu; }
#define XB_SPIN(cond, bar) do { unsigned _sp = 0; while (cond) { __builtin_amdgcn_s_sleep(1); \
    if ((++_sp & 255u) == 0u) { if (xb_ld(&(bar)[XB_TMO])) break; if (_sp > XB_SPIN_CAP) { atomicAdd(&(bar)[XB_TMO], 1u); break; } } } } while (0)

struct XcdBarrier {
    unsigned* bar; unsigned x;
    volatile LAS unsigned* st;
};

__device__ __forceinline__ XcdBarrier xcd_barrier_post(unsigned* bar, volatile LAS unsigned* st) {
    XcdBarrier b; b.bar = bar; b.x = xb_xcc_id(); b.st = st;
    if (threadIdx.x == 0) (void)xb_add(&bar[XB_XCNT(b.x)], 1u);
    return b;
}
__device__ __forceinline__ void xcd_barrier_complete(unsigned* bar, unsigned x, unsigned& nloc, unsigned& nx) {
    const unsigned G = gridDim.x * gridDim.y * gridDim.z;
    unsigned sum, cnt, mine, sp = 0u;
    for (;;) {
        sum = 0u; cnt = 0u; mine = 0u;
#pragma unroll
        for (unsigned j = 0; j < 16; ++j) { const unsigned c = xb_ld(&bar[XB_XCNT(j)]); sum += c; cnt += (c > 0u) ? 1u : 0u; mine = (j == x) ? c : mine; }
        if (sum == G) break;
        __builtin_amdgcn_s_sleep(1);
        if ((++sp & 255u) == 0u) { if (xb_ld(&bar[XB_TMO])) break; if (sp > XB_SPIN_CAP) { atomicAdd(&bar[XB_TMO], 1u); break; } }
    }
    nloc = mine > 0u ? mine : 1u; nx = cnt > 0u ? cnt : 1u;
}

__device__ __forceinline__ void xcd_barrier(const XcdBarrier& b) {
    asm volatile("s_waitcnt vmcnt(0)" ::: "memory");
    __syncthreads();
    if (threadIdx.x == 0) {
        unsigned* bar = b.bar;
        __builtin_amdgcn_s_waitcnt(0);
        unsigned nloc = b.st[0], nx = b.st[1];
        if (nloc == 0u) { xcd_barrier_complete(bar, b.x, nloc, nx); b.st[0] = nloc; b.st[1] = nx; }
        const unsigned old = xb_add(&bar[XB_XSUB(b.x)], 1u);
        const unsigned gen = old / nloc;
        if (old + 1u == (gen + 1u) * nloc) {
            __builtin_amdgcn_fence(__ATOMIC_RELEASE, "agent");
            asm volatile("s_waitcnt vmcnt(0)" ::: "memory");
            const unsigned og = xb_add(&bar[XB_TOP], 1u);
            const unsigned tg = og / nx;
            if (og + 1u == (tg + 1u) * nx) xb_add(&bar[XB_TOPGEN], 1u);
            else XB_SPIN(xb_ld(&bar[XB_TOPGEN]) == tg, bar);
            __builtin_amdgcn_fence(__ATOMIC_ACQUIRE, "agent");
            xb_add(&bar[XB_XGEN(b.x)], 1u);
            asm volatile("s_waitcnt vmcnt(0)" ::: "memory");
        } else {
            XB_SPIN(xb_ld(&bar[XB_XGEN(b.x)]) == gen, bar);
            __builtin_amdgcn_fence(__ATOMIC_ACQUIRE, "agent");
            asm volatile("s_waitcnt vmcnt(0)" ::: "memory");
        }
    }
    __syncthreads();
}

constexpr int LDS_TAB = 131072 + 1024;
__device__ __forceinline__ void fill_rstd_tab(LAS unsigned char* lds, const float* ssp, int t) {
    LAS float* tab = (LAS float*)(lds + LDS_TAB);
    const int tid = opaque_tid();
    if (tid < 256) tab[tid] = pg8::rstd_row(ssp, t * 256 + tid);
    __syncthreads();
}
constexpr int N_PHASES = 28;
#ifndef PGA
#define PGA true
#endif
#ifndef PGA1
#define PGA1 true
#endif
#ifndef PGS
#define PGS true
#endif
#ifndef DBG_DUMP_OFF
#define DBG_DUMP_OFF WS_BC
#endif
#ifndef DBG_NPH
#define DBG_NPH N_PHASES
#endif
#ifndef DBG_DUMP
#define DBG_DUMP 0
#endif
enum Kind { K_P0, K_WIN, K_S1, K_S2, K_WOUT, K_QKV, K_ATT, K_W1, K_W2, K_PLE, K_FINAL, K_DUMP };

__global__ void __launch_bounds__(NTHREADS, 2) mega_fwd(Args args) {
    extern __shared__ __attribute__((aligned(16))) unsigned char lds_raw[];
    LAS unsigned char* lds = (LAS unsigned char*)lds_raw;
    cg::grid_group grid = cg::this_grid();
    const int G = gridDim.x;
    KA ka0 = (KA)__builtin_amdgcn_kernarg_segment_ptr();
    const int lo = *(const int __attribute__((address_space(4)))*)(ka0 + 192), hi = *(const int __attribute__((address_space(4)))*)(ka0 + 196);
    if (hi - lo > 1) {
        volatile LAS unsigned* st = (volatile LAS unsigned*)(lds + 131072 + 64);
        if (threadIdx.x < 2) st[threadIdx.x] = 0u;
        __syncthreads();
        unsigned char* ws0 = *(unsigned char* const __attribute__((address_space(4)))*)(ka0 + 184);
        (void)xcd_barrier_post((unsigned*)(ws0 + WS_BAR), st);
    }
    if (hi > 100000) grid.sync();
    for (int ph = lo; ph < hi; ++ph) {
        KA ka = ka0; asm volatile("" : "+s"(ka));
        unsigned char* ws = *(unsigned char* const __attribute__((address_space(4)))*)(ka + 184);
        float* hout = *(float* const __attribute__((address_space(4)))*)(ka + 176);
        float* ss = (float*)(ws + WS_SS);
        int kind, L = 0;
        if (ph == 0) kind = K_P0; else if (ph == 99) kind = K_DUMP; else if (ph == N_PHASES - 1) kind = K_FINAL;
        else { int q = ph - 1; const int pair = q / 13; q -= pair * 13; L = 2 * pair;
            if (q < 7) { kind = (q == 0) ? K_WIN : (q == 1) ? K_S1 : (q == 2) ? K_S2 : (q == 3) ? K_WOUT : (q == 4) ? K_W1 : (q == 5) ? K_W2 : K_PLE; }
            else { q -= 7; L += 1; kind = (q == 0) ? K_QKV : (q == 1) ? K_ATT : (q == 2) ? K_WOUT : (q == 3) ? K_W1 : (q == 4) ? K_W2 : K_PLE; } }
        const int j = L >> 1;
        bf16* Xc = (bf16*)(ws + ((L & 1) ? WS_X1 : WS_X0));
        bf16* Xo = (bf16*)(ws + ((L & 1) ? WS_X0 : WS_X1));
        const float* ss_mix = ss + (size_t)(3 * L) * SEQ * 32; float* ss_mlp = ss + (size_t)(3 * L + 1) * SEQ * 32; float* ss_ple = ss + (size_t)(3 * L + 2) * SEQ * 32; float* ss_next = ss + (size_t)(3 * L + 3) * SEQ * 32;
        switch (kind) {
        case K_P0:
#ifndef DIS_P0
 p0_phase(lds, ka, ws, G);
#endif
 break;
        case K_WIN: {
#ifdef DBG_BJ0
            pg8::Gemm g{Xc, (const bf16*)(ws + WS_WINT), SEQ, 2 * DM, DM};
#elif defined(DBG_AX1)
            pg8::Gemm g{(L == 2) ? Xo : Xc, (const bf16*)(ws + WS_WINT) + (size_t)j * DM * 2 * DM, SEQ, 2 * DM, DM};
#else
            pg8::Gemm g{Xc, (const bf16*)(ws + WS_WINT) + (size_t)j * DM * 2 * DM, SEQ, 2 * DM, DM};
#endif
            pg8::StaticOrder S; S.init(SEQ, 2 * DM, G, (int)blockIdx.x);
#ifdef DBG_FRESHOUT

#elif defined(DBG_SS0)

#else
            pg8::Unit u0; S.next(0, u0); fill_rstd_tab(lds, ss_mix, u0.pm);
            pg8::EpiAct<0> E{(bf16*)(ws + WS_BA), (bf16*)(ws + WS_BB), DM, DM, ss_mix, (const LAS float*)(lds + LDS_TAB), u0.pm};
#endif
#ifndef DIS_ACT0
            pg8::gemm_phase<pg8::EpiAct<0>, pg8::StaticOrder, PGA, PGS>(lds, g, S, E);
#endif
        } break;
        case K_S1: case K_S2: {
            ScanArgs sa{(const bf16*)(ws + WS_BA), (const bf16*)(ws + WS_BB), (bf16*)(ws + WS_BC),
                        INP(7) + (size_t)j * 4 * DM, INP(8) + (size_t)j * DM,
                        (const bf16*)(ws + WS_GAT) + (size_t)j * 32 * 128 * 128, (const bf16*)(ws + WS_GXT) + (size_t)j * 32 * 128 * 128,
                        INP(10) + (size_t)j * 2 * DM, INP(12) + (size_t)j * 2 * DM, INP(13) + (size_t)j * 2 * DM,
                        (f32x2*)(ws + WS_AGG)};
            #ifndef DIS_SCAN
            if (kind == K_S1) scan_phase<false>(lds, sa, G); else scan_phase<true>(lds, sa, G);
#endif
        } break;
        case K_QKV: {
            {
                pg8::Gemm g{Xc, (const bf16*)(ws + WS_WQKVT) + (size_t)j * 3 * DM * DM, SEQ, 2 * DM, DM};
                pg8::StaticOrder S; S.init(SEQ, 2 * DM, G, (int)blockIdx.x);
                pg8::Unit u0; S.next(0, u0); fill_rstd_tab(lds, ss_mix, u0.pm);
                pg8::EpiAct<1> E{(bf16*)(ws + WS_BA), (bf16*)(ws + WS_BB), DM, DM, ss_mix, (const LAS float*)(lds + LDS_TAB), u0.pm};
#ifndef DIS_ACT1
                pg8::gemm_phase<pg8::EpiAct<1>, pg8::StaticOrder, PGA, PGS>(lds, g, S, E);
#endif
            }
            __syncthreads();
            {
                pg8::Gemm g{(const bf16*)(ws + WS_WQKVT) + (size_t)j * 3 * DM * DM + (size_t)2 * DM * DM, Xc, DM, SEQ, DM};
                pg8::StaticOrder S; S.init(DM, SEQ, G, (int)blockIdx.x);
                pg8::Unit u0; S.next(0, u0); fill_rstd_tab(lds, ss_mix, u0.pn);
                pg8::EpiAct<4> E{(bf16*)(ws + WS_BD), nullptr, SEQ, 0, ss_mix, (const LAS float*)(lds + LDS_TAB), u0.pn};
#ifndef DIS_ACT4
                pg8::gemm_phase<pg8::EpiAct<4>, pg8::StaticOrder, PGA1, PGS>(lds, g, S, E);
#endif
            }
        } break;
        case K_ATT: {
            AttArgs aa{(const bf16*)(ws + WS_BA), (const bf16*)(ws + WS_BB), (const bf16*)(ws + WS_BD), (bf16*)(ws + WS_BC), INP(16) + (size_t)j * NHEAD * 465};
#ifndef DIS_ATT
#ifdef ATT_V1
            attn_phase(lds, aa, G);
#else
            attn_phase2(lds, aa, G);
#endif
#endif
        } break;
        case K_WOUT: case K_W2: {
            const bf16* A; const bf16* Bt; int K;
            float* sso; bf16* hb;
            if (kind == K_WOUT) { A = (const bf16*)(ws + WS_BC); K = DM; Bt = (L & 1) ? (const bf16*)(ws + WS_WONT) + (size_t)j * DM * DM : (const bf16*)(ws + WS_WORT) + (size_t)j * DM * DM; sso = ss_mlp; hb = Xo; }
            else { A = (const bf16*)(ws + WS_A1); K = DFF; Bt = (const bf16*)(ws + WS_W2T) + (size_t)L * DM * DFF; sso = ss_ple; hb = Xc; }
            const float* base = (kind == K_WOUT && L == 0) ? INP(0) : hout;
            pg8::Gemm g{A, Bt, SEQ, DM, K};
            pg8::StaticOrder S; S.init(SEQ, DM, G, (int)blockIdx.x);
            pg8::EpiRes<0> E{base, hout, hb, sso, nullptr, nullptr, (const LAS float*)(lds + LDS_TAB), -1};
#ifndef DIS_RES0
            pg8::gemm_phase<pg8::EpiRes<0>, pg8::StaticOrder, PGA1, PGS>(lds, g, S, E);
#endif
        } break;
        case K_W1: {
            {
                int Kp = PLE; asm volatile("" : "+s"(Kp));
                pg8::Gemm g{(const bf16*)(ws + WS_PB) + (size_t)L * SEQ * PLE, (const bf16*)(ws + WS_WPT) + (size_t)L * DM * PLE, SEQ, DM, Kp};
                pg8::StaticOrder S; S.init(SEQ, DM, G, (int)blockIdx.x);
                pg8::EpiAct<3> E{(bf16*)(ws + WS_PROJ) + (size_t)L * SEQ * DM, nullptr, DM, 0, nullptr, (const LAS float*)(lds + LDS_TAB), -1};
#ifndef DIS_ACT3
                pg8::gemm_phase<pg8::EpiAct<3>, pg8::StaticOrder, PGA1, PGS>(lds, g, S, E);
#endif
            }
            __syncthreads();
            pg8::Gemm g{Xo, (const bf16*)(ws + WS_W1T) + (size_t)L * DM * DFF, SEQ, DFF, DM};
            pg8::StaticOrder S; S.init(SEQ, DFF, G, (int)blockIdx.x);
            pg8::Unit u0; S.next(0, u0); fill_rstd_tab(lds, ss_mlp, u0.pm);
            pg8::EpiAct<2> E{(bf16*)(ws + WS_A1), nullptr, DFF, 0, ss_mlp, (const LAS float*)(lds + LDS_TAB), u0.pm};
#ifndef DIS_ACT2
            pg8::gemm_phase<pg8::EpiAct<2>, pg8::StaticOrder, PGA, PGS>(lds, g, S, E);
#endif
        } break;
        case K_PLE: {
            pg8::Gemm g{Xc, (const bf16*)(ws + WS_WGT) + (size_t)L * DM * DM, SEQ, DM, DM};
            pg8::StaticOrder S; S.init(SEQ, DM, G, (int)blockIdx.x);
            pg8::Unit u0; S.next(0, u0); fill_rstd_tab(lds, ss_ple, u0.pm);
            pg8::EpiRes<1> E{hout, hout, Xo, ss_next, ss_ple, (const bf16*)(ws + WS_PROJ) + (size_t)L * SEQ * DM, (const LAS float*)(lds + LDS_TAB), u0.pm};
#ifndef DIS_RES1
            pg8::gemm_phase<pg8::EpiRes<1>, pg8::StaticOrder, PGA1, PGS>(lds, g, S, E);
#endif
        } break;
#if DBG_DUMP
        case K_DUMP: {
            const bf16* src = (const bf16*)(ws + DBG_DUMP_OFF); const float* srcf = (const float*)(ws + DBG_DUMP_OFF);
            for (size_t i = (size_t)blockIdx.x * NTHREADS + threadIdx.x; i < (size_t)SEQ * DM; i += (size_t)G * NTHREADS) hout[i] = (DBG_DUMP == 2) ? srcf[i & 8191] : bfl((unsigned)src[i]);
        } break;
#endif
        case K_FINAL: final_phase(hout, ss + (size_t)12 * SEQ * 32, INP(5), G); break;
        }
        if (ph + 1 < hi) { XcdBarrier b; b.bar = (unsigned*)(ws + WS_BAR); b.x = xb_xcc_id(); b.st = (volatile LAS unsigned*)(lds + 131072 + 64); xcd_barrier(b);
#ifdef DBG_DBLBAR
            xcd_barrier(b);
#endif
        }
    }
}

#ifndef MK_MULTI
#define MK_MULTI 0
#endif

extern "C" void kernel_launch(void* const* d_in, const int* in_sizes, int n_in, void* d_out, int out_size, void* d_ws, size_t ws_size, hipStream_t stream) {
    static int grid = 0;
    if (grid == 0) {
        if (n_in != 22 || out_size != SEQ * DM || ws_size < WS_END) { fprintf(stderr, "kernel_launch: unexpected shapes (n_in %d out %d ws %zu)\n", n_in, out_size, ws_size); grid = -1; return; }
        int dev = 0, cus = 0, per_cu = 0;
        (void)hipGetDevice(&dev); (void)hipDeviceGetAttribute(&cus, hipDeviceAttributeMultiprocessorCount, dev);
        if (hipFuncSetAttribute((const void*)mega_fwd, hipFuncAttributeMaxDynamicSharedMemorySize, LDS_BYTES) != hipSuccess) { fprintf(stderr, "kernel_launch: hipFuncSetAttribute failed\n"); grid = -1; return; }
        if (hipOccupancyMaxActiveBlocksPerMultiprocessor(&per_cu, (const void*)mega_fwd, NTHREADS, LDS_BYTES) != hipSuccess || per_cu < 1) { fprintf(stderr, "kernel_launch: occupancy query says %d\n", per_cu); per_cu = 1; }
        (void)hipGetLastError();
        grid = cus * per_cu; if (grid > 256) grid = 256;
        fprintf(stderr, "kernel_launch: grid %d (cus %d per_cu %d)\n", grid, cus, per_cu);
    }
    if (grid < 0) return;
    Args a{};
    for (int i = 0; i < 22; ++i) a.in[i] = (const float*)d_in[i];
    a.out = (float*)d_out; a.ws = (unsigned char*)d_ws;
#if MK_MULTI
#ifdef DBG_SEQ
    { const int seq[] = {DBG_SEQ}; for (int ph : seq) { a.ph_lo = ph; a.ph_hi = ph + 1; hipLaunchKernelGGL(mega_fwd, dim3(grid), dim3(NTHREADS), LDS_BYTES, stream, a); } }
#else
    for (int ph = 0; ph < DBG_NPH; ++ph) { a.ph_lo = ph; a.ph_hi = ph + 1; hipLaunchKernelGGL(mega_fwd, dim3(grid), dim3(NTHREADS), LDS_BYTES, stream, a); }
#endif
    if (DBG_DUMP) { a.ph_lo = 99; a.ph_hi = 100; hipLaunchKernelGGL(mega_fwd, dim3(grid), dim3(NTHREADS), LDS_BYTES, stream, a); }
#else
    a.ph_lo = 0; a.ph_hi = N_PHASES;
    if (hipMemsetAsync((char*)d_ws + WS_BAR, 0, 16384, stream) != hipSuccess) { fprintf(stderr, "kernel_launch: memset of the barrier words failed\n"); return; }
    void* kargs[] = {&a};
    hipError_t e = hipLaunchCooperativeKernel((const void*)mega_fwd, dim3(grid), dim3(NTHREADS), kargs, LDS_BYTES, stream);
    if (e != hipSuccess) fprintf(stderr, "kernel_launch: cooperative launch failed: %s (grid %d)\n", hipGetErrorString(e), grid);
#endif
}
```

```cpp
#include <hip/hip_runtime.h>
#include <hip/hip_cooperative_groups.h>
#include <cstdio>
#include <cstdint>
namespace cg = cooperative_groups;
namespace pg8 {
#define PG8_LAS __attribute__((address_space(3)))
typedef unsigned short bf16_t;
typedef short bf16x8 __attribute__((ext_vector_type(8)));
typedef float f32x4 __attribute__((ext_vector_type(4)));
typedef unsigned u32x4 __attribute__((ext_vector_type(4)));
constexpr int BM = 256, BK = 64, HALF = 128, HTB = HALF * BK * 2  , STAGE_BYTES = 8 * HTB, NXCD = 8, WGM = 8;

__host__ __device__ __forceinline__ int lds_byte(int r, int c) { const int st = (r >> 4) * 2 + (c >> 5), rr = r & 15, cc = c & 31, ob = rr * 64 + cc * 2; return st * 1024 + (ob ^ (((ob >> 9) & 1) << 5)); }
__host__ __device__ __forceinline__ void stage_rc(int b, int& R, int& C) { const int st = b / 1024, sb = b % 1024, swz = sb ^ (((sb >> 9) & 1) << 5); R = (st >> 1) * 16 + swz / 64; C = (st & 1) * 32 + (swz % 64) / 2; }
__host__ __device__ __forceinline__ int perm32(int rho) { const int n = rho >> 4, i = rho & 15; return 8 * (i >> 2) + 4 * n + (i & 3); }

struct Unit { int pm, pn; };
struct Gemm { const bf16_t* A; const bf16_t* Bt; int M, N, K; };

struct StaticOrder {
    int nM, nN, nwg, G, c;
    __host__ __device__ void init(int M, int N, int G_, int c_) { nM = M / BM; nN = N / BM; nwg = nM * nN; G = G_; c = c_; }
    __host__ __device__ bool next(int i, Unit& u) const {
        const long L = (long)i * G + c; if (L >= nwg) return false;
        int wgid = (int)L; { const int q = nwg / NXCD, r = nwg % NXCD, xcd = wgid % NXCD, off = wgid / NXCD; wgid = (xcd < r ? xcd * (q + 1) : r * (q + 1) + (xcd - r) * q) + off; }
        const int nig = WGM * nN, gid = wgid / nig, fm = gid * WGM, gsz = (nM - fm) < WGM ? (nM - fm) : WGM;
        u.pm = fm + ((wgid % nig) % gsz); u.pn = (wgid % nig) / gsz; return true;
    }
    __device__ __forceinline__ void a_ready(const Unit&) const {}
    __device__ __forceinline__ void done(const Unit&) const {}
};

__device__ __forceinline__ unsigned cvt_pk_bf16(float lo, float hi) { unsigned r; asm volatile("v_cvt_pk_bf16_f32 %0, %1, %2" : "=v"(r) : "v"(lo), "v"(hi)); return r; }
typedef float f32x2 __attribute__((ext_vector_type(2)));
constexpr float RMS_EPS = 1e-6f;
constexpr int DM = 2048;
__device__ __forceinline__ float fsigmoid(float x) { return __builtin_amdgcn_rcpf(1.f + __expf(-x)); }
__device__ __forceinline__ float gelu_tanh(float v) { return v * fsigmoid(1.5957691216057308f * (v + 0.044715f * v * v * v)); }
__device__ __forceinline__ float rstd_row(const float* ssp, int row) {
    const f32x4* p = (const f32x4*)(ssp + (size_t)row * 32); float s = 0.f;
#pragma unroll
    for (int i = 0; i < 8; ++i) { const f32x4 v = p[i]; s += (v[0] + v[1]) + (v[2] + v[3]); }
    return rsqrtf(s * (1.f / DM) + RMS_EPS);
}
__device__ __forceinline__ float bf_lo(unsigned w) { return __uint_as_float(w << 16); }
__device__ __forceinline__ float bf_hi(unsigned w) { return __uint_as_float(w & 0xffff0000u); }

template <int MODE> struct EpiAct {
    static constexpr bool PERM = true, AFTER_DRAIN = false;
    bf16_t* O0; bf16_t* O1; int ldc; int split; const float* ss; const PG8_LAS float* tab; int tab_t;
    __device__ __forceinline__ void operator()(const f32x4 (&acc)[2][2][4][2], const Unit& u, int wr, int wc, int fr, int fq) const {
        const int row0 = u.pm * BM + wr * 64 + fr; int colt = u.pn * BM; bf16_t* base = O0; bool second = false;
        if (MODE <= 1) { if (colt >= split) { base = O1; colt -= split; second = true; } }
        const int col0 = colt + wc * 32 + 8 * fq;
        f32x4 cs[2][2];
        if (MODE == 4) {
#pragma unroll
            for (int bj = 0; bj < 2; ++bj)
#pragma unroll
                for (int n = 0; n < 2; ++n) {
#pragma unroll
                    for (int e = 0; e < 4; ++e) cs[bj][n][e] = (u.pn == tab_t) ? tab[col0 - u.pn * BM + bj * HALF + 4 * n + e] : rstd_row(ss, col0 + bj * HALF + 4 * n + e); }
        }
#pragma unroll
        for (int ai = 0; ai < 2; ++ai)
#pragma unroll
            for (int m = 0; m < 4; ++m) {
                const int row = row0 + ai * HALF + m * 16;
                float rs = 1.f;
                if (MODE <= 2) { rs = (u.pm == tab_t) ? tab[row - u.pm * BM] : rstd_row(ss, row); if (MODE == 1 && !second) rs *= 0.08838834764831845f; }
                bf16_t* rowp = base + (size_t)row * ldc + col0;
#pragma unroll
                for (int bj = 0; bj < 2; ++bj) {
                    f32x4 v0 = acc[ai][bj][m][0], v1 = acc[ai][bj][m][1];
                    if (MODE == 4) { v0 = v0 * cs[bj][0]; v1 = v1 * cs[bj][1]; } else { v0 = v0 * rs; v1 = v1 * rs; }
                    if (MODE == 0) { if (second) {
#pragma unroll
                        for (int e = 0; e < 4; ++e) { v0[e] = gelu_tanh(v0[e]); v1[e] = gelu_tanh(v1[e]); } } }
                    if (MODE == 2) {
#pragma unroll
                        for (int e = 0; e < 4; ++e) { const float a = fmaxf(v0[e], 0.f), b = fmaxf(v1[e], 0.f); v0[e] = a * a; v1[e] = b * b; } }
                    u32x4 w; w.x = cvt_pk_bf16(v0[0], v0[1]); w.y = cvt_pk_bf16(v0[2], v0[3]); w.z = cvt_pk_bf16(v1[0], v1[1]); w.w = cvt_pk_bf16(v1[2], v1[3]);
                    *(u32x4*)(rowp + bj * HALF) = w;
                }
                asm volatile("" ::: "memory");
            }
    }
};

template <int MODE> struct EpiRes {
    static constexpr bool PERM = true, AFTER_DRAIN = false;
    const bf16_t* base; bf16_t* out; float* ss_out; const float* ss_in; const bf16_t* proj; const PG8_LAS float* tab; int tab_t;
    __device__ __forceinline__ void operator()(const f32x4 (&acc)[2][2][4][2], const Unit& u, int wr, int wc, int fr, int fq) const {
        const int row0 = u.pm * BM + wr * 64 + fr; const int col0 = u.pn * BM + wc * 32 + 8 * fq;
#pragma unroll
        for (int aim = 0; aim < 4; ++aim) { const int ai = aim >> 1, mh = (aim & 1) * 2;
            u32x4 bpre[2][2]; u32x4 ppre[2][2];
#pragma unroll
            for (int mm = 0; mm < 2; ++mm) { const int m = mh + mm; const size_t off = (size_t)(row0 + ai * HALF + m * 16) * DM + col0;
#pragma unroll
                for (int bj = 0; bj < 2; ++bj) { bpre[mm][bj] = *(const u32x4*)(base + off + bj * HALF);
                    if (MODE == 1) ppre[mm][bj] = *(const u32x4*)(proj + off + bj * HALF); } }
#pragma unroll
            for (int mm = 0; mm < 2; ++mm) { const int m = mh + mm;
                const int row = row0 + ai * HALF + m * 16; const size_t off = (size_t)row * DM + col0;
                float rs = 0.f; if (MODE == 1) rs = (u.pm == tab_t) ? tab[row - u.pm * BM] : rstd_row(ss_in, row);
                float sq = 0.f;
#pragma unroll
                for (int bj = 0; bj < 2; ++bj) {
                    const u32x4 bw = bpre[mm][bj];
                    const f32x4 b0 = (f32x4){bf_lo(bw.x), bf_hi(bw.x), bf_lo(bw.y), bf_hi(bw.y)}, b1 = (f32x4){bf_lo(bw.z), bf_hi(bw.z), bf_lo(bw.w), bf_hi(bw.w)};
                    f32x4 v0 = acc[ai][bj][m][0], v1 = acc[ai][bj][m][1];
                    if (MODE == 1) {
                        const u32x4 pw = ppre[mm][bj];
                        const f32x4 p0 = (f32x4){bf_lo(pw.x), bf_hi(pw.x), bf_lo(pw.y), bf_hi(pw.y)}, p1 = (f32x4){bf_lo(pw.z), bf_hi(pw.z), bf_lo(pw.w), bf_hi(pw.w)};
#pragma unroll
                        for (int e = 0; e < 4; ++e) { v0[e] = fsigmoid(v0[e] * rs) * p0[e]; v1[e] = fsigmoid(v1[e] * rs) * p1[e]; }
                    }
                    const f32x4 o0 = b0 + v0, o1 = b1 + v1;
                    u32x4 w; w.x = cvt_pk_bf16(o0[0], o0[1]); w.y = cvt_pk_bf16(o0[2], o0[3]); w.z = cvt_pk_bf16(o1[0], o1[1]); w.w = cvt_pk_bf16(o1[2], o1[3]);
                    *(u32x4*)(out + off + bj * HALF) = w;
                    sq += (o0[0] * o0[0] + o0[1] * o0[1]) + (o0[2] * o0[2] + o0[3] * o0[3]) + (o1[0] * o1[0] + o1[1] * o1[1]) + (o1[2] * o1[2] + o1[3] * o1[3]);
                }
                sq += __shfl_xor(sq, 16); sq += __shfl_xor(sq, 32);
                if (fq == 0) ss_out[(size_t)row * 32 + u.pn * 4 + wc] = sq;
            }
            asm volatile("" ::: "memory");
        }
    }
};

template <class Epi, class Sched, bool ALIGN_EPI = false, bool SP2 = false>
__device__ __forceinline__ void gemm_phase(PG8_LAS unsigned char* lds, const Gemm g, const Sched& S, const Epi& E) {
    int tid_ = threadIdx.x; asm volatile("" : "+v"(tid_)); const int tid = tid_, wid = __builtin_amdgcn_readfirstlane(tid >> 6), lane = tid & 63, wr = wid >> 2, wc = wid & 3, fr = lane & 15, fq = lane >> 4;
    const int K = g.K, nt = K / BK;
    unsigned voffA[2], voffB[2];
#pragma unroll
    for (int i = 0; i < 2; ++i) { int R, C; stage_rc(tid * 16 + i * 8192, R, C); const int Rb = Epi::PERM ? ((R & ~31) + perm32(R & 31)) : R;
        voffA[i] = (unsigned)(R * K + C) * 2u; voffB[i] = (unsigned)(Rb * K + C) * 2u; }
    const size_t kstep = (size_t)(BK * 2);
    const size_t hstep = (size_t)HALF * K * 2;
    const size_t tstep = 2 * hstep;
    const unsigned ldsw = (unsigned)wid * 1024u;
    const int aoff = lds_byte(wr * 64 + fr, fq * 8), boff = lds_byte(wc * 32 + fr, fq * 8);
#define PG8_SA(b, h) (((b) * 2 + (h)) * HTB)
#define PG8_SB(b, h) ((4 + (b) * 2 + (h)) * HTB)
#define PG8_STAGE(bufoff, gbase, voff) do { _Pragma("unroll") for (int _i = 0; _i < 2; ++_i) \
        __builtin_amdgcn_global_load_lds((const unsigned*)((const char*)(gbase) + (voff)[_i]), (PG8_LAS unsigned*)(lds + (bufoff) + ldsw + _i * 8192), 16, 0, 0); } while (0)
#define PG8_LDA(dst, b, h) do { _Pragma("unroll") for (int m = 0; m < 4; ++m) _Pragma("unroll") for (int k = 0; k < 2; ++k) dst[m][k] = *(const PG8_LAS bf16x8*)(lds + PG8_SA(b, h) + aoff + m * 2048 + k * 1024); } while (0)
#define PG8_LDB(dst, b, h) do { _Pragma("unroll") for (int n = 0; n < 2; ++n) _Pragma("unroll") for (int k = 0; k < 2; ++k) dst[n][k] = *(const PG8_LAS bf16x8*)(lds + PG8_SB(b, h) + boff + n * 2048 + k * 1024); } while (0)
#define PG8_MMA(ai, bj, At, Bt) do { __builtin_amdgcn_s_setprio(1); _Pragma("unroll") for (int m = 0; m < 4; ++m) _Pragma("unroll") for (int n = 0; n < 2; ++n) _Pragma("unroll") for (int k = 0; k < 2; ++k) \
        acc[ai][bj][m][n] = __builtin_amdgcn_mfma_f32_16x16x32_bf16(Bt[n][k], At[m][k], acc[ai][bj][m][n], 0, 0, 0); __builtin_amdgcn_s_setprio(0); } while (0)
#define PG8_WAIT_V(n) asm volatile("s_waitcnt vmcnt(" #n ")" ::: "memory")
#define PG8_WAIT_L(n) asm volatile("s_waitcnt lgkmcnt(" #n ")" ::: "memory")
#define PG8_BAR __builtin_amdgcn_s_barrier()
#define PG8_SCHED __builtin_amdgcn_sched_barrier(0)
    Unit cur, nxt; int ui = 0;
    if (!S.next(0, cur)) return;
    f32x4 acc[2][2][4][2];
#pragma unroll
    for (int a = 0; a < 2; ++a)
#pragma unroll
        for (int b = 0; b < 2; ++b)
#pragma unroll
            for (int m = 0; m < 4; ++m)
#pragma unroll
                for (int n = 0; n < 2; ++n) acc[a][b][m][n] = (f32x4){0.f, 0.f, 0.f, 0.f};
    bf16x8 At[4][2], B0[2][2], B1[2][2];
    const char* cA = (const char*)g.A + (size_t)cur.pm * tstep; const char* cB = (const char*)g.Bt + (size_t)cur.pn * tstep;
    S.a_ready(cur);
    if constexpr (SP2) {
        PG8_STAGE(PG8_SB(0, 0), cB, voffB); PG8_STAGE(PG8_SB(0, 1), cB + hstep, voffB); PG8_STAGE(PG8_SA(0, 0), cA, voffA); PG8_STAGE(PG8_SA(0, 1), cA + hstep, voffA);
        if (wr == 1) PG8_BAR;
        PG8_WAIT_V(2); PG8_BAR;
        PG8_STAGE(PG8_SB(1, 0), cB + kstep, voffB); PG8_STAGE(PG8_SA(1, 0), cA + kstep, voffA); PG8_STAGE(PG8_SB(1, 1), cB + hstep + kstep, voffB);
        PG8_WAIT_V(6); PG8_BAR;
    } else {
        PG8_STAGE(PG8_SB(0, 0), cB, voffB); PG8_STAGE(PG8_SA(0, 0), cA, voffA); PG8_STAGE(PG8_SB(0, 1), cB + hstep, voffB); PG8_STAGE(PG8_SA(0, 1), cA + hstep, voffA);
        if (wr == 1) PG8_BAR;
        PG8_WAIT_V(4); PG8_BAR;
        PG8_STAGE(PG8_SB(1, 0), cB + kstep, voffB); PG8_STAGE(PG8_SA(1, 0), cA + kstep, voffA); PG8_STAGE(PG8_SB(1, 1), cB + hstep + kstep, voffB);
        PG8_WAIT_V(6); PG8_BAR;
    }
    for (;;) {
        const bool has_next = S.next(ui + 1, nxt);
        const char* nA = has_next ? (const char*)g.A + (size_t)nxt.pm * tstep : cA; const char* nB = has_next ? (const char*)g.Bt + (size_t)nxt.pn * tstep : cB;
        for (int t = 0; t < nt; t += 2) {
            const bool last = (t == nt - 2);
            const char* a1 = cA + (size_t)(t + 1) * kstep;
            const char* a2 = last ? nA : cA + (size_t)(t + 2) * kstep; const char* b2 = last ? nB : cB + (size_t)(t + 2) * kstep;
            const char* a3 = a2 + kstep; const char* b3 = b2 + kstep;
            if (last && has_next) S.a_ready(nxt);
            if constexpr (SP2) {
            PG8_LDB(B0, 0, 0); PG8_LDB(B1, 0, 1); PG8_SCHED; PG8_LDA(At, 0, 0); PG8_STAGE(PG8_SA(1, 1), a1 + hstep, voffA);
            PG8_WAIT_V(8); PG8_WAIT_L(0); PG8_BAR; PG8_MMA(0, 0, At, B0); PG8_MMA(0, 1, At, B1); PG8_BAR; PG8_SCHED;
            PG8_LDA(At, 0, 1); PG8_STAGE(PG8_SB(0, 0), b2, voffB); PG8_STAGE(PG8_SB(0, 1), b2 + hstep, voffB); PG8_STAGE(PG8_SA(0, 0), a2, voffA);
            PG8_WAIT_V(8); PG8_WAIT_L(0); PG8_BAR; PG8_MMA(1, 0, At, B0); PG8_MMA(1, 1, At, B1); PG8_BAR; PG8_SCHED;
            PG8_LDB(B0, 1, 0); PG8_LDB(B1, 1, 1); PG8_SCHED; PG8_LDA(At, 1, 0); PG8_STAGE(PG8_SA(0, 1), a2 + hstep, voffA);
            PG8_WAIT_V(8); PG8_WAIT_L(0); PG8_BAR; PG8_MMA(0, 0, At, B0); PG8_MMA(0, 1, At, B1); PG8_BAR; PG8_SCHED;
            PG8_LDA(At, 1, 1); PG8_STAGE(PG8_SB(1, 0), b3, voffB); PG8_STAGE(PG8_SB(1, 1), b3 + hstep, voffB); PG8_STAGE(PG8_SA(1, 0), a3, voffA);
            PG8_WAIT_V(8); PG8_WAIT_L(0); PG8_BAR; PG8_MMA(1, 0, At, B0); PG8_MMA(1, 1, At, B1); PG8_BAR; PG8_SCHED;
            } else {
            PG8_LDB(B0, 0, 0); PG8_SCHED; PG8_LDA(At, 0, 0); PG8_STAGE(PG8_SA(1, 1), a1 + hstep, voffA);
            PG8_WAIT_L(8); PG8_BAR; PG8_WAIT_L(0); PG8_MMA(0, 0, At, B0); PG8_BAR; PG8_SCHED;
            PG8_LDB(B1, 0, 1); PG8_STAGE(PG8_SB(0, 0), b2, voffB);
            PG8_BAR; PG8_WAIT_L(0); PG8_MMA(0, 1, At, B1); PG8_BAR;
            PG8_LDA(At, 0, 1); PG8_STAGE(PG8_SA(0, 0), a2, voffA);
            PG8_BAR; PG8_WAIT_L(0); PG8_MMA(1, 0, At, B0); PG8_BAR; PG8_SCHED;
            PG8_STAGE(PG8_SB(0, 1), b2 + hstep, voffB);
            PG8_WAIT_V(6); PG8_BAR; PG8_MMA(1, 1, At, B1); PG8_BAR;
            PG8_LDB(B0, 1, 0); PG8_SCHED; PG8_LDA(At, 1, 0); PG8_STAGE(PG8_SA(0, 1), a2 + hstep, voffA);
            PG8_WAIT_L(8); PG8_BAR; PG8_WAIT_L(0); PG8_MMA(0, 0, At, B0); PG8_BAR; PG8_SCHED;
            PG8_LDB(B1, 1, 1); PG8_STAGE(PG8_SB(1, 0), b3, voffB);
            PG8_BAR; PG8_WAIT_L(0); PG8_MMA(0, 1, At, B1); PG8_BAR;
            PG8_LDA(At, 1, 1); PG8_STAGE(PG8_SA(1, 0), a3, voffA);
            PG8_BAR; PG8_WAIT_L(0); PG8_MMA(1, 0, At, B0); PG8_BAR; PG8_SCHED;
            PG8_STAGE(PG8_SB(1, 1), b3 + hstep, voffB);
            PG8_WAIT_V(6); PG8_BAR; PG8_MMA(1, 1, At, B1); PG8_BAR;
            }
        }
        if constexpr (ALIGN_EPI) { if (wr == 0) PG8_BAR; }
        if constexpr (!Epi::AFTER_DRAIN) { E(acc, cur, wr, wc, fr, fq); S.done(cur); }
        if (!has_next) break;
#pragma unroll
        for (int a = 0; a < 2; ++a)
#pragma unroll
            for (int b = 0; b < 2; ++b)
#pragma unroll
                for (int m = 0; m < 4; ++m)
#pragma unroll
                    for (int n = 0; n < 2; ++n) acc[a][b][m][n] = (f32x4){0.f, 0.f, 0.f, 0.f};
        cur = nxt; cA = nA; cB = nB; ++ui;
        if constexpr (ALIGN_EPI) { if (wr == 1) PG8_BAR; }
    }
    PG8_WAIT_V(0);
    if constexpr (!ALIGN_EPI) { if (wr == 0) PG8_BAR; }
    PG8_BAR;
    if constexpr (Epi::AFTER_DRAIN) { E.fused(acc, cur, wr, wc, fr, fq, lds, wid, lane); S.done(cur); }
#undef PG8_SA
#undef PG8_SB
#undef PG8_STAGE
#undef PG8_LDA
#undef PG8_LDB
#undef PG8_MMA
#undef PG8_WAIT_V
#undef PG8_WAIT_L
#undef PG8_BAR
#undef PG8_SCHED
}
}

constexpr int SEQ = 8192, DM = 2048, DFF = 8192, PLE = 256, DEPTH = 4, NHEAD = 16, HD = 128;
constexpr int NWAVES = 8, NTHREADS = 512;
constexpr int LDS_BYTES = 147456;
typedef unsigned short bf16;
typedef unsigned u32x4 __attribute__((ext_vector_type(4)));
typedef unsigned u32x2 __attribute__((ext_vector_type(2)));
typedef float f32x4 __attribute__((ext_vector_type(4)));
typedef float f32x2 __attribute__((ext_vector_type(2)));
typedef short bf16x8 __attribute__((ext_vector_type(8)));
#define LAS __attribute__((address_space(3)))
#define LDS_WAIT() asm volatile("s_waitcnt lgkmcnt(0)" ::: "memory")

constexpr size_t MiB = 1u << 20;
constexpr size_t WS_SS = 880 * MiB;
constexpr size_t WS_BAR = 0;
constexpr size_t WS_AGG = 2 * MiB;
constexpr size_t WS_X0 = 8 * MiB, WS_X1 = 40 * MiB;
constexpr size_t WS_BA = 72 * MiB, WS_BB = 104 * MiB, WS_BC = 136 * MiB, WS_BD = 168 * MiB;
constexpr size_t WS_A1 = 200 * MiB;
constexpr size_t WS_PROJ = 328 * MiB;
constexpr size_t WS_PB = 456 * MiB;
constexpr size_t WS_W1T = 472 * MiB, WS_W2T = 600 * MiB, WS_WGT = 728 * MiB, WS_WPT = 760 * MiB, WS_WINT = 764 * MiB, WS_WORT = 796 * MiB,
                 WS_GAT = 812 * MiB, WS_GXT = 814 * MiB, WS_WQKVT = 816 * MiB, WS_WONT = 864 * MiB, WS_END = 893 * MiB;

struct Args {
    const float* in[22];
    float* out; unsigned char* ws;
    int ph_lo, ph_hi;
};
static_assert(sizeof(Args) == 200 && offsetof(Args, out) == 176 && offsetof(Args, ws) == 184 && offsetof(Args, ph_lo) == 192, "Args layout");

typedef const unsigned char __attribute__((address_space(4)))* KA;
#define INP(k) (*(const float* const __attribute__((address_space(4)))*)(ka + 8 * (k)))
__device__ __forceinline__ int opaque_tid() { int t = threadIdx.x; asm volatile("" : "+v"(t)); return t; }
__device__ __forceinline__ unsigned cvt_pk(float lo, float hi) { return pg8::cvt_pk_bf16(lo, hi); }
__device__ __forceinline__ float bfl(unsigned w) { return __uint_as_float(w << 16); }
__device__ __forceinline__ float bfh(unsigned w) { return __uint_as_float(w & 0xffff0000u); }
__device__ __forceinline__ float wave_sum(float v) {
#pragma unroll
    for (int o = 1; o < 64; o <<= 1) v += __shfl_xor(v, o);
    return v;
}

__device__ __forceinline__ void transpose_item(const float* W, int K, int N, const float* g, bf16* WT, int kb, int nb, int lane) {
    const int q = lane >> 4, ln = lane & 15;
    const int kbase = 64 * kb + 16 * q, n = 64 * nb + 4 * ln;
    f32x4 v[16];
    const float* wp = W + (size_t)kbase * N + n;
#pragma unroll
    for (int i = 0; i < 16; ++i) v[i] = *(const f32x4*)(wp + (size_t)i * N);
    if (g) {
#pragma unroll
        for (int i4 = 0; i4 < 4; ++i4) { const f32x4 gv = *(const f32x4*)(g + kbase + 4 * i4);
#pragma unroll
            for (int e = 0; e < 4; ++e) v[4 * i4 + e] = v[4 * i4 + e] * gv[e]; }
    }
#pragma unroll
    for (int e = 0; e < 4; ++e) {
        bf16* op = WT + (size_t)(n + e) * K + kbase;
#pragma unroll
        for (int h = 0; h < 2; ++h) {
            u32x4 o; o.x = cvt_pk(v[8 * h + 0][e], v[8 * h + 1][e]); o.y = cvt_pk(v[8 * h + 2][e], v[8 * h + 3][e]); o.z = cvt_pk(v[8 * h + 4][e], v[8 * h + 5][e]); o.w = cvt_pk(v[8 * h + 6][e], v[8 * h + 7][e]);
            *(u32x4*)(op + 8 * h) = o;
        }
    }
}

__device__ __forceinline__ void p0_phase(LAS unsigned char* lds, KA ka, unsigned char* ws, int G) {
    const int tid = opaque_tid(), lane = tid & 63, wave = tid >> 6;
    const int gw = blockIdx.x * NWAVES + wave, NGW = G * NWAVES;
    float* ss = (float*)(ws + WS_SS);
    {
        const float* x = INP(0); bf16* X0 = (bf16*)(ws + WS_X0);
        for (int row = gw; row < SEQ; row += NGW) {
            const f32x4* xr = (const f32x4*)(x + (size_t)row * DM) + lane; float s = 0.f;
            u32x2* o = (u32x2*)(X0 + (size_t)row * DM) + lane;
#pragma unroll
            for (int j = 0; j < 8; ++j) { const f32x4 v = xr[64 * j]; s += (v[0] * v[0] + v[1] * v[1]) + (v[2] * v[2] + v[3] * v[3]); u32x2 w; w.x = cvt_pk(v[0], v[1]); w.y = cvt_pk(v[2], v[3]); o[64 * j] = w; }
            s = wave_sum(s);
            if (lane < 32) ss[(size_t)row * 32 + lane] = (lane == 0) ? s : 0.f;
        }
    }
    {
        const f32x4* p = (const f32x4*)INP(1); u32x2* o = (u32x2*)(ws + WS_PB);
        const int n4 = DEPTH * SEQ * PLE / 4;
        for (int i = blockIdx.x * NTHREADS + tid; i < n4; i += G * NTHREADS) { const f32x4 v = p[i]; u32x2 w; w.x = cvt_pk(v[0], v[1]); w.y = cvt_pk(v[2], v[3]); o[i] = w; }
    }
    const int nitems_total =
        4 * (2048 / 64) * (8192 / 64) + 4 * (8192 / 64) * (2048 / 64) + 4 * (2048 / 64) * (2048 / 64) + 4 * (256 / 64) * (2048 / 64) +
        2 * (2048 / 64) * (4096 / 64) + 2 * (2048 / 64) * (2048 / 64) + 64 * (128 / 64) * (128 / 64) + 64 * (128 / 64) * (128 / 64) +
        2 * (2048 / 64) * (6144 / 64) + 2 * (2048 / 64) * (2048 / 64);
    for (int it = gw; it < nitems_total; it += NGW) {
        int r = it;
#define CONV_TRY(Wp, nmat, K, N, gp, gstride, WTp) { const int ipm = ((K) / 64) * ((N) / 64); const int tot = (nmat) * ipm; \
            if (r < tot) { const int mat = r / ipm, rr = r % ipm, kb = rr / ((N) / 64), nb = rr % ((N) / 64); const float* g_ = (gp); \
                transpose_item((Wp) + (size_t)mat * (K) * (N), (K), (N), g_ ? g_ + (size_t)mat * (gstride) : nullptr, (bf16*)(ws + (WTp)) + (size_t)mat * (K) * (N), kb, nb, lane); continue; } r -= tot; }
        CONV_TRY(INP(18), 4, 2048, 8192, INP(3), 2048, WS_W1T)
        CONV_TRY(INP(19), 4, 8192, 2048, (const float*)nullptr, 0, WS_W2T)
        CONV_TRY(INP(20), 4, 2048, 2048, INP(4), 2048, WS_WGT)
        CONV_TRY(INP(21), 4, 256, 2048, (const float*)nullptr, 0, WS_WPT)
        CONV_TRY(INP(6), 2, 2048, 4096, INP(2), 4096, WS_WINT)
        CONV_TRY(INP(14), 2, 2048, 2048, (const float*)nullptr, 0, WS_WORT)
        CONV_TRY(INP(9), 64, 128, 128, (const float*)nullptr, 0, WS_GAT)
        CONV_TRY(INP(11), 64, 128, 128, (const float*)nullptr, 0, WS_GXT)
        CONV_TRY(INP(15), 2, 2048, 6144, INP(2) + 2048, 4096, WS_WQKVT)
        CONV_TRY(INP(17), 2, 2048, 2048, (const float*)nullptr, 0, WS_WONT)
#undef CONV_TRY
    }
}

constexpr int SC_T = 64, SC_NCH = SEQ / SC_T;
constexpr int XCF_STRIDE = 132;
constexpr int XCB_STRIDE = 136;
constexpr int LDS_XCF = 0, LDS_XCB = LDS_XCF + SC_T * XCF_STRIDE * 4, LDS_YGS = LDS_XCB + SC_T * XCB_STRIDE * 2, LDS_SEG = LDS_YGS + SC_T * 128 * 2, LDS_CAR = LDS_SEG + 2 * 128 * 17 * 8, LDS_SC_END = LDS_CAR + 2 * 8 * 128 * 4;
static_assert(LDS_SC_END <= 131072, "scan LDS");

struct ScanArgs {
    const bf16* XR; const bf16* YG; bf16* Y;
    const float* conv_w; const float* conv_b;
    const bf16* gaT; const bf16* gxT;
    const float* ga_b; const float* gx_b; const float* lam;
    f32x2* agg;
};

template <bool FINAL>
__device__ __forceinline__ void scan_phase(LAS unsigned char* lds, const ScanArgs& sa, int G) {
    const int tid = opaque_tid(), lane = tid & 63, w = tid >> 6, fr = lane & 15, fq = lane >> 4;
    LAS float* xcf = (LAS float*)(lds + LDS_XCF);
    LAS bf16* xcb = (LAS bf16*)(lds + LDS_XCB);
    LAS bf16* ygs = (LAS bf16*)(lds + LDS_YGS);
    LAS f32x2* seg = (LAS f32x2*)(lds + LDS_SEG);
    int cur_hd = -1;
    bf16x8 Bf[4][4];
    float ba[2], bx[2], sp8[2];
    ba[0] = ba[1] = bx[0] = bx[1] = sp8[0] = sp8[1] = 0.f;
    LAS float* car = (LAS float*)(lds + LDS_CAR);
    const bool fast = FINAL && (G == 256);
    if (fast) {
        if (tid < 256) {
            const int dir = tid >> 7, c = tid & 127, gch = (blockIdx.x & 15) * 128 + c, cmod = blockIdx.x >> 4;
            const f32x2* ag = sa.agg + (size_t)dir * SC_NCH * DM + gch;
            float h = 0.f;
            if (dir == 0) {
#pragma unroll 32
                for (int cc = 0; cc < SC_NCH; ++cc) { const f32x2 e = ag[(size_t)cc * DM]; if ((cc & 15) == cmod) car[(dir * 8 + (cc >> 4)) * 128 + c] = h; h = e[0] * h + e[1]; }
            } else {
#pragma unroll 32
                for (int cc = SC_NCH - 1; cc >= 0; --cc) { const f32x2 e = ag[(size_t)cc * DM]; if ((cc & 15) == cmod) car[(dir * 8 + (cc >> 4)) * 128 + c] = h; h = e[0] * h + e[1]; }
            }
        }
    }
    unsigned xpre[11]; u32x4 ypre[2];
#define SCAN_PREFETCH(itx) do { const int hd_ = (itx) & 15, t0_ = ((itx) >> 4) * SC_T; const int gc_ = hd_ * 128 + 2 * (tid & 63), tg_ = tid >> 6; \
        _Pragma("unroll") for (int q = 0; q < 11; ++q) { const int t = t0_ + 8 * tg_ - 1 + q; unsigned v = 0u; if (t >= 0 && t < SEQ) v = *(const unsigned*)(sa.XR + (size_t)t * DM + gc_); xpre[q] = v; } \
        if (FINAL) { _Pragma("unroll") for (int i = 0; i < 2; ++i) { const int idx = tid + i * NTHREADS, row = idx >> 4, c16 = idx & 15; \
            ypre[i] = *(const u32x4*)(sa.YG + (size_t)(t0_ + row) * DM + hd_ * 128 + c16 * 8); } } } while (0)
    ypre[0] = (u32x4){0u, 0u, 0u, 0u}; ypre[1] = (u32x4){0u, 0u, 0u, 0u};
    if ((int)blockIdx.x < SC_NCH * NHEAD) SCAN_PREFETCH((int)blockIdx.x);
    for (int it = blockIdx.x; it < SC_NCH * NHEAD; it += G) {
        const int hd = it & 15, chunk = it >> 4, t0 = chunk * SC_T;
        __syncthreads();
#pragma unroll
        for (int dir = 0; dir < 2; ++dir) {
            const bf16* wa = sa.gaT + ((size_t)(dir * 16 + hd) * 128 + 16 * w + fr) * 128 + 8 * fq;
            const bf16* wx = sa.gxT + ((size_t)(dir * 16 + hd) * 128 + 16 * w + fr) * 128 + 8 * fq;
#pragma unroll
            for (int k = 0; k < 4; ++k) { Bf[dir * 2 + 0][k] = *(const bf16x8*)(wa + 32 * k); Bf[dir * 2 + 1][k] = *(const bf16x8*)(wx + 32 * k); }
        }
        if (hd != cur_hd) {
            cur_hd = hd;
#pragma unroll
            for (int dir = 0; dir < 2; ++dir) {
                const int gch = hd * 128 + 16 * w + fr;
                ba[dir] = -1.4426950408889634f * sa.ga_b[dir * DM + gch]; bx[dir] = -1.4426950408889634f * sa.gx_b[dir * DM + gch];
                sp8[dir] = 1.4426950408889634f * 8.f * log1pf(expf(-sa.lam[dir * DM + gch]));
            }
        }
        {
            const int cp = tid & 63, tg = tid >> 6;
            const int gc = hd * 128 + 2 * cp;
            float x0[11], x1[11];
#pragma unroll
            for (int q = 0; q < 11; ++q) { x0[q] = bfl(xpre[q]); x1[q] = bfh(xpre[q]); }
            float w0[4], w1[4];
#pragma unroll
            for (int k = 0; k < 4; ++k) { const f32x2 wv = *(const f32x2*)(sa.conv_w + k * DM + gc); w0[k] = wv[0]; w1[k] = wv[1]; }
            const f32x2 bv = *(const f32x2*)(sa.conv_b + gc);
#pragma unroll
            for (int q = 0; q < 8; ++q) {
                const float c0 = bv[0] + ((w0[0] * x0[q] + w0[1] * x0[q + 1]) + (w0[2] * x0[q + 2] + w0[3] * x0[q + 3]));
                const float c1 = bv[1] + ((w1[0] * x1[q] + w1[1] * x1[q + 1]) + (w1[2] * x1[q + 2] + w1[3] * x1[q + 3]));
                const int tau = 8 * tg + q;
                *(LAS f32x2*)(xcf + tau * XCF_STRIDE + 2 * cp) = (f32x2){c0, c1};
                *(LAS unsigned*)(xcb + tau * XCB_STRIDE + 2 * cp) = cvt_pk(c0, c1);
            }
            if (FINAL) {
#pragma unroll
                for (int i = 0; i < 2; ++i) { const int idx = tid + i * NTHREADS, row = idx >> 4, c16 = idx & 15;
                    *(LAS u32x4*)(ygs + row * 128 + c16 * 8) = ypre[i]; }
            }
            if (it + G < SC_NCH * NHEAD) SCAN_PREFETCH(it + G);
        }
        __syncthreads();
        f32x4 acc[4][4];
#pragma unroll
        for (int m = 0; m < 4; ++m)
#pragma unroll
            for (int mb = 0; mb < 4; ++mb) acc[m][mb] = (f32x4){0.f, 0.f, 0.f, 0.f};
#pragma unroll
        for (int mb = 0; mb < 4; ++mb) {
            bf16x8 Af[4];
#pragma unroll
            for (int k = 0; k < 4; ++k) Af[k] = *(const LAS bf16x8*)(xcb + (16 * mb + fr) * XCB_STRIDE + 32 * k + 8 * fq);
#pragma unroll
            for (int m = 0; m < 4; ++m)
#pragma unroll
                for (int k = 0; k < 4; ++k) acc[m][mb] = __builtin_amdgcn_mfma_f32_16x16x32_bf16(Af[k], Bf[m][k], acc[m][mb], 0, 0, 0);
        }
        const int ch = 16 * w + fr;
#pragma unroll
        for (int mb = 0; mb < 4; ++mb) {
            float xv[4];
#pragma unroll
            for (int j = 0; j < 4; ++j) xv[j] = xcf[(16 * mb + 4 * fq + j) * XCF_STRIDE + ch];
#pragma unroll
            for (int dir = 0; dir < 2; ++dir) {
#pragma unroll
                for (int j = 0; j < 4; ++j) {
                    const float e1 = __builtin_amdgcn_exp2f(fminf(fmaf(acc[2 * dir][mb][j], -1.4426950408889634f, ba[dir]), 60.f));
                    const float e2 = __builtin_amdgcn_exp2f(fminf(fmaf(acc[2 * dir + 1][mb][j], -1.4426950408889634f, bx[dir]), 60.f));
                    const float d1 = 1.f + e1, d2 = 1.f + e2, rd = __builtin_amdgcn_rcpf(d1 * d2);
                    const float r = d2 * rd, ig = d1 * rd;
                    const float av = __builtin_amdgcn_exp2f(-sp8[dir] * r);
                    const float om = fmaxf(fmaf(-av, av, 1.f), 0.f);
                    acc[2 * dir][mb][j] = av;
                    acc[2 * dir + 1][mb][j] = __builtin_amdgcn_sqrtf(om) * (ig * xv[j]);
                }
                const f32x4 A = acc[2 * dir][mb], U = acc[2 * dir + 1][mb];
                float P, Q;
                if (dir == 0) { P = (A[0] * A[1]) * (A[2] * A[3]); Q = ((U[0] * A[1] + U[1]) * A[2] + U[2]) * A[3] + U[3]; }
                else          { P = (A[0] * A[1]) * (A[2] * A[3]); Q = ((U[3] * A[2] + U[2]) * A[1] + U[1]) * A[0] + U[0]; }
                seg[(dir * 128 + ch) * 17 + mb * 4 + fq] = (f32x2){P, Q};
            }
        }
        __syncthreads();
        float hb0[4], hb1[4];
        {
            const int gch = hd * 128 + ch;
            float h0 = 0.f, h1 = 0.f, P0 = 1.f, P1 = 1.f;
            if (FINAL) {
                if (fast) { h0 = car[(0 * 8 + (chunk >> 4)) * 128 + ch]; h1 = car[(1 * 8 + (chunk >> 4)) * 128 + ch]; }
                else {
                    const f32x2* ag0 = sa.agg + gch; const f32x2* ag1 = sa.agg + (size_t)SC_NCH * DM + gch;
                    for (int cc = 0; cc < chunk; ++cc) { const f32x2 e = ag0[(size_t)cc * DM]; h0 = e[0] * h0 + e[1]; }
                    for (int cc = SC_NCH - 1; cc > chunk; --cc) { const f32x2 e = ag1[(size_t)cc * DM]; h1 = e[0] * h1 + e[1]; }
                }
            }
            const LAS f32x2* sg0 = seg + (0 * 128 + ch) * 17; const LAS f32x2* sg1 = seg + (1 * 128 + ch) * 17;
#pragma unroll
            for (int s = 0; s < 16; ++s) { const f32x2 e = sg0[s]; if ((s & 3) == fq) hb0[s >> 2] = h0; h0 = e[0] * h0 + e[1]; P0 *= e[0]; }
#pragma unroll
            for (int s = 15; s >= 0; --s) { const f32x2 e = sg1[s]; if ((s & 3) == fq) hb1[s >> 2] = h1; h1 = e[0] * h1 + e[1]; P1 *= e[0]; }
            if (!FINAL) {
                if (fq == 0) { sa.agg[((size_t)0 * SC_NCH + chunk) * DM + gch] = (f32x2){P0, h0}; sa.agg[((size_t)1 * SC_NCH + chunk) * DM + gch] = (f32x2){P1, h1}; }
            }
        }
        if (FINAL) {
#pragma unroll
            for (int mb = 0; mb < 4; ++mb) {
                float hs[4];
                { float h = hb0[mb]; const f32x4 A = acc[0][mb], U = acc[1][mb];
#pragma unroll
                  for (int j = 0; j < 4; ++j) { h = A[j] * h + U[j]; hs[j] = h; } }
                { float h = hb1[mb]; const f32x4 A = acc[2][mb], U = acc[3][mb];
#pragma unroll
                  for (int j = 3; j >= 0; --j) { h = A[j] * h + U[j]; hs[j] += h; } }
#pragma unroll
                for (int j = 0; j < 4; ++j) {
                    LAS bf16* yp = ygs + (16 * mb + 4 * fq + j) * 128 + ch;
                    const float yg = __uint_as_float((unsigned)(*yp) << 16);
                    *yp = (bf16)(cvt_pk(hs[j] * yg, 0.f) & 0xffffu);
                }
            }
            __syncthreads();
#pragma unroll
            for (int i = 0; i < 2; ++i) { const int idx = tid + i * NTHREADS, row = idx >> 4, c16 = idx & 15;
                *(u32x4*)(sa.Y + (size_t)(t0 + row) * DM + hd * 128 + c16 * 8) = *(const LAS u32x4*)(ygs + row * 128 + c16 * 8); }
        }
    }
}

struct AttArgs { const bf16* Q; const bf16* K; const bf16* VT; bf16* O; const float* rpb; };

__device__ __forceinline__ void attn_phase(LAS unsigned char* lds, const AttArgs& aa, int G) {
    const int tid = opaque_tid(), lane = tid & 63, w = tid >> 6, fr = lane & 15, fq = lane >> 4;
    const int hsel = w >> 2, qg = w & 3;
    LAS float* rp = (LAS float*)lds;
    const int c0 = 16 * qg, kb0 = (qg == 0) ? 0 : (qg == 1) ? 8 : (qg == 2) ? 24 : 32;
    const int qc = c0 + fr;
    const int cs = min(max(qc - 8, 0), 48);
    for (int id = blockIdx.x; id < 128 * 8; id += G) {
        const int hp = id & 7, r = id >> 3, h = hp * 2 + hsel;
        const int rs = min(max(r - 4, 0), 120);
        __syncthreads();
        for (int i = tid; i < 2 * 465; i += NTHREADS) { const int hh = i / 465, e = i % 465; rp[hh * 480 + e] = aa.rpb[(size_t)(hp * 2 + hh) * 465 + e]; }
        __syncthreads();
        bf16x8 qf[4];
        { const bf16* qp = aa.Q + (size_t)(r * 64 + qc) * DM + h * 128 + 8 * fq;
#pragma unroll
          for (int k = 0; k < 4; ++k) qf[k] = *(const bf16x8*)(qp + 32 * k); }
        f32x4 s[8][2];
        const int krow = 8 * (fr >> 2) + (fr & 3);
#pragma unroll
        for (int i = 0; i < 8; ++i)
#pragma unroll
            for (int nb = 0; nb < 2; ++nb) {
                const bf16* kp = aa.K + (size_t)((rs + i) * 64 + kb0 + krow + 4 * nb) * DM + h * 128 + 8 * fq;
                f32x4 c = (f32x4){0.f, 0.f, 0.f, 0.f};
#pragma unroll
                for (int k = 0; k < 4; ++k) { const bf16x8 kf = *(const bf16x8*)(kp + 32 * k); c = __builtin_amdgcn_mfma_f32_16x16x32_bf16(kf, qf[k], c, 0, 0, 0); }
                s[i][nb] = c;
            }
        float mx = -INFINITY;
        const LAS float* rph = rp + hsel * 480;
#pragma unroll
        for (int i = 0; i < 8; ++i) {
            const int relr = rs + i - r + 7;
#pragma unroll
            for (int nb = 0; nb < 2; ++nb)
#pragma unroll
                for (int j = 0; j < 4; ++j) {
                    const int kc = kb0 + 8 * fq + 4 * nb + j;
                    const bool valid = (unsigned)(kc - cs) < 16u;
                    const int idx = valid ? relr * 31 + (kc - qc + 15) : 0;
                    const float v = valid ? s[i][nb][j] + rph[idx] : -INFINITY;
                    s[i][nb][j] = v; mx = fmaxf(mx, v);
                }
        }
        mx = fmaxf(mx, __shfl_xor(mx, 16)); mx = fmaxf(mx, __shfl_xor(mx, 32));
        float l = 0.f;
#pragma unroll
        for (int i = 0; i < 8; ++i)
#pragma unroll
            for (int nb = 0; nb < 2; ++nb)
#pragma unroll
                for (int j = 0; j < 4; ++j) { const float p = __expf(s[i][nb][j] - mx); s[i][nb][j] = p; l += p; }
        l += __shfl_xor(l, 16); l += __shfl_xor(l, 32);
        f32x4 o[8];
#pragma unroll
        for (int db = 0; db < 8; ++db) o[db] = (f32x4){0.f, 0.f, 0.f, 0.f};
#pragma unroll
        for (int i = 0; i < 8; ++i) {
            u32x4 pw; pw.x = cvt_pk(s[i][0][0], s[i][0][1]); pw.y = cvt_pk(s[i][0][2], s[i][0][3]); pw.z = cvt_pk(s[i][1][0], s[i][1][1]); pw.w = cvt_pk(s[i][1][2], s[i][1][3]);
            const bf16x8 pb = __builtin_bit_cast(bf16x8, pw);
            const bf16* vp = aa.VT + (size_t)(h * 128 + fr) * SEQ + (rs + i) * 64 + kb0 + 8 * fq;
#pragma unroll
            for (int db = 0; db < 8; ++db) { const bf16x8 vf = *(const bf16x8*)(vp + (size_t)(16 * db) * SEQ); o[db] = __builtin_amdgcn_mfma_f32_16x16x32_bf16(vf, pb, o[db], 0, 0, 0); }
        }
        const float inv = 1.f / l;
        bf16* op = aa.O + (size_t)(r * 64 + qc) * DM + h * 128 + 4 * fq;
#pragma unroll
        for (int db = 0; db < 8; ++db) { u32x2 wv; wv.x = cvt_pk(o[db][0] * inv, o[db][1] * inv); wv.y = cvt_pk(o[db][2] * inv, o[db][3] * inv); *(u32x2*)(op + 16 * db) = wv; }
    }
}

#define ATT_BAR() do { asm volatile("s_waitcnt lgkmcnt(0)" ::: "memory"); __builtin_amdgcn_s_barrier(); asm volatile("" ::: "memory"); } while (0)
constexpr int KS_PITCH = 136, VS_PITCH = 72;
constexpr int ATT_KS = 0, ATT_VS = ATT_KS + 2 * 64 * KS_PITCH * 2, ATT_RP = ATT_VS + 2 * 128 * VS_PITCH * 2, ATT_END = ATT_RP + 2048;
static_assert(ATT_END <= 131072, "attention LDS");
__device__ __forceinline__ void attn_phase2(LAS unsigned char* lds, const AttArgs& aa, int G) {
    const int tid = opaque_tid(), lane = tid & 63, w = tid >> 6, fr = lane & 15, fq = lane >> 4;
    const int rsel = w >> 2, qg = w & 3;
    LAS bf16* KS = (LAS bf16*)(lds + ATT_KS);
    LAS bf16* VS = (LAS bf16*)(lds + ATT_VS);
    LAS float* rp = (LAS float*)(lds + ATT_RP);
    const int c0 = 16 * qg, kb0 = (qg == 0) ? 0 : (qg == 1) ? 8 : (qg == 2) ? 24 : 32;
    const int qc = c0 + fr;
    const int cs = min(max(qc - 8, 0), 48);
    const int krow = 8 * (fr >> 2) + (fr & 3);
    const int ktok0 = tid >> 4, kpart = tid & 15, vd0 = tid >> 3, vpart = tid & 7;
    for (int id = blockIdx.x; id < 64 * NHEAD; id += G) {
        const int h = id & 15, rpair = id >> 4, r0 = 2 * rpair;
        const int rsA = min(max(r0 - 4, 0), 120), rsB = min(max(r0 - 3, 0), 120), off = rsB - rsA, nJ = 8 + off;
        const int r = r0 + rsel, rs = rsel ? rsB : rsA, woff = rsel ? off : 0;
        u32x4 R[9][2];
#pragma unroll
        for (int jj = 0; jj < 9; ++jj) { R[jj][0] = (u32x4){0u, 0u, 0u, 0u}; R[jj][1] = (u32x4){0u, 0u, 0u, 0u}; }
        const bf16* kbase = aa.K + (size_t)(rsA * 64 + ktok0) * DM + h * 128 + kpart * 8;
        const bf16* vbase = aa.VT + (size_t)(h * 128 + vd0) * SEQ + rsA * 64 + vpart * 8;
#pragma unroll
        for (int jj = 0; jj < 9; ++jj) if (jj < nJ) {
#pragma unroll
            for (int u = 0; u < 2; ++u) R[jj][u] = *(const u32x4*)(kbase + (size_t)(jj * 64 + 32 * u) * DM);
        }
        for (int i = tid; i < 465; i += NTHREADS) rp[i] = aa.rpb[(size_t)h * 465 + i];
        bf16x8 qf[4];
        { const bf16* qp = aa.Q + (size_t)(r * 64 + qc) * DM + h * 128 + 8 * fq;
#pragma unroll
          for (int k = 0; k < 4; ++k) qf[k] = *(const bf16x8*)(qp + 32 * k); }
#define ATT_KWRITE(j, b) do { _Pragma("unroll") for (int u = 0; u < 2; ++u) *(LAS u32x4*)(KS + (b) * 64 * KS_PITCH + (ktok0 + 32 * u) * KS_PITCH + kpart * 8) = R[j][u]; } while (0)
#define ATT_VLOAD(j) do { _Pragma("unroll") for (int u = 0; u < 2; ++u) R[j][u] = *(const u32x4*)(vbase + (size_t)(64 * u) * SEQ + (j) * 64); } while (0)
#define ATT_VWRITE(j, b) do { _Pragma("unroll") for (int u = 0; u < 2; ++u) *(LAS u32x4*)(VS + (b) * 128 * VS_PITCH + (vd0 + 64 * u) * VS_PITCH + vpart * 8) = R[j][u]; } while (0)
#define ATT_QK(i, b) do { _Pragma("unroll") for (int nb = 0; nb < 2; ++nb) { f32x4 c_ = (f32x4){0.f, 0.f, 0.f, 0.f}; \
            _Pragma("unroll") for (int k = 0; k < 4; ++k) { const bf16x8 kf = *(const LAS bf16x8*)(KS + (b) * 64 * KS_PITCH + (kb0 + krow + 4 * nb) * KS_PITCH + 32 * k + 8 * fq); \
                c_ = __builtin_amdgcn_mfma_f32_16x16x32_bf16(kf, qf[k], c_, 0, 0, 0); } s[i][nb] = c_; } } while (0)
#define ATT_PV(i, b) do { u32x4 pw; pw.x = cvt_pk(s[i][0][0], s[i][0][1]); pw.y = cvt_pk(s[i][0][2], s[i][0][3]); pw.z = cvt_pk(s[i][1][0], s[i][1][1]); pw.w = cvt_pk(s[i][1][2], s[i][1][3]); \
            const bf16x8 pb = __builtin_bit_cast(bf16x8, pw); \
            _Pragma("unroll") for (int db = 0; db < 8; ++db) { const bf16x8 vf = *(const LAS bf16x8*)(VS + (b) * 128 * VS_PITCH + (16 * db + fr) * VS_PITCH + kb0 + 8 * fq); \
                o[db] = __builtin_amdgcn_mfma_f32_16x16x32_bf16(vf, pb, o[db], 0, 0, 0); } } while (0)
        f32x4 s[8][2];
        ATT_KWRITE(0, 0); ATT_VLOAD(0);
        ATT_BAR();
#pragma unroll
        for (int jj = 0; jj < 9; ++jj) {
            if (jj + 1 < 9) { if (jj + 1 < nJ) { ATT_KWRITE((jj + 1 < 9 ? jj + 1 : 8), ((jj + 1) & 1)); ATT_VLOAD((jj + 1 < 9 ? jj + 1 : 8)); } }
            if (woff == 0) { if (jj < 8) ATT_QK((jj < 8 ? jj : 7), (jj & 1)); }
            else           { if (jj >= 1) ATT_QK((jj >= 1 ? jj - 1 : 0), (jj & 1)); }
            ATT_BAR();
        }
        float mx = -INFINITY;
#pragma unroll
        for (int i = 0; i < 8; ++i) {
            const int relr = rs + i - r + 7;
#pragma unroll
            for (int nb = 0; nb < 2; ++nb)
#pragma unroll
                for (int j = 0; j < 4; ++j) {
                    const int kc = kb0 + 8 * fq + 4 * nb + j;
                    const bool valid = (unsigned)(kc - cs) < 16u;
                    const int idx = valid ? relr * 31 + (kc - qc + 15) : 0;
                    const float v = valid ? s[i][nb][j] + rp[idx] : -INFINITY;
                    s[i][nb][j] = v; mx = fmaxf(mx, v);
                }
        }
        mx = fmaxf(mx, __shfl_xor(mx, 16)); mx = fmaxf(mx, __shfl_xor(mx, 32));
        float l = 0.f;
#pragma unroll
        for (int i = 0; i < 8; ++i)
#pragma unroll
            for (int nb = 0; nb < 2; ++nb)
#pragma unroll
                for (int j = 0; j < 4; ++j) { const float p = __expf(s[i][nb][j] - mx); s[i][nb][j] = p; l += p; }
        l += __shfl_xor(l, 16); l += __shfl_xor(l, 32);
        f32x4 o[8];
#pragma unroll
        for (int db = 0; db < 8; ++db) o[db] = (f32x4){0.f, 0.f, 0.f, 0.f};
        ATT_VWRITE(0, 0);
        ATT_BAR();
#pragma unroll
        for (int jj = 0; jj < 9; ++jj) {
            if (jj + 1 < 9) { if (jj + 1 < nJ) ATT_VWRITE((jj + 1 < 9 ? jj + 1 : 8), ((jj + 1) & 1)); }
            if (woff == 0) { if (jj < 8) ATT_PV((jj < 8 ? jj : 7), (jj & 1)); }
            else           { if (jj >= 1) ATT_PV((jj >= 1 ? jj - 1 : 0), (jj & 1)); }
            ATT_BAR();
        }
        const float inv = 1.f / l;
        bf16* op = aa.O + (size_t)(r * 64 + qc) * DM + h * 128 + 4 * fq;
#pragma unroll
        for (int db = 0; db < 8; ++db) { u32x2 wv; wv.x = cvt_pk(o[db][0] * inv, o[db][1] * inv); wv.y = cvt_pk(o[db][2] * inv, o[db][3] * inv); *(u32x2*)(op + 16 * db) = wv; }
#undef ATT_KWRITE
#undef ATT_VLOAD
#undef ATT_VWRITE
#undef ATT_QK
#undef ATT_PV
    }
}

__device__ __forceinline__ void final_phase(float* out, const bf16* X, const float* ss, const float* g, int G) {
    const int tid = opaque_tid(), lane = tid & 63, wave = tid >> 6;
    const int gw = blockIdx.x * NWAVES + wave, NGW = G * NWAVES;
    for (int row = gw; row < SEQ; row += NGW) {
        const float rs = pg8::rstd_row(ss, row);
        f32x4* o = (f32x4*)(out + (size_t)row * DM) + lane; const f32x4* gp = (const f32x4*)g + lane; const u32x2* xp = (const u32x2*)(X + (size_t)row * DM) + lane;
#pragma unroll
        for (int j = 0; j < 8; ++j) { const u32x2 xw = xp[64 * j]; const f32x4 gv = gp[64 * j]; f32x4 v = (f32x4){bfl(xw.x), bfh(xw.x), bfl(xw.y), bfh(xw.y)}; v = v * rs * gv; o[64 * j] = v; }
    }
}

#define XB_TMO      128
#define XB_XCNT(j)  (256  + 64 * (j))
#define XB_XSUB(j)  (1280 + 64 * (j))
#define XB_XGEN(j)  (2304 + 64 * (j))
#define XB_TOP      3328
#define XB_TOPGEN   3392
#define XCD_BAR_WORDS 3456
#define XB_SPIN_CAP (1u << 18)

__device__ __forceinline__ unsigned xb_ld(unsigned* p)              { return __hip_atomic_load(p, __ATOMIC_RELAXED, __HIP_MEMORY_SCOPE_AGENT); }
__device__ __forceinline__ unsigned xb_add(unsigned* p, unsigned v) { return __hip_atomic_fetch_add(p, v, __ATOMIC_RELAXED, __HIP_MEMORY_SCOPE_AGENT); }
__device__ __forceinline__ unsigned xb_xcc_id() { return (unsigned)__builtin_amdgcn_s_getreg((3 << 11) | 20) & 0xFu; }
#define XB_SPIN(cond, bar) do { unsigned _sp = 0; while (cond) { __builtin_amdgcn_s_sleep(1); \
    if ((++_sp & 255u) == 0u) { if (xb_ld(&(bar)[XB_TMO])) break; if (_sp > XB_SPIN_CAP) { atomicAdd(&(bar)[XB_TMO], 1u); break; } } } } while (0)

struct XcdBarrier {
    unsigned* bar; unsigned x;
    volatile LAS unsigned* st;
};

__device__ __forceinline__ XcdBarrier xcd_barrier_post(unsigned* bar, volatile LAS unsigned* st) {
    XcdBarrier b; b.bar = bar; b.x = xb_xcc_id(); b.st = st;
    if (threadIdx.x == 0) (void)xb_add(&bar[XB_XCNT(b.x)], 1u);
    return b;
}
__device__ __forceinline__ void xcd_barrier_complete(unsigned* bar, unsigned x, unsigned& nloc, unsigned& nx) {
    const unsigned G = gridDim.x * gridDim.y * gridDim.z;
    unsigned sum, cnt, mine, sp = 0u;
    for (;;) {
        sum = 0u; cnt = 0u; mine = 0u;
#pragma unroll
        for (unsigned j = 0; j < 16; ++j) { const unsigned c = xb_ld(&bar[XB_XCNT(j)]); sum += c; cnt += (c > 0u) ? 1u : 0u; mine = (j == x) ? c : mine; }
        if (sum == G) break;
        __builtin_amdgcn_s_sleep(1);
        if ((++sp & 255u) == 0u) { if (xb_ld(&bar[XB_TMO])) break; if (sp > XB_SPIN_CAP) { atomicAdd(&bar[XB_TMO], 1u); break; } }
    }
    nloc = mine > 0u ? mine : 1u; nx = cnt > 0u ? cnt : 1u;
}

__device__ __forceinline__ void xcd_barrier(const XcdBarrier& b) {
    asm volatile("s_waitcnt vmcnt(0)" ::: "memory");
    __syncthreads();
    if (threadIdx.x == 0) {
        unsigned* bar = b.bar;
        __builtin_amdgcn_s_waitcnt(0);
        unsigned nloc = b.st[0], nx = b.st[1];
        if (nloc == 0u) { xcd_barrier_complete(bar, b.x, nloc, nx); b.st[0] = nloc; b.st[1] = nx; }
        const unsigned old = xb_add(&bar[XB_XSUB(b.x)], 1u);
        const unsigned gen = old / nloc;
        if (old + 1u == (gen + 1u) * nloc) {
            __builtin_amdgcn_fence(__ATOMIC_RELEASE, "agent");
            asm volatile("s_waitcnt vmcnt(0)" ::: "memory");
            const unsigned og = xb_add(&bar[XB_TOP], 1u);
            const unsigned tg = og / nx;
            if (og + 1u == (tg + 1u) * nx) xb_add(&bar[XB_TOPGEN], 1u);
            else XB_SPIN(xb_ld(&bar[XB_TOPGEN]) == tg, bar);
            __builtin_amdgcn_fence(__ATOMIC_ACQUIRE, "agent");
            xb_add(&bar[XB_XGEN(b.x)], 1u);
            asm volatile("s_waitcnt vmcnt(0)" ::: "memory");
        } else {
            XB_SPIN(xb_ld(&bar[XB_XGEN(b.x)]) == gen, bar);
            __builtin_amdgcn_fence(__ATOMIC_ACQUIRE, "agent");
            asm volatile("s_waitcnt vmcnt(0)" ::: "memory");
        }
    }
    __syncthreads();
}

constexpr int LDS_TAB = 131072 + 1024;
__device__ __forceinline__ void fill_rstd_tab(LAS unsigned char* lds, const float* ssp, int t) {
    LAS float* tab = (LAS float*)(lds + LDS_TAB);
    const int tid = opaque_tid();
    if (tid < 256) tab[tid] = pg8::rstd_row(ssp, t * 256 + tid);
    __syncthreads();
}
constexpr int N_PHASES = 28;
#ifndef PGA
#define PGA true
#endif
#ifndef PGA1
#define PGA1 true
#endif
#ifndef PGS
#define PGS true
#endif
#ifndef DBG_DUMP_OFF
#define DBG_DUMP_OFF WS_BC
#endif
#ifndef DBG_NPH
#define DBG_NPH N_PHASES
#endif
#ifndef DBG_DUMP
#define DBG_DUMP 0
#endif
enum Kind { K_P0, K_WIN, K_S1, K_S2, K_WOUT, K_QKV, K_ATT, K_W1, K_W2, K_PLE, K_FINAL, K_DUMP };

__global__ void __launch_bounds__(NTHREADS, 2) mega_fwd(Args args) {
    extern __shared__ __attribute__((aligned(16))) unsigned char lds_raw[];
    LAS unsigned char* lds = (LAS unsigned char*)lds_raw;
    cg::grid_group grid = cg::this_grid();
    const int G = gridDim.x;
    KA ka0 = (KA)__builtin_amdgcn_kernarg_segment_ptr();
    const int lo = *(const int __attribute__((address_space(4)))*)(ka0 + 192), hi = *(const int __attribute__((address_space(4)))*)(ka0 + 196);
    if (hi - lo > 1) {
        volatile LAS unsigned* st = (volatile LAS unsigned*)(lds + 131072 + 64);
        if (threadIdx.x < 2) st[threadIdx.x] = 0u;
        __syncthreads();
        unsigned char* ws0 = *(unsigned char* const __attribute__((address_space(4)))*)(ka0 + 184);
        (void)xcd_barrier_post((unsigned*)(ws0 + WS_BAR), st);
    }
    if (hi > 100000) grid.sync();
    for (int ph = lo; ph < hi; ++ph) {
        KA ka = ka0; asm volatile("" : "+s"(ka));
        unsigned char* ws = *(unsigned char* const __attribute__((address_space(4)))*)(ka + 184);
        float* hout = *(float* const __attribute__((address_space(4)))*)(ka + 176);
        float* ss = (float*)(ws + WS_SS);
        int kind, L = 0;
        if (ph == 0) kind = K_P0; else if (ph == 99) kind = K_DUMP; else if (ph == N_PHASES - 1) kind = K_FINAL;
        else { int q = ph - 1; const int pair = q / 13; q -= pair * 13; L = 2 * pair;
            if (q < 7) { kind = (q == 0) ? K_WIN : (q == 1) ? K_S1 : (q == 2) ? K_S2 : (q == 3) ? K_WOUT : (q == 4) ? K_W1 : (q == 5) ? K_W2 : K_PLE; }
            else { q -= 7; L += 1; kind = (q == 0) ? K_QKV : (q == 1) ? K_ATT : (q == 2) ? K_WOUT : (q == 3) ? K_W1 : (q == 4) ? K_W2 : K_PLE; } }
        const int j = L >> 1;
        bf16* Xc = (bf16*)(ws + ((L & 1) ? WS_X1 : WS_X0));
        bf16* Xo = (bf16*)(ws + ((L & 1) ? WS_X0 : WS_X1));
        const float* ss_mix = ss + (size_t)(3 * L) * SEQ * 32; float* ss_mlp = ss + (size_t)(3 * L + 1) * SEQ * 32; float* ss_ple = ss + (size_t)(3 * L + 2) * SEQ * 32; float* ss_next = ss + (size_t)(3 * L + 3) * SEQ * 32;
        switch (kind) {
        case K_P0:
#ifndef DIS_P0
 p0_phase(lds, ka, ws, G);
#endif
 break;
        case K_WIN: {
#ifdef DBG_BJ0
            pg8::Gemm g{Xc, (const bf16*)(ws + WS_WINT), SEQ, 2 * DM, DM};
#elif defined(DBG_AX1)
            pg8::Gemm g{(L == 2) ? Xo : Xc, (const bf16*)(ws + WS_WINT) + (size_t)j * DM * 2 * DM, SEQ, 2 * DM, DM};
#else
            pg8::Gemm g{Xc, (const bf16*)(ws + WS_WINT) + (size_t)j * DM * 2 * DM, SEQ, 2 * DM, DM};
#endif
            pg8::StaticOrder S; S.init(SEQ, 2 * DM, G, (int)blockIdx.x);
#ifdef DBG_FRESHOUT

#elif defined(DBG_SS0)

#else
            pg8::Unit u0; S.next(0, u0); fill_rstd_tab(lds, ss_mix, u0.pm);
            pg8::EpiAct<0> E{(bf16*)(ws + WS_BA), (bf16*)(ws + WS_BB), DM, DM, ss_mix, (const LAS float*)(lds + LDS_TAB), u0.pm};
#endif
#ifndef DIS_ACT0
            pg8::gemm_phase<pg8::EpiAct<0>, pg8::StaticOrder, PGA, PGS>(lds, g, S, E);
#endif
        } break;
        case K_S1: case K_S2: {
            ScanArgs sa{(const bf16*)(ws + WS_BA), (const bf16*)(ws + WS_BB), (bf16*)(ws + WS_BC),
                        INP(7) + (size_t)j * 4 * DM, INP(8) + (size_t)j * DM,
                        (const bf16*)(ws + WS_GAT) + (size_t)j * 32 * 128 * 128, (const bf16*)(ws + WS_GXT) + (size_t)j * 32 * 128 * 128,
                        INP(10) + (size_t)j * 2 * DM, INP(12) + (size_t)j * 2 * DM, INP(13) + (size_t)j * 2 * DM,
                        (f32x2*)(ws + WS_AGG)};
            #ifndef DIS_SCAN
            if (kind == K_S1) scan_phase<false>(lds, sa, G); else scan_phase<true>(lds, sa, G);
#endif
        } break;
        case K_QKV: {
            {
                pg8::Gemm g{Xc, (const bf16*)(ws + WS_WQKVT) + (size_t)j * 3 * DM * DM, SEQ, 2 * DM, DM};
                pg8::StaticOrder S; S.init(SEQ, 2 * DM, G, (int)blockIdx.x);
                pg8::Unit u0; S.next(0, u0); fill_rstd_tab(lds, ss_mix, u0.pm);
                pg8::EpiAct<1> E{(bf16*)(ws + WS_BA), (bf16*)(ws + WS_BB), DM, DM, ss_mix, (const LAS float*)(lds + LDS_TAB), u0.pm};
#ifndef DIS_ACT1
                pg8::gemm_phase<pg8::EpiAct<1>, pg8::StaticOrder, PGA, PGS>(lds, g, S, E);
#endif
            }
            __syncthreads();
            {
                pg8::Gemm g{(const bf16*)(ws + WS_WQKVT) + (size_t)j * 3 * DM * DM + (size_t)2 * DM * DM, Xc, DM, SEQ, DM};
                pg8::StaticOrder S; S.init(DM, SEQ, G, (int)blockIdx.x);
                pg8::Unit u0; S.next(0, u0); fill_rstd_tab(lds, ss_mix, u0.pn);
                pg8::EpiAct<4> E{(bf16*)(ws + WS_BD), nullptr, SEQ, 0, ss_mix, (const LAS float*)(lds + LDS_TAB), u0.pn};
#ifndef DIS_ACT4
                pg8::gemm_phase<pg8::EpiAct<4>, pg8::StaticOrder, PGA1, PGS>(lds, g, S, E);
#endif
            }
        } break;
        case K_ATT: {
            AttArgs aa{(const bf16*)(ws + WS_BA), (const bf16*)(ws + WS_BB), (const bf16*)(ws + WS_BD), (bf16*)(ws + WS_BC), INP(16) + (size_t)j * NHEAD * 465};
#ifndef DIS_ATT
#ifdef ATT_V1
            attn_phase(lds, aa, G);
#else
            attn_phase2(lds, aa, G);
#endif
#endif
        } break;
        case K_WOUT: case K_W2: {
            const bf16* A; const bf16* Bt; int K;
            float* sso; bf16* hb; const bf16* base;
            if (kind == K_WOUT) { A = (const bf16*)(ws + WS_BC); K = DM; Bt = (L & 1) ? (const bf16*)(ws + WS_WONT) + (size_t)j * DM * DM : (const bf16*)(ws + WS_WORT) + (size_t)j * DM * DM; sso = ss_mlp; hb = Xo; base = Xc; }
            else { A = (const bf16*)(ws + WS_A1); K = DFF; Bt = (const bf16*)(ws + WS_W2T) + (size_t)L * DM * DFF; sso = ss_ple; hb = Xc; base = Xo; }
            pg8::Gemm g{A, Bt, SEQ, DM, K};
            pg8::StaticOrder S; S.init(SEQ, DM, G, (int)blockIdx.x);
            pg8::EpiRes<0> E{base, hb, sso, nullptr, nullptr, (const LAS float*)(lds + LDS_TAB), -1};
#ifndef DIS_RES0
            pg8::gemm_phase<pg8::EpiRes<0>, pg8::StaticOrder, PGA1, PGS>(lds, g, S, E);
#endif
        } break;
        case K_W1: {
            {
                int Kp = PLE; asm volatile("" : "+s"(Kp));
                pg8::Gemm g{(const bf16*)(ws + WS_PB) + (size_t)L * SEQ * PLE, (const bf16*)(ws + WS_WPT) + (size_t)L * DM * PLE, SEQ, DM, Kp};
                pg8::StaticOrder S; S.init(SEQ, DM, G, (int)blockIdx.x);
                pg8::EpiAct<3> E{(bf16*)(ws + WS_PROJ) + (size_t)L * SEQ * DM, nullptr, DM, 0, nullptr, (const LAS float*)(lds + LDS_TAB), -1};
#ifndef DIS_ACT3
                pg8::gemm_phase<pg8::EpiAct<3>, pg8::StaticOrder, PGA1, PGS>(lds, g, S, E);
#endif
            }
            __syncthreads();
            pg8::Gemm g{Xo, (const bf16*)(ws + WS_W1T) + (size_t)L * DM * DFF, SEQ, DFF, DM};
            pg8::StaticOrder S; S.init(SEQ, DFF, G, (int)blockIdx.x);
            pg8::Unit u0; S.next(0, u0); fill_rstd_tab(lds, ss_mlp, u0.pm);
            pg8::EpiAct<2> E{(bf16*)(ws + WS_A1), nullptr, DFF, 0, ss_mlp, (const LAS float*)(lds + LDS_TAB), u0.pm};
#ifndef DIS_ACT2
            pg8::gemm_phase<pg8::EpiAct<2>, pg8::StaticOrder, PGA, PGS>(lds, g, S, E);
#endif
        } break;
        case K_PLE: {
            pg8::Gemm g{Xc, (const bf16*)(ws + WS_WGT) + (size_t)L * DM * DM, SEQ, DM, DM};
            pg8::StaticOrder S; S.init(SEQ, DM, G, (int)blockIdx.x);
            pg8::Unit u0; S.next(0, u0); fill_rstd_tab(lds, ss_ple, u0.pm);
            pg8::EpiRes<1> E{Xc, Xo, ss_next, ss_ple, (const bf16*)(ws + WS_PROJ) + (size_t)L * SEQ * DM, (const LAS float*)(lds + LDS_TAB), u0.pm};
#ifndef DIS_RES1
            pg8::gemm_phase<pg8::EpiRes<1>, pg8::StaticOrder, PGA1, PGS>(lds, g, S, E);
#endif
        } break;
#if DBG_DUMP
        case K_DUMP: {
            const bf16* src = (const bf16*)(ws + DBG_DUMP_OFF); const float* srcf = (const float*)(ws + DBG_DUMP_OFF);
            for (size_t i = (size_t)blockIdx.x * NTHREADS + threadIdx.x; i < (size_t)SEQ * DM; i += (size_t)G * NTHREADS) hout[i] = (DBG_DUMP == 2) ? srcf[i & 8191] : bfl((unsigned)src[i]);
        } break;
#endif
        case K_FINAL: final_phase(hout, (const bf16*)(ws + WS_X0), ss + (size_t)12 * SEQ * 32, INP(5), G); break;
        }
        if (ph + 1 < hi) { XcdBarrier b; b.bar = (unsigned*)(ws + WS_BAR); b.x = xb_xcc_id(); b.st = (volatile LAS unsigned*)(lds + 131072 + 64); xcd_barrier(b);
#ifdef DBG_DBLBAR
            xcd_barrier(b);
#endif
        }
    }
}

#ifndef MK_MULTI
#define MK_MULTI 0
#endif

extern "C" void kernel_launch(void* const* d_in, const int* in_sizes, int n_in, void* d_out, int out_size, void* d_ws, size_t ws_size, hipStream_t stream) {
    static int grid = 0;
    if (grid == 0) {
        if (n_in != 22 || out_size != SEQ * DM || ws_size < WS_END) { fprintf(stderr, "kernel_launch: unexpected shapes (n_in %d out %d ws %zu)\n", n_in, out_size, ws_size); grid = -1; return; }
        int dev = 0, cus = 0, per_cu = 0;
        (void)hipGetDevice(&dev); (void)hipDeviceGetAttribute(&cus, hipDeviceAttributeMultiprocessorCount, dev);
        if (hipFuncSetAttribute((const void*)mega_fwd, hipFuncAttributeMaxDynamicSharedMemorySize, LDS_BYTES) != hipSuccess) { fprintf(stderr, "kernel_launch: hipFuncSetAttribute failed\n"); grid = -1; return; }
        if (hipOccupancyMaxActiveBlocksPerMultiprocessor(&per_cu, (const void*)mega_fwd, NTHREADS, LDS_BYTES) != hipSuccess || per_cu < 1) { fprintf(stderr, "kernel_launch: occupancy query says %d\n", per_cu); per_cu = 1; }
        (void)hipGetLastError();
        grid = cus * per_cu; if (grid > 256) grid = 256;
        fprintf(stderr, "kernel_launch: grid %d (cus %d per_cu %d)\n", grid, cus, per_cu);
    }
    if (grid < 0) return;
    Args a{};
    for (int i = 0; i < 22; ++i) a.in[i] = (const float*)d_in[i];
    a.out = (float*)d_out; a.ws = (unsigned char*)d_ws;
#if MK_MULTI
#ifdef DBG_SEQ
    { const int seq[] = {DBG_SEQ}; for (int ph : seq) { a.ph_lo = ph; a.ph_hi = ph + 1; hipLaunchKernelGGL(mega_fwd, dim3(grid), dim3(NTHREADS), LDS_BYTES, stream, a); } }
#else
    for (int ph = 0; ph < DBG_NPH; ++ph) { a.ph_lo = ph; a.ph_hi = ph + 1; hipLaunchKernelGGL(mega_fwd, dim3(grid), dim3(NTHREADS), LDS_BYTES, stream, a); }
#endif
    if (DBG_DUMP) { a.ph_lo = 99; a.ph_hi = 100; hipLaunchKernelGGL(mega_fwd, dim3(grid), dim3(NTHREADS), LDS_BYTES, stream, a); }
#else
    a.ph_lo = 0; a.ph_hi = N_PHASES;
    if (hipMemsetAsync((char*)d_ws + WS_BAR, 0, 16384, stream) != hipSuccess) { fprintf(stderr, "kernel_launch: memset of the barrier words failed\n"); return; }
    void* kargs[] = {&a};
    hipError_t e = hipLaunchCooperativeKernel((const void*)mega_fwd, dim3(grid), dim3(NTHREADS), kargs, LDS_BYTES, stream);
    if (e != hipSuccess) fprintf(stderr, "kernel_launch: cooperative launch failed: %s (grid %d)\n", hipGetErrorString(e), grid);
#endif
}
```

```cpp
#include <hip/hip_runtime.h>
#include <hip/hip_cooperative_groups.h>
#include <cstdio>
#include <cstdint>
namespace cg = cooperative_groups;
namespace pg8 {
#define PG8_LAS __attribute__((address_space(3)))
typedef unsigned short bf16_t;
typedef short bf16x8 __attribute__((ext_vector_type(8)));
typedef float f32x4 __attribute__((ext_vector_type(4)));
typedef unsigned u32x4 __attribute__((ext_vector_type(4)));
constexpr int BM = 256, BK = 64, HALF = 128, HTB = HALF * BK * 2  , STAGE_BYTES = 8 * HTB, NXCD = 8, WGM = 8;

__host__ __device__ __forceinline__ int lds_byte(int r, int c) { const int st = (r >> 4) * 2 + (c >> 5), rr = r & 15, cc = c & 31, ob = rr * 64 + cc * 2; return st * 1024 + (ob ^ (((ob >> 9) & 1) << 5)); }
__host__ __device__ __forceinline__ void stage_rc(int b, int& R, int& C) { const int st = b / 1024, sb = b % 1024, swz = sb ^ (((sb >> 9) & 1) << 5); R = (st >> 1) * 16 + swz / 64; C = (st & 1) * 32 + (swz % 64) / 2; }
__host__ __device__ __forceinline__ int perm32(int rho) { const int n = rho >> 4, i = rho & 15; return 8 * (i >> 2) + 4 * n + (i & 3); }

struct Unit { int pm, pn; };
struct Gemm { const bf16_t* A; const bf16_t* Bt; int M, N, K; };

struct StaticOrder {
    int nM, nN, nwg, G, c;
    __host__ __device__ void init(int M, int N, int G_, int c_) { nM = M / BM; nN = N / BM; nwg = nM * nN; G = G_; c = c_; }
    __host__ __device__ bool next(int i, Unit& u) const {
        const long L = (long)i * G + c; if (L >= nwg) return false;
        int wgid = (int)L; { const int q = nwg / NXCD, r = nwg % NXCD, xcd = wgid % NXCD, off = wgid / NXCD; wgid = (xcd < r ? xcd * (q + 1) : r * (q + 1) + (xcd - r) * q) + off; }
        const int nig = WGM * nN, gid = wgid / nig, fm = gid * WGM, gsz = (nM - fm) < WGM ? (nM - fm) : WGM;
        u.pm = fm + ((wgid % nig) % gsz); u.pn = (wgid % nig) / gsz; return true;
    }
    __device__ __forceinline__ void a_ready(const Unit&) const {}
    __device__ __forceinline__ void done(const Unit&) const {}
};

__device__ __forceinline__ unsigned cvt_pk_bf16(float lo, float hi) { unsigned r; asm volatile("v_cvt_pk_bf16_f32 %0, %1, %2" : "=v"(r) : "v"(lo), "v"(hi)); return r; }
typedef float f32x2 __attribute__((ext_vector_type(2)));
constexpr float RMS_EPS = 1e-6f;
constexpr int DM = 2048;
__device__ __forceinline__ float fsigmoid(float x) { return __builtin_amdgcn_rcpf(1.f + __expf(-x)); }
__device__ __forceinline__ float gelu_tanh(float v) { return v * fsigmoid(1.5957691216057308f * (v + 0.044715f * v * v * v)); }
__device__ __forceinline__ float rstd_row(const float* ssp, int row) {
    const f32x4* p = (const f32x4*)(ssp + (size_t)row * 32); float s = 0.f;
#pragma unroll
    for (int i = 0; i < 8; ++i) { const f32x4 v = p[i]; s += (v[0] + v[1]) + (v[2] + v[3]); }
    return rsqrtf(s * (1.f / DM) + RMS_EPS);
}
__device__ __forceinline__ float bf_lo(unsigned w) { return __uint_as_float(w << 16); }
__device__ __forceinline__ float bf_hi(unsigned w) { return __uint_as_float(w & 0xffff0000u); }

template <int MODE> struct EpiAct {
    static constexpr bool PERM = true, AFTER_DRAIN = false;
    bf16_t* O0; bf16_t* O1; int ldc; int split; const float* ss; const PG8_LAS float* tab; int tab_t;
    __device__ __forceinline__ void operator()(const f32x4 (&acc)[2][2][4][2], const Unit& u, int wr, int wc, int fr, int fq) const {
        const int row0 = u.pm * BM + wr * 64 + fr; int colt = u.pn * BM; bf16_t* base = O0; bool second = false;
        if (MODE <= 1) { if (colt >= split) { base = O1; colt -= split; second = true; } }
        const int col0 = colt + wc * 32 + 8 * fq;
        f32x4 cs[2][2];
        if (MODE == 4) {
#pragma unroll
            for (int bj = 0; bj < 2; ++bj)
#pragma unroll
                for (int n = 0; n < 2; ++n) {
#pragma unroll
                    for (int e = 0; e < 4; ++e) cs[bj][n][e] = (u.pn == tab_t) ? tab[col0 - u.pn * BM + bj * HALF + 4 * n + e] : rstd_row(ss, col0 + bj * HALF + 4 * n + e); }
        }
#pragma unroll
        for (int ai = 0; ai < 2; ++ai)
#pragma unroll
            for (int m = 0; m < 4; ++m) {
                const int row = row0 + ai * HALF + m * 16;
                float rs = 1.f;
                if (MODE <= 2) { rs = (u.pm == tab_t) ? tab[row - u.pm * BM] : rstd_row(ss, row); if (MODE == 1 && !second) rs *= 0.08838834764831845f; }
                bf16_t* rowp = base + (size_t)row * ldc + col0;
#pragma unroll
                for (int bj = 0; bj < 2; ++bj) {
                    f32x4 v0 = acc[ai][bj][m][0], v1 = acc[ai][bj][m][1];
                    if (MODE == 4) { v0 = v0 * cs[bj][0]; v1 = v1 * cs[bj][1]; } else { v0 = v0 * rs; v1 = v1 * rs; }
                    if (MODE == 0) { if (second) {
#pragma unroll
                        for (int e = 0; e < 4; ++e) { v0[e] = gelu_tanh(v0[e]); v1[e] = gelu_tanh(v1[e]); } } }
                    if (MODE == 2) {
#pragma unroll
                        for (int e = 0; e < 4; ++e) { const float a = fmaxf(v0[e], 0.f), b = fmaxf(v1[e], 0.f); v0[e] = a * a; v1[e] = b * b; } }
                    u32x4 w; w.x = cvt_pk_bf16(v0[0], v0[1]); w.y = cvt_pk_bf16(v0[2], v0[3]); w.z = cvt_pk_bf16(v1[0], v1[1]); w.w = cvt_pk_bf16(v1[2], v1[3]);
                    *(u32x4*)(rowp + bj * HALF) = w;
                }
                asm volatile("" ::: "memory");
            }
    }
};

template <int MODE> struct EpiRes {
    static constexpr bool PERM = true, AFTER_DRAIN = false;
    const bf16_t* base; bf16_t* out; float* ss_out; const float* ss_in; const bf16_t* proj; const PG8_LAS float* tab; int tab_t;
    __device__ __forceinline__ void operator()(const f32x4 (&acc)[2][2][4][2], const Unit& u, int wr, int wc, int fr, int fq) const {
        const int row0 = u.pm * BM + wr * 64 + fr; const int col0 = u.pn * BM + wc * 32 + 8 * fq;
#pragma unroll
        for (int aim = 0; aim < 4; ++aim) { const int ai = aim >> 1, mh = (aim & 1) * 2;
            u32x4 bpre[2][2]; u32x4 ppre[2][2];
#pragma unroll
            for (int mm = 0; mm < 2; ++mm) { const int m = mh + mm; const size_t off = (size_t)(row0 + ai * HALF + m * 16) * DM + col0;
#pragma unroll
                for (int bj = 0; bj < 2; ++bj) { bpre[mm][bj] = *(const u32x4*)(base + off + bj * HALF);
                    if (MODE == 1) ppre[mm][bj] = *(const u32x4*)(proj + off + bj * HALF); } }
#pragma unroll
            for (int mm = 0; mm < 2; ++mm) { const int m = mh + mm;
                const int row = row0 + ai * HALF + m * 16; const size_t off = (size_t)row * DM + col0;
                float rs = 0.f; if (MODE == 1) rs = (u.pm == tab_t) ? tab[row - u.pm * BM] : rstd_row(ss_in, row);
                float sq = 0.f;
#pragma unroll
                for (int bj = 0; bj < 2; ++bj) {
                    const u32x4 bw = bpre[mm][bj];
                    const f32x4 b0 = (f32x4){bf_lo(bw.x), bf_hi(bw.x), bf_lo(bw.y), bf_hi(bw.y)}, b1 = (f32x4){bf_lo(bw.z), bf_hi(bw.z), bf_lo(bw.w), bf_hi(bw.w)};
                    f32x4 v0 = acc[ai][bj][m][0], v1 = acc[ai][bj][m][1];
                    if (MODE == 1) {
                        const u32x4 pw = ppre[mm][bj];
                        const f32x4 p0 = (f32x4){bf_lo(pw.x), bf_hi(pw.x), bf_lo(pw.y), bf_hi(pw.y)}, p1 = (f32x4){bf_lo(pw.z), bf_hi(pw.z), bf_lo(pw.w), bf_hi(pw.w)};
#pragma unroll
                        for (int e = 0; e < 4; ++e) { v0[e] = fsigmoid(v0[e] * rs) * p0[e]; v1[e] = fsigmoid(v1[e] * rs) * p1[e]; }
                    }
                    const f32x4 o0 = b0 + v0, o1 = b1 + v1;
                    u32x4 w; w.x = cvt_pk_bf16(o0[0], o0[1]); w.y = cvt_pk_bf16(o0[2], o0[3]); w.z = cvt_pk_bf16(o1[0], o1[1]); w.w = cvt_pk_bf16(o1[2], o1[3]);
                    *(u32x4*)(out + off + bj * HALF) = w;
                    sq += (o0[0] * o0[0] + o0[1] * o0[1]) + (o0[2] * o0[2] + o0[3] * o0[3]) + (o1[0] * o1[0] + o1[1] * o1[1]) + (o1[2] * o1[2] + o1[3] * o1[3]);
                }
                sq += __shfl_xor(sq, 16); sq += __shfl_xor(sq, 32);
                if (fq == 0) ss_out[(size_t)row * 32 + u.pn * 4 + wc] = sq;
            }
            asm volatile("" ::: "memory");
        }
    }
};

template <class Epi, class Sched, bool ALIGN_EPI = false, bool SP2 = false>
__device__ __forceinline__ void gemm_phase(PG8_LAS unsigned char* lds, const Gemm g, const Sched& S, const Epi& E) {
    int tid_ = threadIdx.x; asm volatile("" : "+v"(tid_)); const int tid = tid_, wid = __builtin_amdgcn_readfirstlane(tid >> 6), lane = tid & 63, wr = wid >> 2, wc = wid & 3, fr = lane & 15, fq = lane >> 4;
    const int K = g.K, nt = K / BK;
    unsigned voffA[2], voffB[2];
#pragma unroll
    for (int i = 0; i < 2; ++i) { int R, C; stage_rc(tid * 16 + i * 8192, R, C); const int Rb = Epi::PERM ? ((R & ~31) + perm32(R & 31)) : R;
        voffA[i] = (unsigned)(R * K + C) * 2u; voffB[i] = (unsigned)(Rb * K + C) * 2u; }
    const size_t kstep = (size_t)(BK * 2);
    const size_t hstep = (size_t)HALF * K * 2;
    const size_t tstep = 2 * hstep;
    const unsigned ldsw = (unsigned)wid * 1024u;
    const int aoff = lds_byte(wr * 64 + fr, fq * 8), boff = lds_byte(wc * 32 + fr, fq * 8);
#define PG8_SA(b, h) (((b) * 2 + (h)) * HTB)
#define PG8_SB(b, h) ((4 + (b) * 2 + (h)) * HTB)
#define PG8_STAGE(bufoff, gbase, voff) do { _Pragma("unroll") for (int _i = 0; _i < 2; ++_i) \
        __builtin_amdgcn_global_load_lds((const unsigned*)((const char*)(gbase) + (voff)[_i]), (PG8_LAS unsigned*)(lds + (bufoff) + ldsw + _i * 8192), 16, 0, 0); } while (0)
#define PG8_LDA(dst, b, h) do { _Pragma("unroll") for (int m = 0; m < 4; ++m) _Pragma("unroll") for (int k = 0; k < 2; ++k) dst[m][k] = *(const PG8_LAS bf16x8*)(lds + PG8_SA(b, h) + aoff + m * 2048 + k * 1024); } while (0)
#define PG8_LDB(dst, b, h) do { _Pragma("unroll") for (int n = 0; n < 2; ++n) _Pragma("unroll") for (int k = 0; k < 2; ++k) dst[n][k] = *(const PG8_LAS bf16x8*)(lds + PG8_SB(b, h) + boff + n * 2048 + k * 1024); } while (0)
#define PG8_MMA(ai, bj, At, Bt) do { __builtin_amdgcn_s_setprio(1); _Pragma("unroll") for (int m = 0; m < 4; ++m) _Pragma("unroll") for (int n = 0; n < 2; ++n) _Pragma("unroll") for (int k = 0; k < 2; ++k) \
        acc[ai][bj][m][n] = __builtin_amdgcn_mfma_f32_16x16x32_bf16(Bt[n][k], At[m][k], acc[ai][bj][m][n], 0, 0, 0); __builtin_amdgcn_s_setprio(0); } while (0)
#define PG8_WAIT_V(n) asm volatile("s_waitcnt vmcnt(" #n ")" ::: "memory")
#define PG8_WAIT_L(n) asm volatile("s_waitcnt lgkmcnt(" #n ")" ::: "memory")
#define PG8_BAR __builtin_amdgcn_s_barrier()
#define PG8_SCHED __builtin_amdgcn_sched_barrier(0)
    Unit cur, nxt; int ui = 0;
    if (!S.next(0, cur)) return;
    f32x4 acc[2][2][4][2];
#pragma unroll
    for (int a = 0; a < 2; ++a)
#pragma unroll
        for (int b = 0; b < 2; ++b)
#pragma unroll
            for (int m = 0; m < 4; ++m)
#pragma unroll
                for (int n = 0; n < 2; ++n) acc[a][b][m][n] = (f32x4){0.f, 0.f, 0.f, 0.f};
    bf16x8 At[4][2], B0[2][2], B1[2][2];
    const char* cA = (const char*)g.A + (size_t)cur.pm * tstep; const char* cB = (const char*)g.Bt + (size_t)cur.pn * tstep;
    S.a_ready(cur);
    if constexpr (SP2) {
        PG8_STAGE(PG8_SB(0, 0), cB, voffB); PG8_STAGE(PG8_SB(0, 1), cB + hstep, voffB); PG8_STAGE(PG8_SA(0, 0), cA, voffA); PG8_STAGE(PG8_SA(0, 1), cA + hstep, voffA);
        if (wr == 1) PG8_BAR;
        PG8_WAIT_V(2); PG8_BAR;
        PG8_STAGE(PG8_SB(1, 0), cB + kstep, voffB); PG8_STAGE(PG8_SA(1, 0), cA + kstep, voffA); PG8_STAGE(PG8_SB(1, 1), cB + hstep + kstep, voffB);
        PG8_WAIT_V(6); PG8_BAR;
    } else {
        PG8_STAGE(PG8_SB(0, 0), cB, voffB); PG8_STAGE(PG8_SA(0, 0), cA, voffA); PG8_STAGE(PG8_SB(0, 1), cB + hstep, voffB); PG8_STAGE(PG8_SA(0, 1), cA + hstep, voffA);
        if (wr == 1) PG8_BAR;
        PG8_WAIT_V(4); PG8_BAR;
        PG8_STAGE(PG8_SB(1, 0), cB + kstep, voffB); PG8_STAGE(PG8_SA(1, 0), cA + kstep, voffA); PG8_STAGE(PG8_SB(1, 1), cB + hstep + kstep, voffB);
        PG8_WAIT_V(6); PG8_BAR;
    }
    for (;;) {
        const bool has_next = S.next(ui + 1, nxt);
        const char* nA = has_next ? (const char*)g.A + (size_t)nxt.pm * tstep : cA; const char* nB = has_next ? (const char*)g.Bt + (size_t)nxt.pn * tstep : cB;
        for (int t = 0; t < nt; t += 2) {
            const bool last = (t == nt - 2);
            const char* a1 = cA + (size_t)(t + 1) * kstep;
            const char* a2 = last ? nA : cA + (size_t)(t + 2) * kstep; const char* b2 = last ? nB : cB + (size_t)(t + 2) * kstep;
            const char* a3 = a2 + kstep; const char* b3 = b2 + kstep;
            if (last && has_next) S.a_ready(nxt);
            if constexpr (SP2) {
            PG8_LDB(B0, 0, 0); PG8_LDB(B1, 0, 1); PG8_SCHED; PG8_LDA(At, 0, 0); PG8_STAGE(PG8_SA(1, 1), a1 + hstep, voffA);
            PG8_WAIT_V(8); PG8_WAIT_L(0); PG8_BAR; PG8_MMA(0, 0, At, B0); PG8_MMA(0, 1, At, B1); PG8_BAR; PG8_SCHED;
            PG8_LDA(At, 0, 1); PG8_STAGE(PG8_SB(0, 0), b2, voffB); PG8_STAGE(PG8_SB(0, 1), b2 + hstep, voffB); PG8_STAGE(PG8_SA(0, 0), a2, voffA);
            PG8_WAIT_V(8); PG8_WAIT_L(0); PG8_BAR; PG8_MMA(1, 0, At, B0); PG8_MMA(1, 1, At, B1); PG8_BAR; PG8_SCHED;
            PG8_LDB(B0, 1, 0); PG8_LDB(B1, 1, 1); PG8_SCHED; PG8_LDA(At, 1, 0); PG8_STAGE(PG8_SA(0, 1), a2 + hstep, voffA);
            PG8_WAIT_V(8); PG8_WAIT_L(0); PG8_BAR; PG8_MMA(0, 0, At, B0); PG8_MMA(0, 1, At, B1); PG8_BAR; PG8_SCHED;
            PG8_LDA(At, 1, 1); PG8_STAGE(PG8_SB(1, 0), b3, voffB); PG8_STAGE(PG8_SB(1, 1), b3 + hstep, voffB); PG8_STAGE(PG8_SA(1, 0), a3, voffA);
            PG8_WAIT_V(8); PG8_WAIT_L(0); PG8_BAR; PG8_MMA(1, 0, At, B0); PG8_MMA(1, 1, At, B1); PG8_BAR; PG8_SCHED;
            } else {
            PG8_LDB(B0, 0, 0); PG8_SCHED; PG8_LDA(At, 0, 0); PG8_STAGE(PG8_SA(1, 1), a1 + hstep, voffA);
            PG8_WAIT_L(8); PG8_BAR; PG8_WAIT_L(0); PG8_MMA(0, 0, At, B0); PG8_BAR; PG8_SCHED;
            PG8_LDB(B1, 0, 1); PG8_STAGE(PG8_SB(0, 0), b2, voffB);
            PG8_BAR; PG8_WAIT_L(0); PG8_MMA(0, 1, At, B1); PG8_BAR;
            PG8_LDA(At, 0, 1); PG8_STAGE(PG8_SA(0, 0), a2, voffA);
            PG8_BAR; PG8_WAIT_L(0); PG8_MMA(1, 0, At, B0); PG8_BAR; PG8_SCHED;
            PG8_STAGE(PG8_SB(0, 1), b2 + hstep, voffB);
            PG8_WAIT_V(6); PG8_BAR; PG8_MMA(1, 1, At, B1); PG8_BAR;
            PG8_LDB(B0, 1, 0); PG8_SCHED; PG8_LDA(At, 1, 0); PG8_STAGE(PG8_SA(0, 1), a2 + hstep, voffA);
            PG8_WAIT_L(8); PG8_BAR; PG8_WAIT_L(0); PG8_MMA(0, 0, At, B0); PG8_BAR; PG8_SCHED;
            PG8_LDB(B1, 1, 1); PG8_STAGE(PG8_SB(1, 0), b3, voffB);
            PG8_BAR; PG8_WAIT_L(0); PG8_MMA(0, 1, At, B1); PG8_BAR;
            PG8_LDA(At, 1, 1); PG8_STAGE(PG8_SA(1, 0), a3, voffA);
            PG8_BAR; PG8_WAIT_L(0); PG8_MMA(1, 0, At, B0); PG8_BAR; PG8_SCHED;
            PG8_STAGE(PG8_SB(1, 1), b3 + hstep, voffB);
            PG8_WAIT_V(6); PG8_BAR; PG8_MMA(1, 1, At, B1); PG8_BAR;
            }
        }
        if constexpr (ALIGN_EPI) { if (wr == 0) PG8_BAR; }
        if constexpr (!Epi::AFTER_DRAIN) { E(acc, cur, wr, wc, fr, fq); S.done(cur); }
        if (!has_next) break;
#pragma unroll
        for (int a = 0; a < 2; ++a)
#pragma unroll
            for (int b = 0; b < 2; ++b)
#pragma unroll
                for (int m = 0; m < 4; ++m)
#pragma unroll
                    for (int n = 0; n < 2; ++n) acc[a][b][m][n] = (f32x4){0.f, 0.f, 0.f, 0.f};
        cur = nxt; cA = nA; cB = nB; ++ui;
        if constexpr (ALIGN_EPI) { if (wr == 1) PG8_BAR; }
    }
    PG8_WAIT_V(0);
    if constexpr (!ALIGN_EPI) { if (wr == 0) PG8_BAR; }
    PG8_BAR;
    if constexpr (Epi::AFTER_DRAIN) { E.fused(acc, cur, wr, wc, fr, fq, lds, wid, lane); S.done(cur); }
#undef PG8_SA
#undef PG8_SB
#undef PG8_STAGE
#undef PG8_LDA
#undef PG8_LDB
#undef PG8_MMA
#undef PG8_WAIT_V
#undef PG8_WAIT_L
#undef PG8_BAR
#undef PG8_SCHED
}
}

constexpr int SEQ = 8192, DM = 2048, DFF = 8192, PLE = 256, DEPTH = 4, NHEAD = 16, HD = 128;
constexpr int NWAVES = 8, NTHREADS = 512;
constexpr int LDS_BYTES = 147456;
typedef unsigned short bf16;
typedef unsigned u32x4 __attribute__((ext_vector_type(4)));
typedef unsigned u32x2 __attribute__((ext_vector_type(2)));
typedef float f32x4 __attribute__((ext_vector_type(4)));
typedef float f32x2 __attribute__((ext_vector_type(2)));
typedef short bf16x8 __attribute__((ext_vector_type(8)));
#define LAS __attribute__((address_space(3)))
#define LDS_WAIT() asm volatile("s_waitcnt lgkmcnt(0)" ::: "memory")

constexpr size_t MiB = 1u << 20;
constexpr size_t WS_SS = 880 * MiB;
constexpr size_t WS_BAR = 0;
constexpr size_t WS_AGG = 2 * MiB;
constexpr size_t WS_X0 = 8 * MiB, WS_X1 = 40 * MiB;
constexpr size_t WS_BA = 72 * MiB, WS_BB = 104 * MiB, WS_BC = 136 * MiB, WS_BD = 168 * MiB;
constexpr size_t WS_A1 = 200 * MiB;
constexpr size_t WS_PROJ = 328 * MiB;
constexpr size_t WS_PB = 456 * MiB;
constexpr size_t WS_W1T = 472 * MiB, WS_W2T = 600 * MiB, WS_WGT = 728 * MiB, WS_WPT = 760 * MiB, WS_WINT = 764 * MiB, WS_WORT = 796 * MiB,
                 WS_GAT = 812 * MiB, WS_GXT = 814 * MiB, WS_WQKVT = 816 * MiB, WS_WONT = 864 * MiB, WS_END = 893 * MiB;

struct Args {
    const float* in[22];
    float* out; unsigned char* ws;
    int ph_lo, ph_hi;
};
static_assert(sizeof(Args) == 200 && offsetof(Args, out) == 176 && offsetof(Args, ws) == 184 && offsetof(Args, ph_lo) == 192, "Args layout");

typedef const unsigned char __attribute__((address_space(4)))* KA;
#define INP(k) (*(const float* const __attribute__((address_space(4)))*)(ka + 8 * (k)))
__device__ __forceinline__ int opaque_tid() { int t = threadIdx.x; asm volatile("" : "+v"(t)); return t; }
__device__ __forceinline__ unsigned cvt_pk(float lo, float hi) { return pg8::cvt_pk_bf16(lo, hi); }
__device__ __forceinline__ float bfl(unsigned w) { return __uint_as_float(w << 16); }
__device__ __forceinline__ float bfh(unsigned w) { return __uint_as_float(w & 0xffff0000u); }
__device__ __forceinline__ float wave_sum(float v) {
#pragma unroll
    for (int o = 1; o < 64; o <<= 1) v += __shfl_xor(v, o);
    return v;
}

__device__ __forceinline__ void transpose_item(const float* W, int K, int N, const float* g, bf16* WT, int kb, int nb, int lane) {
    const int q = lane >> 4, ln = lane & 15;
    const int kbase = 64 * kb + 16 * q, n = 64 * nb + 4 * ln;
    f32x4 v[16];
    const float* wp = W + (size_t)kbase * N + n;
#pragma unroll
    for (int i = 0; i < 16; ++i) v[i] = *(const f32x4*)(wp + (size_t)i * N);
    if (g) {
#pragma unroll
        for (int i4 = 0; i4 < 4; ++i4) { const f32x4 gv = *(const f32x4*)(g + kbase + 4 * i4);
#pragma unroll
            for (int e = 0; e < 4; ++e) v[4 * i4 + e] = v[4 * i4 + e] * gv[e]; }
    }
#pragma unroll
    for (int e = 0; e < 4; ++e) {
        bf16* op = WT + (size_t)(n + e) * K + kbase;
#pragma unroll
        for (int h = 0; h < 2; ++h) {
            u32x4 o; o.x = cvt_pk(v[8 * h + 0][e], v[8 * h + 1][e]); o.y = cvt_pk(v[8 * h + 2][e], v[8 * h + 3][e]); o.z = cvt_pk(v[8 * h + 4][e], v[8 * h + 5][e]); o.w = cvt_pk(v[8 * h + 6][e], v[8 * h + 7][e]);
            *(u32x4*)(op + 8 * h) = o;
        }
    }
}

__device__ __forceinline__ void p0_phase(LAS unsigned char* lds, KA ka, unsigned char* ws, int G) {
    const int tid = opaque_tid(), lane = tid & 63, wave = tid >> 6;
    const int gw = blockIdx.x * NWAVES + wave, NGW = G * NWAVES;
    float* ss = (float*)(ws + WS_SS);
    {
        const float* x = INP(0); bf16* X0 = (bf16*)(ws + WS_X0);
        for (int row = gw; row < SEQ; row += NGW) {
            const f32x4* xr = (const f32x4*)(x + (size_t)row * DM) + lane; float s = 0.f;
            u32x2* o = (u32x2*)(X0 + (size_t)row * DM) + lane;
#pragma unroll
            for (int j = 0; j < 8; ++j) { const f32x4 v = xr[64 * j]; s += (v[0] * v[0] + v[1] * v[1]) + (v[2] * v[2] + v[3] * v[3]); u32x2 w; w.x = cvt_pk(v[0], v[1]); w.y = cvt_pk(v[2], v[3]); o[64 * j] = w; }
            s = wave_sum(s);
            if (lane < 32) ss[(size_t)row * 32 + lane] = (lane == 0) ? s : 0.f;
        }
    }
    {
        const f32x4* p = (const f32x4*)INP(1); u32x2* o = (u32x2*)(ws + WS_PB);
        const int n4 = DEPTH * SEQ * PLE / 4;
        for (int i = blockIdx.x * NTHREADS + tid; i < n4; i += G * NTHREADS) { const f32x4 v = p[i]; u32x2 w; w.x = cvt_pk(v[0], v[1]); w.y = cvt_pk(v[2], v[3]); o[i] = w; }
    }
    const int nitems_total =
        4 * (2048 / 64) * (8192 / 64) + 4 * (8192 / 64) * (2048 / 64) + 4 * (2048 / 64) * (2048 / 64) + 4 * (256 / 64) * (2048 / 64) +
        2 * (2048 / 64) * (4096 / 64) + 2 * (2048 / 64) * (2048 / 64) + 64 * (128 / 64) * (128 / 64) + 64 * (128 / 64) * (128 / 64) +
        2 * (2048 / 64) * (6144 / 64) + 2 * (2048 / 64) * (2048 / 64);
    for (int it = gw; it < nitems_total; it += NGW) {
        int r = it;
#define CONV_TRY(Wp, nmat, K, N, gp, gstride, WTp) { const int ipm = ((K) / 64) * ((N) / 64); const int tot = (nmat) * ipm; \
            if (r < tot) { const int mat = r / ipm, rr = r % ipm, kb = rr / ((N) / 64), nb = rr % ((N) / 64); const float* g_ = (gp); \
                transpose_item((Wp) + (size_t)mat * (K) * (N), (K), (N), g_ ? g_ + (size_t)mat * (gstride) : nullptr, (bf16*)(ws + (WTp)) + (size_t)mat * (K) * (N), kb, nb, lane); continue; } r -= tot; }
        CONV_TRY(INP(18), 4, 2048, 8192, INP(3), 2048, WS_W1T)
        CONV_TRY(INP(19), 4, 8192, 2048, (const float*)nullptr, 0, WS_W2T)
        CONV_TRY(INP(20), 4, 2048, 2048, INP(4), 2048, WS_WGT)
        CONV_TRY(INP(21), 4, 256, 2048, (const float*)nullptr, 0, WS_WPT)
        CONV_TRY(INP(6), 2, 2048, 4096, INP(2), 4096, WS_WINT)
        CONV_TRY(INP(14), 2, 2048, 2048, (const float*)nullptr, 0, WS_WORT)
        CONV_TRY(INP(9), 64, 128, 128, (const float*)nullptr, 0, WS_GAT)
        CONV_TRY(INP(11), 64, 128, 128, (const float*)nullptr, 0, WS_GXT)
        CONV_TRY(INP(15), 2, 2048, 6144, INP(2) + 2048, 4096, WS_WQKVT)
        CONV_TRY(INP(17), 2, 2048, 2048, (const float*)nullptr, 0, WS_WONT)
#undef CONV_TRY
    }
}

constexpr int SC_T = 64, SC_NCH = SEQ / SC_T;
constexpr int XCF_STRIDE = 132;
constexpr int XCB_STRIDE = 136;
constexpr int LDS_XCF = 0, LDS_XCB = LDS_XCF + SC_T * XCF_STRIDE * 4, LDS_YGS = LDS_XCB + SC_T * XCB_STRIDE * 2, LDS_SEG = LDS_YGS + SC_T * 128 * 2, LDS_CAR = LDS_SEG + 2 * 128 * 17 * 8, LDS_SC_END = LDS_CAR + 2 * 8 * 128 * 4;
static_assert(LDS_SC_END <= 131072, "scan LDS");

struct ScanArgs {
    const bf16* XR; const bf16* YG; bf16* Y;
    const float* conv_w; const float* conv_b;
    const bf16* gaT; const bf16* gxT;
    const float* ga_b; const float* gx_b; const float* lam;
    f32x2* agg;
    unsigned* au;
};

template <bool FINAL>
__device__ __forceinline__ void scan_phase(LAS unsigned char* lds, const ScanArgs& sa, int G) {
    const int tid = opaque_tid(), lane = tid & 63, w = tid >> 6, fr = lane & 15, fq = lane >> 4;
    LAS float* xcf = (LAS float*)(lds + LDS_XCF);
    LAS bf16* xcb = (LAS bf16*)(lds + LDS_XCB);
    LAS bf16* ygs = (LAS bf16*)(lds + LDS_YGS);
    LAS f32x2* seg = (LAS f32x2*)(lds + LDS_SEG);
    int cur_hd = -1;
    bf16x8 Bf[4][4];
    float ba[2], bx[2], sp8[2];
    ba[0] = ba[1] = bx[0] = bx[1] = sp8[0] = sp8[1] = 0.f;
    LAS float* car = (LAS float*)(lds + LDS_CAR);
    const bool fast = FINAL && (G == 256);
    if (fast) {
        if (tid < 256) {
            const int dir = tid >> 7, c = tid & 127, gch = (blockIdx.x & 15) * 128 + c, cmod = blockIdx.x >> 4;
            const f32x2* ag = sa.agg + (size_t)dir * SC_NCH * DM + gch;
            float h = 0.f;
            if (dir == 0) {
#pragma unroll 32
                for (int cc = 0; cc < SC_NCH; ++cc) { const f32x2 e = ag[(size_t)cc * DM]; if ((cc & 15) == cmod) car[(dir * 8 + (cc >> 4)) * 128 + c] = h; h = e[0] * h + e[1]; }
            } else {
#pragma unroll 32
                for (int cc = SC_NCH - 1; cc >= 0; --cc) { const f32x2 e = ag[(size_t)cc * DM]; if ((cc & 15) == cmod) car[(dir * 8 + (cc >> 4)) * 128 + c] = h; h = e[0] * h + e[1]; }
            }
        }
    }
    unsigned xpre[11]; u32x4 ypre[2];
#define SCAN_PREFETCH(itx) do { const int hd_ = (itx) & 15, t0_ = ((itx) >> 4) * SC_T; const int gc_ = hd_ * 128 + 2 * (tid & 63), tg_ = tid >> 6; \
        _Pragma("unroll") for (int q = 0; q < 11; ++q) { const int t = t0_ + 8 * tg_ - 1 + q; unsigned v = 0u; if (t >= 0 && t < SEQ) v = *(const unsigned*)(sa.XR + (size_t)t * DM + gc_); xpre[q] = v; } \
        if (FINAL) { _Pragma("unroll") for (int i = 0; i < 2; ++i) { const int idx = tid + i * NTHREADS, row = idx >> 4, c16 = idx & 15; \
            ypre[i] = *(const u32x4*)(sa.YG + (size_t)(t0_ + row) * DM + hd_ * 128 + c16 * 8); } } } while (0)
    ypre[0] = (u32x4){0u, 0u, 0u, 0u}; ypre[1] = (u32x4){0u, 0u, 0u, 0u};
    if ((int)blockIdx.x < SC_NCH * NHEAD) SCAN_PREFETCH((int)blockIdx.x);
    for (int it = blockIdx.x; it < SC_NCH * NHEAD; it += G) {
        const int hd = it & 15, chunk = it >> 4, t0 = chunk * SC_T;
        __syncthreads();
#pragma unroll
        for (int dir = 0; dir < 2; ++dir) {
            const bf16* wa = sa.gaT + ((size_t)(dir * 16 + hd) * 128 + 16 * w + fr) * 128 + 8 * fq;
            const bf16* wx = sa.gxT + ((size_t)(dir * 16 + hd) * 128 + 16 * w + fr) * 128 + 8 * fq;
#pragma unroll
            for (int k = 0; k < 4; ++k) { Bf[dir * 2 + 0][k] = *(const bf16x8*)(wa + 32 * k); Bf[dir * 2 + 1][k] = *(const bf16x8*)(wx + 32 * k); }
        }
        if (hd != cur_hd) {
            cur_hd = hd;
#pragma unroll
            for (int dir = 0; dir < 2; ++dir) {
                const int gch = hd * 128 + 16 * w + fr;
                ba[dir] = -1.4426950408889634f * sa.ga_b[dir * DM + gch]; bx[dir] = -1.4426950408889634f * sa.gx_b[dir * DM + gch];
                sp8[dir] = 1.4426950408889634f * 8.f * log1pf(expf(-sa.lam[dir * DM + gch]));
            }
        }
        {
            const int cp = tid & 63, tg = tid >> 6;
            const int gc = hd * 128 + 2 * cp;
            float x0[11], x1[11];
#pragma unroll
            for (int q = 0; q < 11; ++q) { x0[q] = bfl(xpre[q]); x1[q] = bfh(xpre[q]); }
            float w0[4], w1[4];
#pragma unroll
            for (int k = 0; k < 4; ++k) { const f32x2 wv = *(const f32x2*)(sa.conv_w + k * DM + gc); w0[k] = wv[0]; w1[k] = wv[1]; }
            const f32x2 bv = *(const f32x2*)(sa.conv_b + gc);
#pragma unroll
            for (int q = 0; q < 8; ++q) {
                const float c0 = bv[0] + ((w0[0] * x0[q] + w0[1] * x0[q + 1]) + (w0[2] * x0[q + 2] + w0[3] * x0[q + 3]));
                const float c1 = bv[1] + ((w1[0] * x1[q] + w1[1] * x1[q + 1]) + (w1[2] * x1[q + 2] + w1[3] * x1[q + 3]));
                const int tau = 8 * tg + q;
                *(LAS f32x2*)(xcf + tau * XCF_STRIDE + 2 * cp) = (f32x2){c0, c1};
                *(LAS unsigned*)(xcb + tau * XCB_STRIDE + 2 * cp) = cvt_pk(c0, c1);
            }
            if (FINAL) {
#pragma unroll
                for (int i = 0; i < 2; ++i) { const int idx = tid + i * NTHREADS, row = idx >> 4, c16 = idx & 15;
                    *(LAS u32x4*)(ygs + row * 128 + c16 * 8) = ypre[i]; }
            }
            if (it + G < SC_NCH * NHEAD) SCAN_PREFETCH(it + G);
        }
        __syncthreads();
        f32x4 acc[4][4];
#pragma unroll
        for (int m = 0; m < 4; ++m)
#pragma unroll
            for (int mb = 0; mb < 4; ++mb) acc[m][mb] = (f32x4){0.f, 0.f, 0.f, 0.f};
#pragma unroll
        for (int mb = 0; mb < 4; ++mb) {
            bf16x8 Af[4];
#pragma unroll
            for (int k = 0; k < 4; ++k) Af[k] = *(const LAS bf16x8*)(xcb + (16 * mb + fr) * XCB_STRIDE + 32 * k + 8 * fq);
#pragma unroll
            for (int m = 0; m < 4; ++m)
#pragma unroll
                for (int k = 0; k < 4; ++k) acc[m][mb] = __builtin_amdgcn_mfma_f32_16x16x32_bf16(Af[k], Bf[m][k], acc[m][mb], 0, 0, 0);
        }
        const int ch = 16 * w + fr;
#pragma unroll
        for (int mb = 0; mb < 4; ++mb) {
            float xv[4];
#pragma unroll
            for (int j = 0; j < 4; ++j) xv[j] = xcf[(16 * mb + 4 * fq + j) * XCF_STRIDE + ch];
#pragma unroll
            for (int dir = 0; dir < 2; ++dir) {
#pragma unroll
                for (int j = 0; j < 4; ++j) {
                    const float e1 = __builtin_amdgcn_exp2f(fminf(fmaf(acc[2 * dir][mb][j], -1.4426950408889634f, ba[dir]), 60.f));
                    const float e2 = __builtin_amdgcn_exp2f(fminf(fmaf(acc[2 * dir + 1][mb][j], -1.4426950408889634f, bx[dir]), 60.f));
                    const float d1 = 1.f + e1, d2 = 1.f + e2, rd = __builtin_amdgcn_rcpf(d1 * d2);
                    const float r = d2 * rd, ig = d1 * rd;
                    const float la2 = -sp8[dir] * r;
                    const float av = __builtin_amdgcn_exp2f(la2);
                    const float om = fmaxf(fmaf(-av, av, 1.f), 0.f);
                    const float uv = __builtin_amdgcn_sqrtf(om) * (ig * xv[j]);
                    acc[2 * dir][mb][j] = av;
                    acc[2 * dir + 1][mb][j] = uv;
                    if (!FINAL) sa.au[((size_t)dir * SEQ + t0 + 16 * mb + 4 * fq + j) * DM + hd * 128 + ch] = cvt_pk(la2, uv);
                }
                const f32x4 A = acc[2 * dir][mb], U = acc[2 * dir + 1][mb];
                float P, Q;
                if (dir == 0) { P = (A[0] * A[1]) * (A[2] * A[3]); Q = ((U[0] * A[1] + U[1]) * A[2] + U[2]) * A[3] + U[3]; }
                else          { P = (A[0] * A[1]) * (A[2] * A[3]); Q = ((U[3] * A[2] + U[2]) * A[1] + U[1]) * A[0] + U[0]; }
                seg[(dir * 128 + ch) * 17 + mb * 4 + fq] = (f32x2){P, Q};
            }
        }
        __syncthreads();
        float hb0[4], hb1[4];
        {
            const int gch = hd * 128 + ch;
            float h0 = 0.f, h1 = 0.f, P0 = 1.f, P1 = 1.f;
            if (FINAL) {
                if (fast) { h0 = car[(0 * 8 + (chunk >> 4)) * 128 + ch]; h1 = car[(1 * 8 + (chunk >> 4)) * 128 + ch]; }
                else {
                    const f32x2* ag0 = sa.agg + gch; const f32x2* ag1 = sa.agg + (size_t)SC_NCH * DM + gch;
                    for (int cc = 0; cc < chunk; ++cc) { const f32x2 e = ag0[(size_t)cc * DM]; h0 = e[0] * h0 + e[1]; }
                    for (int cc = SC_NCH - 1; cc > chunk; --cc) { const f32x2 e = ag1[(size_t)cc * DM]; h1 = e[0] * h1 + e[1]; }
                }
            }
            const LAS f32x2* sg0 = seg + (0 * 128 + ch) * 17; const LAS f32x2* sg1 = seg + (1 * 128 + ch) * 17;
#pragma unroll
            for (int s = 0; s < 16; ++s) { const f32x2 e = sg0[s]; if ((s & 3) == fq) hb0[s >> 2] = h0; h0 = e[0] * h0 + e[1]; P0 *= e[0]; }
#pragma unroll
            for (int s = 15; s >= 0; --s) { const f32x2 e = sg1[s]; if ((s & 3) == fq) hb1[s >> 2] = h1; h1 = e[0] * h1 + e[1]; P1 *= e[0]; }
            if (!FINAL) {
                if (fq == 0) { sa.agg[((size_t)0 * SC_NCH + chunk) * DM + gch] = (f32x2){P0, h0}; sa.agg[((size_t)1 * SC_NCH + chunk) * DM + gch] = (f32x2){P1, h1}; }
            }
        }
        if (FINAL) {
#pragma unroll
            for (int mb = 0; mb < 4; ++mb) {
                float hs[4];
                { float h = hb0[mb]; const f32x4 A = acc[0][mb], U = acc[1][mb];
#pragma unroll
                  for (int j = 0; j < 4; ++j) { h = A[j] * h + U[j]; hs[j] = h; } }
                { float h = hb1[mb]; const f32x4 A = acc[2][mb], U = acc[3][mb];
#pragma unroll
                  for (int j = 3; j >= 0; --j) { h = A[j] * h + U[j]; hs[j] += h; } }
#pragma unroll
                for (int j = 0; j < 4; ++j) {
                    LAS bf16* yp = ygs + (16 * mb + 4 * fq + j) * 128 + ch;
                    const float yg = __uint_as_float((unsigned)(*yp) << 16);
                    *yp = (bf16)(cvt_pk(hs[j] * yg, 0.f) & 0xffffu);
                }
            }
            __syncthreads();
#pragma unroll
            for (int i = 0; i < 2; ++i) { const int idx = tid + i * NTHREADS, row = idx >> 4, c16 = idx & 15;
                *(u32x4*)(sa.Y + (size_t)(t0 + row) * DM + hd * 128 + c16 * 8) = *(const LAS u32x4*)(ygs + row * 128 + c16 * 8); }
        }
    }
}

__device__ __forceinline__ void scan_replay(LAS unsigned char* lds, const ScanArgs& sa, int G) {
    const int tid = opaque_tid(), lane = tid & 63, w = tid >> 6, fr = lane & 15, fq = lane >> 4;
    LAS bf16* ygs = (LAS bf16*)(lds + LDS_YGS);
    LAS f32x2* seg = (LAS f32x2*)(lds + LDS_SEG);
    LAS float* car = (LAS float*)(lds + LDS_CAR);
    const bool fast = (G == 256);
    if (fast) {
        if (tid < 256) {
            const int dir = tid >> 7, c = tid & 127, gch = (blockIdx.x & 15) * 128 + c, cmod = blockIdx.x >> 4;
            const f32x2* ag = sa.agg + (size_t)dir * SC_NCH * DM + gch;
            float h = 0.f;
            if (dir == 0) {
#pragma unroll 32
                for (int cc = 0; cc < SC_NCH; ++cc) { const f32x2 e = ag[(size_t)cc * DM]; if ((cc & 15) == cmod) car[(dir * 8 + (cc >> 4)) * 128 + c] = h; h = e[0] * h + e[1]; }
            } else {
#pragma unroll 32
                for (int cc = SC_NCH - 1; cc >= 0; --cc) { const f32x2 e = ag[(size_t)cc * DM]; if ((cc & 15) == cmod) car[(dir * 8 + (cc >> 4)) * 128 + c] = h; h = e[0] * h + e[1]; }
            }
        }
    }
    const int ch = 16 * w + fr;
    unsigned aupre[2][4][4]; u32x4 ypre[2];
#define S2_PREFETCH(itx) do { const int hd_ = (itx) & 15, t0_ = ((itx) >> 4) * SC_T; \
        _Pragma("unroll") for (int dir = 0; dir < 2; ++dir) { const unsigned* ap = sa.au + ((size_t)dir * SEQ + t0_ + 4 * fq) * DM + hd_ * 128 + ch; \
            _Pragma("unroll") for (int mb = 0; mb < 4; ++mb) _Pragma("unroll") for (int j = 0; j < 4; ++j) aupre[dir][mb][j] = ap[(size_t)(16 * mb + j) * DM]; } \
        _Pragma("unroll") for (int i = 0; i < 2; ++i) { const int idx = tid + i * NTHREADS, row = idx >> 4, c16 = idx & 15; \
            ypre[i] = *(const u32x4*)(sa.YG + (size_t)(t0_ + row) * DM + hd_ * 128 + c16 * 8); } } while (0)
    if ((int)blockIdx.x < SC_NCH * NHEAD) S2_PREFETCH((int)blockIdx.x);
    for (int it = blockIdx.x; it < SC_NCH * NHEAD; it += G) {
        const int hd = it & 15, chunk = it >> 4, t0 = chunk * SC_T;
        __syncthreads();
#pragma unroll
        for (int i = 0; i < 2; ++i) { const int idx = tid + i * NTHREADS, row = idx >> 4, c16 = idx & 15; *(LAS u32x4*)(ygs + row * 128 + c16 * 8) = ypre[i]; }
        f32x4 A[2][4], U[2][4];
#pragma unroll
        for (int dir = 0; dir < 2; ++dir)
#pragma unroll
            for (int mb = 0; mb < 4; ++mb)
#pragma unroll
                for (int j = 0; j < 4; ++j) { const unsigned wv = aupre[dir][mb][j]; A[dir][mb][j] = __builtin_amdgcn_exp2f(bfl(wv)); U[dir][mb][j] = bfh(wv); }
        if (it + G < SC_NCH * NHEAD) S2_PREFETCH(it + G);
#pragma unroll
        for (int mb = 0; mb < 4; ++mb) {
            { const f32x4 a = A[0][mb], u = U[0][mb]; seg[(0 * 128 + ch) * 17 + mb * 4 + fq] = (f32x2){(a[0] * a[1]) * (a[2] * a[3]), ((u[0] * a[1] + u[1]) * a[2] + u[2]) * a[3] + u[3]}; }
            { const f32x4 a = A[1][mb], u = U[1][mb]; seg[(1 * 128 + ch) * 17 + mb * 4 + fq] = (f32x2){(a[0] * a[1]) * (a[2] * a[3]), ((u[3] * a[2] + u[2]) * a[1] + u[1]) * a[0] + u[0]}; }
        }
        __syncthreads();
        float hb0[4], hb1[4];
        {
            const int gch = hd * 128 + ch;
            float h0 = 0.f, h1 = 0.f;
            if (fast) { h0 = car[(0 * 8 + (chunk >> 4)) * 128 + ch]; h1 = car[(1 * 8 + (chunk >> 4)) * 128 + ch]; }
            else {
                const f32x2* ag0 = sa.agg + gch; const f32x2* ag1 = sa.agg + (size_t)SC_NCH * DM + gch;
                for (int cc = 0; cc < chunk; ++cc) { const f32x2 e = ag0[(size_t)cc * DM]; h0 = e[0] * h0 + e[1]; }
                for (int cc = SC_NCH - 1; cc > chunk; --cc) { const f32x2 e = ag1[(size_t)cc * DM]; h1 = e[0] * h1 + e[1]; }
            }
            const LAS f32x2* sg0 = seg + (0 * 128 + ch) * 17; const LAS f32x2* sg1 = seg + (1 * 128 + ch) * 17;
#pragma unroll
            for (int s2 = 0; s2 < 16; ++s2) { const f32x2 e = sg0[s2]; if ((s2 & 3) == fq) hb0[s2 >> 2] = h0; h0 = e[0] * h0 + e[1]; }
#pragma unroll
            for (int s2 = 15; s2 >= 0; --s2) { const f32x2 e = sg1[s2]; if ((s2 & 3) == fq) hb1[s2 >> 2] = h1; h1 = e[0] * h1 + e[1]; }
        }
#pragma unroll
        for (int mb = 0; mb < 4; ++mb) {
            float hs[4];
            { float h = hb0[mb]; const f32x4 a = A[0][mb], u = U[0][mb];
#pragma unroll
              for (int j = 0; j < 4; ++j) { h = a[j] * h + u[j]; hs[j] = h; } }
            { float h = hb1[mb]; const f32x4 a = A[1][mb], u = U[1][mb];
#pragma unroll
              for (int j = 3; j >= 0; --j) { h = a[j] * h + u[j]; hs[j] += h; } }
#pragma unroll
            for (int j = 0; j < 4; ++j) {
                LAS bf16* yp = ygs + (16 * mb + 4 * fq + j) * 128 + ch;
                const float yg = __uint_as_float((unsigned)(*yp) << 16);
                *yp = (bf16)(cvt_pk(hs[j] * yg, 0.f) & 0xffffu);
            }
        }
        __syncthreads();
#pragma unroll
        for (int i = 0; i < 2; ++i) { const int idx = tid + i * NTHREADS, row = idx >> 4, c16 = idx & 15;
            *(u32x4*)(sa.Y + (size_t)(t0 + row) * DM + hd * 128 + c16 * 8) = *(const LAS u32x4*)(ygs + row * 128 + c16 * 8); }
    }
#undef S2_PREFETCH
}

struct AttArgs { const bf16* Q; const bf16* K; const bf16* VT; bf16* O; const float* rpb; };

__device__ __forceinline__ void attn_phase(LAS unsigned char* lds, const AttArgs& aa, int G) {
    const int tid = opaque_tid(), lane = tid & 63, w = tid >> 6, fr = lane & 15, fq = lane >> 4;
    const int hsel = w >> 2, qg = w & 3;
    LAS float* rp = (LAS float*)lds;
    const int c0 = 16 * qg, kb0 = (qg == 0) ? 0 : (qg == 1) ? 8 : (qg == 2) ? 24 : 32;
    const int qc = c0 + fr;
    const int cs = min(max(qc - 8, 0), 48);
    for (int id = blockIdx.x; id < 128 * 8; id += G) {
        const int hp = id & 7, r = id >> 3, h = hp * 2 + hsel;
        const int rs = min(max(r - 4, 0), 120);
        __syncthreads();
        for (int i = tid; i < 2 * 465; i += NTHREADS) { const int hh = i / 465, e = i % 465; rp[hh * 480 + e] = aa.rpb[(size_t)(hp * 2 + hh) * 465 + e]; }
        __syncthreads();
        bf16x8 qf[4];
        { const bf16* qp = aa.Q + (size_t)(r * 64 + qc) * DM + h * 128 + 8 * fq;
#pragma unroll
          for (int k = 0; k < 4; ++k) qf[k] = *(const bf16x8*)(qp + 32 * k); }
        f32x4 s[8][2];
        const int krow = 8 * (fr >> 2) + (fr & 3);
#pragma unroll
        for (int i = 0; i < 8; ++i)
#pragma unroll
            for (int nb = 0; nb < 2; ++nb) {
                const bf16* kp = aa.K + (size_t)((rs + i) * 64 + kb0 + krow + 4 * nb) * DM + h * 128 + 8 * fq;
                f32x4 c = (f32x4){0.f, 0.f, 0.f, 0.f};
#pragma unroll
                for (int k = 0; k < 4; ++k) { const bf16x8 kf = *(const bf16x8*)(kp + 32 * k); c = __builtin_amdgcn_mfma_f32_16x16x32_bf16(kf, qf[k], c, 0, 0, 0); }
                s[i][nb] = c;
            }
        float mx = -INFINITY;
        const LAS float* rph = rp + hsel * 480;
#pragma unroll
        for (int i = 0; i < 8; ++i) {
            const int relr = rs + i - r + 7;
#pragma unroll
            for (int nb = 0; nb < 2; ++nb)
#pragma unroll
                for (int j = 0; j < 4; ++j) {
                    const int kc = kb0 + 8 * fq + 4 * nb + j;
                    const bool valid = (unsigned)(kc - cs) < 16u;
                    const int idx = valid ? relr * 31 + (kc - qc + 15) : 0;
                    const float v = valid ? s[i][nb][j] + rph[idx] : -INFINITY;
                    s[i][nb][j] = v; mx = fmaxf(mx, v);
                }
        }
        mx = fmaxf(mx, __shfl_xor(mx, 16)); mx = fmaxf(mx, __shfl_xor(mx, 32));
        float l = 0.f;
#pragma unroll
        for (int i = 0; i < 8; ++i)
#pragma unroll
            for (int nb = 0; nb < 2; ++nb)
#pragma unroll
                for (int j = 0; j < 4; ++j) { const float p = __expf(s[i][nb][j] - mx); s[i][nb][j] = p; l += p; }
        l += __shfl_xor(l, 16); l += __shfl_xor(l, 32);
        f32x4 o[8];
#pragma unroll
        for (int db = 0; db < 8; ++db) o[db] = (f32x4){0.f, 0.f, 0.f, 0.f};
#pragma unroll
        for (int i = 0; i < 8; ++i) {
            u32x4 pw; pw.x = cvt_pk(s[i][0][0], s[i][0][1]); pw.y = cvt_pk(s[i][0][2], s[i][0][3]); pw.z = cvt_pk(s[i][1][0], s[i][1][1]); pw.w = cvt_pk(s[i][1][2], s[i][1][3]);
            const bf16x8 pb = __builtin_bit_cast(bf16x8, pw);
            const bf16* vp = aa.VT + (size_t)(h * 128 + fr) * SEQ + (rs + i) * 64 + kb0 + 8 * fq;
#pragma unroll
            for (int db = 0; db < 8; ++db) { const bf16x8 vf = *(const bf16x8*)(vp + (size_t)(16 * db) * SEQ); o[db] = __builtin_amdgcn_mfma_f32_16x16x32_bf16(vf, pb, o[db], 0, 0, 0); }
        }
        const float inv = 1.f / l;
        bf16* op = aa.O + (size_t)(r * 64 + qc) * DM + h * 128 + 4 * fq;
#pragma unroll
        for (int db = 0; db < 8; ++db) { u32x2 wv; wv.x = cvt_pk(o[db][0] * inv, o[db][1] * inv); wv.y = cvt_pk(o[db][2] * inv, o[db][3] * inv); *(u32x2*)(op + 16 * db) = wv; }
    }
}

#define ATT_BAR() do { asm volatile("s_waitcnt lgkmcnt(0)" ::: "memory"); __builtin_amdgcn_s_barrier(); asm volatile("" ::: "memory"); } while (0)
constexpr int KS_PITCH = 136, VS_PITCH = 72;
constexpr int ATT_KS = 0, ATT_VS = ATT_KS + 2 * 64 * KS_PITCH * 2, ATT_RP = ATT_VS + 2 * 128 * VS_PITCH * 2, ATT_END = ATT_RP + 2048;
static_assert(ATT_END <= 131072, "attention LDS");
__device__ __forceinline__ void attn_phase2(LAS unsigned char* lds, const AttArgs& aa, int G) {
    const int tid = opaque_tid(), lane = tid & 63, w = tid >> 6, fr = lane & 15, fq = lane >> 4;
    const int rsel = w >> 2, qg = w & 3;
    LAS bf16* KS = (LAS bf16*)(lds + ATT_KS);
    LAS bf16* VS = (LAS bf16*)(lds + ATT_VS);
    LAS float* rp = (LAS float*)(lds + ATT_RP);
    const int c0 = 16 * qg, kb0 = (qg == 0) ? 0 : (qg == 1) ? 8 : (qg == 2) ? 24 : 32;
    const int qc = c0 + fr;
    const int cs = min(max(qc - 8, 0), 48);
    const int krow = 8 * (fr >> 2) + (fr & 3);
    const int ktok0 = tid >> 4, kpart = tid & 15, vd0 = tid >> 3, vpart = tid & 7;
    for (int id = blockIdx.x; id < 64 * NHEAD; id += G) {
        const int h = id & 15, rpair = id >> 4, r0 = 2 * rpair;
        const int rsA = min(max(r0 - 4, 0), 120), rsB = min(max(r0 - 3, 0), 120), off = rsB - rsA, nJ = 8 + off;
        const int r = r0 + rsel, rs = rsel ? rsB : rsA, woff = rsel ? off : 0;
        u32x4 R[9][2];
#pragma unroll
        for (int jj = 0; jj < 9; ++jj) { R[jj][0] = (u32x4){0u, 0u, 0u, 0u}; R[jj][1] = (u32x4){0u, 0u, 0u, 0u}; }
        const bf16* kbase = aa.K + (size_t)(rsA * 64 + ktok0) * DM + h * 128 + kpart * 8;
        const bf16* vbase = aa.VT + (size_t)(h * 128 + vd0) * SEQ + rsA * 64 + vpart * 8;
#pragma unroll
        for (int jj = 0; jj < 9; ++jj) if (jj < nJ) {
#pragma unroll
            for (int u = 0; u < 2; ++u) R[jj][u] = *(const u32x4*)(kbase + (size_t)(jj * 64 + 32 * u) * DM);
        }
        for (int i = tid; i < 465; i += NTHREADS) rp[i] = aa.rpb[(size_t)h * 465 + i];
        bf16x8 qf[4];
        { const bf16* qp = aa.Q + (size_t)(r * 64 + qc) * DM + h * 128 + 8 * fq;
#pragma unroll
          for (int k = 0; k < 4; ++k) qf[k] = *(const bf16x8*)(qp + 32 * k); }
#define ATT_KWRITE(j, b) do { _Pragma("unroll") for (int u = 0; u < 2; ++u) *(LAS u32x4*)(KS + (b) * 64 * KS_PITCH + (ktok0 + 32 * u) * KS_PITCH + kpart * 8) = R[j][u]; } while (0)
#define ATT_VLOAD(j) do { _Pragma("unroll") for (int u = 0; u < 2; ++u) R[j][u] = *(const u32x4*)(vbase + (size_t)(64 * u) * SEQ + (j) * 64); } while (0)
#define ATT_VWRITE(j, b) do { _Pragma("unroll") for (int u = 0; u < 2; ++u) *(LAS u32x4*)(VS + (b) * 128 * VS_PITCH + (vd0 + 64 * u) * VS_PITCH + vpart * 8) = R[j][u]; } while (0)
#define ATT_QK(i, b) do { _Pragma("unroll") for (int nb = 0; nb < 2; ++nb) { f32x4 c_ = (f32x4){0.f, 0.f, 0.f, 0.f}; \
            _Pragma("unroll") for (int k = 0; k < 4; ++k) { const bf16x8 kf = *(const LAS bf16x8*)(KS + (b) * 64 * KS_PITCH + (kb0 + krow + 4 * nb) * KS_PITCH + 32 * k + 8 * fq); \
                c_ = __builtin_amdgcn_mfma_f32_16x16x32_bf16(kf, qf[k], c_, 0, 0, 0); } s[i][nb] = c_; } } while (0)
#define ATT_PV(i, b) do { u32x4 pw; pw.x = cvt_pk(s[i][0][0], s[i][0][1]); pw.y = cvt_pk(s[i][0][2], s[i][0][3]); pw.z = cvt_pk(s[i][1][0], s[i][1][1]); pw.w = cvt_pk(s[i][1][2], s[i][1][3]); \
            const bf16x8 pb = __builtin_bit_cast(bf16x8, pw); \
            _Pragma("unroll") for (int db = 0; db < 8; ++db) { const bf16x8 vf = *(const LAS bf16x8*)(VS + (b) * 128 * VS_PITCH + (16 * db + fr) * VS_PITCH + kb0 + 8 * fq); \
                o[db] = __builtin_amdgcn_mfma_f32_16x16x32_bf16(vf, pb, o[db], 0, 0, 0); } } while (0)
        f32x4 s[8][2];
        ATT_KWRITE(0, 0); ATT_VLOAD(0);
        ATT_BAR();
#pragma unroll
        for (int jj = 0; jj < 9; ++jj) {
            if (jj + 1 < 9) { if (jj + 1 < nJ) { ATT_KWRITE((jj + 1 < 9 ? jj + 1 : 8), ((jj + 1) & 1)); ATT_VLOAD((jj + 1 < 9 ? jj + 1 : 8)); } }
            if (woff == 0) { if (jj < 8) ATT_QK((jj < 8 ? jj : 7), (jj & 1)); }
            else           { if (jj >= 1) ATT_QK((jj >= 1 ? jj - 1 : 0), (jj & 1)); }
            ATT_BAR();
        }
        float mx = -INFINITY;
#pragma unroll
        for (int i = 0; i < 8; ++i) {
            const int relr = rs + i - r + 7;
#pragma unroll
            for (int nb = 0; nb < 2; ++nb)
#pragma unroll
                for (int j = 0; j < 4; ++j) {
                    const int kc = kb0 + 8 * fq + 4 * nb + j;
                    const bool valid = (unsigned)(kc - cs) < 16u;
                    const int idx = valid ? relr * 31 + (kc - qc + 15) : 0;
                    const float v = valid ? s[i][nb][j] + rp[idx] : -INFINITY;
                    s[i][nb][j] = v; mx = fmaxf(mx, v);
                }
        }
        mx = fmaxf(mx, __shfl_xor(mx, 16)); mx = fmaxf(mx, __shfl_xor(mx, 32));
        float l = 0.f;
#pragma unroll
        for (int i = 0; i < 8; ++i)
#pragma unroll
            for (int nb = 0; nb < 2; ++nb)
#pragma unroll
                for (int j = 0; j < 4; ++j) { const float p = __expf(s[i][nb][j] - mx); s[i][nb][j] = p; l += p; }
        l += __shfl_xor(l, 16); l += __shfl_xor(l, 32);
        f32x4 o[8];
#pragma unroll
        for (int db = 0; db < 8; ++db) o[db] = (f32x4){0.f, 0.f, 0.f, 0.f};
        ATT_VWRITE(0, 0);
        ATT_BAR();
#pragma unroll
        for (int jj = 0; jj < 9; ++jj) {
            if (jj + 1 < 9) { if (jj + 1 < nJ) ATT_VWRITE((jj + 1 < 9 ? jj + 1 : 8), ((jj + 1) & 1)); }
            if (woff == 0) { if (jj < 8) ATT_PV((jj < 8 ? jj : 7), (jj & 1)); }
            else           { if (jj >= 1) ATT_PV((jj >= 1 ? jj - 1 : 0), (jj & 1)); }
            ATT_BAR();
        }
        const float inv = 1.f / l;
        bf16* op = aa.O + (size_t)(r * 64 + qc) * DM + h * 128 + 4 * fq;
#pragma unroll
        for (int db = 0; db < 8; ++db) { u32x2 wv; wv.x = cvt_pk(o[db][0] * inv, o[db][1] * inv); wv.y = cvt_pk(o[db][2] * inv, o[db][3] * inv); *(u32x2*)(op + 16 * db) = wv; }
#undef ATT_KWRITE
#undef ATT_VLOAD
#undef ATT_VWRITE
#undef ATT_QK
#undef ATT_PV
    }
}

__device__ __forceinline__ void final_phase(float* out, const bf16* X, const float* ss, const float* g, int G) {
    const int tid = opaque_tid(), lane = tid & 63, wave = tid >> 6;
    const int gw = blockIdx.x * NWAVES + wave, NGW = G * NWAVES;
    for (int row = gw; row < SEQ; row += NGW) {
        const float rs = pg8::rstd_row(ss, row);
        f32x4* o = (f32x4*)(out + (size_t)row * DM) + lane; const f32x4* gp = (const f32x4*)g + lane; const u32x2* xp = (const u32x2*)(X + (size_t)row * DM) + lane;
#pragma unroll
        for (int j = 0; j < 8; ++j) { const u32x2 xw = xp[64 * j]; const f32x4 gv = gp[64 * j]; f32x4 v = (f32x4){bfl(xw.x), bfh(xw.x), bfl(xw.y), bfh(xw.y)}; v = v * rs * gv; o[64 * j] = v; }
    }
}

#define XB_TMO      128
#define XB_XCNT(j)  (256  + 64 * (j))
#define XB_XSUB(j)  (1280 + 64 * (j))
#define XB_XGEN(j)  (2304 + 64 * (j))
#define XB_TOP      3328
#define XB_TOPGEN   3392
#define XCD_BAR_WORDS 3456
#define XB_SPIN_CAP (1u << 18)

__device__ __forceinline__ unsigned xb_ld(unsigned* p)              { return __hip_atomic_load(p, __ATOMIC_RELAXED, __HIP_MEMORY_SCOPE_AGENT); }
__device__ __forceinline__ unsigned xb_add(unsigned* p, unsigned v) { return __hip_atomic_fetch_add(p, v, __ATOMIC_RELAXED, __HIP_MEMORY_SCOPE_AGENT); }
__device__ __forceinline__ unsigned xb_xcc_id() { return (unsigned)__builtin_amdgcn_s_getreg((3 << 11) | 20) & 0xFu; }
#define XB_SPIN(cond, bar) do { unsigned _sp = 0; while (cond) { __builtin_amdgcn_s_sleep(1); \
    if ((++_sp & 255u) == 0u) { if (xb_ld(&(bar)[XB_TMO])) break; if (_sp > XB_SPIN_CAP) { atomicAdd(&(bar)[XB_TMO], 1u); break; } } } } while (0)

struct XcdBarrier {
    unsigned* bar; unsigned x;
    volatile LAS unsigned* st;
};

__device__ __forceinline__ XcdBarrier xcd_barrier_post(unsigned* bar, volatile LAS unsigned* st) {
    XcdBarrier b; b.bar = bar; b.x = xb_xcc_id(); b.st = st;
    if (threadIdx.x == 0) (void)xb_add(&bar[XB_XCNT(b.x)], 1u);
    return b;
}
__device__ __forceinline__ void xcd_barrier_complete(unsigned* bar, unsigned x, unsigned& nloc, unsigned& nx) {
    const unsigned G = gridDim.x * gridDim.y * gridDim.z;
    unsigned sum, cnt, mine, sp = 0u;
    for (;;) {
        sum = 0u; cnt = 0u; mine = 0u;
#pragma unroll
        for (unsigned j = 0; j < 16; ++j) { const unsigned c = xb_ld(&bar[XB_XCNT(j)]); sum += c; cnt += (c > 0u) ? 1u : 0u; mine = (j == x) ? c : mine; }
        if (sum == G) break;
        __builtin_amdgcn_s_sleep(1);
        if ((++sp & 255u) == 0u) { if (xb_ld(&bar[XB_TMO])) break; if (sp > XB_SPIN_CAP) { atomicAdd(&bar[XB_TMO], 1u); break; } }
    }
    nloc = mine > 0u ? mine : 1u; nx = cnt > 0u ? cnt : 1u;
}

__device__ __forceinline__ void xcd_barrier(const XcdBarrier& b) {
    asm volatile("s_waitcnt vmcnt(0)" ::: "memory");
    __syncthreads();
    if (threadIdx.x == 0) {
        unsigned* bar = b.bar;
        __builtin_amdgcn_s_waitcnt(0);
        unsigned nloc = b.st[0], nx = b.st[1];
        if (nloc == 0u) { xcd_barrier_complete(bar, b.x, nloc, nx); b.st[0] = nloc; b.st[1] = nx; }
        const unsigned old = xb_add(&bar[XB_XSUB(b.x)], 1u);
        const unsigned gen = old / nloc;
        if (old + 1u == (gen + 1u) * nloc) {
            __builtin_amdgcn_fence(__ATOMIC_RELEASE, "agent");
            asm volatile("s_waitcnt vmcnt(0)" ::: "memory");
            const unsigned og = xb_add(&bar[XB_TOP], 1u);
            const unsigned tg = og / nx;
            if (og + 1u == (tg + 1u) * nx) xb_add(&bar[XB_TOPGEN], 1u);
            else XB_SPIN(xb_ld(&bar[XB_TOPGEN]) == tg, bar);
            __builtin_amdgcn_fence(__ATOMIC_ACQUIRE, "agent");
            xb_add(&bar[XB_XGEN(b.x)], 1u);
            asm volatile("s_waitcnt vmcnt(0)" ::: "memory");
        } else {
            XB_SPIN(xb_ld(&bar[XB_XGEN(b.x)]) == gen, bar);
            __builtin_amdgcn_fence(__ATOMIC_ACQUIRE, "agent");
            asm volatile("s_waitcnt vmcnt(0)" ::: "memory");
        }
    }
    __syncthreads();
}

constexpr int LDS_TAB = 131072 + 1024;
__device__ __forceinline__ void fill_rstd_tab(LAS unsigned char* lds, const float* ssp, int t) {
    LAS float* tab = (LAS float*)(lds + LDS_TAB);
    const int tid = opaque_tid();
    if (tid < 256) tab[tid] = pg8::rstd_row(ssp, t * 256 + tid);
    __syncthreads();
}
constexpr int N_PHASES = 28;
#ifndef PGA
#define PGA true
#endif
#ifndef PGA1
#define PGA1 true
#endif
#ifndef PGS
#define PGS true
#endif
#ifndef DBG_DUMP_OFF
#define DBG_DUMP_OFF WS_BC
#endif
#ifndef DBG_NPH
#define DBG_NPH N_PHASES
#endif
#ifndef DBG_DUMP
#define DBG_DUMP 0
#endif
enum Kind { K_P0, K_WIN, K_S1, K_S2, K_WOUT, K_QKV, K_ATT, K_W1, K_W2, K_PLE, K_FINAL, K_DUMP };

__global__ void __launch_bounds__(NTHREADS, 2) mega_fwd(Args args) {
    extern __shared__ __attribute__((aligned(16))) unsigned char lds_raw[];
    LAS unsigned char* lds = (LAS unsigned char*)lds_raw;
    cg::grid_group grid = cg::this_grid();
    const int G = gridDim.x;
    KA ka0 = (KA)__builtin_amdgcn_kernarg_segment_ptr();
    const int lo = *(const int __attribute__((address_space(4)))*)(ka0 + 192), hi = *(const int __attribute__((address_space(4)))*)(ka0 + 196);
    if (hi - lo > 1) {
        volatile LAS unsigned* st = (volatile LAS unsigned*)(lds + 131072 + 64);
        if (threadIdx.x < 2) st[threadIdx.x] = 0u;
        __syncthreads();
        unsigned char* ws0 = *(unsigned char* const __attribute__((address_space(4)))*)(ka0 + 184);
        (void)xcd_barrier_post((unsigned*)(ws0 + WS_BAR), st);
    }
    if (hi > 100000) grid.sync();
    for (int ph = lo; ph < hi; ++ph) {
        KA ka = ka0; asm volatile("" : "+s"(ka));
        unsigned char* ws = *(unsigned char* const __attribute__((address_space(4)))*)(ka + 184);
        float* hout = *(float* const __attribute__((address_space(4)))*)(ka + 176);
        float* ss = (float*)(ws + WS_SS);
        int kind, L = 0;
        if (ph == 0) kind = K_P0; else if (ph == 99) kind = K_DUMP; else if (ph == N_PHASES - 1) kind = K_FINAL;
        else { int q = ph - 1; const int pair = q / 13; q -= pair * 13; L = 2 * pair;
            if (q < 7) { kind = (q == 0) ? K_WIN : (q == 1) ? K_S1 : (q == 2) ? K_S2 : (q == 3) ? K_WOUT : (q == 4) ? K_W1 : (q == 5) ? K_W2 : K_PLE; }
            else { q -= 7; L += 1; kind = (q == 0) ? K_QKV : (q == 1) ? K_ATT : (q == 2) ? K_WOUT : (q == 3) ? K_W1 : (q == 4) ? K_W2 : K_PLE; } }
        const int j = L >> 1;
        bf16* Xc = (bf16*)(ws + ((L & 1) ? WS_X1 : WS_X0));
        bf16* Xo = (bf16*)(ws + ((L & 1) ? WS_X0 : WS_X1));
        const float* ss_mix = ss + (size_t)(3 * L) * SEQ * 32; float* ss_mlp = ss + (size_t)(3 * L + 1) * SEQ * 32; float* ss_ple = ss + (size_t)(3 * L + 2) * SEQ * 32; float* ss_next = ss + (size_t)(3 * L + 3) * SEQ * 32;
        switch (kind) {
        case K_P0:
#ifndef DIS_P0
 p0_phase(lds, ka, ws, G);
#endif
 break;
        case K_WIN: {
#ifdef DBG_BJ0
            pg8::Gemm g{Xc, (const bf16*)(ws + WS_WINT), SEQ, 2 * DM, DM};
#elif defined(DBG_AX1)
            pg8::Gemm g{(L == 2) ? Xo : Xc, (const bf16*)(ws + WS_WINT) + (size_t)j * DM * 2 * DM, SEQ, 2 * DM, DM};
#else
            pg8::Gemm g{Xc, (const bf16*)(ws + WS_WINT) + (size_t)j * DM * 2 * DM, SEQ, 2 * DM, DM};
#endif
            pg8::StaticOrder S; S.init(SEQ, 2 * DM, G, (int)blockIdx.x);
#ifdef DBG_FRESHOUT

#elif defined(DBG_SS0)

#else
            pg8::Unit u0; S.next(0, u0); fill_rstd_tab(lds, ss_mix, u0.pm);
            pg8::EpiAct<0> E{(bf16*)(ws + WS_BA), (bf16*)(ws + WS_BB), DM, DM, ss_mix, (const LAS float*)(lds + LDS_TAB), u0.pm};
#endif
#ifndef DIS_ACT0
            pg8::gemm_phase<pg8::EpiAct<0>, pg8::StaticOrder, PGA, PGS>(lds, g, S, E);
#endif
        } break;
        case K_S1: case K_S2: {
            ScanArgs sa{(const bf16*)(ws + WS_BA), (const bf16*)(ws + WS_BB), (bf16*)(ws + WS_BC),
                        INP(7) + (size_t)j * 4 * DM, INP(8) + (size_t)j * DM,
                        (const bf16*)(ws + WS_GAT) + (size_t)j * 32 * 128 * 128, (const bf16*)(ws + WS_GXT) + (size_t)j * 32 * 128 * 128,
                        INP(10) + (size_t)j * 2 * DM, INP(12) + (size_t)j * 2 * DM, INP(13) + (size_t)j * 2 * DM,
                        (f32x2*)(ws + WS_AGG), (unsigned*)(ws + WS_A1)};
            #ifndef DIS_SCAN
#ifdef SCAN_RECOMPUTE
            if (kind == K_S1) scan_phase<false>(lds, sa, G); else scan_phase<true>(lds, sa, G);
#else
            if (kind == K_S1) scan_phase<false>(lds, sa, G); else scan_replay(lds, sa, G);
#endif
#endif
        } break;
        case K_QKV: {
            {
                pg8::Gemm g{Xc, (const bf16*)(ws + WS_WQKVT) + (size_t)j * 3 * DM * DM, SEQ, 2 * DM, DM};
                pg8::StaticOrder S; S.init(SEQ, 2 * DM, G, (int)blockIdx.x);
                pg8::Unit u0; S.next(0, u0); fill_rstd_tab(lds, ss_mix, u0.pm);
                pg8::EpiAct<1> E{(bf16*)(ws + WS_BA), (bf16*)(ws + WS_BB), DM, DM, ss_mix, (const LAS float*)(lds + LDS_TAB), u0.pm};
#ifndef DIS_ACT1
                pg8::gemm_phase<pg8::EpiAct<1>, pg8::StaticOrder, PGA, PGS>(lds, g, S, E);
#endif
            }
            __syncthreads();
            {
                pg8::Gemm g{(const bf16*)(ws + WS_WQKVT) + (size_t)j * 3 * DM * DM + (size_t)2 * DM * DM, Xc, DM, SEQ, DM};
                pg8::StaticOrder S; S.init(DM, SEQ, G, (int)blockIdx.x);
                pg8::Unit u0; S.next(0, u0); fill_rstd_tab(lds, ss_mix, u0.pn);
                pg8::EpiAct<4> E{(bf16*)(ws + WS_BD), nullptr, SEQ, 0, ss_mix, (const LAS float*)(lds + LDS_TAB), u0.pn};
#ifndef DIS_ACT4
                pg8::gemm_phase<pg8::EpiAct<4>, pg8::StaticOrder, PGA1, PGS>(lds, g, S, E);
#endif
            }
        } break;
        case K_ATT: {
            AttArgs aa{(const bf16*)(ws + WS_BA), (const bf16*)(ws + WS_BB), (const bf16*)(ws + WS_BD), (bf16*)(ws + WS_BC), INP(16) + (size_t)j * NHEAD * 465};
#ifndef DIS_ATT
#ifdef ATT_V1
            attn_phase(lds, aa, G);
#else
            attn_phase2(lds, aa, G);
#endif
#endif
        } break;
        case K_WOUT: case K_W2: {
            const bf16* A; const bf16* Bt; int K;
            float* sso; bf16* hb; const bf16* base;
            if (kind == K_WOUT) { A = (const bf16*)(ws + WS_BC); K = DM; Bt = (L & 1) ? (const bf16*)(ws + WS_WONT) + (size_t)j * DM * DM : (const bf16*)(ws + WS_WORT) + (size_t)j * DM * DM; sso = ss_mlp; hb = Xo; base = Xc; }
            else { A = (const bf16*)(ws + WS_A1); K = DFF; Bt = (const bf16*)(ws + WS_W2T) + (size_t)L * DM * DFF; sso = ss_ple; hb = Xc; base = Xo; }
            pg8::Gemm g{A, Bt, SEQ, DM, K};
            pg8::StaticOrder S; S.init(SEQ, DM, G, (int)blockIdx.x);
            pg8::EpiRes<0> E{base, hb, sso, nullptr, nullptr, (const LAS float*)(lds + LDS_TAB), -1};
#ifndef DIS_RES0
            pg8::gemm_phase<pg8::EpiRes<0>, pg8::StaticOrder, PGA1, PGS>(lds, g, S, E);
#endif
        } break;
        case K_W1: {
            {
                int Kp = PLE; asm volatile("" : "+s"(Kp));
                pg8::Gemm g{(const bf16*)(ws + WS_PB) + (size_t)L * SEQ * PLE, (const bf16*)(ws + WS_WPT) + (size_t)L * DM * PLE, SEQ, DM, Kp};
                pg8::StaticOrder S; S.init(SEQ, DM, G, (int)blockIdx.x);
                pg8::EpiAct<3> E{(bf16*)(ws + WS_PROJ) + (size_t)L * SEQ * DM, nullptr, DM, 0, nullptr, (const LAS float*)(lds + LDS_TAB), -1};
#ifndef DIS_ACT3
                pg8::gemm_phase<pg8::EpiAct<3>, pg8::StaticOrder, PGA1, PGS>(lds, g, S, E);
#endif
            }
            __syncthreads();
            pg8::Gemm g{Xo, (const bf16*)(ws + WS_W1T) + (size_t)L * DM * DFF, SEQ, DFF, DM};
            pg8::StaticOrder S; S.init(SEQ, DFF, G, (int)blockIdx.x);
            pg8::Unit u0; S.next(0, u0); fill_rstd_tab(lds, ss_mlp, u0.pm);
            pg8::EpiAct<2> E{(bf16*)(ws + WS_A1), nullptr, DFF, 0, ss_mlp, (const LAS float*)(lds + LDS_TAB), u0.pm};
#ifndef DIS_ACT2
            pg8::gemm_phase<pg8::EpiAct<2>, pg8::StaticOrder, PGA, PGS>(lds, g, S, E);
#endif
        } break;
        case K_PLE: {
            pg8::Gemm g{Xc, (const bf16*)(ws + WS_WGT) + (size_t)L * DM * DM, SEQ, DM, DM};
            pg8::StaticOrder S; S.init(SEQ, DM, G, (int)blockIdx.x);
            pg8::Unit u0; S.next(0, u0); fill_rstd_tab(lds, ss_ple, u0.pm);
            pg8::EpiRes<1> E{Xc, Xo, ss_next, ss_ple, (const bf16*)(ws + WS_PROJ) + (size_t)L * SEQ * DM, (const LAS float*)(lds + LDS_TAB), u0.pm};
#ifndef DIS_RES1
            pg8::gemm_phase<pg8::EpiRes<1>, pg8::StaticOrder, PGA1, PGS>(lds, g, S, E);
#endif
        } break;
#if DBG_DUMP
        case K_DUMP: {
            const bf16* src = (const bf16*)(ws + DBG_DUMP_OFF); const float* srcf = (const float*)(ws + DBG_DUMP_OFF);
            for (size_t i = (size_t)blockIdx.x * NTHREADS + threadIdx.x; i < (size_t)SEQ * DM; i += (size_t)G * NTHREADS) hout[i] = (DBG_DUMP == 2) ? srcf[i & 8191] : bfl((unsigned)src[i]);
        } break;
#endif
        case K_FINAL: final_phase(hout, (const bf16*)(ws + WS_X0), ss + (size_t)12 * SEQ * 32, INP(5), G); break;
        }
        if (ph + 1 < hi) { XcdBarrier b; b.bar = (unsigned*)(ws + WS_BAR); b.x = xb_xcc_id(); b.st = (volatile LAS unsigned*)(lds + 131072 + 64); xcd_barrier(b);
#ifdef DBG_DBLBAR
            xcd_barrier(b);
#endif
        }
    }
}

#ifndef MK_MULTI
#define MK_MULTI 0
#endif

extern "C" void kernel_launch(void* const* d_in, const int* in_sizes, int n_in, void* d_out, int out_size, void* d_ws, size_t ws_size, hipStream_t stream) {
    static int grid = 0;
    if (grid == 0) {
        if (n_in != 22 || out_size != SEQ * DM || ws_size < WS_END) { fprintf(stderr, "kernel_launch: unexpected shapes (n_in %d out %d ws %zu)\n", n_in, out_size, ws_size); grid = -1; return; }
        int dev = 0, cus = 0, per_cu = 0;
        (void)hipGetDevice(&dev); (void)hipDeviceGetAttribute(&cus, hipDeviceAttributeMultiprocessorCount, dev);
        if (hipFuncSetAttribute((const void*)mega_fwd, hipFuncAttributeMaxDynamicSharedMemorySize, LDS_BYTES) != hipSuccess) { fprintf(stderr, "kernel_launch: hipFuncSetAttribute failed\n"); grid = -1; return; }
        if (hipOccupancyMaxActiveBlocksPerMultiprocessor(&per_cu, (const void*)mega_fwd, NTHREADS, LDS_BYTES) != hipSuccess || per_cu < 1) { fprintf(stderr, "kernel_launch: occupancy query says %d\n", per_cu); per_cu = 1; }
        (void)hipGetLastError();
        grid = cus * per_cu; if (grid > 256) grid = 256;
        fprintf(stderr, "kernel_launch: grid %d (cus %d per_cu %d)\n", grid, cus, per_cu);
    }
    if (grid < 0) return;
    Args a{};
    for (int i = 0; i < 22; ++i) a.in[i] = (const float*)d_in[i];
    a.out = (float*)d_out; a.ws = (unsigned char*)d_ws;
#if MK_MULTI
#ifdef DBG_SEQ
    { const int seq[] = {DBG_SEQ}; for (int ph : seq) { a.ph_lo = ph; a.ph_hi = ph + 1; hipLaunchKernelGGL(mega_fwd, dim3(grid), dim3(NTHREADS), LDS_BYTES, stream, a); } }
#else
    for (int ph = 0; ph < DBG_NPH; ++ph) { a.ph_lo = ph; a.ph_hi = ph + 1; hipLaunchKernelGGL(mega_fwd, dim3(grid), dim3(NTHREADS), LDS_BYTES, stream, a); }
#endif
    if (DBG_DUMP) { a.ph_lo = 99; a.ph_hi = 100; hipLaunchKernelGGL(mega_fwd, dim3(grid), dim3(NTHREADS), LDS_BYTES, stream, a); }
#else
    a.ph_lo = 0; a.ph_hi = N_PHASES;
    if (hipMemsetAsync((char*)d_ws + WS_BAR, 0, 16384, stream) != hipSuccess) { fprintf(stderr, "kernel_launch: memset of the barrier words failed\n"); return; }
    void* kargs[] = {&a};
    hipError_t e = hipLaunchCooperativeKernel((const void*)mega_fwd, dim3(grid), dim3(NTHREADS), kargs, LDS_BYTES, stream);
    if (e != hipSuccess) fprintf(stderr, "kernel_launch: cooperative launch failed: %s (grid %d)\n", hipGetErrorString(e), grid);
#endif
}
```
